# Optimizing an MI355X kernel written in HIP

```python
import jax, jax.numpy as jnp
from jax import lax
import numpy as np

D_MODEL = 1024
BATCH = 8
SEQ = 2048
DEPTH = 1

M_INNER = D_MODEL
M_HEADDIM = 64
M_HEADS = M_INNER // M_HEADDIM
M_GROUPS = 2
M_STATE = 64
M_CONV = 4
M_CHUNK = 128
M_CONV_DIM = M_INNER + 2 * M_GROUPS * M_STATE
R_HEADS = 8
R_QK_DIM = D_MODEL // 2
R_HEAD_QK = R_QK_DIM // R_HEADS
R_V_DIM = D_MODEL
R_HEAD_V = R_V_DIM // R_HEADS
R_CHUNK = 128
ROPE_BASE = 10000.0
EPS = 1e-6
SPLITS = (M_INNER, M_CONV_DIM, M_HEADS, R_QK_DIM, R_QK_DIM, R_V_DIM, R_V_DIM, D_MODEL, D_MODEL)
D_IN_PROJ = sum(SPLITS)

kernel_name = 'hybrid_ssd_retention_gated_block'


def rms_norm(x, w=None):
    xf = x.astype(jnp.float32)
    y = xf * lax.rsqrt(jnp.mean(xf * xf, axis=-1, keepdims=True) + EPS)
    if w is not None:
        y = y * w.astype(jnp.float32)
    return y


def causal_dwconv(u, w, b):
    K = w.shape[0]
    out = lax.conv_general_dilated(
        u, w.astype(u.dtype)[:, None, :], window_strides=(1,), padding=[(K - 1, 0)],
        dimension_numbers=('NWC', 'WIO', 'NWC'), feature_group_count=u.shape[-1])
    return out + b.astype(u.dtype)


def ssd_chunked(x, dt, A, Bm, Cm):
    Bsz, L, H, P = x.shape
    G, N = Bm.shape[-2], Bm.shape[-1]
    Hg = H // G
    Q = M_CHUNK
    nc = L // Q
    x = x.reshape(Bsz, nc, Q, G, Hg, P)
    dt = dt.reshape(Bsz, nc, Q, G, Hg)
    Bm = Bm.reshape(Bsz, nc, Q, G, N)
    Cm = Cm.reshape(Bsz, nc, Q, G, N)
    a = dt * A.reshape(G, Hg)
    a_cs = jnp.cumsum(a, axis=2)
    seg = a_cs[:, :, :, None] - a_cs[:, :, None, :]
    causal = jnp.tril(jnp.ones((Q, Q), dtype=bool))[:, :, None, None]
    Lmat = jnp.exp(jnp.where(causal, seg, -jnp.inf))
    cb = jnp.einsum('bcign,bcjgn->bcijg', Cm, Bm)
    w_ij = cb[..., None] * Lmat * dt[:, :, None]
    y_diag = jnp.einsum('bcijgh,bcjghp->bcighp', w_ij, x)
    decay_to_end = jnp.exp(a_cs[:, :, -1:] - a_cs)
    x_w = x * (decay_to_end * dt)[..., None]
    states = jnp.einsum('bcjgn,bcjghp->bcghpn', Bm, x_w)
    chunk_decay = jnp.exp(a_cs[:, :, -1])

    def step(S, inp):
        st, dec = inp
        return S * dec[..., None, None] + st, S

    S0 = jnp.zeros_like(states[:, 0])
    _, S_prev = lax.scan(step, S0, (jnp.moveaxis(states, 1, 0), jnp.moveaxis(chunk_decay, 1, 0)))
    S_prev = jnp.moveaxis(S_prev, 0, 1)
    y_off = jnp.einsum('bcign,bcghpn->bcighp', Cm, S_prev) * jnp.exp(a_cs)[..., None]
    return (y_diag + y_off).reshape(Bsz, L, H, P)


def rotary(t, pos):
    half = t.shape[-1] // 2
    inv = ROPE_BASE ** (-jnp.arange(half, dtype=jnp.float32) / half)
    ang = pos[:, None] * inv[None, :]
    cos = jnp.cos(ang)[:, None, :]
    sin = jnp.sin(ang)[:, None, :]
    t1, t2 = t[..., :half], t[..., half:]
    return jnp.concatenate([t1 * cos - t2 * sin, t1 * sin + t2 * cos], axis=-1)


def retention_chunked(q, k, v):
    Bsz, L, H, dk = q.shape
    dv = v.shape[-1]
    Q = R_CHUNK
    nc = L // Q
    log_g = jnp.log1p(-jnp.exp2(-5.0 - jnp.arange(H, dtype=jnp.float32)))
    idx = jnp.arange(Q, dtype=jnp.float32)
    rel = idx[:, None] - idx[None, :]
    dmat = jnp.exp(jnp.where(rel[None] >= 0, rel[None] * log_g[:, None, None], -jnp.inf))
    q = q.reshape(Bsz, nc, Q, H, dk)
    k = k.reshape(Bsz, nc, Q, H, dk)
    v = v.reshape(Bsz, nc, Q, H, dv)
    s = jnp.einsum('bcihd,bcjhd->bchij', q, k) * dmat
    inner = jnp.einsum('bchij,bcjhe->bcihe', s, v)
    k_w = k * jnp.exp((Q - 1 - idx)[:, None] * log_g[None, :])[:, :, None]
    kv = jnp.einsum('bcjhd,bcjhe->bchde', k_w, v)
    chunk_decay = jnp.exp(Q * log_g)

    def step(R, kv_c):
        return R * chunk_decay[:, None, None] + kv_c, R

    R0 = jnp.zeros_like(kv[:, 0])
    _, R_prev = lax.scan(step, R0, jnp.moveaxis(kv, 1, 0))
    R_prev = jnp.moveaxis(R_prev, 0, 1)
    q_w = q * jnp.exp((idx + 1)[:, None] * log_g[None, :])[:, :, None]
    cross = jnp.einsum('bcihd,bchde->bcihe', q_w, R_prev)
    return (inner + cross).reshape(Bsz, L, H, dv)


def hybrid_layer(x, c, w_ada, b_ada, norm_w, w_in, conv_w, conv_b, dt_bias, a_log, d_skip,
                 m_norm_w, w_proj_m, w_proj_r, w_out):
    f32 = jnp.float32
    Bsz, L, _ = x.shape
    mod = c.astype(f32) @ w_ada.astype(f32) + b_ada.astype(f32)
    shift, scale, gate = jnp.split(mod, 3, axis=-1)
    h = rms_norm(x, norm_w) * (1.0 + scale[:, None]) + shift[:, None]
    proj = h @ w_in.astype(f32)
    offs = []
    acc = 0
    for s_ in SPLITS[:-1]:
        acc += s_
        offs.append(acc)
    z_m, xbc, dt_raw, q, k, v, g_r, ga_m, ga_r = jnp.split(proj, offs, axis=-1)

    xbc = jax.nn.silu(causal_dwconv(xbc, conv_w, conv_b))
    xm, Bm, Cm = jnp.split(xbc, [M_INNER, M_INNER + M_GROUPS * M_STATE], axis=-1)
    xm = xm.reshape(Bsz, L, M_HEADS, M_HEADDIM)
    dt = jax.nn.softplus(dt_raw + dt_bias.astype(f32))
    A = -jnp.exp(a_log.astype(f32))
    y = ssd_chunked(xm, dt, A,
                    Bm.reshape(Bsz, L, M_GROUPS, M_STATE), Cm.reshape(Bsz, L, M_GROUPS, M_STATE))
    y = (y + d_skip.astype(f32)[:, None] * xm).reshape(Bsz, L, M_INNER)
    yz = (y * jax.nn.silu(z_m)).reshape(Bsz, L, M_GROUPS, M_INNER // M_GROUPS)
    y_m = rms_norm(yz).reshape(Bsz, L, M_INNER) * m_norm_w.astype(f32)
    u_m = y_m @ w_proj_m.astype(f32)

    pos = jnp.arange(L, dtype=f32)
    q = rotary(q.reshape(Bsz, L, R_HEADS, R_HEAD_QK), pos)
    k = rotary(k.reshape(Bsz, L, R_HEADS, R_HEAD_QK), pos) * (R_HEAD_QK ** -0.5)
    v = v.reshape(Bsz, L, R_HEADS, R_HEAD_V)
    o = rms_norm(retention_chunked(q, k, v))
    y_r = jax.nn.silu(g_r) * o.reshape(Bsz, L, R_V_DIM)
    u_r = y_r @ w_proj_r.astype(f32)

    merged = jax.nn.sigmoid(ga_m) * u_m + jax.nn.sigmoid(ga_r) * u_r
    out = merged @ w_out.astype(f32)
    return (x.astype(f32) + gate[:, None] * out).astype(x.dtype)


def setup_inputs(seed: int = 0) -> dict:
    key = jax.random.key(seed)
    ks = jax.random.split(key, 18)
    D = D_MODEL
    nrm = jax.random.normal
    x = nrm(ks[0], (BATCH, SEQ, D), jnp.float32)
    c = nrm(ks[1], (BATCH, D), jnp.float32)
    w_ada = nrm(ks[2], (DEPTH, D, 3 * D), jnp.float32) * (0.5 * D ** -0.5)
    b_ada = nrm(ks[3], (DEPTH, 3 * D), jnp.float32) * 0.01
    norm_w = 1.0 + 0.02 * nrm(ks[4], (DEPTH, D), jnp.float32)
    w_in = nrm(ks[5], (DEPTH, D, D_IN_PROJ), jnp.float32) * D ** -0.5
    conv_w = nrm(ks[6], (DEPTH, M_CONV, M_CONV_DIM), jnp.float32) * M_CONV ** -0.5
    conv_b = nrm(ks[7], (DEPTH, M_CONV_DIM), jnp.float32) * 0.01
    dt0 = jnp.exp(jax.random.uniform(ks[8], (DEPTH, M_HEADS), jnp.float32,
                                     jnp.log(1e-3), jnp.log(1e-1)))
    dt_bias = dt0 + jnp.log(-jnp.expm1(-dt0))
    a_log = jnp.log(jax.random.uniform(ks[9], (DEPTH, M_HEADS), jnp.float32, 1.0, 16.0))
    d_skip = 1.0 + 0.02 * nrm(ks[10], (DEPTH, M_HEADS), jnp.float32)
    m_norm_w = 1.0 + 0.02 * nrm(ks[11], (DEPTH, M_INNER), jnp.float32)
    w_proj_m = nrm(ks[12], (DEPTH, M_INNER, D), jnp.float32) * M_INNER ** -0.5
    w_proj_r = nrm(ks[13], (DEPTH, R_V_DIM, D), jnp.float32) * R_V_DIM ** -0.5
    w_out = nrm(ks[14], (DEPTH, D, D), jnp.float32) * D ** -0.5
    final_norm_w = 1.0 + 0.02 * nrm(ks[15], (D,), jnp.float32)
    return {'x': x, 'c': c, 'w_ada': w_ada, 'b_ada': b_ada, 'norm_w': norm_w, 'w_in': w_in,
            'conv_w': conv_w, 'conv_b': conv_b, 'dt_bias': dt_bias, 'a_log': a_log,
            'd_skip': d_skip, 'm_norm_w': m_norm_w, 'w_proj_m': w_proj_m,
            'w_proj_r': w_proj_r, 'w_out': w_out, 'final_norm_w': final_norm_w}


def reference(x, c, w_ada, b_ada, norm_w, w_in, conv_w, conv_b, dt_bias, a_log, d_skip,
              m_norm_w, w_proj_m, w_proj_r, w_out, final_norm_w):
    for l in range(DEPTH):
        x = hybrid_layer(x, c, w_ada[l], b_ada[l], norm_w[l], w_in[l], conv_w[l], conv_b[l],
                         dt_bias[l], a_log[l], d_skip[l], m_norm_w[l], w_proj_m[l],
                         w_proj_r[l], w_out[l])
    return rms_norm(x, final_norm_w).astype(x.dtype)
```

```cpp
#include <hip/hip_runtime.h>
#include <hip/hip_cooperative_groups.h>
#include <cstdio>
#include <cstdint>
namespace cg = cooperative_groups;
#define N_LAUNCHES 1
namespace pg8 {
#define PG8_LAS __attribute__((address_space(3)))
typedef unsigned short bf16_t;
typedef short bf16x8 __attribute__((ext_vector_type(8)));
typedef float f32x4 __attribute__((ext_vector_type(4)));
typedef unsigned u32x4 __attribute__((ext_vector_type(4)));
constexpr int BM = 256, BK = 64, HALF = 128, HTB = HALF * BK * 2  , STAGE_BYTES = 8 * HTB, NXCD = 8, WGM = 8;

__host__ __device__ __forceinline__ int lds_byte(int r, int c) { const int st = (r >> 4) * 2 + (c >> 5), rr = r & 15, cc = c & 31, ob = rr * 64 + cc * 2; return st * 1024 + (ob ^ (((ob >> 9) & 1) << 5)); }
__host__ __device__ __forceinline__ void stage_rc(int b, int& R, int& C) { const int st = b / 1024, sb = b % 1024, swz = sb ^ (((sb >> 9) & 1) << 5); R = (st >> 1) * 16 + swz / 64; C = (st & 1) * 32 + (swz % 64) / 2; }
__host__ __device__ __forceinline__ int perm32(int rho) { const int n = rho >> 4, i = rho & 15; return 8 * (i >> 2) + 4 * n + (i & 3); }

struct Unit { int pm, pn; };
struct Gemm { const bf16_t* A; const bf16_t* Bt; int M, N, K; };

struct StaticOrder {
    int nM, nN, nwg, G, c;
    __host__ __device__ void init(int M, int N, int G_, int c_) { nM = M / BM; nN = N / BM; nwg = nM * nN; G = G_; c = c_; }
    __host__ __device__ bool next(int i, Unit& u) const {
        const long L = (long)i * G + c; if (L >= nwg) return false;
        int wgid = (int)L; { const int q = nwg / NXCD, r = nwg % NXCD, xcd = wgid % NXCD, off = wgid / NXCD; wgid = (xcd < r ? xcd * (q + 1) : r * (q + 1) + (xcd - r) * q) + off; }
        const int nig = WGM * nN, gid = wgid / nig, fm = gid * WGM, gsz = (nM - fm) < WGM ? (nM - fm) : WGM;
        u.pm = fm + ((wgid % nig) % gsz); u.pn = (wgid % nig) / gsz; return true;
    }
    __device__ __forceinline__ void a_ready(const Unit&) const {}
    __device__ __forceinline__ void done(const Unit&) const {}
};
__device__ __forceinline__ unsigned cvt_pk_bf16(float lo, float hi) { unsigned r; asm volatile("v_cvt_pk_bf16_f32 %0, %1, %2" : "=v"(r) : "v"(lo), "v"(hi)); return r; }
struct EpiProj {
    static constexpr bool PERM = true, AFTER_DRAIN = false;
    bf16_t* O; int ldc;
    __device__ __forceinline__ void operator()(const f32x4 (&acc)[2][2][4][2], const Unit& u, int wr, int wc, int fr, int fq) const {
        const int row0 = u.pm * BM + wr * 64 + fr; const int col0 = u.pn * BM + wc * 32 + 8 * fq;
#pragma unroll
        for (int ai = 0; ai < 2; ++ai)
#pragma unroll
            for (int m = 0; m < 4; ++m) { bf16_t* rowp = O + (size_t)(row0 + ai * HALF + m * 16) * ldc + col0;
#pragma unroll
                for (int bj = 0; bj < 2; ++bj) { const f32x4 v0 = acc[ai][bj][m][0], v1 = acc[ai][bj][m][1];
                    u32x4 w; w.x = cvt_pk_bf16(v0[0], v0[1]); w.y = cvt_pk_bf16(v0[2], v0[3]); w.z = cvt_pk_bf16(v1[0], v1[1]); w.w = cvt_pk_bf16(v1[2], v1[3]);
                    *(u32x4*)(rowp + bj * HALF) = w; } }
    }
    __device__ __forceinline__ void fused(f32x4 (&)[2][2][4][2], const Unit&, int, int, int, int, PG8_LAS unsigned char*, int, int) const {}
};
template <class Epi, class Sched, bool ALIGN_EPI = false, bool SP2 = false>
__device__ __forceinline__ void gemm_phase(PG8_LAS unsigned char* lds, const Gemm g, const Sched& S, const Epi& E) {
    const int tid = threadIdx.x, wid = __builtin_amdgcn_readfirstlane(tid >> 6), lane = tid & 63, wr = wid >> 2, wc = wid & 3, fr = lane & 15, fq = lane >> 4;
    const int K = g.K, nt = K / BK;
    unsigned voffA[2], voffB[2];
#pragma unroll
    for (int i = 0; i < 2; ++i) { int R, C; stage_rc(tid * 16 + i * 8192, R, C); const int Rb = Epi::PERM ? ((R & ~31) + perm32(R & 31)) : R;
        voffA[i] = (unsigned)(R * K + C) * 2u; voffB[i] = (unsigned)(Rb * K + C) * 2u; }
    const size_t kstep = (size_t)(BK * 2);
    const size_t hstep = (size_t)HALF * K * 2;
    const size_t tstep = 2 * hstep;
    const unsigned ldsw = (unsigned)wid * 1024u;
    const int aoff = lds_byte(wr * 64 + fr, fq * 8), boff = lds_byte(wc * 32 + fr, fq * 8);
#define PG8_SA(b, h) (((b) * 2 + (h)) * HTB)
#define PG8_SB(b, h) ((4 + (b) * 2 + (h)) * HTB)
#define PG8_STAGE(bufoff, gbase, voff) do { _Pragma("unroll") for (int _i = 0; _i < 2; ++_i) \
        __builtin_amdgcn_global_load_lds((const unsigned*)((const char*)(gbase) + (voff)[_i]), (PG8_LAS unsigned*)(lds + (bufoff) + ldsw + _i * 8192), 16, 0, 0); } while (0)
#define PG8_LDA(dst, b, h) do { _Pragma("unroll") for (int m = 0; m < 4; ++m) _Pragma("unroll") for (int k = 0; k < 2; ++k) dst[m][k] = *(const PG8_LAS bf16x8*)(lds + PG8_SA(b, h) + aoff + m * 2048 + k * 1024); } while (0)
#define PG8_LDB(dst, b, h) do { _Pragma("unroll") for (int n = 0; n < 2; ++n) _Pragma("unroll") for (int k = 0; k < 2; ++k) dst[n][k] = *(const PG8_LAS bf16x8*)(lds + PG8_SB(b, h) + boff + n * 2048 + k * 1024); } while (0)
#define PG8_MMA(ai, bj, At, Bt) do { __builtin_amdgcn_s_setprio(1); _Pragma("unroll") for (int m = 0; m < 4; ++m) _Pragma("unroll") for (int n = 0; n < 2; ++n) _Pragma("unroll") for (int k = 0; k < 2; ++k) \
        acc[ai][bj][m][n] = __builtin_amdgcn_mfma_f32_16x16x32_bf16(Bt[n][k], At[m][k], acc[ai][bj][m][n], 0, 0, 0); __builtin_amdgcn_s_setprio(0); } while (0)
#define PG8_WAIT_V(n) asm volatile("s_waitcnt vmcnt(" #n ")" ::: "memory")
#define PG8_WAIT_L(n) asm volatile("s_waitcnt lgkmcnt(" #n ")" ::: "memory")
#define PG8_BAR __builtin_amdgcn_s_barrier()
#define PG8_SCHED __builtin_amdgcn_sched_barrier(0)
    Unit cur, nxt; int ui = 0;
    if (!S.next(0, cur)) return;
    f32x4 acc[2][2][4][2];
#pragma unroll
    for (int a = 0; a < 2; ++a)
#pragma unroll
        for (int b = 0; b < 2; ++b)
#pragma unroll
            for (int m = 0; m < 4; ++m)
#pragma unroll
                for (int n = 0; n < 2; ++n) acc[a][b][m][n] = (f32x4){0.f, 0.f, 0.f, 0.f};
    bf16x8 At[4][2], B0[2][2], B1[2][2];
    const char* cA = (const char*)g.A + (size_t)cur.pm * tstep; const char* cB = (const char*)g.Bt + (size_t)cur.pn * tstep;
    S.a_ready(cur);
    if constexpr (SP2) {
        PG8_STAGE(PG8_SB(0, 0), cB, voffB); PG8_STAGE(PG8_SB(0, 1), cB + hstep, voffB); PG8_STAGE(PG8_SA(0, 0), cA, voffA); PG8_STAGE(PG8_SA(0, 1), cA + hstep, voffA);
        if (wr == 1) PG8_BAR;
        PG8_WAIT_V(2); PG8_BAR;
        PG8_STAGE(PG8_SB(1, 0), cB + kstep, voffB); PG8_STAGE(PG8_SA(1, 0), cA + kstep, voffA); PG8_STAGE(PG8_SB(1, 1), cB + hstep + kstep, voffB);
        PG8_WAIT_V(6); PG8_BAR;
    } else {
        PG8_STAGE(PG8_SB(0, 0), cB, voffB); PG8_STAGE(PG8_SA(0, 0), cA, voffA); PG8_STAGE(PG8_SB(0, 1), cB + hstep, voffB); PG8_STAGE(PG8_SA(0, 1), cA + hstep, voffA);
        if (wr == 1) PG8_BAR;
        PG8_WAIT_V(4); PG8_BAR;
        PG8_STAGE(PG8_SB(1, 0), cB + kstep, voffB); PG8_STAGE(PG8_SA(1, 0), cA + kstep, voffA); PG8_STAGE(PG8_SB(1, 1), cB + hstep + kstep, voffB);
        PG8_WAIT_V(6); PG8_BAR;
    }
    for (;;) {
        const bool has_next = S.next(ui + 1, nxt);
        const char* nA = has_next ? (const char*)g.A + (size_t)nxt.pm * tstep : cA; const char* nB = has_next ? (const char*)g.Bt + (size_t)nxt.pn * tstep : cB;
        for (int t = 0; t < nt; t += 2) {
            const bool last = (t == nt - 2);
            const char* a1 = cA + (size_t)(t + 1) * kstep;
            const char* a2 = last ? nA : cA + (size_t)(t + 2) * kstep; const char* b2 = last ? nB : cB + (size_t)(t + 2) * kstep;
            const char* a3 = a2 + kstep; const char* b3 = b2 + kstep;
            if (last && has_next) S.a_ready(nxt);
            if constexpr (SP2) {
            PG8_LDB(B0, 0, 0); PG8_LDB(B1, 0, 1); PG8_SCHED; PG8_LDA(At, 0, 0); PG8_STAGE(PG8_SA(1, 1), a1 + hstep, voffA);
            PG8_WAIT_V(8); PG8_WAIT_L(0); PG8_BAR; PG8_MMA(0, 0, At, B0); PG8_MMA(0, 1, At, B1); PG8_BAR; PG8_SCHED;
            PG8_LDA(At, 0, 1); PG8_STAGE(PG8_SB(0, 0), b2, voffB); PG8_STAGE(PG8_SB(0, 1), b2 + hstep, voffB); PG8_STAGE(PG8_SA(0, 0), a2, voffA);
            PG8_WAIT_V(8); PG8_WAIT_L(0); PG8_BAR; PG8_MMA(1, 0, At, B0); PG8_MMA(1, 1, At, B1); PG8_BAR; PG8_SCHED;
            PG8_LDB(B0, 1, 0); PG8_LDB(B1, 1, 1); PG8_SCHED; PG8_LDA(At, 1, 0); PG8_STAGE(PG8_SA(0, 1), a2 + hstep, voffA);
            PG8_WAIT_V(8); PG8_WAIT_L(0); PG8_BAR; PG8_MMA(0, 0, At, B0); PG8_MMA(0, 1, At, B1); PG8_BAR; PG8_SCHED;
            PG8_LDA(At, 1, 1); PG8_STAGE(PG8_SB(1, 0), b3, voffB); PG8_STAGE(PG8_SB(1, 1), b3 + hstep, voffB); PG8_STAGE(PG8_SA(1, 0), a3, voffA);
            PG8_WAIT_V(8); PG8_WAIT_L(0); PG8_BAR; PG8_MMA(1, 0, At, B0); PG8_MMA(1, 1, At, B1); PG8_BAR; PG8_SCHED;
            } else {
            PG8_LDB(B0, 0, 0); PG8_SCHED; PG8_LDA(At, 0, 0); PG8_STAGE(PG8_SA(1, 1), a1 + hstep, voffA);
            PG8_WAIT_L(8); PG8_BAR; PG8_WAIT_L(0); PG8_MMA(0, 0, At, B0); PG8_BAR; PG8_SCHED;
            PG8_LDB(B1, 0, 1); PG8_STAGE(PG8_SB(0, 0), b2, voffB);
            PG8_BAR; PG8_WAIT_L(0); PG8_MMA(0, 1, At, B1); PG8_BAR;
            PG8_LDA(At, 0, 1); PG8_STAGE(PG8_SA(0, 0), a2, voffA);
            PG8_BAR; PG8_WAIT_L(0); PG8_MMA(1, 0, At, B0); PG8_BAR; PG8_SCHED;
            PG8_STAGE(PG8_SB(0, 1), b2 + hstep, voffB);
            PG8_WAIT_V(6); PG8_BAR; PG8_MMA(1, 1, At, B1); PG8_BAR;
            PG8_LDB(B0, 1, 0); PG8_SCHED; PG8_LDA(At, 1, 0); PG8_STAGE(PG8_SA(0, 1), a2 + hstep, voffA);
            PG8_WAIT_L(8); PG8_BAR; PG8_WAIT_L(0); PG8_MMA(0, 0, At, B0); PG8_BAR; PG8_SCHED;
            PG8_LDB(B1, 1, 1); PG8_STAGE(PG8_SB(1, 0), b3, voffB);
            PG8_BAR; PG8_WAIT_L(0); PG8_MMA(0, 1, At, B1); PG8_BAR;
            PG8_LDA(At, 1, 1); PG8_STAGE(PG8_SA(1, 0), a3, voffA);
            PG8_BAR; PG8_WAIT_L(0); PG8_MMA(1, 0, At, B0); PG8_BAR; PG8_SCHED;
            PG8_STAGE(PG8_SB(1, 1), b3 + hstep, voffB);
            PG8_WAIT_V(6); PG8_BAR; PG8_MMA(1, 1, At, B1); PG8_BAR;
            }
        }
        if constexpr (ALIGN_EPI) { if (wr == 0) PG8_BAR; }
        if constexpr (!Epi::AFTER_DRAIN) { E(acc, cur, wr, wc, fr, fq); S.done(cur); }
        if (!has_next) break;
#pragma unroll
        for (int a = 0; a < 2; ++a)
#pragma unroll
            for (int b = 0; b < 2; ++b)
#pragma unroll
                for (int m = 0; m < 4; ++m)
#pragma unroll
                    for (int n = 0; n < 2; ++n) acc[a][b][m][n] = (f32x4){0.f, 0.f, 0.f, 0.f};
        cur = nxt; cA = nA; cB = nB; ++ui;
        if constexpr (ALIGN_EPI) { if (wr == 1) PG8_BAR; }
    }
    PG8_WAIT_V(0);
    if constexpr (!ALIGN_EPI) { if (wr == 0) PG8_BAR; }
    PG8_BAR;
    if constexpr (Epi::AFTER_DRAIN) { E.fused(acc, cur, wr, wc, fr, fq, lds, wid, lane); S.done(cur); }
#undef PG8_SA
#undef PG8_SB
#undef PG8_STAGE
#undef PG8_LDA
#undef PG8_LDB
#undef PG8_MMA
#undef PG8_WAIT_V
#undef PG8_WAIT_L
#undef PG8_BAR
#undef PG8_SCHED
}
}

#define LAS __attribute__((address_space(3)))
typedef unsigned short bf16;
typedef short bf16x8 __attribute__((ext_vector_type(8)));
typedef short s16x4 __attribute__((ext_vector_type(4)));
typedef float f32x4 __attribute__((ext_vector_type(4)));
typedef float f32x16 __attribute__((ext_vector_type(16)));
typedef unsigned u32x4 __attribute__((ext_vector_type(4)));
typedef unsigned u32x2 __attribute__((ext_vector_type(2)));
typedef float f32x2_t __attribute__((ext_vector_type(2)));
typedef __bf16 bf16x2_t __attribute__((ext_vector_type(2)));

#ifndef N_LAUNCHES
#define N_LAUNCHES 1
#endif
constexpr int NPH = 5;
constexpr int D = 1024, NB = 8, SEQ = 2048, MTOK = NB * SEQ, NIN = 7440, NP = 7424;
constexpr int C_Z = 0, C_X = 1024, C_B = 2048, C_C = 2176, C_Q = 2304, C_K = 2816, C_V = 3328, C_GR = 4352, C_GAM = 5376, C_GAR = 6400;
constexpr float EPS = 1e-6f;
constexpr size_t MiB = 1u << 20;
constexpr size_t WS_PROJ = 0;
constexpr size_t WS_WMF = 232 * MiB, WS_WRF = 234 * MiB, WS_WOF = 236 * MiB;
constexpr size_t WS_MOD = 238 * MiB;
constexpr size_t WS_DT = 239 * MiB;
constexpr size_t WS_SSQM = 240 * MiB;
constexpr size_t WS_SSQR = 242 * MiB;
constexpr size_t WS_END = 244 * MiB;
constexpr size_t OUT_H = 0, OUT_WINT = 32 * MiB;
constexpr int LDS_BYTES = 155648;
constexpr int NTHR = 512;

struct Args { const float* in[16]; float* out; unsigned char* ws; int ph_lo, ph_hi; };

__device__ __forceinline__ float bf_lo(unsigned u) { return __uint_as_float(u << 16); }
__device__ __forceinline__ float bf_hi(unsigned u) { return __uint_as_float(u & 0xffff0000u); }
__device__ __forceinline__ unsigned pk2(float lo, float hi) { f32x2_t v = {lo, hi}; bf16x2_t b = __builtin_convertvector(v, bf16x2_t); return __builtin_bit_cast(unsigned, b); }
__device__ __forceinline__ float silu_f(float x) { return x / (1.f + __expf(-x)); }
__device__ __forceinline__ float sigm_f(float x) { return 1.f / (1.f + __expf(-x)); }
__device__ __forceinline__ float wave_sum(float v) {
#pragma unroll
    for (int o = 1; o < 64; o <<= 1) v += __shfl_xor(v, o);
    return v;
}
__device__ __forceinline__ unsigned launder(unsigned v) { asm volatile("" : "+v"(v)); return v; }
__device__ __forceinline__ int crow(int reg, int h) { return (reg & 3) + 8 * (reg >> 2) + 4 * h; }
#define MFMA32(a, b, c) __builtin_amdgcn_mfma_f32_32x32x16_bf16((a), (b), (c), 0, 0, 0)
__device__ __forceinline__ s16x4 tr_read(const LAS unsigned char* p) {
    typedef short v4i16_t __attribute__((ext_vector_type(4)));
    return __builtin_bit_cast(s16x4, __builtin_amdgcn_ds_read_tr16_b64_v4i16((LAS v4i16_t*)p));
}
__device__ __forceinline__ bf16x8 tr_pair(const LAS unsigned char* plo, const LAS unsigned char* phi) {
    const s16x4 lo = tr_read(plo), hi = tr_read(phi);
    return __builtin_shufflevector(lo, hi, 0, 1, 2, 3, 4, 5, 6, 7);
}
__device__ __forceinline__ bf16x8 pack8(float a0, float a1, float a2, float a3, float a4, float a5, float a6, float a7) {
    u32x4 p; p.x = pk2(a0, a1); p.y = pk2(a2, a3); p.z = pk2(a4, a5); p.w = pk2(a6, a7);
    return __builtin_bit_cast(bf16x8, p);
}

__device__ __forceinline__ void p0_load_tile(const float* W, int ldw, int k0, int n0, LAS float* scr, int lane) {
#pragma unroll 8
    for (int i = 0; i < 32; ++i) { const int kk = 2 * i + (lane >> 5); scr[kk * 33 + (lane & 31)] = W[(size_t)(k0 + kk) * ldw + n0 + (lane & 31)]; }
}
__device__ __forceinline__ void p0_phase(const Args& a, LAS unsigned char* lds, int tid, int lane, int wave, int G) {
    const float* cvec = a.in[1]; const float* w_ada = a.in[2]; const float* b_ada = a.in[3];
    float* MOD = (float*)(a.ws + WS_MOD);
    LAS float* red = (LAS float*)lds;
    for (int item = blockIdx.x; item < 48; item += G) {
        const int j0 = item * 64, kq = wave;
        float acc[8];
#pragma unroll
        for (int b = 0; b < 8; ++b) acc[b] = 0.f;
        for (int k = kq * 128; k < kq * 128 + 128; ++k) {
            const float w = w_ada[(size_t)k * 3072 + j0 + lane];
#pragma unroll
            for (int b = 0; b < 8; ++b) acc[b] += cvec[b * 1024 + k] * w;
        }
#pragma unroll
        for (int b = 0; b < 8; ++b) red[(kq * 8 + b) * 64 + lane] = acc[b];
        __syncthreads();
        { const int b = wave; float s = 0.f;
#pragma unroll
          for (int q = 0; q < 8; ++q) s += red[(q * 8 + b) * 64 + lane];
          MOD[b * 3072 + j0 + lane] = s + b_ada[j0 + lane]; }
        __syncthreads();
    }
    LAS float* scr = (LAS float*)(lds + wave * 8448);
    const int gw = blockIdx.x * 8 + wave, NGW = G * 8;
    constexpr int I_IN = 16 * (NP / 32), I_W = 16 * 32;
    bf16* WINT = (bf16*)((unsigned char*)a.out + OUT_WINT);
    for (int it = gw; it < I_IN + 3 * I_W; it += NGW) {
        if (it < I_IN) {
            const int nblk = NP / 32, kb = it / nblk, nb = it % nblk, k0 = 64 * kb, n0p = 32 * nb, n0 = n0p + (n0p >= 2304 ? 16 : 0);
            p0_load_tile(a.in[5], NIN, k0, n0, scr, lane);
            const int c = lane & 7;
#pragma unroll
            for (int j = 0; j < 4; ++j) { const int n = (lane >> 3) + 8 * j; const LAS float* s = scr + (8 * c) * 33 + n;
                u32x4 o; o.x = pk2(s[0 * 33], s[1 * 33]); o.y = pk2(s[2 * 33], s[3 * 33]); o.z = pk2(s[4 * 33], s[5 * 33]); o.w = pk2(s[6 * 33], s[7 * 33]);
                *(u32x4*)(WINT + (size_t)(n0p + n) * 1024 + k0 + 8 * c) = o; }
        } else {
            int r_ = it - I_IN; const int which = r_ / I_W; r_ -= which * I_W;
            const float* W = a.in[12 + which];
            bf16* WF = (bf16*)(a.ws + WS_WMF + (size_t)which * 2 * MiB);
            const int nt = r_ & 31, kb = r_ >> 5;
            p0_load_tile(W, 1024, 64 * kb, 32 * nt, scr, lane);
            const int r = lane & 31, h = lane >> 5;
#pragma unroll
            for (int s4 = 0; s4 < 4; ++s4) { const LAS float* s = scr + (16 * s4 + 8 * h) * 33 + r;
                u32x4 o; o.x = pk2(s[0 * 33], s[1 * 33]); o.y = pk2(s[2 * 33], s[3 * 33]); o.z = pk2(s[4 * 33], s[5 * 33]); o.w = pk2(s[6 * 33], s[7 * 33]);
                *(u32x4*)(WF + ((size_t)(nt * 64 + 4 * kb + s4) * 64 + lane) * 8) = o; }
        }
    }
}

__device__ __forceinline__ void p1_phase(const Args& a, LAS unsigned char* lds, int tid, int lane_in, int wave, int G) {
    const float* x = a.in[0]; const float* norm_w = a.in[4]; const float* w_in = a.in[5]; const float* dt_bias = a.in[8];
    const float* MOD = (const float*)(a.ws + WS_MOD);
    float* DT = (float*)(a.ws + WS_DT);
    bf16* H = (bf16*)((unsigned char*)a.out + OUT_H);
    LAS float* wdt = (LAS float*)lds;
    for (int idx = tid; idx < 16384; idx += NTHR) { const int k = idx >> 4, j = idx & 15; wdt[j * 1028 + k] = w_in[(size_t)k * NIN + 2304 + j]; }
    __syncthreads();
    for (int blk = blockIdx.x; blk < 256; blk += G) {
        const int b = blk >> 5;
        float gk[16], sh[16];
#pragma unroll
        for (int jj = 0; jj < 4; ++jj) { const int k = 4 * lane_in + 256 * jj;
            const f32x4 nw = *(const f32x4*)(norm_w + k), sc = *(const f32x4*)(MOD + b * 3072 + 1024 + k), sf = *(const f32x4*)(MOD + b * 3072 + k);
#pragma unroll
            for (int e = 0; e < 4; ++e) { gk[4 * jj + e] = nw[e] * (1.f + sc[e]); sh[4 * jj + e] = sf[e]; } }
        for (int g = 0; g < 4; ++g) {
            asm volatile("" ::: "memory");
            const int lane = (int)launder((unsigned)lane_in);
            const int m0 = blk * 64 + wave * 8 + g * 2;
            float hv[2][16];
#pragma unroll
            for (int rr = 0; rr < 2; ++rr) {
                const f32x4* xr = (const f32x4*)(x + (size_t)(m0 + rr) * D) + lane;
                f32x4 v[4]; float ss = 0.f;
#pragma unroll
                for (int jj = 0; jj < 4; ++jj) { v[jj] = xr[64 * jj]; ss += (v[jj].x * v[jj].x + v[jj].y * v[jj].y) + (v[jj].z * v[jj].z + v[jj].w * v[jj].w); }
                const float rs = 1.0f / sqrtf(wave_sum(ss) * (1.f / D) + EPS);
                unsigned long long* o8 = (unsigned long long*)(H + (size_t)(m0 + rr) * D) + lane;
#pragma unroll
                for (int jj = 0; jj < 4; ++jj) {
#pragma unroll
                    for (int e = 0; e < 4; ++e) hv[rr][4 * jj + e] = v[jj][e] * rs * gk[4 * jj + e] + sh[4 * jj + e];
                    o8[64 * jj] = (unsigned long long)pk2(hv[rr][4 * jj], hv[rr][4 * jj + 1]) | ((unsigned long long)pk2(hv[rr][4 * jj + 2], hv[rr][4 * jj + 3]) << 32);
                }
            }
            float acc[32];
#pragma unroll
            for (int i = 0; i < 32; ++i) acc[i] = 0.f;
#pragma unroll
            for (int j = 0; j < 16; ++j) {
#pragma unroll
                for (int jj = 0; jj < 4; ++jj) { const f32x4 w = *(const LAS f32x4*)(wdt + j * 1028 + 4 * lane + 256 * jj);
#pragma unroll
                    for (int rr = 0; rr < 2; ++rr) acc[rr * 16 + j] += (hv[rr][4 * jj] * w.x + hv[rr][4 * jj + 1] * w.y) + (hv[rr][4 * jj + 2] * w.z + hv[rr][4 * jj + 3] * w.w); }
                if ((j & 3) == 3) asm volatile("" ::: "memory");
            }
#pragma unroll
            for (int half = 16; half >= 1; half >>= 1) {
                const bool up = (lane & half) != 0;
#pragma unroll
                for (int i = 0; i < half; ++i) { const float keep = up ? acc[i + half] : acc[i], send = up ? acc[i] : acc[i + half]; acc[i] = keep + __shfl_xor(send, half); }
            }
            const float tot = acc[0] + __shfl_xor(acc[0], 32);
            const float xr_ = tot + dt_bias[lane & 15];
            const float dtv = xr_ > 20.f ? xr_ : log1pf(__expf(xr_));
            if (lane < 32) DT[(size_t)m0 * 16 + lane] = dtv;
        }
    }
}

constexpr int TP = 72;
constexpr int L_CQ = 0, L_BK = 18432, L_BKW = 36864, L_XV = 55296, L_ST0 = 73728, L_ST1 = 82944, L_ACS = 92160, L_DTJ = 93184, L_WJ = 94208;

__device__ __forceinline__ void p3_phase(const Args& a, LAS unsigned char* lds, int tid, int lane, int wave, int G) {
    bf16* PROJ = (bf16*)(a.ws + WS_PROJ);
    const float* DT = (const float*)(a.ws + WS_DT);
    float* SSQM = (float*)(a.ws + WS_SSQM); float* SSQR = (float*)(a.ws + WS_SSQR);
    const float* conv_w = a.in[6]; const float* conv_b = a.in[7]; const float* a_log = a.in[9]; const float* d_skip = a.in[10]; const float* m_norm_w = a.in[11];
    const int r = lane & 31, h = lane >> 5, i16 = lane & 15, q4 = i16 >> 2, p4 = i16 & 3, blk16 = (lane >> 4) & 1;
    const int pt = wave & 1, it = wave >> 1;
    for (int item = blockIdx.x; item < 256; item += G) {
        const bool ssd = item < 128;
        int b, hd, half;
        if (ssd) { b = item >> 4; hd = item & 15; half = 0; } else { const int t = item - 128; b = t >> 4; hd = (t >> 1) & 7; half = t & 1; }
        const size_t mb = (size_t)b * SEQ;
        __syncthreads();
        for (int idx = tid; idx < 9216 / 4; idx += NTHR) ((LAS unsigned*)(lds + L_ST0))[idx] = 0u;
        const float lg = ssd ? 0.f : log1pf(-exp2f(-5.0f - (float)hd));
        if (!ssd && tid < 256) { const int par = tid >> 7, j = tid & 127;
            ((LAS float*)(lds + L_ACS))[par * 128 + j] = (float)(j + 1) * lg; ((LAS float*)(lds + L_DTJ))[par * 128 + j] = 1.f; ((LAS float*)(lds + L_WJ))[par * 128 + j] = __expf((float)(127 - j) * lg); }
        const float Ah = ssd ? -__expf(a_log[hd]) : 0.f;
        const float Dsk = ssd ? d_skip[hd] : 0.f;
        const int ltile = tid >> 7, loct = tid & 7, ltg = (tid >> 3) & 15;
        int lcol = 0;
        float cw[4][8], cb[8];
        if (ssd) {
            lcol = (ltile == 0) ? (C_X + 64 * hd + 8 * loct) : (ltile == 1 ? (C_B + 64 * (hd >> 3) + 8 * loct) : (C_C + 64 * (hd >> 3) + 8 * loct));
            if (ltile == 3) lcol = C_X;
#pragma unroll
            for (int e = 0; e < 8; ++e) { cb[e] = conv_b[lcol - 1024 + e];
#pragma unroll
                for (int k = 0; k < 4; ++k) cw[k][e] = conv_w[k * 1280 + lcol - 1024 + e]; }
        } else {
#pragma unroll
            for (int e = 0; e < 8; ++e) { cb[e] = exp2f(-(float)(8 * (tid & 3) + e) * (13.287712379549449f / 32.f));
#pragma unroll
                for (int k = 0; k < 4; ++k) cw[k][e] = 0.f; }
        }
        f32x16 sacc;
#pragma unroll
        for (int i = 0; i < 16; ++i) sacc[i] = 0.f;

        for (int c = 0; c < 16; ++c) {
            const int par = c & 1;
            const size_t m0 = mb + (size_t)c * 128;
            LAS float* ACS = (LAS float*)(lds + L_ACS) + par * 128; LAS float* DTJ = (LAS float*)(lds + L_DTJ) + par * 128; LAS float* WJ = (LAS float*)(lds + L_WJ) + par * 128;
            if (ssd && wave == 0) {
                const float d0 = DT[(m0 + 2 * lane) * 16 + hd], d1 = DT[(m0 + 2 * lane + 1) * 16 + hd];
                const float v0 = d0 * Ah, v1 = d1 * Ah, s = v0 + v1; float incl = s;
#pragma unroll
                for (int o = 1; o < 64; o <<= 1) { const float t = __shfl_up(incl, o); if (lane >= o) incl += t; }
                const float c0 = (incl - s) + v0, c1 = c0 + v1, tot = __shfl(incl, 63);
                ACS[2 * lane] = c0; ACS[2 * lane + 1] = c1; DTJ[2 * lane] = d0; DTJ[2 * lane + 1] = d1;
                WJ[2 * lane] = d0 * __expf(tot - c0); WJ[2 * lane + 1] = d1 * __expf(tot - c1);
                if (lane == 63) { ACS[127] = tot; WJ[127] = d1; }
            }
            __syncthreads();
            if (ssd) {
                if (tid < 384) {
                    const int j0 = 8 * ltg;
                    const bf16* src = PROJ + (m0 + j0) * NP + lcol;
                    u32x4 raw[11];
#pragma unroll
                    for (int i = 0; i < 11; ++i) { const bool ok = (c * 128 + j0 - 3 + i) >= 0;
                        raw[i] = ok ? *(const u32x4*)(src + ((long)i - 3) * NP) : (u32x4){0u, 0u, 0u, 0u}; }
                    LAS unsigned char* dst = lds + (ltile == 0 ? L_XV : (ltile == 1 ? L_BK : L_CQ));
#pragma unroll
                    for (int jj = 0; jj < 8; ++jj) {
                        float o[8];
#pragma unroll
                        for (int e = 0; e < 8; ++e) {
                            float s = cb[e];
#pragma unroll
                            for (int k = 0; k < 4; ++k) { const unsigned w = raw[jj + k][e >> 1]; s += cw[k][e] * ((e & 1) ? bf_hi(w) : bf_lo(w)); }
                            o[e] = silu_f(s);
                        }
                        u32x4 ov; ov.x = pk2(o[0], o[1]); ov.y = pk2(o[2], o[3]); ov.z = pk2(o[4], o[5]); ov.w = pk2(o[6], o[7]);
                        *(LAS u32x4*)(dst + ((j0 + jj) * TP + 8 * loct) * 2) = ov;
                        if (ltile == 1) { const float wj = WJ[j0 + jj];
                            u32x4 ow; ow.x = pk2(o[0] * wj, o[1] * wj); ow.y = pk2(o[2] * wj, o[3] * wj); ow.z = pk2(o[4] * wj, o[5] * wj); ow.w = pk2(o[6] * wj, o[7] * wj);
                            *(LAS u32x4*)(lds + L_BKW + ((j0 + jj) * TP + 8 * loct) * 2) = ow; }
                    }
                }
            } else {
                const int j = tid >> 2, o4 = tid & 3;
                const bf16* rowp = PROJ + (m0 + j) * NP;
                const u32x4 q1 = *(const u32x4*)(rowp + C_Q + 64 * hd + 8 * o4), q2 = *(const u32x4*)(rowp + C_Q + 64 * hd + 32 + 8 * o4);
                const u32x4 k1 = *(const u32x4*)(rowp + C_K + 64 * hd + 8 * o4), k2 = *(const u32x4*)(rowp + C_K + 64 * hd + 32 + 8 * o4);
                const u32x4 v1 = *(const u32x4*)(rowp + C_V + 128 * hd + 64 * half + 16 * o4), v2 = *(const u32x4*)(rowp + C_V + 128 * hd + 64 * half + 16 * o4 + 8);
                const float pos = (float)(c * 128 + j), wj = WJ[j];
                float ql[8], qh[8], kl[8], kh[8];
#pragma unroll
                for (int e = 0; e < 8; ++e) {
                    const float rev = pos * cb[e] * 0.15915494309189535f, fr = rev - floorf(rev);
                    const float cs = __builtin_amdgcn_cosf(fr), sn = __builtin_amdgcn_sinf(fr);
                    const unsigned wq1 = q1[e >> 1], wq2 = q2[e >> 1], wk1 = k1[e >> 1], wk2 = k2[e >> 1];
                    const float a1 = (e & 1) ? bf_hi(wq1) : bf_lo(wq1), a2 = (e & 1) ? bf_hi(wq2) : bf_lo(wq2);
                    const float b1 = ((e & 1) ? bf_hi(wk1) : bf_lo(wk1)) * 0.125f, b2 = ((e & 1) ? bf_hi(wk2) : bf_lo(wk2)) * 0.125f;
                    ql[e] = a1 * cs - a2 * sn; qh[e] = a1 * sn + a2 * cs;
                    kl[e] = b1 * cs - b2 * sn; kh[e] = b1 * sn + b2 * cs;
                }
                u32x4 t;
                t.x = pk2(ql[0], ql[1]); t.y = pk2(ql[2], ql[3]); t.z = pk2(ql[4], ql[5]); t.w = pk2(ql[6], ql[7]); *(LAS u32x4*)(lds + L_CQ + (j * TP + 8 * o4) * 2) = t;
                t.x = pk2(qh[0], qh[1]); t.y = pk2(qh[2], qh[3]); t.z = pk2(qh[4], qh[5]); t.w = pk2(qh[6], qh[7]); *(LAS u32x4*)(lds + L_CQ + (j * TP + 32 + 8 * o4) * 2) = t;
                t.x = pk2(kl[0], kl[1]); t.y = pk2(kl[2], kl[3]); t.z = pk2(kl[4], kl[5]); t.w = pk2(kl[6], kl[7]); *(LAS u32x4*)(lds + L_BK + (j * TP + 8 * o4) * 2) = t;
                t.x = pk2(kh[0], kh[1]); t.y = pk2(kh[2], kh[3]); t.z = pk2(kh[4], kh[5]); t.w = pk2(kh[6], kh[7]); *(LAS u32x4*)(lds + L_BK + (j * TP + 32 + 8 * o4) * 2) = t;
                t.x = pk2(kl[0] * wj, kl[1] * wj); t.y = pk2(kl[2] * wj, kl[3] * wj); t.z = pk2(kl[4] * wj, kl[5] * wj); t.w = pk2(kl[6] * wj, kl[7] * wj); *(LAS u32x4*)(lds + L_BKW + (j * TP + 8 * o4) * 2) = t;
                t.x = pk2(kh[0] * wj, kh[1] * wj); t.y = pk2(kh[2] * wj, kh[3] * wj); t.z = pk2(kh[4] * wj, kh[5] * wj); t.w = pk2(kh[6] * wj, kh[7] * wj); *(LAS u32x4*)(lds + L_BKW + (j * TP + 32 + 8 * o4) * 2) = t;
                *(LAS u32x4*)(lds + L_XV + (j * TP + 16 * o4) * 2) = v1; *(LAS u32x4*)(lds + L_XV + (j * TP + 16 * o4 + 8) * 2) = v2;
            }
            __syncthreads();
            const int i0 = 32 * it, iTok = i0 + r;
            bf16x8 cqb[4];
#pragma unroll
            for (int s = 0; s < 4; ++s) cqb[s] = *(const LAS bf16x8*)(lds + L_CQ + ((i0 + r) * TP + 16 * s + 8 * h) * 2);
            const LAS unsigned char* STr = lds + (par ? L_ST1 : L_ST0);
            LAS unsigned char* STw = lds + (par ? L_ST0 : L_ST1);
            f32x16 acc;
#pragma unroll
            for (int i = 0; i < 16; ++i) acc[i] = 0.f;
#pragma unroll
            for (int s = 0; s < 4; ++s) { const bf16x8 sa = *(const LAS bf16x8*)(STr + ((32 * pt + r) * TP + 16 * s + 8 * h) * 2); acc = MFMA32(sa, cqb[s], acc); }
            const float acs_i = ACS[iTok];
            { const float ei = __expf(acs_i);
#pragma unroll
              for (int i = 0; i < 16; ++i) acc[i] *= ei; }
            for (int jt = 0; jt <= it; ++jt) {
                f32x16 g;
#pragma unroll
                for (int i = 0; i < 16; ++i) g[i] = 0.f;
#pragma unroll
                for (int s = 0; s < 4; ++s) { const bf16x8 ka = *(const LAS bf16x8*)(lds + L_BK + ((32 * jt + r) * TP + 16 * s + 8 * h) * 2); g = MFMA32(ka, cqb[s], g); }
                const bool diag = (jt == it);
#pragma unroll
                for (int g4 = 0; g4 < 4; ++g4) {
                    const f32x4 aj = *(const LAS f32x4*)(ACS + 32 * jt + 8 * g4 + 4 * h), dj = *(const LAS f32x4*)(DTJ + 32 * jt + 8 * g4 + 4 * h);
#pragma unroll
                    for (int e = 0; e < 4; ++e) { float v = g[4 * g4 + e] * __expf(acs_i - aj[e]) * dj[e]; if (diag && (8 * g4 + 4 * h + e) > r) v = 0.f; g[4 * g4 + e] = v; }
                }
#pragma unroll
                for (int s2 = 0; s2 < 2; ++s2) {
                    const bf16x8 pf = pack8(g[8 * s2], g[8 * s2 + 1], g[8 * s2 + 2], g[8 * s2 + 3], g[8 * s2 + 4], g[8 * s2 + 5], g[8 * s2 + 6], g[8 * s2 + 7]);
                    const LAS unsigned char* xb = lds + L_XV + ((32 * jt + 16 * s2 + 4 * h + q4) * TP + 32 * pt + 16 * blk16 + 4 * p4) * 2;
                    const bf16x8 xa = tr_pair(xb, xb + 8 * TP * 2);
                    acc = MFMA32(xa, pf, acc);
                }
            }
            {
                float ss = 0.f;
                bf16* orow = PROJ + (m0 + iTok) * NP + (ssd ? (C_Z + 64 * hd) : (C_GR + 128 * hd + 64 * half));
#pragma unroll
                for (int g4 = 0; g4 < 4; ++g4) {
                    const int p = 32 * pt + 8 * g4 + 4 * h;
                    const u32x2 zz = *(const u32x2*)(orow + p);
                    const float z0 = bf_lo(zz.x), z1 = bf_hi(zz.x), z2 = bf_lo(zz.y), z3 = bf_hi(zz.y);
                    float y0 = acc[4 * g4], y1 = acc[4 * g4 + 1], y2 = acc[4 * g4 + 2], y3 = acc[4 * g4 + 3];
                    float o0, o1, o2, o3;
                    if (ssd) {
                        const u32x2 xv = *(const LAS u32x2*)(lds + L_XV + (iTok * TP + p) * 2);
                        const f32x4 mw = *(const f32x4*)(m_norm_w + 64 * hd + p);
                        y0 = (y0 + Dsk * bf_lo(xv.x)) * silu_f(z0); y1 = (y1 + Dsk * bf_hi(xv.x)) * silu_f(z1); y2 = (y2 + Dsk * bf_lo(xv.y)) * silu_f(z2); y3 = (y3 + Dsk * bf_hi(xv.y)) * silu_f(z3);
                        ss += (y0 * y0 + y1 * y1) + (y2 * y2 + y3 * y3);
                        o0 = y0 * mw.x; o1 = y1 * mw.y; o2 = y2 * mw.z; o3 = y3 * mw.w;
                    } else {
                        ss += (y0 * y0 + y1 * y1) + (y2 * y2 + y3 * y3);
                        o0 = y0 * silu_f(z0); o1 = y1 * silu_f(z1); o2 = y2 * silu_f(z2); o3 = y3 * silu_f(z3);
                    }
                    u32x2 ov; ov.x = pk2(o0, o1); ov.y = pk2(o2, o3);
                    *(u32x2*)(orow + p) = ov;
                }
                ss += __shfl_xor(ss, 32);
                if (h == 0) { if (ssd) SSQM[(m0 + iTok) * 32 + hd * 2 + pt] = ss; else SSQR[(m0 + iTok) * 32 + hd * 4 + half * 2 + pt] = ss; }
            }
            if (it < 2 && c < 15) {
                const int nt = it;
                const float dec = __expf(ACS[127]);
#pragma unroll
                for (int i = 0; i < 16; ++i) sacc[i] *= dec;
#pragma unroll
                for (int ks = 0; ks < 8; ++ks) {
                    const LAS unsigned char* xb = lds + L_XV + ((16 * ks + 8 * h + q4) * TP + 32 * pt + 16 * blk16 + 4 * p4) * 2;
                    const LAS unsigned char* kb = lds + L_BKW + ((16 * ks + 8 * h + q4) * TP + 32 * nt + 16 * blk16 + 4 * p4) * 2;
                    const bf16x8 xa = tr_pair(xb, xb + 4 * TP * 2), kbf = tr_pair(kb, kb + 4 * TP * 2);
                    sacc = MFMA32(xa, kbf, sacc);
                }
#pragma unroll
                for (int i = 0; i < 16; ++i) { const int p = 32 * pt + crow(i, h);
                    *(LAS unsigned short*)(STw + (p * TP + 32 * nt + r) * 2) = (unsigned short)(pk2(sacc[i], 0.f) & 0xffffu); }
            }
        }
    }
}

constexpr int MP = 1032;
constexpr int L4_MERGED = 0, L4_ASTG = 132096, L4_RM = 150528, L4_RR = 151040, L4_RED = 153088, L4_RS = 155136;
static_assert(L4_RS + 256 <= LDS_BYTES, "P4 LDS map");

template <int SEGSHIFT>
__device__ __forceinline__ void p4_gemmT(f32x16 (&accT)[2][2], const bf16* Abase  , const LAS float* rsc  , int nseg,
                                         const bf16* WF  , int nt0  , LAS unsigned char* lds, int tid, int lane) {
    const int srow = tid >> 3, soct = tid & 7, r = lane & 31, h = lane >> 5;
    const char* ab = (const char*)Abase; const unsigned aoff = (unsigned)((srow * NP + 8 * soct) * 2);
    const char* wb = (const char*)WF + (size_t)nt0 * 65536; const unsigned woff = (unsigned)(lane * 16);
    u32x4 araw = *(const u32x4*)(ab + aoff);
    bf16x8 wc[4][2];
#pragma unroll
    for (int s = 0; s < 4; ++s) { wc[s][0] = *(const bf16x8*)(wb + s * 1024 + woff); wc[s][1] = *(const bf16x8*)(wb + 65536 + s * 1024 + woff); }
    for (int kc = 0; kc < 16; ++kc) {
        LAS unsigned char* stg = lds + L4_ASTG + (kc & 1) * 9216;
        { const float sc = rsc[srow * nseg + ((kc * 64) >> SEGSHIFT)];
          u32x4 o;
          o.x = pk2(bf_lo(araw.x) * sc, bf_hi(araw.x) * sc); o.y = pk2(bf_lo(araw.y) * sc, bf_hi(araw.y) * sc);
          o.z = pk2(bf_lo(araw.z) * sc, bf_hi(araw.z) * sc); o.w = pk2(bf_lo(araw.w) * sc, bf_hi(araw.w) * sc);
          *(LAS u32x4*)(stg + (srow * TP + 8 * soct) * 2) = o; }
        __syncthreads();
        const int kn = (kc + 1 < 16) ? kc + 1 : kc;
        araw = *(const u32x4*)(ab + kn * 128 + aoff);
        const char* wk = wb + kn * 4096;
#pragma unroll
        for (int s = 0; s < 4; ++s) {
            const bf16x8 a0 = *(const LAS bf16x8*)(stg + (r * TP + 16 * s + 8 * h) * 2), a1 = *(const LAS bf16x8*)(stg + ((32 + r) * TP + 16 * s + 8 * h) * 2);
            accT[0][0] = MFMA32(wc[s][0], a0, accT[0][0]); accT[0][1] = MFMA32(wc[s][1], a0, accT[0][1]);
            accT[1][0] = MFMA32(wc[s][0], a1, accT[1][0]); accT[1][1] = MFMA32(wc[s][1], a1, accT[1][1]);
            wc[s][0] = *(const bf16x8*)(wk + s * 1024 + woff); wc[s][1] = *(const bf16x8*)(wk + 65536 + s * 1024 + woff);
        }
    }
    __syncthreads();
}

__device__ __forceinline__ void p4_phase(const Args& a, LAS unsigned char* lds, int tid_in, int lane_in, int wave, int G) {
    const bf16* PROJ = (const bf16*)(a.ws + WS_PROJ);
    const float* SSQM = (const float*)(a.ws + WS_SSQM); const float* SSQR = (const float*)(a.ws + WS_SSQR);
    const float* MOD = (const float*)(a.ws + WS_MOD);
    const bf16* WMF = (const bf16*)(a.ws + WS_WMF); const bf16* WRF = (const bf16*)(a.ws + WS_WRF); const bf16* WOF = (const bf16*)(a.ws + WS_WOF);
    const float* x = a.in[0]; const float* fw = a.in[15]; float* out = a.out;
    LAS float* RM = (LAS float*)(lds + L4_RM); LAS float* RR = (LAS float*)(lds + L4_RR); LAS float* RED = (LAS float*)(lds + L4_RED); LAS float* RS = (LAS float*)(lds + L4_RS);
    for (int blk = blockIdx.x; blk < 256; blk += G) {
        const size_t m0 = (size_t)blk * 64; const int b = blk >> 5;
        int tid = (int)launder((unsigned)tid_in), lane = tid & 63, r = lane & 31, h = lane >> 5;
        __syncthreads();
        { const int row = tid >> 3, sub = tid & 7;
          const f32x4 qv = *(const f32x4*)(SSQR + (m0 + row) * 32 + 4 * sub);
          RR[row * 8 + sub] = 1.0f / sqrtf(((qv.x + qv.y) + (qv.z + qv.w)) * (1.f / 128.f) + EPS);
          if (sub < 2) { float s = 0.f;
#pragma unroll
              for (int i = 0; i < 4; ++i) { const f32x4 v = *(const f32x4*)(SSQM + (m0 + row) * 32 + 16 * sub + 4 * i); s += (v.x + v.y) + (v.z + v.w); }
              RM[row * 2 + sub] = 1.0f / sqrtf(s * (1.f / 512.f) + EPS); } }
        __syncthreads();
#ifndef P4_SKIP1
        for (int nh = 0; nh < 2; ++nh) {
            tid = (int)launder((unsigned)tid_in); lane = tid & 63; r = lane & 31; h = lane >> 5;
            const int nt0 = 16 * nh + 2 * wave;
            f32x16 accM[2][2], accR[2][2];
#pragma unroll
            for (int i = 0; i < 2; ++i)
#pragma unroll
                for (int j = 0; j < 2; ++j)
#pragma unroll
                    for (int e = 0; e < 16; ++e) { accM[i][j][e] = 0.f; accR[i][j][e] = 0.f; }
            const bf16* pblk = PROJ + m0 * NP;
            p4_gemmT<9>(accM, pblk + C_Z, RM, 2, WMF, nt0, lds, tid, lane);
            {
                const unsigned lo1 = launder((unsigned)((r * NP + 4 * h) * 2));
                const char* gb = (const char*)(pblk + C_GAM + 32 * nt0);
#pragma unroll
                for (int rt = 0; rt < 2; ++rt)
#pragma unroll
                    for (int ct = 0; ct < 2; ++ct)
#pragma unroll
                        for (int g4 = 0; g4 < 4; ++g4) {
                            const u32x2 gg = *(const u32x2*)(gb + (lo1 + (unsigned)((32 * rt * NP + 32 * ct + 8 * g4) * 2)));
                            accM[rt][ct][4 * g4] *= sigm_f(bf_lo(gg.x)); accM[rt][ct][4 * g4 + 1] *= sigm_f(bf_hi(gg.x)); accM[rt][ct][4 * g4 + 2] *= sigm_f(bf_lo(gg.y)); accM[rt][ct][4 * g4 + 3] *= sigm_f(bf_hi(gg.y)); }
            }
            p4_gemmT<7>(accR, pblk + C_GR, RR, 8, WRF, nt0, lds, tid, lane);
            {
                const unsigned lo1 = launder((unsigned)((r * NP + 4 * h) * 2));
                const char* gb = (const char*)(pblk + C_GAR + 32 * nt0);
                const unsigned lm = launder((unsigned)(L4_MERGED + (r * MP + 4 * h) * 2));
#pragma unroll
                for (int rt = 0; rt < 2; ++rt)
#pragma unroll
                    for (int ct = 0; ct < 2; ++ct)
#pragma unroll
                        for (int g4 = 0; g4 < 4; ++g4) {
                            const u32x2 gg = *(const u32x2*)(gb + (lo1 + (unsigned)((32 * rt * NP + 32 * ct + 8 * g4) * 2)));
                            const float v0 = accM[rt][ct][4 * g4] + accR[rt][ct][4 * g4] * sigm_f(bf_lo(gg.x)), v1 = accM[rt][ct][4 * g4 + 1] + accR[rt][ct][4 * g4 + 1] * sigm_f(bf_hi(gg.x));
                            const float v2 = accM[rt][ct][4 * g4 + 2] + accR[rt][ct][4 * g4 + 2] * sigm_f(bf_lo(gg.y)), v3 = accM[rt][ct][4 * g4 + 3] + accR[rt][ct][4 * g4 + 3] * sigm_f(bf_hi(gg.y));
                            u32x2 ov; ov.x = pk2(v0, v1); ov.y = pk2(v2, v3);
                            *(LAS u32x2*)(lds + lm + (unsigned)((32 * rt * MP + 32 * (nt0 + ct) + 8 * g4) * 2)) = ov; }
            }
        }
#endif
        __syncthreads();
        tid = (int)launder((unsigned)tid_in); lane = tid & 63; r = lane & 31; h = lane >> 5;
#ifndef P4_SKIP2
        {
            f32x16 acc[2][4];
#pragma unroll
            for (int i = 0; i < 2; ++i)
#pragma unroll
                for (int j = 0; j < 4; ++j)
#pragma unroll
                    for (int e = 0; e < 16; ++e) acc[i][j][e] = 0.f;
            const char* wb = (const char*)WOF + (size_t)(4 * wave) * 65536; const unsigned woff = (unsigned)(lane * 16);
            bf16x8 wc[2][4];
#pragma unroll
            for (int s = 0; s < 2; ++s)
#pragma unroll
                for (int ct = 0; ct < 4; ++ct) wc[s][ct] = *(const bf16x8*)(wb + ct * 65536 + s * 1024 + woff);
            for (int kp = 0; kp < 32; ++kp) {
                const int kpn = (kp + 1 < 32) ? kp + 1 : kp;
#pragma unroll
                for (int s = 0; s < 2; ++s) {
                    const int ks = 2 * kp + s;
                    const bf16x8 a0 = *(const LAS bf16x8*)(lds + L4_MERGED + (r * MP + 16 * ks + 8 * h) * 2), a1 = *(const LAS bf16x8*)(lds + L4_MERGED + ((32 + r) * MP + 16 * ks + 8 * h) * 2);
#pragma unroll
                    for (int ct = 0; ct < 4; ++ct) { acc[0][ct] = MFMA32(a0, wc[s][ct], acc[0][ct]); acc[1][ct] = MFMA32(a1, wc[s][ct], acc[1][ct]); }
#pragma unroll
                    for (int ct = 0; ct < 4; ++ct) wc[s][ct] = *(const bf16x8*)(wb + ct * 65536 + (2 * kpn + s) * 1024 + woff);
                }
            }
            const char* xblk = (const char*)(x + m0 * D); char* oblk = (char*)(out + m0 * D);
            const unsigned eo = launder((unsigned)(4 * (4 * h * D + 128 * wave + r)));
            const unsigned rb = launder((unsigned)(L4_RED + (4 * h * 8 + wave) * 4));
            float gate[4], fwv[4];
#pragma unroll
            for (int ct = 0; ct < 4; ++ct) { const int n = 32 * (4 * wave + ct) + r; gate[ct] = MOD[b * 3072 + 2048 + n]; fwv[ct] = fw[n]; }
#pragma unroll
            for (int rt = 0; rt < 2; ++rt)
#pragma unroll
                for (int reg = 0; reg < 16; ++reg) {
                    const int rowc = 32 * rt + (reg & 3) + 8 * (reg >> 2);
                    float s = 0.f;
#pragma unroll
                    for (int ct = 0; ct < 4; ++ct) { const float v = *(const float*)(xblk + (eo + (unsigned)((rowc * D + 32 * ct) * 4))) + gate[ct] * acc[rt][ct][reg]; s += v * v; }
                    s += __shfl_xor(s, 16); s += __shfl_xor(s, 8); s += __shfl_xor(s, 4); s += __shfl_xor(s, 2); s += __shfl_xor(s, 1);
                    *(LAS float*)(lds + rb + (unsigned)(rowc * 32)) = s;
                    if ((reg & 3) == 3) { asm volatile("" ::: "memory"); __builtin_amdgcn_sched_barrier(0); }
                }
            __syncthreads();
            if (tid < 64) { float s = 0.f;
#pragma unroll
                for (int w = 0; w < 8; ++w) s += RED[tid * 8 + w];
                RS[tid] = 1.0f / sqrtf(s * (1.f / D) + EPS); }
            __syncthreads();
            const unsigned eo2 = launder(eo);
            const unsigned sb = launder((unsigned)(L4_RS + 4 * h * 4));
#pragma unroll
            for (int rt = 0; rt < 2; ++rt)
#pragma unroll
                for (int reg = 0; reg < 16; ++reg) {
                    const int rowc = 32 * rt + (reg & 3) + 8 * (reg >> 2); const float rs = *(const LAS float*)(lds + sb + (unsigned)(rowc * 4));
#pragma unroll
                    for (int ct = 0; ct < 4; ++ct) { const unsigned o = eo2 + (unsigned)((rowc * D + 32 * ct) * 4);
                        *(float*)(oblk + o) = (*(const float*)(xblk + o) + gate[ct] * acc[rt][ct][reg]) * rs * fwv[ct]; }
                    if ((reg & 3) == 3) { asm volatile("" ::: "memory"); __builtin_amdgcn_sched_barrier(0); }
                }
        }
#endif
    }
}

__global__ void __launch_bounds__(NTHR, 2) hybrid_fwd(Args args) {
    extern __shared__ __attribute__((aligned(16))) unsigned char lds_raw[];
    LAS unsigned char* lds = (LAS unsigned char*)lds_raw;
    const int tid = threadIdx.x, lane = tid & 63, wave = __builtin_amdgcn_readfirstlane(tid >> 6), G = gridDim.x;
    cg::grid_group grid = cg::this_grid();
    const int lo = args.ph_lo, hi = args.ph_hi;
#ifndef PHMASK
#define PHMASK 31
#endif
#define IN(k) (((PHMASK >> (k)) & 1) && lo <= (k) && (k) < hi)
#define SEAM(k) do { if (IN(k) && IN((k) + 1)) grid.sync(); } while (0)
    if (IN(0)) p0_phase(args, lds, tid, lane, wave, G);
    SEAM(0);
    if (IN(1)) p1_phase(args, lds, tid, lane, wave, G);
    SEAM(1);
    if (IN(2)) {
        __syncthreads();
        pg8::Gemm g{(const pg8::bf16_t*)((const unsigned char*)args.out + OUT_H), (const pg8::bf16_t*)((const unsigned char*)args.out + OUT_WINT), MTOK, NP, D};
        pg8::StaticOrder S; S.init(MTOK, NP, G, (int)blockIdx.x);
        pg8::EpiProj E{(pg8::bf16_t*)(args.ws + WS_PROJ), NP};
        pg8::gemm_phase<pg8::EpiProj, pg8::StaticOrder, true, true>(lds, g, S, E);
    }
    SEAM(2);
    if (IN(3)) p3_phase(args, lds, tid, lane, wave, G);
    SEAM(3);
    if (IN(4)) p4_phase(args, lds, tid, lane, wave, G);
#undef IN
#undef SEAM
}

extern "C" void kernel_launch(void* const* d_in, const int* in_sizes, int n_in, void* d_out, int out_size, void* d_ws, size_t ws_size, hipStream_t stream) {
    static int grid = 0;
    if (grid == 0) {
        if (n_in != 16 || out_size != MTOK * D || ws_size < WS_END) { fprintf(stderr, "kernel_launch: unexpected shapes (n_in %d out %d ws %zu)\n", n_in, out_size, ws_size); grid = -1; return; }
        int dev = 0, cus = 0, per_cu = 0;
        (void)hipGetDevice(&dev);
        (void)hipDeviceGetAttribute(&cus, hipDeviceAttributeMultiprocessorCount, dev);
        if (hipFuncSetAttribute((const void*)hybrid_fwd, hipFuncAttributeMaxDynamicSharedMemorySize, LDS_BYTES) != hipSuccess) { fprintf(stderr, "kernel_launch: hipFuncSetAttribute failed\n"); grid = -1; return; }
        if (hipOccupancyMaxActiveBlocksPerMultiprocessor(&per_cu, (const void*)hybrid_fwd, NTHR, LDS_BYTES) != hipSuccess || per_cu < 1) { fprintf(stderr, "kernel_launch: occupancy query says %d\n", per_cu); per_cu = 1; }
        (void)hipGetLastError();
        grid = cus * per_cu;
        if (grid > 256) grid = 256;
        if (grid < 1) grid = 1;
    }
    if (grid < 0) return;
    Args a{};
    for (int i = 0; i < 16; ++i) a.in[i] = (const float*)d_in[i];
    a.out = (float*)d_out; a.ws = (unsigned char*)d_ws;
#if N_LAUNCHES == 1
    a.ph_lo = 0; a.ph_hi = NPH;
    void* kargs[] = {&a};
    hipError_t e = hipLaunchCooperativeKernel((const void*)hybrid_fwd, dim3(grid), dim3(NTHR), kargs, LDS_BYTES, stream);
    if (e != hipSuccess) fprintf(stderr, "kernel_launch: cooperative launch failed: %s (grid %d)\n", hipGetErrorString(e), grid);
#else
    for (int p = 0; p < NPH; ++p) {
        a.ph_lo = p; a.ph_hi = p + 1;
        hipLaunchKernelGGL(hybrid_fwd, dim3(grid), dim3(NTHR), LDS_BYTES, stream, a);
    }
#endif
}
```

```cpp
#include <hip/hip_runtime.h>
#include <hip/hip_cooperative_groups.h>
#include <cstdio>
#include <cstdint>
namespace cg = cooperative_groups;
#define N_LAUNCHES 1
#define REPEAT_MASK 0
__device__ __forceinline__ unsigned launder(unsigned v) { asm volatile("" : "+v"(v)); return v; }
__device__ __forceinline__ int fresh_lane() { unsigned z; asm volatile("v_mov_b32 %0, 0" : "=v"(z)); return (int)__builtin_amdgcn_mbcnt_hi(~0u, __builtin_amdgcn_mbcnt_lo(~0u, z)); }
namespace pg8 {
#define PG8_LAS __attribute__((address_space(3)))
typedef unsigned short bf16_t;
typedef short bf16x8 __attribute__((ext_vector_type(8)));
typedef float f32x4 __attribute__((ext_vector_type(4)));
typedef unsigned u32x4 __attribute__((ext_vector_type(4)));
constexpr int BM = 256, BK = 64, HALF = 128, HTB = HALF * BK * 2  , STAGE_BYTES = 8 * HTB, NXCD = 8, WGM = 8;

__host__ __device__ __forceinline__ int lds_byte(int r, int c) { const int st = (r >> 4) * 2 + (c >> 5), rr = r & 15, cc = c & 31, ob = rr * 64 + cc * 2; return st * 1024 + (ob ^ (((ob >> 9) & 1) << 5)); }
__host__ __device__ __forceinline__ void stage_rc(int b, int& R, int& C) { const int st = b / 1024, sb = b % 1024, swz = sb ^ (((sb >> 9) & 1) << 5); R = (st >> 1) * 16 + swz / 64; C = (st & 1) * 32 + (swz % 64) / 2; }
__host__ __device__ __forceinline__ int perm32(int rho) { const int n = rho >> 4, i = rho & 15; return 8 * (i >> 2) + 4 * n + (i & 3); }

struct Unit { int pm, pn; };
struct Gemm { const bf16_t* A; const bf16_t* Bt; int M, N, K; };

struct StaticOrder {
    int nM, nN, nwg, G, c;
    __host__ __device__ void init(int M, int N, int G_, int c_) { nM = M / BM; nN = N / BM; nwg = nM * nN; G = G_; c = c_; }
    __host__ __device__ bool next(int i, Unit& u) const {
        const long L = (long)i * G + c; if (L >= nwg) return false;
        int wgid = (int)L; { const int q = nwg / NXCD, r = nwg % NXCD, xcd = wgid % NXCD, off = wgid / NXCD; wgid = (xcd < r ? xcd * (q + 1) : r * (q + 1) + (xcd - r) * q) + off; }
        const int nig = WGM * nN, gid = wgid / nig, fm = gid * WGM, gsz = (nM - fm) < WGM ? (nM - fm) : WGM;
        u.pm = fm + ((wgid % nig) % gsz); u.pn = (wgid % nig) / gsz; return true;
    }
    __device__ __forceinline__ void a_ready(const Unit&) const {}
    __device__ __forceinline__ void done(const Unit&) const {}
};
__device__ __forceinline__ unsigned cvt_pk_bf16(float lo, float hi) { unsigned r; asm volatile("v_cvt_pk_bf16_f32 %0, %1, %2" : "=v"(r) : "v"(lo), "v"(hi)); return r; }
struct EpiProj {
    static constexpr bool PERM = true, AFTER_DRAIN = false;
    bf16_t* O; int ldc;
    __device__ __forceinline__ void operator()(const f32x4 (&acc)[2][2][4][2], const Unit& u, int wr, int wc, int fr, int fq) const {
        const int row0 = u.pm * BM + wr * 64 + fr; const int col0 = u.pn * BM + wc * 32 + 8 * fq;
#pragma unroll
        for (int ai = 0; ai < 2; ++ai)
#pragma unroll
            for (int m = 0; m < 4; ++m) { bf16_t* rowp = O + (size_t)(row0 + ai * HALF + m * 16) * ldc + col0;
#pragma unroll
                for (int bj = 0; bj < 2; ++bj) { const f32x4 v0 = acc[ai][bj][m][0], v1 = acc[ai][bj][m][1];
                    u32x4 w; w.x = cvt_pk_bf16(v0[0], v0[1]); w.y = cvt_pk_bf16(v0[2], v0[3]); w.z = cvt_pk_bf16(v1[0], v1[1]); w.w = cvt_pk_bf16(v1[2], v1[3]);
                    *(u32x4*)(rowp + bj * HALF) = w; } }
    }
    __device__ __forceinline__ void fused(f32x4 (&)[2][2][4][2], const Unit&, int, int, int, int, PG8_LAS unsigned char*, int, int) const {}
};
template <class Epi, class Sched, bool ALIGN_EPI = false, bool SP2 = false>
__device__ __forceinline__ void gemm_phase(PG8_LAS unsigned char* lds, const Gemm g, const Sched& S, const Epi& E, const int wid) {
    const int lane = ::fresh_lane(), tid = wid * 64 + lane, wr = wid >> 2, wc = wid & 3, fr = lane & 15, fq = lane >> 4;
    const int K = g.K, nt = K / BK;
    unsigned voffA[2], voffB[2];
#pragma unroll
    for (int i = 0; i < 2; ++i) { int R, C; stage_rc(tid * 16 + i * 8192, R, C); const int Rb = Epi::PERM ? ((R & ~31) + perm32(R & 31)) : R;
        voffA[i] = (unsigned)(R * K + C) * 2u; voffB[i] = (unsigned)(Rb * K + C) * 2u; }
    const size_t kstep = (size_t)(BK * 2);
    const size_t hstep = (size_t)HALF * K * 2;
    const size_t tstep = 2 * hstep;
    const unsigned ldsw = (unsigned)wid * 1024u;
    const int aoff = lds_byte(wr * 64 + fr, fq * 8), boff = lds_byte(wc * 32 + fr, fq * 8);
#define PG8_SA(b, h) (((b) * 2 + (h)) * HTB)
#define PG8_SB(b, h) ((4 + (b) * 2 + (h)) * HTB)
#define PG8_STAGE(bufoff, gbase, voff) do { _Pragma("unroll") for (int _i = 0; _i < 2; ++_i) \
        __builtin_amdgcn_global_load_lds((const unsigned*)((const char*)(gbase) + (voff)[_i]), (PG8_LAS unsigned*)(lds + (bufoff) + ldsw + _i * 8192), 16, 0, 0); } while (0)
#define PG8_LDA(dst, b, h) do { _Pragma("unroll") for (int m = 0; m < 4; ++m) _Pragma("unroll") for (int k = 0; k < 2; ++k) dst[m][k] = *(const PG8_LAS bf16x8*)(lds + PG8_SA(b, h) + aoff + m * 2048 + k * 1024); } while (0)
#define PG8_LDB(dst, b, h) do { _Pragma("unroll") for (int n = 0; n < 2; ++n) _Pragma("unroll") for (int k = 0; k < 2; ++k) dst[n][k] = *(const PG8_LAS bf16x8*)(lds + PG8_SB(b, h) + boff + n * 2048 + k * 1024); } while (0)
#define PG8_MMA(ai, bj, At, Bt) do { __builtin_amdgcn_s_setprio(1); _Pragma("unroll") for (int m = 0; m < 4; ++m) _Pragma("unroll") for (int n = 0; n < 2; ++n) _Pragma("unroll") for (int k = 0; k < 2; ++k) \
        acc[ai][bj][m][n] = __builtin_amdgcn_mfma_f32_16x16x32_bf16(Bt[n][k], At[m][k], acc[ai][bj][m][n], 0, 0, 0); __builtin_amdgcn_s_setprio(0); } while (0)
#define PG8_WAIT_V(n) asm volatile("s_waitcnt vmcnt(" #n ")" ::: "memory")
#define PG8_WAIT_L(n) asm volatile("s_waitcnt lgkmcnt(" #n ")" ::: "memory")
#define PG8_BAR __builtin_amdgcn_s_barrier()
#define PG8_SCHED __builtin_amdgcn_sched_barrier(0)
    Unit cur, nxt; int ui = 0;
    if (!S.next(0, cur)) return;
    f32x4 acc[2][2][4][2];
#pragma unroll
    for (int a = 0; a < 2; ++a)
#pragma unroll
        for (int b = 0; b < 2; ++b)
#pragma unroll
            for (int m = 0; m < 4; ++m)
#pragma unroll
                for (int n = 0; n < 2; ++n) acc[a][b][m][n] = (f32x4){0.f, 0.f, 0.f, 0.f};
    bf16x8 At[4][2], B0[2][2], B1[2][2];
    const char* cA = (const char*)g.A + (size_t)cur.pm * tstep; const char* cB = (const char*)g.Bt + (size_t)cur.pn * tstep;
    S.a_ready(cur);
    if constexpr (SP2) {
        PG8_STAGE(PG8_SB(0, 0), cB, voffB); PG8_STAGE(PG8_SB(0, 1), cB + hstep, voffB); PG8_STAGE(PG8_SA(0, 0), cA, voffA); PG8_STAGE(PG8_SA(0, 1), cA + hstep, voffA);
        if (wr == 1) PG8_BAR;
        PG8_WAIT_V(2); PG8_BAR;
        PG8_STAGE(PG8_SB(1, 0), cB + kstep, voffB); PG8_STAGE(PG8_SA(1, 0), cA + kstep, voffA); PG8_STAGE(PG8_SB(1, 1), cB + hstep + kstep, voffB);
        PG8_WAIT_V(6); PG8_BAR;
    } else {
        PG8_STAGE(PG8_SB(0, 0), cB, voffB); PG8_STAGE(PG8_SA(0, 0), cA, voffA); PG8_STAGE(PG8_SB(0, 1), cB + hstep, voffB); PG8_STAGE(PG8_SA(0, 1), cA + hstep, voffA);
        if (wr == 1) PG8_BAR;
        PG8_WAIT_V(4); PG8_BAR;
        PG8_STAGE(PG8_SB(1, 0), cB + kstep, voffB); PG8_STAGE(PG8_SA(1, 0), cA + kstep, voffA); PG8_STAGE(PG8_SB(1, 1), cB + hstep + kstep, voffB);
        PG8_WAIT_V(6); PG8_BAR;
    }
    for (;;) {
        const bool has_next = S.next(ui + 1, nxt);
        const char* nA = has_next ? (const char*)g.A + (size_t)nxt.pm * tstep : cA; const char* nB = has_next ? (const char*)g.Bt + (size_t)nxt.pn * tstep : cB;
        for (int t = 0; t < nt; t += 2) {
            const bool last = (t == nt - 2);
            const char* a1 = cA + (size_t)(t + 1) * kstep;
            const char* a2 = last ? nA : cA + (size_t)(t + 2) * kstep; const char* b2 = last ? nB : cB + (size_t)(t + 2) * kstep;
            const char* a3 = a2 + kstep; const char* b3 = b2 + kstep;
            if (last && has_next) S.a_ready(nxt);
            if constexpr (SP2) {
            PG8_LDB(B0, 0, 0); PG8_LDB(B1, 0, 1); PG8_SCHED; PG8_LDA(At, 0, 0); PG8_STAGE(PG8_SA(1, 1), a1 + hstep, voffA);
            PG8_WAIT_V(8); PG8_WAIT_L(0); PG8_BAR; PG8_MMA(0, 0, At, B0); PG8_MMA(0, 1, At, B1); PG8_BAR; PG8_SCHED;
            PG8_LDA(At, 0, 1); PG8_STAGE(PG8_SB(0, 0), b2, voffB); PG8_STAGE(PG8_SB(0, 1), b2 + hstep, voffB); PG8_STAGE(PG8_SA(0, 0), a2, voffA);
            PG8_WAIT_V(8); PG8_WAIT_L(0); PG8_BAR; PG8_MMA(1, 0, At, B0); PG8_MMA(1, 1, At, B1); PG8_BAR; PG8_SCHED;
            PG8_LDB(B0, 1, 0); PG8_LDB(B1, 1, 1); PG8_SCHED; PG8_LDA(At, 1, 0); PG8_STAGE(PG8_SA(0, 1), a2 + hstep, voffA);
            PG8_WAIT_V(8); PG8_WAIT_L(0); PG8_BAR; PG8_MMA(0, 0, At, B0); PG8_MMA(0, 1, At, B1); PG8_BAR; PG8_SCHED;
            PG8_LDA(At, 1, 1); PG8_STAGE(PG8_SB(1, 0), b3, voffB); PG8_STAGE(PG8_SB(1, 1), b3 + hstep, voffB); PG8_STAGE(PG8_SA(1, 0), a3, voffA);
            PG8_WAIT_V(8); PG8_WAIT_L(0); PG8_BAR; PG8_MMA(1, 0, At, B0); PG8_MMA(1, 1, At, B1); PG8_BAR; PG8_SCHED;
            } else {
            PG8_LDB(B0, 0, 0); PG8_SCHED; PG8_LDA(At, 0, 0); PG8_STAGE(PG8_SA(1, 1), a1 + hstep, voffA);
            PG8_WAIT_L(8); PG8_BAR; PG8_WAIT_L(0); PG8_MMA(0, 0, At, B0); PG8_BAR; PG8_SCHED;
            PG8_LDB(B1, 0, 1); PG8_STAGE(PG8_SB(0, 0), b2, voffB);
            PG8_BAR; PG8_WAIT_L(0); PG8_MMA(0, 1, At, B1); PG8_BAR;
            PG8_LDA(At, 0, 1); PG8_STAGE(PG8_SA(0, 0), a2, voffA);
            PG8_BAR; PG8_WAIT_L(0); PG8_MMA(1, 0, At, B0); PG8_BAR; PG8_SCHED;
            PG8_STAGE(PG8_SB(0, 1), b2 + hstep, voffB);
            PG8_WAIT_V(6); PG8_BAR; PG8_MMA(1, 1, At, B1); PG8_BAR;
            PG8_LDB(B0, 1, 0); PG8_SCHED; PG8_LDA(At, 1, 0); PG8_STAGE(PG8_SA(0, 1), a2 + hstep, voffA);
            PG8_WAIT_L(8); PG8_BAR; PG8_WAIT_L(0); PG8_MMA(0, 0, At, B0); PG8_BAR; PG8_SCHED;
            PG8_LDB(B1, 1, 1); PG8_STAGE(PG8_SB(1, 0), b3, voffB);
            PG8_BAR; PG8_WAIT_L(0); PG8_MMA(0, 1, At, B1); PG8_BAR;
            PG8_LDA(At, 1, 1); PG8_STAGE(PG8_SA(1, 0), a3, voffA);
            PG8_BAR; PG8_WAIT_L(0); PG8_MMA(1, 0, At, B0); PG8_BAR; PG8_SCHED;
            PG8_STAGE(PG8_SB(1, 1), b3 + hstep, voffB);
            PG8_WAIT_V(6); PG8_BAR; PG8_MMA(1, 1, At, B1); PG8_BAR;
            }
        }
        if constexpr (ALIGN_EPI) { if (wr == 0) PG8_BAR; }
        if constexpr (!Epi::AFTER_DRAIN) { E(acc, cur, wr, wc, fr, fq); S.done(cur); }
        if (!has_next) break;
#pragma unroll
        for (int a = 0; a < 2; ++a)
#pragma unroll
            for (int b = 0; b < 2; ++b)
#pragma unroll
                for (int m = 0; m < 4; ++m)
#pragma unroll
                    for (int n = 0; n < 2; ++n) acc[a][b][m][n] = (f32x4){0.f, 0.f, 0.f, 0.f};
        cur = nxt; cA = nA; cB = nB; ++ui;
        if constexpr (ALIGN_EPI) { if (wr == 1) PG8_BAR; }
    }
    PG8_WAIT_V(0);
    if constexpr (!ALIGN_EPI) { if (wr == 0) PG8_BAR; }
    PG8_BAR;
    if constexpr (Epi::AFTER_DRAIN) { E.fused(acc, cur, wr, wc, fr, fq, lds, wid, lane); S.done(cur); }
#undef PG8_SA
#undef PG8_SB
#undef PG8_STAGE
#undef PG8_LDA
#undef PG8_LDB
#undef PG8_MMA
#undef PG8_WAIT_V
#undef PG8_WAIT_L
#undef PG8_BAR
#undef PG8_SCHED
}
}

#define LAS __attribute__((address_space(3)))
typedef unsigned short bf16;
typedef short bf16x8 __attribute__((ext_vector_type(8)));
typedef short s16x4 __attribute__((ext_vector_type(4)));
typedef float f32x4 __attribute__((ext_vector_type(4)));
typedef float f32x16 __attribute__((ext_vector_type(16)));
typedef unsigned u32x4 __attribute__((ext_vector_type(4)));
typedef unsigned u32x2 __attribute__((ext_vector_type(2)));
typedef float f32x2_t __attribute__((ext_vector_type(2)));
typedef __bf16 bf16x2_t __attribute__((ext_vector_type(2)));

#ifndef N_LAUNCHES
#define N_LAUNCHES 1
#endif
constexpr int NPH = 5;
constexpr int D = 1024, NB = 8, SEQ = 2048, MTOK = NB * SEQ, NIN = 7440, NP = 7424;
constexpr int C_Z = 0, C_X = 1024, C_B = 2048, C_C = 2176, C_Q = 2304, C_K = 2816, C_V = 3328, C_GR = 4352, C_GAM = 5376, C_GAR = 6400;
constexpr float EPS = 1e-6f;
constexpr size_t MiB = 1u << 20;
constexpr size_t WS_PROJ = 0;
constexpr size_t WS_WMF = 232 * MiB, WS_WRF = 234 * MiB, WS_WOF = 236 * MiB;
constexpr size_t WS_MOD = 238 * MiB;
constexpr size_t WS_DT = 239 * MiB;
constexpr size_t WS_SSQM = 240 * MiB;
constexpr size_t WS_SSQR = 242 * MiB;
constexpr size_t WS_END = 244 * MiB;
constexpr size_t OUT_H = 0, OUT_WINT = 32 * MiB;
constexpr int LDS_BYTES = 155648;
constexpr int NTHR = 512;

struct Args { const float* in[16]; float* out; unsigned char* ws; int ph_lo, ph_hi; };

__device__ __forceinline__ float bf_lo(unsigned u) { return __uint_as_float(u << 16); }
__device__ __forceinline__ float bf_hi(unsigned u) { return __uint_as_float(u & 0xffff0000u); }
__device__ __forceinline__ unsigned pk2(float lo, float hi) { f32x2_t v = {lo, hi}; bf16x2_t b = __builtin_convertvector(v, bf16x2_t); return __builtin_bit_cast(unsigned, b); }
__device__ __forceinline__ float silu_f(float x) { return x * __builtin_amdgcn_rcpf(1.f + __expf(-x)); }
__device__ __forceinline__ float sigm_f(float x) { return __builtin_amdgcn_rcpf(1.f + __expf(-x)); }
__device__ __forceinline__ float wave_sum(float v) {
#pragma unroll
    for (int o = 1; o < 64; o <<= 1) v += __shfl_xor(v, o);
    return v;
}
__device__ __forceinline__ int crow(int reg, int h) { return (reg & 3) + 8 * (reg >> 2) + 4 * h; }
#define MFMA32(a, b, c) __builtin_amdgcn_mfma_f32_32x32x16_bf16((a), (b), (c), 0, 0, 0)
__device__ __forceinline__ s16x4 tr_read(const LAS unsigned char* p) {
    typedef short v4i16_t __attribute__((ext_vector_type(4)));
    return __builtin_bit_cast(s16x4, __builtin_amdgcn_ds_read_tr16_b64_v4i16((LAS v4i16_t*)p));
}
__device__ __forceinline__ bf16x8 tr_pair(const LAS unsigned char* plo, const LAS unsigned char* phi) {
    const s16x4 lo = tr_read(plo), hi = tr_read(phi);
    return __builtin_shufflevector(lo, hi, 0, 1, 2, 3, 4, 5, 6, 7);
}
__device__ __forceinline__ bf16x8 pack8(float a0, float a1, float a2, float a3, float a4, float a5, float a6, float a7) {
    u32x4 p; p.x = pk2(a0, a1); p.y = pk2(a2, a3); p.z = pk2(a4, a5); p.w = pk2(a6, a7);
    return __builtin_bit_cast(bf16x8, p);
}

__device__ __forceinline__ void p0_load_tile(const float* W, int ldw, int k0, int n0, LAS float* scr, int lane) {
    float t[32];
#pragma unroll
    for (int i = 0; i < 32; ++i) t[i] = W[(size_t)(k0 + 2 * i + (lane >> 5)) * ldw + n0 + (lane & 31)];
#pragma unroll
    for (int i = 0; i < 32; ++i) scr[(2 * i + (lane >> 5)) * 33 + (lane & 31)] = t[i];
}
__device__ __forceinline__ void p0_phase(const Args& a, LAS unsigned char* lds, int tid_unused, int lane_unused, int wave, int G) {
    const int lane = fresh_lane(), tid = wave * 64 + lane;
    const float* cvec = a.in[1]; const float* w_ada = a.in[2]; const float* b_ada = a.in[3];
    float* MOD = (float*)(a.ws + WS_MOD);
    LAS float* cT = (LAS float*)lds;
    LAS float* red = (LAS float*)(lds + 32768);
    if ((int)blockIdx.x < 192) {
        { float t[16];
#pragma unroll
          for (int i = 0; i < 16; ++i) t[i] = cvec[tid + 512 * i];
#pragma unroll
          for (int i = 0; i < 16; ++i) { const int idx = tid + 512 * i; cT[(idx & 1023) * 8 + (idx >> 10)] = t[i]; } }
        __syncthreads();
        for (int item = blockIdx.x; item < 192; item += G) {
            const int j0 = item * 16, col = lane & 15, rsub = lane >> 4, kq = wave;
            float w[32];
#pragma unroll
            for (int i = 0; i < 32; ++i) w[i] = w_ada[(size_t)(kq * 128 + 4 * i + rsub) * 3072 + j0 + col];
            float acc[8];
#pragma unroll
            for (int bb = 0; bb < 8; ++bb) acc[bb] = 0.f;
#pragma unroll
            for (int i = 0; i < 32; ++i) { const int k = kq * 128 + 4 * i + rsub;
                const f32x4 c0 = *(const LAS f32x4*)(cT + k * 8), c1 = *(const LAS f32x4*)(cT + k * 8 + 4);
                acc[0] += c0.x * w[i]; acc[1] += c0.y * w[i]; acc[2] += c0.z * w[i]; acc[3] += c0.w * w[i];
                acc[4] += c1.x * w[i]; acc[5] += c1.y * w[i]; acc[6] += c1.z * w[i]; acc[7] += c1.w * w[i]; }
#pragma unroll
            for (int bb = 0; bb < 8; ++bb) { acc[bb] += __shfl_xor(acc[bb], 16); acc[bb] += __shfl_xor(acc[bb], 32); }
            if (lane < 16) {
#pragma unroll
                for (int bb = 0; bb < 8; ++bb) red[(kq * 8 + bb) * 16 + col] = acc[bb]; }
            __syncthreads();
            if (tid < 128) { const int bb = tid >> 4, cc = tid & 15; float sum = 0.f;
#pragma unroll
                for (int q = 0; q < 8; ++q) sum += red[(q * 8 + bb) * 16 + cc];
                MOD[bb * 3072 + j0 + cc] = sum + b_ada[j0 + cc]; }
            __syncthreads();
        }
    }
    LAS float* scr = (LAS float*)(lds + 40960 + wave * 8448);
    const int gw = blockIdx.x * 8 + wave, NGW = G * 8;
    constexpr int I_IN = 16 * (NP / 32), I_W = 16 * 32;
    bf16* WINT = (bf16*)((unsigned char*)a.out + OUT_WINT);
    for (int it = gw; it < I_IN + 3 * I_W; it += NGW) {
        if (it < I_IN) {
            const int nblk = NP / 32, kb = it / nblk, nb = it % nblk, k0 = 64 * kb, n0p = 32 * nb, n0 = n0p + (n0p >= 2304 ? 16 : 0);
            p0_load_tile(a.in[5], NIN, k0, n0, scr, lane);
            const int c = lane & 7;
#pragma unroll
            for (int j = 0; j < 4; ++j) { const int n = (lane >> 3) + 8 * j; const LAS float* s = scr + (8 * c) * 33 + n;
                u32x4 o; o.x = pk2(s[0 * 33], s[1 * 33]); o.y = pk2(s[2 * 33], s[3 * 33]); o.z = pk2(s[4 * 33], s[5 * 33]); o.w = pk2(s[6 * 33], s[7 * 33]);
                *(u32x4*)(WINT + (size_t)(n0p + n) * 1024 + k0 + 8 * c) = o; }
        } else {
            int r_ = it - I_IN; const int which = r_ / I_W; r_ -= which * I_W;
            const float* W = a.in[12 + which];
            bf16* WF = (bf16*)(a.ws + WS_WMF + (size_t)which * 2 * MiB);
            const int nt = r_ & 31, kb = r_ >> 5;
            p0_load_tile(W, 1024, 64 * kb, 32 * nt, scr, lane);
            const int r = lane & 31, h = lane >> 5;
#pragma unroll
            for (int s4 = 0; s4 < 4; ++s4) { const LAS float* s = scr + (16 * s4 + 8 * h) * 33 + r;
                u32x4 o; o.x = pk2(s[0 * 33], s[1 * 33]); o.y = pk2(s[2 * 33], s[3 * 33]); o.z = pk2(s[4 * 33], s[5 * 33]); o.w = pk2(s[6 * 33], s[7 * 33]);
                *(u32x4*)(WF + ((size_t)(nt * 64 + 4 * kb + s4) * 64 + lane) * 8) = o; }
        }
    }
}

__device__ __forceinline__ void p1_phase(const Args& a, LAS unsigned char* lds, int tid_unused, int lane_unused, int wave, int G) {
    const int lane_in = fresh_lane(), tid = wave * 64 + lane_in;
    const float* x = a.in[0]; const float* norm_w = a.in[4]; const float* w_in = a.in[5]; const float* dt_bias = a.in[8];
    const float* MOD = (const float*)(a.ws + WS_MOD);
    float* DT = (float*)(a.ws + WS_DT);
    bf16* H = (bf16*)((unsigned char*)a.out + OUT_H);
    LAS float* wdt = (LAS float*)lds;
    { float t[32];
#pragma unroll
      for (int i = 0; i < 32; ++i) { const int idx = tid + NTHR * i; t[i] = w_in[(size_t)(idx >> 4) * NIN + 2304 + (idx & 15)]; }
#pragma unroll
      for (int i = 0; i < 32; ++i) { const int idx = tid + NTHR * i; wdt[(idx & 15) * 1028 + (idx >> 4)] = t[i]; } }
    __syncthreads();
    for (int blk = blockIdx.x; blk < 256; blk += G) {
        const int b = blk >> 5;
        float gk[16], sh[16];
#pragma unroll
        for (int jj = 0; jj < 4; ++jj) { const int k = 4 * lane_in + 256 * jj;
            const f32x4 nw = *(const f32x4*)(norm_w + k), sc = *(const f32x4*)(MOD + b * 3072 + 1024 + k), sf = *(const f32x4*)(MOD + b * 3072 + k);
#pragma unroll
            for (int e = 0; e < 4; ++e) { gk[4 * jj + e] = nw[e] * (1.f + sc[e]); sh[4 * jj + e] = sf[e]; } }
        f32x4 vn[2][4];
        { const int lane = fresh_lane();
#pragma unroll
          for (int rr = 0; rr < 2; ++rr)
#pragma unroll
              for (int jj = 0; jj < 4; ++jj) vn[rr][jj] = *((const f32x4*)(x + (size_t)(blk * 64 + wave * 8 + rr) * D) + lane + 64 * jj); }
        for (int g = 0; g < 4; ++g) {
            asm volatile("" ::: "memory");
            const int lane = fresh_lane();
            const int m0 = blk * 64 + wave * 8 + g * 2;
            f32x4 v[2][4];
#pragma unroll
            for (int rr = 0; rr < 2; ++rr)
#pragma unroll
                for (int jj = 0; jj < 4; ++jj) v[rr][jj] = vn[rr][jj];
            if (g + 1 < 4) {
#pragma unroll
                for (int rr = 0; rr < 2; ++rr)
#pragma unroll
                    for (int jj = 0; jj < 4; ++jj) vn[rr][jj] = *((const f32x4*)(x + (size_t)(m0 + 2 + rr) * D) + lane + 64 * jj);
            }
            __builtin_amdgcn_sched_barrier(0);
            float hv[2][16];
#pragma unroll
            for (int rr = 0; rr < 2; ++rr) {
                float ss = 0.f;
#pragma unroll
                for (int jj = 0; jj < 4; ++jj) ss += (v[rr][jj].x * v[rr][jj].x + v[rr][jj].y * v[rr][jj].y) + (v[rr][jj].z * v[rr][jj].z + v[rr][jj].w * v[rr][jj].w);
                const float rs = 1.0f / sqrtf(wave_sum(ss) * (1.f / D) + EPS);
                unsigned long long* o8 = (unsigned long long*)(H + (size_t)(m0 + rr) * D) + lane;
#pragma unroll
                for (int jj = 0; jj < 4; ++jj) {
#pragma unroll
                    for (int e = 0; e < 4; ++e) hv[rr][4 * jj + e] = v[rr][jj][e] * rs * gk[4 * jj + e] + sh[4 * jj + e];
                    o8[64 * jj] = (unsigned long long)pk2(hv[rr][4 * jj], hv[rr][4 * jj + 1]) | ((unsigned long long)pk2(hv[rr][4 * jj + 2], hv[rr][4 * jj + 3]) << 32);
                }
            }
            float acc[32];
#pragma unroll
            for (int i = 0; i < 32; ++i) acc[i] = 0.f;
#pragma unroll
            for (int j = 0; j < 16; ++j) {
#pragma unroll
                for (int jj = 0; jj < 4; ++jj) { const f32x4 w = *(const LAS f32x4*)(wdt + j * 1028 + 4 * lane + 256 * jj);
#pragma unroll
                    for (int rr = 0; rr < 2; ++rr) acc[rr * 16 + j] += (hv[rr][4 * jj] * w.x + hv[rr][4 * jj + 1] * w.y) + (hv[rr][4 * jj + 2] * w.z + hv[rr][4 * jj + 3] * w.w); }
                if ((j & 3) == 3) asm volatile("" ::: "memory");
            }
#pragma unroll
            for (int half = 16; half >= 1; half >>= 1) {
                const bool up = (lane & half) != 0;
#pragma unroll
                for (int i = 0; i < half; ++i) { float lo_ = acc[i], hi_ = acc[i + half]; asm volatile("" : "+v"(lo_), "+v"(hi_));
                    const float keep = up ? hi_ : lo_, send = up ? lo_ : hi_; acc[i] = keep + __shfl_xor(send, half); }
            }
            const float tot = acc[0] + __shfl_xor(acc[0], 32);
            const float xr_ = tot + dt_bias[lane & 15];
            const float dtv = xr_ > 20.f ? xr_ : log1pf(__expf(xr_));
            if (lane < 32) DT[(size_t)m0 * 16 + lane] = dtv;
        }
    }
}

constexpr int TP = 72;
constexpr int L_CQ = 0, L_BK = 18432, L_BKW = 36864, L_XV = 55296, L_ST0 = 73728, L_ST1 = 82944, L_ACS = 92160, L_DTJ = 93184, L_WJ = 94208, L_CW = 95232;

__device__ __forceinline__ void p3_phase(const Args& a, LAS unsigned char* lds, int tid_in, int lane_in, int wave, int G, const bool dry = false) {
    bf16* PROJ = (bf16*)(a.ws + WS_PROJ);
    const float* DT = (const float*)(a.ws + WS_DT);
    float* SSQM = (float*)(a.ws + WS_SSQM); float* SSQR = (float*)(a.ws + WS_SSQR);
    const float* conv_w = a.in[6]; const float* conv_b = a.in[7]; const float* a_log = a.in[9]; const float* d_skip = a.in[10]; const float* m_norm_w = a.in[11];
    const int pt = wave & 1, it = wave >> 1;
    for (int item = blockIdx.x; item < 256; item += G) {
        const int lane = fresh_lane(), tid = wave * 64 + lane;
        const int r = lane & 31, h = lane >> 5, i16 = lane & 15, q4 = i16 >> 2, p4 = i16 & 3, blk16 = (lane >> 4) & 1;
        const bool ssd = item < 128;
        int b, hd, half;
        if (ssd) { b = item >> 4; hd = item & 15; half = 0; } else { const int t = item - 128; b = t >> 4; hd = (t >> 1) & 7; half = t & 1; }
        const size_t mb = (size_t)b * SEQ;
        __syncthreads();
        for (int idx = tid; idx < 9216 / 4; idx += NTHR) ((LAS unsigned*)(lds + L_ST0))[idx] = 0u;
        const float lg = ssd ? 0.f : log1pf(-exp2f(-5.0f - (float)hd));
        if (!ssd && tid < 256) { const int par = tid >> 7, j = tid & 127;
            ((LAS float*)(lds + L_ACS))[par * 128 + j] = (float)(j + 1) * lg; ((LAS float*)(lds + L_DTJ))[par * 128 + j] = 1.f; ((LAS float*)(lds + L_WJ))[par * 128 + j] = __expf((float)(127 - j) * lg); }
        const float Ah = ssd ? -__expf(a_log[hd]) : 0.f;
        const float Dsk = ssd ? d_skip[hd] : 0.f;
        const int ltile = tid >> 7, loct = tid & 7, ltg = (tid >> 3) & 15;
        int lcol = C_X;
        float invf[8];
        LAS float* cwl = (LAS float*)(lds + L_CW) + (ltile * 8 + loct) * 40;
        if (ssd) {
            lcol = (ltile == 0) ? (C_X + 64 * hd + 8 * loct) : (ltile == 1 ? (C_B + 64 * (hd >> 3) + 8 * loct) : (C_C + 64 * (hd >> 3) + 8 * loct));
            if (ltile == 3) lcol = C_X;
            if (tid < 384 && ltg == 0) {
#pragma unroll
                for (int e = 0; e < 8; ++e) { cwl[32 + e] = conv_b[lcol - 1024 + e];
#pragma unroll
                    for (int k = 0; k < 4; ++k) cwl[k * 8 + e] = conv_w[k * 1280 + lcol - 1024 + e]; }
            }
#pragma unroll
            for (int e = 0; e < 8; ++e) invf[e] = 0.f;
        } else {
#pragma unroll
            for (int e = 0; e < 8; ++e) invf[e] = exp2f(-(float)(8 * (tid & 3) + e) * (13.287712379549449f / 32.f));
        }
        f32x16 sacc;
#pragma unroll
        for (int i = 0; i < 16; ++i) sacc[i] = 0.f;
        u32x4 raw[11];
        const int rj = tid >> 2, ro4 = tid & 3;
        const int j0 = 8 * ltg;
        const char* pbase = (const char*)(PROJ + mb * NP);
        const unsigned soff = (unsigned)((j0 * NP + lcol) * 2);
        const unsigned roff = (unsigned)((rj * NP) * 2);
#define P3_ISSUE(cc) do { const char* cbp = pbase + (size_t)(cc) * (128 * NP * 2); \
        if (ssd) { _Pragma("unroll") for (int i = 0; i < 11; ++i) { const bool ok = ((cc) * 128 + j0 - 3 + i) >= 0 && tid < 384; \
                raw[i] = ok ? *(const u32x4*)(cbp + (long)soff + ((long)i - 3) * (NP * 2)) : (u32x4){0u, 0u, 0u, 0u}; } } \
        else { const char* rp = cbp + roff; \
            raw[0] = *(const u32x4*)(rp + (C_Q + 64 * hd + 8 * ro4) * 2); raw[1] = *(const u32x4*)(rp + (C_Q + 64 * hd + 32 + 8 * ro4) * 2); \
            raw[2] = *(const u32x4*)(rp + (C_K + 64 * hd + 8 * ro4) * 2); raw[3] = *(const u32x4*)(rp + (C_K + 64 * hd + 32 + 8 * ro4) * 2); \
            raw[4] = *(const u32x4*)(rp + (C_V + 128 * hd + 64 * half + 16 * ro4) * 2); raw[5] = *(const u32x4*)(rp + (C_V + 128 * hd + 64 * half + 16 * ro4 + 8) * 2); } } while (0)
        float dq0 = 0.f, dq1 = 0.f;
#define P3_SCAN(cc) do { LAS float* ACSw = (LAS float*)(lds + L_ACS) + ((cc) & 1) * 128; LAS float* DTJw = (LAS float*)(lds + L_DTJ) + ((cc) & 1) * 128; LAS float* WJw = (LAS float*)(lds + L_WJ) + ((cc) & 1) * 128; \
        const float v0 = dq0 * Ah, v1 = dq1 * Ah, s_ = v0 + v1; float incl = s_; \
        _Pragma("unroll") for (int o = 1; o < 64; o <<= 1) { const float t = __shfl_up(incl, o); if (lane >= o) incl += t; } \
        const float c0 = (incl - s_) + v0, tot = __shfl(incl, 63), c1 = (lane == 63) ? tot : c0 + v1; \
        ACSw[2 * lane] = c0; ACSw[2 * lane + 1] = c1; DTJw[2 * lane] = dq0; DTJw[2 * lane + 1] = dq1; \
        WJw[2 * lane] = dq0 * __expf(tot - c0); WJw[2 * lane + 1] = dq1 * __expf(tot - c1); } while (0)
#define P3_DTLOAD(cc) do { dq0 = DT[(mb + (size_t)(cc) * 128 + 2 * lane) * 16 + hd]; dq1 = DT[(mb + (size_t)(cc) * 128 + 2 * lane + 1) * 16 + hd]; } while (0)
        if (ssd && wave == 0) { P3_DTLOAD(0); P3_SCAN(0); P3_DTLOAD(1); }
        P3_ISSUE(0);

        for (int c = 0; c < 16; ++c) {
            const int par = c & 1;
            const size_t m0 = mb + (size_t)c * 128;
            LAS float* ACS = (LAS float*)(lds + L_ACS) + par * 128; LAS float* DTJ = (LAS float*)(lds + L_DTJ) + par * 128; LAS float* WJ = (LAS float*)(lds + L_WJ) + par * 128;
            __syncthreads();
            if (ssd) {
                if (tid < 384) {
                    LAS unsigned char* dst = lds + (ltile == 0 ? L_XV : (ltile == 1 ? L_BK : L_CQ));
                    float cw[4][8], cb[8];
#pragma unroll
                    for (int k = 0; k < 5; ++k) { const f32x4 t0 = *(const LAS f32x4*)(cwl + 8 * k), t1 = *(const LAS f32x4*)(cwl + 8 * k + 4);
#pragma unroll
                        for (int e = 0; e < 4; ++e) { if (k < 4) { cw[k][e] = t0[e]; cw[k][4 + e] = t1[e]; } else { cb[e] = t0[e]; cb[4 + e] = t1[e]; } } }
#pragma unroll
                    for (int jj = 0; jj < 8; ++jj) {
                        float o[8];
#pragma unroll
                        for (int e = 0; e < 8; ++e) {
                            float s_ = cb[e];
#pragma unroll
                            for (int k = 0; k < 4; ++k) { const unsigned w = raw[jj + k][e >> 1]; s_ += cw[k][e] * ((e & 1) ? bf_hi(w) : bf_lo(w)); }
                            o[e] = silu_f(s_);
                        }
                        u32x4 ov; ov.x = pk2(o[0], o[1]); ov.y = pk2(o[2], o[3]); ov.z = pk2(o[4], o[5]); ov.w = pk2(o[6], o[7]);
                        *(LAS u32x4*)(dst + ((j0 + jj) * TP + 8 * loct) * 2) = ov;
                        if (ltile == 1) { const float wj = WJ[j0 + jj];
                            u32x4 ow; ow.x = pk2(o[0] * wj, o[1] * wj); ow.y = pk2(o[2] * wj, o[3] * wj); ow.z = pk2(o[4] * wj, o[5] * wj); ow.w = pk2(o[6] * wj, o[7] * wj);
                            *(LAS u32x4*)(lds + L_BKW + ((j0 + jj) * TP + 8 * loct) * 2) = ow; }
                    }
                }
            } else {
                const int j = rj, o4 = ro4;
                const u32x4 q1 = raw[0], q2 = raw[1], k1 = raw[2], k2 = raw[3];
                const float pos = (float)(c * 128 + j), wj = WJ[j];
                float ql[8], qh[8], kl[8], kh[8];
#pragma unroll
                for (int e = 0; e < 8; ++e) {
                    const float rev = pos * invf[e] * 0.15915494309189535f, fr = rev - floorf(rev);
                    const float cs = __builtin_amdgcn_cosf(fr), sn = __builtin_amdgcn_sinf(fr);
                    const unsigned wq1 = q1[e >> 1], wq2 = q2[e >> 1], wk1 = k1[e >> 1], wk2 = k2[e >> 1];
                    const float a1 = (e & 1) ? bf_hi(wq1) : bf_lo(wq1), a2 = (e & 1) ? bf_hi(wq2) : bf_lo(wq2);
                    const float b1 = ((e & 1) ? bf_hi(wk1) : bf_lo(wk1)) * 0.125f, b2 = ((e & 1) ? bf_hi(wk2) : bf_lo(wk2)) * 0.125f;
                    ql[e] = a1 * cs - a2 * sn; qh[e] = a1 * sn + a2 * cs;
                    kl[e] = b1 * cs - b2 * sn; kh[e] = b1 * sn + b2 * cs;
                }
                u32x4 t;
                t.x = pk2(ql[0], ql[1]); t.y = pk2(ql[2], ql[3]); t.z = pk2(ql[4], ql[5]); t.w = pk2(ql[6], ql[7]); *(LAS u32x4*)(lds + L_CQ + (j * TP + 8 * o4) * 2) = t;
                t.x = pk2(qh[0], qh[1]); t.y = pk2(qh[2], qh[3]); t.z = pk2(qh[4], qh[5]); t.w = pk2(qh[6], qh[7]); *(LAS u32x4*)(lds + L_CQ + (j * TP + 32 + 8 * o4) * 2) = t;
                t.x = pk2(kl[0], kl[1]); t.y = pk2(kl[2], kl[3]); t.z = pk2(kl[4], kl[5]); t.w = pk2(kl[6], kl[7]); *(LAS u32x4*)(lds + L_BK + (j * TP + 8 * o4) * 2) = t;
                t.x = pk2(kh[0], kh[1]); t.y = pk2(kh[2], kh[3]); t.z = pk2(kh[4], kh[5]); t.w = pk2(kh[6], kh[7]); *(LAS u32x4*)(lds + L_BK + (j * TP + 32 + 8 * o4) * 2) = t;
                t.x = pk2(kl[0] * wj, kl[1] * wj); t.y = pk2(kl[2] * wj, kl[3] * wj); t.z = pk2(kl[4] * wj, kl[5] * wj); t.w = pk2(kl[6] * wj, kl[7] * wj); *(LAS u32x4*)(lds + L_BKW + (j * TP + 8 * o4) * 2) = t;
                t.x = pk2(kh[0] * wj, kh[1] * wj); t.y = pk2(kh[2] * wj, kh[3] * wj); t.z = pk2(kh[4] * wj, kh[5] * wj); t.w = pk2(kh[6] * wj, kh[7] * wj); *(LAS u32x4*)(lds + L_BKW + (j * TP + 32 + 8 * o4) * 2) = t;
                *(LAS u32x4*)(lds + L_XV + (j * TP + 16 * o4) * 2) = raw[4]; *(LAS u32x4*)(lds + L_XV + (j * TP + 16 * o4 + 8) * 2) = raw[5];
            }
            __syncthreads();
            const int i0 = 32 * it, iTok = i0 + r;
            bf16* orow = PROJ + (m0 + iTok) * NP + (ssd ? (C_Z + 64 * hd) : (C_GR + 128 * hd + 64 * half));
            u32x2 zz[4];
#pragma unroll
            for (int g4 = 0; g4 < 4; ++g4) zz[g4] = *(const u32x2*)(orow + 32 * pt + 8 * g4 + 4 * h);
            if (c + 1 < 16) P3_ISSUE(c + 1);
            __builtin_amdgcn_sched_barrier(0);
            if (ssd && wave == 0 && c + 1 < 16) { P3_SCAN(c + 1); if (c + 2 < 16) P3_DTLOAD(c + 2); }
            bf16x8 cqb[4];
#pragma unroll
            for (int s = 0; s < 4; ++s) cqb[s] = *(const LAS bf16x8*)(lds + L_CQ + ((i0 + r) * TP + 16 * s + 8 * h) * 2);
            const LAS unsigned char* STr = lds + (par ? L_ST1 : L_ST0);
            LAS unsigned char* STw = lds + (par ? L_ST0 : L_ST1);
            f32x16 acc;
#pragma unroll
            for (int i = 0; i < 16; ++i) acc[i] = 0.f;
#pragma unroll
            for (int s = 0; s < 4; ++s) { const bf16x8 sa = *(const LAS bf16x8*)(STr + ((32 * pt + r) * TP + 16 * s + 8 * h) * 2); acc = MFMA32(sa, cqb[s], acc); }
            const float acs_i = ACS[iTok];
            { const float ei = __expf(acs_i);
#pragma unroll
              for (int i = 0; i < 16; ++i) acc[i] *= ei; }
            for (int jt = 0; jt <= it; ++jt) {
                f32x16 g;
#pragma unroll
                for (int i = 0; i < 16; ++i) g[i] = 0.f;
#pragma unroll
                for (int s = 0; s < 4; ++s) { const bf16x8 ka = *(const LAS bf16x8*)(lds + L_BK + ((32 * jt + r) * TP + 16 * s + 8 * h) * 2); g = MFMA32(ka, cqb[s], g); }
                const bool diag = (jt == it);
#pragma unroll
                for (int g4 = 0; g4 < 4; ++g4) {
                    const f32x4 aj = *(const LAS f32x4*)(ACS + 32 * jt + 8 * g4 + 4 * h), dj = *(const LAS f32x4*)(DTJ + 32 * jt + 8 * g4 + 4 * h);
#pragma unroll
                    for (int e = 0; e < 4; ++e) { float v = g[4 * g4 + e] * __expf(acs_i - aj[e]) * dj[e]; if (diag && (8 * g4 + 4 * h + e) > r) v = 0.f; g[4 * g4 + e] = v; }
                }
#pragma unroll
                for (int s2 = 0; s2 < 2; ++s2) {
                    const bf16x8 pf = pack8(g[8 * s2], g[8 * s2 + 1], g[8 * s2 + 2], g[8 * s2 + 3], g[8 * s2 + 4], g[8 * s2 + 5], g[8 * s2 + 6], g[8 * s2 + 7]);
                    const LAS unsigned char* xb = lds + L_XV + ((32 * jt + 16 * s2 + 4 * h + q4) * TP + 32 * pt + 16 * blk16 + 4 * p4) * 2;
                    const bf16x8 xa = tr_pair(xb, xb + 8 * TP * 2);
                    acc = MFMA32(xa, pf, acc);
                }
            }
            {
                float ss = 0.f;
#pragma unroll
                for (int g4 = 0; g4 < 4; ++g4) {
                    const int p = 32 * pt + 8 * g4 + 4 * h;
                    const float z0 = bf_lo(zz[g4].x), z1 = bf_hi(zz[g4].x), z2 = bf_lo(zz[g4].y), z3 = bf_hi(zz[g4].y);
                    float y0 = acc[4 * g4], y1 = acc[4 * g4 + 1], y2 = acc[4 * g4 + 2], y3 = acc[4 * g4 + 3];
                    float o0, o1, o2, o3;
                    if (ssd) {
                        const u32x2 xv = *(const LAS u32x2*)(lds + L_XV + (iTok * TP + p) * 2);
                        const f32x4 mw = *(const f32x4*)(m_norm_w + 64 * hd + p);
                        y0 = (y0 + Dsk * bf_lo(xv.x)) * silu_f(z0); y1 = (y1 + Dsk * bf_hi(xv.x)) * silu_f(z1); y2 = (y2 + Dsk * bf_lo(xv.y)) * silu_f(z2); y3 = (y3 + Dsk * bf_hi(xv.y)) * silu_f(z3);
                        ss += (y0 * y0 + y1 * y1) + (y2 * y2 + y3 * y3);
                        o0 = y0 * mw.x; o1 = y1 * mw.y; o2 = y2 * mw.z; o3 = y3 * mw.w;
                    } else {
                        ss += (y0 * y0 + y1 * y1) + (y2 * y2 + y3 * y3);
                        o0 = y0 * silu_f(z0); o1 = y1 * silu_f(z1); o2 = y2 * silu_f(z2); o3 = y3 * silu_f(z3);
                    }
                    u32x2 ov; ov.x = pk2(o0, o1); ov.y = pk2(o2, o3);
                    if (dry) *(u32x2*)((bf16*)a.out + (m0 + iTok) * 2048 + (ssd ? 64 * hd : 1024 + 128 * hd + 64 * half) + p) = ov; else *(u32x2*)(orow + p) = ov;
                }
                ss += __shfl_xor(ss, 32);
                if (h == 0) { if (ssd) SSQM[(m0 + iTok) * 32 + hd * 2 + pt] = ss; else SSQR[(m0 + iTok) * 32 + hd * 4 + half * 2 + pt] = ss; }
            }
            if (it < 2 && c < 15) {
                const int nt = it;
                const float dec = __expf(ACS[127]);
#pragma unroll
                for (int i = 0; i < 16; ++i) sacc[i] *= dec;
#pragma unroll
                for (int ks = 0; ks < 8; ++ks) {
                    const LAS unsigned char* xb = lds + L_XV + ((16 * ks + 8 * h + q4) * TP + 32 * pt + 16 * blk16 + 4 * p4) * 2;
                    const LAS unsigned char* kb = lds + L_BKW + ((16 * ks + 8 * h + q4) * TP + 32 * nt + 16 * blk16 + 4 * p4) * 2;
                    const bf16x8 xa = tr_pair(xb, xb + 4 * TP * 2), kbf = tr_pair(kb, kb + 4 * TP * 2);
                    sacc = MFMA32(xa, kbf, sacc);
                }
#pragma unroll
                for (int i = 0; i < 16; ++i) { const int p = 32 * pt + crow(i, h);
                    *(LAS unsigned short*)(STw + (p * TP + 32 * nt + r) * 2) = (unsigned short)(pk2(sacc[i], 0.f) & 0xffffu); }
            }
        }
#undef P3_ISSUE
#undef P3_SCAN
#undef P3_DTLOAD
    }
}

constexpr int MP = 1032;
constexpr int L4_MERGED = 0, L4_ASTG = 132096, L4_RM = 150528, L4_RR = 151040, L4_RED = 153088, L4_RS = 155136;
static_assert(L4_RS + 256 <= LDS_BYTES, "P4 LDS map");

template <int SEGSHIFT>
__device__ __forceinline__ void p4_gemmT(f32x16 (&accT)[2][2], const bf16* Abase  , const LAS float* rsc  , int nseg,
                                         const bf16* WF  , int nt0  , LAS unsigned char* lds, int tid, int lane) {
    const int srow = tid >> 3, soct = tid & 7, r = lane & 31, h = lane >> 5;
    const char* ab = (const char*)Abase; const unsigned aoff = (unsigned)((srow * NP + 8 * soct) * 2);
    const char* wb = (const char*)WF + (size_t)nt0 * 65536; const unsigned woff = (unsigned)(lane * 16);
    u32x4 araw = *(const u32x4*)(ab + aoff);
    bf16x8 wc[4][2];
#pragma unroll
    for (int s = 0; s < 4; ++s) { wc[s][0] = *(const bf16x8*)(wb + s * 1024 + woff); wc[s][1] = *(const bf16x8*)(wb + 65536 + s * 1024 + woff); }
    for (int kc = 0; kc < 16; ++kc) {
        LAS unsigned char* stg = lds + L4_ASTG + (kc & 1) * 9216;
        { const float sc = rsc[srow * nseg + ((kc * 64) >> SEGSHIFT)];
          u32x4 o;
          o.x = pk2(bf_lo(araw.x) * sc, bf_hi(araw.x) * sc); o.y = pk2(bf_lo(araw.y) * sc, bf_hi(araw.y) * sc);
          o.z = pk2(bf_lo(araw.z) * sc, bf_hi(araw.z) * sc); o.w = pk2(bf_lo(araw.w) * sc, bf_hi(araw.w) * sc);
          *(LAS u32x4*)(stg + (srow * TP + 8 * soct) * 2) = o; }
        __syncthreads();
        const int kn = (kc + 1 < 16) ? kc + 1 : kc;
        araw = *(const u32x4*)(ab + kn * 128 + aoff);
        const char* wk = wb + kn * 4096;
#pragma unroll
        for (int s = 0; s < 4; ++s) {
            const bf16x8 a0 = *(const LAS bf16x8*)(stg + (r * TP + 16 * s + 8 * h) * 2), a1 = *(const LAS bf16x8*)(stg + ((32 + r) * TP + 16 * s + 8 * h) * 2);
            accT[0][0] = MFMA32(wc[s][0], a0, accT[0][0]); accT[0][1] = MFMA32(wc[s][1], a0, accT[0][1]);
            accT[1][0] = MFMA32(wc[s][0], a1, accT[1][0]); accT[1][1] = MFMA32(wc[s][1], a1, accT[1][1]);
            wc[s][0] = *(const bf16x8*)(wk + s * 1024 + woff); wc[s][1] = *(const bf16x8*)(wk + 65536 + s * 1024 + woff);
            __builtin_amdgcn_sched_barrier(0);
        }
    }
    __syncthreads();
}

__device__ __forceinline__ void p4_phase(const Args& a, LAS unsigned char* lds, int tid_in, int lane_in, int wave, int G) {
    const bf16* PROJ = (const bf16*)(a.ws + WS_PROJ);
    const float* SSQM = (const float*)(a.ws + WS_SSQM); const float* SSQR = (const float*)(a.ws + WS_SSQR);
    const float* MOD = (const float*)(a.ws + WS_MOD);
    const bf16* WMF = (const bf16*)(a.ws + WS_WMF); const bf16* WRF = (const bf16*)(a.ws + WS_WRF); const bf16* WOF = (const bf16*)(a.ws + WS_WOF);
    const float* x = a.in[0]; const float* fw = a.in[15]; float* out = a.out;
    LAS float* RM = (LAS float*)(lds + L4_RM); LAS float* RR = (LAS float*)(lds + L4_RR); LAS float* RED = (LAS float*)(lds + L4_RED); LAS float* RS = (LAS float*)(lds + L4_RS);
    for (int blk = blockIdx.x; blk < 256; blk += G) {
        const size_t m0 = (size_t)blk * 64; const int b = blk >> 5;
        int lane = fresh_lane(), tid = wave * 64 + lane, r = lane & 31, h = lane >> 5;
        __syncthreads();
        { const int row = tid >> 3, sub = tid & 7;
          const f32x4 qv = *(const f32x4*)(SSQR + (m0 + row) * 32 + 4 * sub);
          RR[row * 8 + sub] = 1.0f / sqrtf(((qv.x + qv.y) + (qv.z + qv.w)) * (1.f / 128.f) + EPS);
          if (sub < 2) { float s = 0.f;
#pragma unroll
              for (int i = 0; i < 4; ++i) { const f32x4 v = *(const f32x4*)(SSQM + (m0 + row) * 32 + 16 * sub + 4 * i); s += (v.x + v.y) + (v.z + v.w); }
              RM[row * 2 + sub] = 1.0f / sqrtf(s * (1.f / 512.f) + EPS); } }
        __syncthreads();
#ifndef P4_SKIP1
        for (int nh = 0; nh < 2; ++nh) {
            lane = fresh_lane(); tid = wave * 64 + lane; r = lane & 31; h = lane >> 5;
            const int nt0 = 16 * nh + 2 * wave;
            f32x16 accM[2][2], accR[2][2];
#pragma unroll
            for (int i = 0; i < 2; ++i)
#pragma unroll
                for (int j = 0; j < 2; ++j)
#pragma unroll
                    for (int e = 0; e < 16; ++e) { accM[i][j][e] = 0.f; accR[i][j][e] = 0.f; }
            const bf16* pblk = PROJ + m0 * NP;
            p4_gemmT<9>(accM, pblk + C_Z, RM, 2, WMF, nt0, lds, tid, lane);
            {
                lane = fresh_lane(); r = lane & 31; h = lane >> 5;
                const unsigned lo1 = launder((unsigned)((r * NP + 4 * h) * 2));
                const char* gb = (const char*)(pblk + C_GAM + 32 * nt0);
#pragma unroll
                for (int rt = 0; rt < 2; ++rt)
#pragma unroll
                    for (int ct = 0; ct < 2; ++ct)
#pragma unroll
                        for (int g4 = 0; g4 < 4; ++g4) {
                            const u32x2 gg = *(const u32x2*)(gb + (lo1 + (unsigned)((32 * rt * NP + 32 * ct + 8 * g4) * 2)));
                            accM[rt][ct][4 * g4] *= sigm_f(bf_lo(gg.x)); accM[rt][ct][4 * g4 + 1] *= sigm_f(bf_hi(gg.x)); accM[rt][ct][4 * g4 + 2] *= sigm_f(bf_lo(gg.y)); accM[rt][ct][4 * g4 + 3] *= sigm_f(bf_hi(gg.y)); }
            }
            p4_gemmT<7>(accR, pblk + C_GR, RR, 8, WRF, nt0, lds, tid, lane);
            {
                lane = fresh_lane(); r = lane & 31; h = lane >> 5;
                const unsigned lo1 = launder((unsigned)((r * NP + 4 * h) * 2));
                const char* gb = (const char*)(pblk + C_GAR + 32 * nt0);
                const unsigned lm = launder((unsigned)(L4_MERGED + (r * MP + 4 * h) * 2));
#pragma unroll
                for (int rt = 0; rt < 2; ++rt)
#pragma unroll
                    for (int ct = 0; ct < 2; ++ct)
#pragma unroll
                        for (int g4 = 0; g4 < 4; ++g4) {
                            const u32x2 gg = *(const u32x2*)(gb + (lo1 + (unsigned)((32 * rt * NP + 32 * ct + 8 * g4) * 2)));
                            const float v0 = accM[rt][ct][4 * g4] + accR[rt][ct][4 * g4] * sigm_f(bf_lo(gg.x)), v1 = accM[rt][ct][4 * g4 + 1] + accR[rt][ct][4 * g4 + 1] * sigm_f(bf_hi(gg.x));
                            const float v2 = accM[rt][ct][4 * g4 + 2] + accR[rt][ct][4 * g4 + 2] * sigm_f(bf_lo(gg.y)), v3 = accM[rt][ct][4 * g4 + 3] + accR[rt][ct][4 * g4 + 3] * sigm_f(bf_hi(gg.y));
                            u32x2 ov; ov.x = pk2(v0, v1); ov.y = pk2(v2, v3);
                            *(LAS u32x2*)(lds + lm + (unsigned)((32 * rt * MP + 32 * (nt0 + ct) + 8 * g4) * 2)) = ov; }
            }
        }
#endif
        __syncthreads();
        lane = fresh_lane(); tid = wave * 64 + lane; r = lane & 31; h = lane >> 5;
#ifndef P4_SKIP2
        {
            f32x16 acc[2][4];
#pragma unroll
            for (int i = 0; i < 2; ++i)
#pragma unroll
                for (int j = 0; j < 4; ++j)
#pragma unroll
                    for (int e = 0; e < 16; ++e) acc[i][j][e] = 0.f;
            const char* wb = (const char*)WOF + (size_t)(4 * wave) * 65536; const unsigned woff = (unsigned)(lane * 16);
            bf16x8 wc[2][4];
#pragma unroll
            for (int s = 0; s < 2; ++s)
#pragma unroll
                for (int ct = 0; ct < 4; ++ct) wc[s][ct] = *(const bf16x8*)(wb + ct * 65536 + s * 1024 + woff);
            for (int kp = 0; kp < 32; ++kp) {
                const int kpn = (kp + 1 < 32) ? kp + 1 : kp;
#pragma unroll
                for (int s = 0; s < 2; ++s) {
                    const int ks = 2 * kp + s;
                    const bf16x8 a0 = *(const LAS bf16x8*)(lds + L4_MERGED + (r * MP + 16 * ks + 8 * h) * 2), a1 = *(const LAS bf16x8*)(lds + L4_MERGED + ((32 + r) * MP + 16 * ks + 8 * h) * 2);
#pragma unroll
                    for (int ct = 0; ct < 4; ++ct) { acc[0][ct] = MFMA32(a0, wc[s][ct], acc[0][ct]); acc[1][ct] = MFMA32(a1, wc[s][ct], acc[1][ct]); }
#pragma unroll
                    for (int ct = 0; ct < 4; ++ct) wc[s][ct] = *(const bf16x8*)(wb + ct * 65536 + (2 * kpn + s) * 1024 + woff);
                    __builtin_amdgcn_sched_barrier(0);
                }
            }
            lane = fresh_lane(); r = lane & 31; h = lane >> 5;
            const char* xblk = (const char*)(x + m0 * D); char* oblk = (char*)(out + m0 * D);
            const unsigned eo = launder((unsigned)(4 * (4 * h * D + 128 * wave + r)));
            const unsigned rb = launder((unsigned)(L4_RED + (4 * h * 8 + wave) * 4));
            float gate[4], fwv[4];
#pragma unroll
            for (int ct = 0; ct < 4; ++ct) { const int n = 32 * (4 * wave + ct) + r; gate[ct] = MOD[b * 3072 + 2048 + n]; fwv[ct] = fw[n]; }
#pragma unroll
            for (int rt = 0; rt < 2; ++rt)
#pragma unroll
                for (int reg = 0; reg < 16; ++reg) {
                    const int rowc = 32 * rt + (reg & 3) + 8 * (reg >> 2);
                    float s = 0.f;
#pragma unroll
                    for (int ct = 0; ct < 4; ++ct) { const float v = *(const float*)(xblk + (eo + (unsigned)((rowc * D + 32 * ct) * 4))) + gate[ct] * acc[rt][ct][reg]; s += v * v; }
                    s += __shfl_xor(s, 16); s += __shfl_xor(s, 8); s += __shfl_xor(s, 4); s += __shfl_xor(s, 2); s += __shfl_xor(s, 1);
                    *(LAS float*)(lds + rb + (unsigned)(rowc * 32)) = s;
                    if ((reg & 3) == 3) { asm volatile("" ::: "memory"); __builtin_amdgcn_sched_barrier(0); }
                }
            __syncthreads();
            if (tid < 64) { float s = 0.f;
#pragma unroll
                for (int w = 0; w < 8; ++w) s += RED[tid * 8 + w];
                RS[tid] = 1.0f / sqrtf(s * (1.f / D) + EPS); }
            __syncthreads();
            const unsigned eo2 = launder(eo);
            const unsigned sb = launder((unsigned)(L4_RS + 4 * h * 4));
#pragma unroll
            for (int rt = 0; rt < 2; ++rt)
#pragma unroll
                for (int g4 = 0; g4 < 4; ++g4) {
                    float xv[4][4];
#pragma unroll
                    for (int e = 0; e < 4; ++e)
#pragma unroll
                        for (int ct = 0; ct < 4; ++ct) xv[e][ct] = *(const float*)(xblk + (eo2 + (unsigned)(((32 * rt + e + 8 * g4) * D + 32 * ct) * 4)));
#pragma unroll
                    for (int e = 0; e < 4; ++e) {
                        const int rowc = 32 * rt + e + 8 * g4; const float rs = *(const LAS float*)(lds + sb + (unsigned)(rowc * 4));
#pragma unroll
                        for (int ct = 0; ct < 4; ++ct) *(float*)(oblk + (eo2 + (unsigned)((rowc * D + 32 * ct) * 4))) = (xv[e][ct] + gate[ct] * acc[rt][ct][4 * g4 + e]) * rs * fwv[ct];
                    }
                    asm volatile("" ::: "memory"); __builtin_amdgcn_sched_barrier(0);
                }
        }
#endif
    }
}

__global__ void __launch_bounds__(NTHR, 2) hybrid_fwd(Args args) {
    extern __shared__ __attribute__((aligned(16))) unsigned char lds_raw[];
    LAS unsigned char* lds = (LAS unsigned char*)lds_raw;
    const int wave = __builtin_amdgcn_readfirstlane((int)threadIdx.x >> 6), G = gridDim.x; const int tid = 0, lane = 0;
    cg::grid_group grid = cg::this_grid();
    const int lo = args.ph_lo, hi = args.ph_hi;
#ifndef PHMASK
#define PHMASK 31
#endif
#define IN(k) (((PHMASK >> (k)) & 1) && lo <= (k) && (k) < hi)
#define SEAM(k) do { if (IN(k) && IN((k) + 1)) grid.sync(); } while (0)
#ifndef REPEAT_MASK
#define REPEAT_MASK 0
#endif
#define REP(k) _Pragma("nounroll") for (int rep_ = 0; rep_ < 1 + ((REPEAT_MASK >> (k)) & 1); ++rep_)
    if (IN(0)) REP(0) { if (rep_) grid.sync(); p0_phase(args, lds, tid, lane, wave, G); }
    SEAM(0);
    if (IN(1)) REP(1) { if (rep_) grid.sync(); p1_phase(args, lds, tid, lane, wave, G); }
    SEAM(1);
    if (IN(2)) REP(2) {
        if (rep_) grid.sync();
        __syncthreads();
        pg8::Gemm g{(const pg8::bf16_t*)((const unsigned char*)args.out + OUT_H), (const pg8::bf16_t*)((const unsigned char*)args.out + OUT_WINT), MTOK, NP, D};
        pg8::StaticOrder S; S.init(MTOK, NP, G, (int)blockIdx.x);
        pg8::EpiProj E{(pg8::bf16_t*)(args.ws + WS_PROJ), NP};
        pg8::gemm_phase<pg8::EpiProj, pg8::StaticOrder, true, true>(lds, g, S, E, wave);
    }
    SEAM(2);
    if (IN(3)) { if ((REPEAT_MASK >> 3) & 1) { p3_phase(args, lds, tid, lane, wave, G, true); grid.sync(); } p3_phase(args, lds, tid, lane, wave, G); }
    SEAM(3);
    if (IN(4)) REP(4) { if (rep_) grid.sync(); p4_phase(args, lds, tid, lane, wave, G); }
#undef REP
#undef IN
#undef SEAM
}

extern "C" void kernel_launch(void* const* d_in, const int* in_sizes, int n_in, void* d_out, int out_size, void* d_ws, size_t ws_size, hipStream_t stream) {
    static int grid = 0;
    if (grid == 0) {
        if (n_in != 16 || out_size != MTOK * D || ws_size < WS_END) { fprintf(stderr, "kernel_launch: unexpected shapes (n_in %d out %d ws %zu)\n", n_in, out_size, ws_size); grid = -1; return; }
        int dev = 0, cus = 0, per_cu = 0;
        (void)hipGetDevice(&dev);
        (void)hipDeviceGetAttribute(&cus, hipDeviceAttributeMultiprocessorCount, dev);
        if (hipFuncSetAttribute((const void*)hybrid_fwd, hipFuncAttributeMaxDynamicSharedMemorySize, LDS_BYTES) != hipSuccess) { fprintf(stderr, "kernel_launch: hipFuncSetAttribute failed\n"); grid = -1; return; }
        if (hipOccupancyMaxActiveBlocksPerMultiprocessor(&per_cu, (const void*)hybrid_fwd, NTHR, LDS_BYTES) != hipSuccess || per_cu < 1) { fprintf(stderr, "kernel_launch: occupancy query says %d\n", per_cu); per_cu = 1; }
        (void)hipGetLastError();
        grid = cus * per_cu;
        if (grid > 256) grid = 256;
        if (grid < 1) grid = 1;
    }
    if (grid < 0) return;
    Args a{};
    for (int i = 0; i < 16; ++i) a.in[i] = (const float*)d_in[i];
    a.out = (float*)d_out; a.ws = (unsigned char*)d_ws;
#if N_LAUNCHES == 1
    a.ph_lo = 0; a.ph_hi = NPH;
    void* kargs[] = {&a};
    hipError_t e = hipLaunchCooperativeKernel((const void*)hybrid_fwd, dim3(grid), dim3(NTHR), kargs, LDS_BYTES, stream);
    if (e != hipSuccess) fprintf(stderr, "kernel_launch: cooperative launch failed: %s (grid %d)\n", hipGetErrorString(e), grid);
#else
    for (int p = 0; p < NPH; ++p) {
        a.ph_lo = p; a.ph_hi = p + 1;
        hipLaunchKernelGGL(hybrid_fwd, dim3(grid), dim3(NTHR), LDS_BYTES, stream, a);
    }
#endif
}
```

```cpp
#include <hip/hip_runtime.h>
#include <hip/hip_cooperative_groups.h>
#include <cstdio>
#include <cstdint>
namespace cg = cooperative_groups;
#define N_LAUNCHES 1
#define REPEAT_MASK 0
#define P4_REP2 1
__device__ __forceinline__ unsigned launder(unsigned v) { asm volatile("" : "+v"(v)); return v; }
__device__ __forceinline__ int fresh_lane() { unsigned z; asm volatile("v_mov_b32 %0, 0" : "=v"(z)); return (int)__builtin_amdgcn_mbcnt_hi(~0u, __builtin_amdgcn_mbcnt_lo(~0u, z)); }
namespace pg8 {
#define PG8_LAS __attribute__((address_space(3)))
typedef unsigned short bf16_t;
typedef short bf16x8 __attribute__((ext_vector_type(8)));
typedef float f32x4 __attribute__((ext_vector_type(4)));
typedef unsigned u32x4 __attribute__((ext_vector_type(4)));
constexpr int BM = 256, BK = 64, HALF = 128, HTB = HALF * BK * 2  , STAGE_BYTES = 8 * HTB, NXCD = 8, WGM = 8;

__host__ __device__ __forceinline__ int lds_byte(int r, int c) { const int st = (r >> 4) * 2 + (c >> 5), rr = r & 15, cc = c & 31, ob = rr * 64 + cc * 2; return st * 1024 + (ob ^ (((ob >> 9) & 1) << 5)); }
__host__ __device__ __forceinline__ void stage_rc(int b, int& R, int& C) { const int st = b / 1024, sb = b % 1024, swz = sb ^ (((sb >> 9) & 1) << 5); R = (st >> 1) * 16 + swz / 64; C = (st & 1) * 32 + (swz % 64) / 2; }
__host__ __device__ __forceinline__ int perm32(int rho) { const int n = rho >> 4, i = rho & 15; return 8 * (i >> 2) + 4 * n + (i & 3); }

struct Unit { int pm, pn; };
struct Gemm { const bf16_t* A; const bf16_t* Bt; int M, N, K; };

struct StaticOrder {
    int nM, nN, nwg, G, c;
    __host__ __device__ void init(int M, int N, int G_, int c_) { nM = M / BM; nN = N / BM; nwg = nM * nN; G = G_; c = c_; }
    __host__ __device__ bool next(int i, Unit& u) const {
        const long L = (long)i * G + c; if (L >= nwg) return false;
        int wgid = (int)L; { const int q = nwg / NXCD, r = nwg % NXCD, xcd = wgid % NXCD, off = wgid / NXCD; wgid = (xcd < r ? xcd * (q + 1) : r * (q + 1) + (xcd - r) * q) + off; }
        const int nig = WGM * nN, gid = wgid / nig, fm = gid * WGM, gsz = (nM - fm) < WGM ? (nM - fm) : WGM;
        u.pm = fm + ((wgid % nig) % gsz); u.pn = (wgid % nig) / gsz; return true;
    }
    __device__ __forceinline__ void a_ready(const Unit&) const {}
    __device__ __forceinline__ void done(const Unit&) const {}
};
__device__ __forceinline__ unsigned cvt_pk_bf16(float lo, float hi) { unsigned r; asm volatile("v_cvt_pk_bf16_f32 %0, %1, %2" : "=v"(r) : "v"(lo), "v"(hi)); return r; }
struct EpiProj {
    static constexpr bool PERM = true, AFTER_DRAIN = false;
    bf16_t* O; int ldc;
    __device__ __forceinline__ void operator()(const f32x4 (&acc)[2][2][4][2], const Unit& u, int wr, int wc, int fr, int fq) const {
        const int row0 = u.pm * BM + wr * 64 + fr; const int col0 = u.pn * BM + wc * 32 + 8 * fq;
#pragma unroll
        for (int ai = 0; ai < 2; ++ai)
#pragma unroll
            for (int m = 0; m < 4; ++m) { bf16_t* rowp = O + (size_t)(row0 + ai * HALF + m * 16) * ldc + col0;
#pragma unroll
                for (int bj = 0; bj < 2; ++bj) { const f32x4 v0 = acc[ai][bj][m][0], v1 = acc[ai][bj][m][1];
                    u32x4 w; w.x = cvt_pk_bf16(v0[0], v0[1]); w.y = cvt_pk_bf16(v0[2], v0[3]); w.z = cvt_pk_bf16(v1[0], v1[1]); w.w = cvt_pk_bf16(v1[2], v1[3]);
                    *(u32x4*)(rowp + bj * HALF) = w; } }
    }
    __device__ __forceinline__ void fused(f32x4 (&)[2][2][4][2], const Unit&, int, int, int, int, PG8_LAS unsigned char*, int, int) const {}
};
template <class Epi, class Sched, bool ALIGN_EPI = false, bool SP2 = false>
__device__ __forceinline__ void gemm_phase(PG8_LAS unsigned char* lds, const Gemm g, const Sched& S, const Epi& E, const int wid) {
    const int lane = ::fresh_lane(), tid = wid * 64 + lane, wr = wid >> 2, wc = wid & 3, fr = lane & 15, fq = lane >> 4;
    const int K = g.K, nt = K / BK;
    unsigned voffA[2], voffB[2];
#pragma unroll
    for (int i = 0; i < 2; ++i) { int R, C; stage_rc(tid * 16 + i * 8192, R, C); const int Rb = Epi::PERM ? ((R & ~31) + perm32(R & 31)) : R;
        voffA[i] = (unsigned)(R * K + C) * 2u; voffB[i] = (unsigned)(Rb * K + C) * 2u; }
    const size_t kstep = (size_t)(BK * 2);
    const size_t hstep = (size_t)HALF * K * 2;
    const size_t tstep = 2 * hstep;
    const unsigned ldsw = (unsigned)wid * 1024u;
    const int aoff = lds_byte(wr * 64 + fr, fq * 8), boff = lds_byte(wc * 32 + fr, fq * 8);
#define PG8_SA(b, h) (((b) * 2 + (h)) * HTB)
#define PG8_SB(b, h) ((4 + (b) * 2 + (h)) * HTB)
#define PG8_STAGE(bufoff, gbase, voff) do { _Pragma("unroll") for (int _i = 0; _i < 2; ++_i) \
        __builtin_amdgcn_global_load_lds((const unsigned*)((const char*)(gbase) + (voff)[_i]), (PG8_LAS unsigned*)(lds + (bufoff) + ldsw + _i * 8192), 16, 0, 0); } while (0)
#define PG8_LDA(dst, b, h) do { _Pragma("unroll") for (int m = 0; m < 4; ++m) _Pragma("unroll") for (int k = 0; k < 2; ++k) dst[m][k] = *(const PG8_LAS bf16x8*)(lds + PG8_SA(b, h) + aoff + m * 2048 + k * 1024); } while (0)
#define PG8_LDB(dst, b, h) do { _Pragma("unroll") for (int n = 0; n < 2; ++n) _Pragma("unroll") for (int k = 0; k < 2; ++k) dst[n][k] = *(const PG8_LAS bf16x8*)(lds + PG8_SB(b, h) + boff + n * 2048 + k * 1024); } while (0)
#define PG8_MMA(ai, bj, At, Bt) do { __builtin_amdgcn_s_setprio(1); _Pragma("unroll") for (int m = 0; m < 4; ++m) _Pragma("unroll") for (int n = 0; n < 2; ++n) _Pragma("unroll") for (int k = 0; k < 2; ++k) \
        acc[ai][bj][m][n] = __builtin_amdgcn_mfma_f32_16x16x32_bf16(Bt[n][k], At[m][k], acc[ai][bj][m][n], 0, 0, 0); __builtin_amdgcn_s_setprio(0); } while (0)
#define PG8_WAIT_V(n) asm volatile("s_waitcnt vmcnt(" #n ")" ::: "memory")
#define PG8_WAIT_L(n) asm volatile("s_waitcnt lgkmcnt(" #n ")" ::: "memory")
#define PG8_BAR __builtin_amdgcn_s_barrier()
#define PG8_SCHED __builtin_amdgcn_sched_barrier(0)
    Unit cur, nxt; int ui = 0;
    if (!S.next(0, cur)) return;
    f32x4 acc[2][2][4][2];
#pragma unroll
    for (int a = 0; a < 2; ++a)
#pragma unroll
        for (int b = 0; b < 2; ++b)
#pragma unroll
            for (int m = 0; m < 4; ++m)
#pragma unroll
                for (int n = 0; n < 2; ++n) acc[a][b][m][n] = (f32x4){0.f, 0.f, 0.f, 0.f};
    bf16x8 At[4][2], B0[2][2], B1[2][2];
    const char* cA = (const char*)g.A + (size_t)cur.pm * tstep; const char* cB = (const char*)g.Bt + (size_t)cur.pn * tstep;
    S.a_ready(cur);
    if constexpr (SP2) {
        PG8_STAGE(PG8_SB(0, 0), cB, voffB); PG8_STAGE(PG8_SB(0, 1), cB + hstep, voffB); PG8_STAGE(PG8_SA(0, 0), cA, voffA); PG8_STAGE(PG8_SA(0, 1), cA + hstep, voffA);
        if (wr == 1) PG8_BAR;
        PG8_WAIT_V(2); PG8_BAR;
        PG8_STAGE(PG8_SB(1, 0), cB + kstep, voffB); PG8_STAGE(PG8_SA(1, 0), cA + kstep, voffA); PG8_STAGE(PG8_SB(1, 1), cB + hstep + kstep, voffB);
        PG8_WAIT_V(6); PG8_BAR;
    } else {
        PG8_STAGE(PG8_SB(0, 0), cB, voffB); PG8_STAGE(PG8_SA(0, 0), cA, voffA); PG8_STAGE(PG8_SB(0, 1), cB + hstep, voffB); PG8_STAGE(PG8_SA(0, 1), cA + hstep, voffA);
        if (wr == 1) PG8_BAR;
        PG8_WAIT_V(4); PG8_BAR;
        PG8_STAGE(PG8_SB(1, 0), cB + kstep, voffB); PG8_STAGE(PG8_SA(1, 0), cA + kstep, voffA); PG8_STAGE(PG8_SB(1, 1), cB + hstep + kstep, voffB);
        PG8_WAIT_V(6); PG8_BAR;
    }
    for (;;) {
        const bool has_next = S.next(ui + 1, nxt);
        const char* nA = has_next ? (const char*)g.A + (size_t)nxt.pm * tstep : cA; const char* nB = has_next ? (const char*)g.Bt + (size_t)nxt.pn * tstep : cB;
        for (int t = 0; t < nt; t += 2) {
            const bool last = (t == nt - 2);
            const char* a1 = cA + (size_t)(t + 1) * kstep;
            const char* a2 = last ? nA : cA + (size_t)(t + 2) * kstep; const char* b2 = last ? nB : cB + (size_t)(t + 2) * kstep;
            const char* a3 = a2 + kstep; const char* b3 = b2 + kstep;
            if (last && has_next) S.a_ready(nxt);
            if constexpr (SP2) {
            PG8_LDB(B0, 0, 0); PG8_LDB(B1, 0, 1); PG8_SCHED; PG8_LDA(At, 0, 0); PG8_STAGE(PG8_SA(1, 1), a1 + hstep, voffA);
            PG8_WAIT_V(8); PG8_WAIT_L(0); PG8_BAR; PG8_MMA(0, 0, At, B0); PG8_MMA(0, 1, At, B1); PG8_BAR; PG8_SCHED;
            PG8_LDA(At, 0, 1); PG8_STAGE(PG8_SB(0, 0), b2, voffB); PG8_STAGE(PG8_SB(0, 1), b2 + hstep, voffB); PG8_STAGE(PG8_SA(0, 0), a2, voffA);
            PG8_WAIT_V(8); PG8_WAIT_L(0); PG8_BAR; PG8_MMA(1, 0, At, B0); PG8_MMA(1, 1, At, B1); PG8_BAR; PG8_SCHED;
            PG8_LDB(B0, 1, 0); PG8_LDB(B1, 1, 1); PG8_SCHED; PG8_LDA(At, 1, 0); PG8_STAGE(PG8_SA(0, 1), a2 + hstep, voffA);
            PG8_WAIT_V(8); PG8_WAIT_L(0); PG8_BAR; PG8_MMA(0, 0, At, B0); PG8_MMA(0, 1, At, B1); PG8_BAR; PG8_SCHED;
            PG8_LDA(At, 1, 1); PG8_STAGE(PG8_SB(1, 0), b3, voffB); PG8_STAGE(PG8_SB(1, 1), b3 + hstep, voffB); PG8_STAGE(PG8_SA(1, 0), a3, voffA);
            PG8_WAIT_V(8); PG8_WAIT_L(0); PG8_BAR; PG8_MMA(1, 0, At, B0); PG8_MMA(1, 1, At, B1); PG8_BAR; PG8_SCHED;
            } else {
            PG8_LDB(B0, 0, 0); PG8_SCHED; PG8_LDA(At, 0, 0); PG8_STAGE(PG8_SA(1, 1), a1 + hstep, voffA);
            PG8_WAIT_L(8); PG8_BAR; PG8_WAIT_L(0); PG8_MMA(0, 0, At, B0); PG8_BAR; PG8_SCHED;
            PG8_LDB(B1, 0, 1); PG8_STAGE(PG8_SB(0, 0), b2, voffB);
            PG8_BAR; PG8_WAIT_L(0); PG8_MMA(0, 1, At, B1); PG8_BAR;
            PG8_LDA(At, 0, 1); PG8_STAGE(PG8_SA(0, 0), a2, voffA);
            PG8_BAR; PG8_WAIT_L(0); PG8_MMA(1, 0, At, B0); PG8_BAR; PG8_SCHED;
            PG8_STAGE(PG8_SB(0, 1), b2 + hstep, voffB);
            PG8_WAIT_V(6); PG8_BAR; PG8_MMA(1, 1, At, B1); PG8_BAR;
            PG8_LDB(B0, 1, 0); PG8_SCHED; PG8_LDA(At, 1, 0); PG8_STAGE(PG8_SA(0, 1), a2 + hstep, voffA);
            PG8_WAIT_L(8); PG8_BAR; PG8_WAIT_L(0); PG8_MMA(0, 0, At, B0); PG8_BAR; PG8_SCHED;
            PG8_LDB(B1, 1, 1); PG8_STAGE(PG8_SB(1, 0), b3, voffB);
            PG8_BAR; PG8_WAIT_L(0); PG8_MMA(0, 1, At, B1); PG8_BAR;
            PG8_LDA(At, 1, 1); PG8_STAGE(PG8_SA(1, 0), a3, voffA);
            PG8_BAR; PG8_WAIT_L(0); PG8_MMA(1, 0, At, B0); PG8_BAR; PG8_SCHED;
            PG8_STAGE(PG8_SB(1, 1), b3 + hstep, voffB);
            PG8_WAIT_V(6); PG8_BAR; PG8_MMA(1, 1, At, B1); PG8_BAR;
            }
        }
        if constexpr (ALIGN_EPI) { if (wr == 0) PG8_BAR; }
        if constexpr (!Epi::AFTER_DRAIN) { E(acc, cur, wr, wc, fr, fq); S.done(cur); }
        if (!has_next) break;
#pragma unroll
        for (int a = 0; a < 2; ++a)
#pragma unroll
            for (int b = 0; b < 2; ++b)
#pragma unroll
                for (int m = 0; m < 4; ++m)
#pragma unroll
                    for (int n = 0; n < 2; ++n) acc[a][b][m][n] = (f32x4){0.f, 0.f, 0.f, 0.f};
        cur = nxt; cA = nA; cB = nB; ++ui;
        if constexpr (ALIGN_EPI) { if (wr == 1) PG8_BAR; }
    }
    PG8_WAIT_V(0);
    if constexpr (!ALIGN_EPI) { if (wr == 0) PG8_BAR; }
    PG8_BAR;
    if constexpr (Epi::AFTER_DRAIN) { E.fused(acc, cur, wr, wc, fr, fq, lds, wid, lane); S.done(cur); }
#undef PG8_SA
#undef PG8_SB
#undef PG8_STAGE
#undef PG8_LDA
#undef PG8_LDB
#undef PG8_MMA
#undef PG8_WAIT_V
#undef PG8_WAIT_L
#undef PG8_BAR
#undef PG8_SCHED
}
}

#define LAS __attribute__((address_space(3)))
typedef unsigned short bf16;
typedef short bf16x8 __attribute__((ext_vector_type(8)));
typedef short s16x4 __attribute__((ext_vector_type(4)));
typedef float f32x4 __attribute__((ext_vector_type(4)));
typedef float f32x16 __attribute__((ext_vector_type(16)));
typedef unsigned u32x4 __attribute__((ext_vector_type(4)));
typedef unsigned u32x2 __attribute__((ext_vector_type(2)));
typedef float f32x2_t __attribute__((ext_vector_type(2)));
typedef __bf16 bf16x2_t __attribute__((ext_vector_type(2)));

#ifndef N_LAUNCHES
#define N_LAUNCHES 1
#endif
constexpr int NPH = 5;
constexpr int D = 1024, NB = 8, SEQ = 2048, MTOK = NB * SEQ, NIN = 7440, NP = 7424;
constexpr int C_Z = 0, C_X = 1024, C_B = 2048, C_C = 2176, C_Q = 2304, C_K = 2816, C_V = 3328, C_GR = 4352, C_GAM = 5376, C_GAR = 6400;
constexpr float EPS = 1e-6f;
constexpr size_t MiB = 1u << 20;
constexpr size_t WS_PROJ = 0;
constexpr size_t WS_WMF = 232 * MiB, WS_WRF = 234 * MiB, WS_WOF = 236 * MiB;
constexpr size_t WS_MOD = 238 * MiB;
constexpr size_t WS_DT = 239 * MiB;
constexpr size_t WS_SSQM = 240 * MiB;
constexpr size_t WS_SSQR = 242 * MiB;
constexpr size_t WS_CTL = 244 * MiB, CTL_BYTES = 16384;
constexpr size_t WS_END = 245 * MiB;
constexpr size_t OUT_H = 0, OUT_WINT = 32 * MiB;
constexpr int LDS_BYTES = 155648, LDS_MISC = 155520;
constexpr int NTHR = 512;

struct Args { const float* in[16]; float* out; unsigned char* ws; int ph_lo, ph_hi; };

__device__ __forceinline__ float bf_lo(unsigned u) { return __uint_as_float(u << 16); }
__device__ __forceinline__ float bf_hi(unsigned u) { return __uint_as_float(u & 0xffff0000u); }
__device__ __forceinline__ unsigned pk2(float lo, float hi) { f32x2_t v = {lo, hi}; bf16x2_t b = __builtin_convertvector(v, bf16x2_t); return __builtin_bit_cast(unsigned, b); }
__device__ __forceinline__ float silu_f(float x) { return x * __builtin_amdgcn_rcpf(1.f + __expf(-x)); }
__device__ __forceinline__ float sigm_f(float x) { return __builtin_amdgcn_rcpf(1.f + __expf(-x)); }
__device__ __forceinline__ float wave_sum(float v) {
#pragma unroll
    for (int o = 1; o < 64; o <<= 1) v += __shfl_xor(v, o);
    return v;
}
__device__ __forceinline__ int crow(int reg, int h) { return (reg & 3) + 8 * (reg >> 2) + 4 * h; }
#define MFMA32(a, b, c) __builtin_amdgcn_mfma_f32_32x32x16_bf16((a), (b), (c), 0, 0, 0)
__device__ __forceinline__ s16x4 tr_read(const LAS unsigned char* p) {
    typedef short v4i16_t __attribute__((ext_vector_type(4)));
    return __builtin_bit_cast(s16x4, __builtin_amdgcn_ds_read_tr16_b64_v4i16((LAS v4i16_t*)p));
}
__device__ __forceinline__ bf16x8 tr_pair(const LAS unsigned char* plo, const LAS unsigned char* phi) {
    const s16x4 lo = tr_read(plo), hi = tr_read(phi);
    return __builtin_shufflevector(lo, hi, 0, 1, 2, 3, 4, 5, 6, 7);
}
__device__ __forceinline__ bf16x8 pack8(float a0, float a1, float a2, float a3, float a4, float a5, float a6, float a7) {
    u32x4 p; p.x = pk2(a0, a1); p.y = pk2(a2, a3); p.z = pk2(a4, a5); p.w = pk2(a6, a7);
    return __builtin_bit_cast(bf16x8, p);
}

__device__ __forceinline__ void p0_load_tile(const float* W, int ldw, int k0, int n0, LAS float* scr, int lane) {
    float t[32];
#pragma unroll
    for (int i = 0; i < 32; ++i) t[i] = W[(size_t)(k0 + 2 * i + (lane >> 5)) * ldw + n0 + (lane & 31)];
#pragma unroll
    for (int i = 0; i < 32; ++i) scr[(2 * i + (lane >> 5)) * 33 + (lane & 31)] = t[i];
}
__device__ __forceinline__ void p0_phase(const Args& a, LAS unsigned char* lds, int tid_unused, int lane_unused, int wave, int G) {
    const int lane = fresh_lane(), tid = wave * 64 + lane;
    const float* cvec = a.in[1]; const float* w_ada = a.in[2]; const float* b_ada = a.in[3];
    float* MOD = (float*)(a.ws + WS_MOD);
    LAS float* cT = (LAS float*)lds;
    LAS float* red = (LAS float*)(lds + 32768);
    if ((int)blockIdx.x < 192) {
        { float t[16];
#pragma unroll
          for (int i = 0; i < 16; ++i) t[i] = cvec[tid + 512 * i];
#pragma unroll
          for (int i = 0; i < 16; ++i) { const int idx = tid + 512 * i; cT[(idx & 1023) * 8 + (idx >> 10)] = t[i]; } }
        __syncthreads();
        for (int item = blockIdx.x; item < 192; item += G) {
            const int j0 = item * 16, col = lane & 15, rsub = lane >> 4, kq = wave;
            float w[32];
#pragma unroll
            for (int i = 0; i < 32; ++i) w[i] = w_ada[(size_t)(kq * 128 + 4 * i + rsub) * 3072 + j0 + col];
            float acc[8];
#pragma unroll
            for (int bb = 0; bb < 8; ++bb) acc[bb] = 0.f;
#pragma unroll
            for (int i = 0; i < 32; ++i) { const int k = kq * 128 + 4 * i + rsub;
                const f32x4 c0 = *(const LAS f32x4*)(cT + k * 8), c1 = *(const LAS f32x4*)(cT + k * 8 + 4);
                acc[0] += c0.x * w[i]; acc[1] += c0.y * w[i]; acc[2] += c0.z * w[i]; acc[3] += c0.w * w[i];
                acc[4] += c1.x * w[i]; acc[5] += c1.y * w[i]; acc[6] += c1.z * w[i]; acc[7] += c1.w * w[i]; }
#pragma unroll
            for (int bb = 0; bb < 8; ++bb) { acc[bb] += __shfl_xor(acc[bb], 16); acc[bb] += __shfl_xor(acc[bb], 32); }
            if (lane < 16) {
#pragma unroll
                for (int bb = 0; bb < 8; ++bb) red[(kq * 8 + bb) * 16 + col] = acc[bb]; }
            __syncthreads();
            if (tid < 128) { const int bb = tid >> 4, cc = tid & 15; float sum = 0.f;
#pragma unroll
                for (int q = 0; q < 8; ++q) sum += red[(q * 8 + bb) * 16 + cc];
                MOD[bb * 3072 + j0 + cc] = sum + b_ada[j0 + cc]; }
            __syncthreads();
        }
    }
    LAS float* scr = (LAS float*)(lds + 40960 + wave * 8448);
    const int gw = blockIdx.x * 8 + wave, NGW = G * 8;
    constexpr int I_IN = 16 * (NP / 32), I_W = 16 * 32;
    bf16* WINT = (bf16*)((unsigned char*)a.out + OUT_WINT);
    for (int it = gw; it < I_IN + 3 * I_W; it += NGW) {
        if (it < I_IN) {
            const int nblk = NP / 32, kb = it / nblk, nb = it % nblk, k0 = 64 * kb, n0p = 32 * nb, n0 = n0p + (n0p >= 2304 ? 16 : 0);
            p0_load_tile(a.in[5], NIN, k0, n0, scr, lane);
            const int c = lane & 7;
#pragma unroll
            for (int j = 0; j < 4; ++j) { const int n = (lane >> 3) + 8 * j; const LAS float* s = scr + (8 * c) * 33 + n;
                u32x4 o; o.x = pk2(s[0 * 33], s[1 * 33]); o.y = pk2(s[2 * 33], s[3 * 33]); o.z = pk2(s[4 * 33], s[5 * 33]); o.w = pk2(s[6 * 33], s[7 * 33]);
                *(u32x4*)(WINT + (size_t)(n0p + n) * 1024 + k0 + 8 * c) = o; }
        } else {
            int r_ = it - I_IN; const int which = r_ / I_W; r_ -= which * I_W;
            const float* W = a.in[12 + which];
            bf16* WF = (bf16*)(a.ws + WS_WMF + (size_t)which * 2 * MiB);
            const int nt = r_ & 31, kb = r_ >> 5;
            p0_load_tile(W, 1024, 64 * kb, 32 * nt, scr, lane);
            const int r = lane & 31, h = lane >> 5;
#pragma unroll
            for (int s4 = 0; s4 < 4; ++s4) { const LAS float* s = scr + (16 * s4 + 8 * h) * 33 + r;
                u32x4 o; o.x = pk2(s[0 * 33], s[1 * 33]); o.y = pk2(s[2 * 33], s[3 * 33]); o.z = pk2(s[4 * 33], s[5 * 33]); o.w = pk2(s[6 * 33], s[7 * 33]);
                *(u32x4*)(WF + ((size_t)(nt * 64 + 4 * kb + s4) * 64 + lane) * 8) = o; }
        }
    }
}

__device__ __forceinline__ void p1_phase(const Args& a, LAS unsigned char* lds, int tid_unused, int lane_unused, int wave, int G) {
    const int lane_in = fresh_lane(), tid = wave * 64 + lane_in;
    const float* x = a.in[0]; const float* norm_w = a.in[4]; const float* w_in = a.in[5]; const float* dt_bias = a.in[8];
    const float* MOD = (const float*)(a.ws + WS_MOD);
    float* DT = (float*)(a.ws + WS_DT);
    bf16* H = (bf16*)((unsigned char*)a.out + OUT_H);
    LAS float* wdt = (LAS float*)lds;
    { float t[32];
#pragma unroll
      for (int i = 0; i < 32; ++i) { const int idx = tid + NTHR * i; t[i] = w_in[(size_t)(idx >> 4) * NIN + 2304 + (idx & 15)]; }
#pragma unroll
      for (int i = 0; i < 32; ++i) { const int idx = tid + NTHR * i; wdt[(idx & 15) * 1028 + (idx >> 4)] = t[i]; } }
    __syncthreads();
    for (int blk = blockIdx.x; blk < 256; blk += G) {
        const int b = blk >> 5;
        float gk[16], sh[16];
#pragma unroll
        for (int jj = 0; jj < 4; ++jj) { const int k = 4 * lane_in + 256 * jj;
            const f32x4 nw = *(const f32x4*)(norm_w + k), sc = *(const f32x4*)(MOD + b * 3072 + 1024 + k), sf = *(const f32x4*)(MOD + b * 3072 + k);
#pragma unroll
            for (int e = 0; e < 4; ++e) { gk[4 * jj + e] = nw[e] * (1.f + sc[e]); sh[4 * jj + e] = sf[e]; } }
        f32x4 vn[2][4];
        { const int lane = fresh_lane();
#pragma unroll
          for (int rr = 0; rr < 2; ++rr)
#pragma unroll
              for (int jj = 0; jj < 4; ++jj) vn[rr][jj] = *((const f32x4*)(x + (size_t)(blk * 64 + wave * 8 + rr) * D) + lane + 64 * jj); }
        for (int g = 0; g < 4; ++g) {
            asm volatile("" ::: "memory");
            const int lane = fresh_lane();
            const int m0 = blk * 64 + wave * 8 + g * 2;
            f32x4 v[2][4];
#pragma unroll
            for (int rr = 0; rr < 2; ++rr)
#pragma unroll
                for (int jj = 0; jj < 4; ++jj) v[rr][jj] = vn[rr][jj];
            if (g + 1 < 4) {
#pragma unroll
                for (int rr = 0; rr < 2; ++rr)
#pragma unroll
                    for (int jj = 0; jj < 4; ++jj) vn[rr][jj] = *((const f32x4*)(x + (size_t)(m0 + 2 + rr) * D) + lane + 64 * jj);
            }
            __builtin_amdgcn_sched_barrier(0);
            float hv[2][16];
#pragma unroll
            for (int rr = 0; rr < 2; ++rr) {
                float ss = 0.f;
#pragma unroll
                for (int jj = 0; jj < 4; ++jj) ss += (v[rr][jj].x * v[rr][jj].x + v[rr][jj].y * v[rr][jj].y) + (v[rr][jj].z * v[rr][jj].z + v[rr][jj].w * v[rr][jj].w);
                const float rs = 1.0f / sqrtf(wave_sum(ss) * (1.f / D) + EPS);
                unsigned long long* o8 = (unsigned long long*)(H + (size_t)(m0 + rr) * D) + lane;
#pragma unroll
                for (int jj = 0; jj < 4; ++jj) {
#pragma unroll
                    for (int e = 0; e < 4; ++e) hv[rr][4 * jj + e] = v[rr][jj][e] * rs * gk[4 * jj + e] + sh[4 * jj + e];
                    o8[64 * jj] = (unsigned long long)pk2(hv[rr][4 * jj], hv[rr][4 * jj + 1]) | ((unsigned long long)pk2(hv[rr][4 * jj + 2], hv[rr][4 * jj + 3]) << 32);
                }
            }
            float acc[32];
#pragma unroll
            for (int i = 0; i < 32; ++i) acc[i] = 0.f;
#pragma unroll
            for (int j = 0; j < 16; ++j) {
#pragma unroll
                for (int jj = 0; jj < 4; ++jj) { const f32x4 w = *(const LAS f32x4*)(wdt + j * 1028 + 4 * lane + 256 * jj);
#pragma unroll
                    for (int rr = 0; rr < 2; ++rr) acc[rr * 16 + j] += (hv[rr][4 * jj] * w.x + hv[rr][4 * jj + 1] * w.y) + (hv[rr][4 * jj + 2] * w.z + hv[rr][4 * jj + 3] * w.w); }
                if ((j & 3) == 3) asm volatile("" ::: "memory");
            }
#pragma unroll
            for (int half = 16; half >= 1; half >>= 1) {
                const bool up = (lane & half) != 0;
#pragma unroll
                for (int i = 0; i < half; ++i) { float lo_ = acc[i], hi_ = acc[i + half]; asm volatile("" : "+v"(lo_), "+v"(hi_));
                    const float keep = up ? hi_ : lo_, send = up ? lo_ : hi_; acc[i] = keep + __shfl_xor(send, half); }
            }
            const float tot = acc[0] + __shfl_xor(acc[0], 32);
            const float xr_ = tot + dt_bias[lane & 15];
            const float dtv = xr_ > 20.f ? xr_ : log1pf(__expf(xr_));
            if (lane < 32) DT[(size_t)m0 * 16 + lane] = dtv;
        }
    }
}

constexpr int TP = 72;
constexpr int L_CQ = 0, L_BK = 18432, L_BKW = 36864, L_XV = 55296, L_ST0 = 73728, L_ST1 = 82944, L_ACS = 92160, L_DTJ = 93184, L_WJ = 94208, L_CW = 95232;

__device__ __forceinline__ void p3_phase(const Args& a, LAS unsigned char* lds, int tid_in, int lane_in, int wave, int G, const bool dry = false) {
    bf16* PROJ = (bf16*)(a.ws + WS_PROJ);
    const float* DT = (const float*)(a.ws + WS_DT);
    float* SSQM = (float*)(a.ws + WS_SSQM); float* SSQR = (float*)(a.ws + WS_SSQR);
    const float* conv_w = a.in[6]; const float* conv_b = a.in[7]; const float* a_log = a.in[9]; const float* d_skip = a.in[10]; const float* m_norm_w = a.in[11];
    const int pt = wave & 1, it = wave >> 1;
    for (int item = blockIdx.x; item < 256; item += G) {
        const int lane = fresh_lane(), tid = wave * 64 + lane;
        const int r = lane & 31, h = lane >> 5, i16 = lane & 15, q4 = i16 >> 2, p4 = i16 & 3, blk16 = (lane >> 4) & 1;
        const bool ssd = item < 128;
        int b, hd, half;
        if (ssd) { b = item >> 4; hd = item & 15; half = 0; } else { const int t = item - 128; b = t >> 4; hd = (t >> 1) & 7; half = t & 1; }
        const size_t mb = (size_t)b * SEQ;
        __syncthreads();
        for (int idx = tid; idx < 9216 / 4; idx += NTHR) ((LAS unsigned*)(lds + L_ST0))[idx] = 0u;
        const float lg = ssd ? 0.f : log1pf(-exp2f(-5.0f - (float)hd));
        if (!ssd && tid < 256) { const int par = tid >> 7, j = tid & 127;
            ((LAS float*)(lds + L_ACS))[par * 128 + j] = (float)(j + 1) * lg; ((LAS float*)(lds + L_DTJ))[par * 128 + j] = 1.f; ((LAS float*)(lds + L_WJ))[par * 128 + j] = __expf((float)(127 - j) * lg); }
        const float Ah = ssd ? -__expf(a_log[hd]) : 0.f;
        const float Dsk = ssd ? d_skip[hd] : 0.f;
        const int ltile = tid >> 7, loct = tid & 7, ltg = (tid >> 3) & 15;
        int lcol = C_X;
        float invf[8];
        LAS float* cwl = (LAS float*)(lds + L_CW) + (ltile * 8 + loct) * 40;
        if (ssd) {
            lcol = (ltile == 0) ? (C_X + 64 * hd + 8 * loct) : (ltile == 1 ? (C_B + 64 * (hd >> 3) + 8 * loct) : (C_C + 64 * (hd >> 3) + 8 * loct));
            if (ltile == 3) lcol = C_X;
            if (tid < 384 && ltg == 0) {
#pragma unroll
                for (int e = 0; e < 8; ++e) { cwl[32 + e] = conv_b[lcol - 1024 + e];
#pragma unroll
                    for (int k = 0; k < 4; ++k) cwl[k * 8 + e] = conv_w[k * 1280 + lcol - 1024 + e]; }
            }
#pragma unroll
            for (int e = 0; e < 8; ++e) invf[e] = 0.f;
        } else {
#pragma unroll
            for (int e = 0; e < 8; ++e) invf[e] = exp2f(-(float)(8 * (tid & 3) + e) * (13.287712379549449f / 32.f));
        }
        f32x16 sacc;
#pragma unroll
        for (int i = 0; i < 16; ++i) sacc[i] = 0.f;
        u32x4 raw[11];
        const int rj = tid >> 2, ro4 = tid & 3;
        const int j0 = 8 * ltg;
        const char* pbase = (const char*)(PROJ + mb * NP);
        const unsigned soff = (unsigned)((j0 * NP + lcol) * 2);
        const unsigned roff = (unsigned)((rj * NP) * 2);
#define P3_ISSUE(cc) do { const char* cbp = pbase + (size_t)(cc) * (128 * NP * 2); \
        if (ssd) { _Pragma("unroll") for (int i = 0; i < 11; ++i) { const bool ok = ((cc) * 128 + j0 - 3 + i) >= 0 && tid < 384; \
                raw[i] = ok ? *(const u32x4*)(cbp + (long)soff + ((long)i - 3) * (NP * 2)) : (u32x4){0u, 0u, 0u, 0u}; } } \
        else { const char* rp = cbp + roff; \
            raw[0] = *(const u32x4*)(rp + (C_Q + 64 * hd + 8 * ro4) * 2); raw[1] = *(const u32x4*)(rp + (C_Q + 64 * hd + 32 + 8 * ro4) * 2); \
            raw[2] = *(const u32x4*)(rp + (C_K + 64 * hd + 8 * ro4) * 2); raw[3] = *(const u32x4*)(rp + (C_K + 64 * hd + 32 + 8 * ro4) * 2); \
            raw[4] = *(const u32x4*)(rp + (C_V + 128 * hd + 64 * half + 16 * ro4) * 2); raw[5] = *(const u32x4*)(rp + (C_V + 128 * hd + 64 * half + 16 * ro4 + 8) * 2); } } while (0)
        float dq0 = 0.f, dq1 = 0.f;
#define P3_SCAN(cc) do { LAS float* ACSw = (LAS float*)(lds + L_ACS) + ((cc) & 1) * 128; LAS float* DTJw = (LAS float*)(lds + L_DTJ) + ((cc) & 1) * 128; LAS float* WJw = (LAS float*)(lds + L_WJ) + ((cc) & 1) * 128; \
        const float v0 = dq0 * Ah, v1 = dq1 * Ah, s_ = v0 + v1; float incl = s_; \
        _Pragma("unroll") for (int o = 1; o < 64; o <<= 1) { const float t = __shfl_up(incl, o); if (lane >= o) incl += t; } \
        const float c0 = (incl - s_) + v0, tot = __shfl(incl, 63), c1 = (lane == 63) ? tot : c0 + v1; \
        ACSw[2 * lane] = c0; ACSw[2 * lane + 1] = c1; DTJw[2 * lane] = dq0; DTJw[2 * lane + 1] = dq1; \
        WJw[2 * lane] = dq0 * __expf(tot - c0); WJw[2 * lane + 1] = dq1 * __expf(tot - c1); } while (0)
#define P3_DTLOAD(cc) do { dq0 = DT[(mb + (size_t)(cc) * 128 + 2 * lane) * 16 + hd]; dq1 = DT[(mb + (size_t)(cc) * 128 + 2 * lane + 1) * 16 + hd]; } while (0)
        if (ssd && wave == 0) { P3_DTLOAD(0); P3_SCAN(0); P3_DTLOAD(1); }
        P3_ISSUE(0);

        for (int c = 0; c < 16; ++c) {
            const int par = c & 1;
            const size_t m0 = mb + (size_t)c * 128;
            LAS float* ACS = (LAS float*)(lds + L_ACS) + par * 128; LAS float* DTJ = (LAS float*)(lds + L_DTJ) + par * 128; LAS float* WJ = (LAS float*)(lds + L_WJ) + par * 128;
            __syncthreads();
            if (ssd) {
                if (tid < 384) {
                    LAS unsigned char* dst = lds + (ltile == 0 ? L_XV : (ltile == 1 ? L_BK : L_CQ));
                    float cw[4][8], cb[8];
#pragma unroll
                    for (int k = 0; k < 5; ++k) { const f32x4 t0 = *(const LAS f32x4*)(cwl + 8 * k), t1 = *(const LAS f32x4*)(cwl + 8 * k + 4);
#pragma unroll
                        for (int e = 0; e < 4; ++e) { if (k < 4) { cw[k][e] = t0[e]; cw[k][4 + e] = t1[e]; } else { cb[e] = t0[e]; cb[4 + e] = t1[e]; } } }
#pragma unroll
                    for (int jj = 0; jj < 8; ++jj) {
                        float o[8];
#pragma unroll
                        for (int e = 0; e < 8; ++e) {
                            float s_ = cb[e];
#pragma unroll
                            for (int k = 0; k < 4; ++k) { const unsigned w = raw[jj + k][e >> 1]; s_ += cw[k][e] * ((e & 1) ? bf_hi(w) : bf_lo(w)); }
                            o[e] = silu_f(s_);
                        }
                        u32x4 ov; ov.x = pk2(o[0], o[1]); ov.y = pk2(o[2], o[3]); ov.z = pk2(o[4], o[5]); ov.w = pk2(o[6], o[7]);
                        *(LAS u32x4*)(dst + ((j0 + jj) * TP + 8 * loct) * 2) = ov;
                        if (ltile == 1) { const float wj = WJ[j0 + jj];
                            u32x4 ow; ow.x = pk2(o[0] * wj, o[1] * wj); ow.y = pk2(o[2] * wj, o[3] * wj); ow.z = pk2(o[4] * wj, o[5] * wj); ow.w = pk2(o[6] * wj, o[7] * wj);
                            *(LAS u32x4*)(lds + L_BKW + ((j0 + jj) * TP + 8 * loct) * 2) = ow; }
                    }
                }
            } else {
                const int j = rj, o4 = ro4;
                const u32x4 q1 = raw[0], q2 = raw[1], k1 = raw[2], k2 = raw[3];
                const float pos = (float)(c * 128 + j), wj = WJ[j];
                float ql[8], qh[8], kl[8], kh[8];
#pragma unroll
                for (int e = 0; e < 8; ++e) {
                    const float rev = pos * invf[e] * 0.15915494309189535f, fr = rev - floorf(rev);
                    const float cs = __builtin_amdgcn_cosf(fr), sn = __builtin_amdgcn_sinf(fr);
                    const unsigned wq1 = q1[e >> 1], wq2 = q2[e >> 1], wk1 = k1[e >> 1], wk2 = k2[e >> 1];
                    const float a1 = (e & 1) ? bf_hi(wq1) : bf_lo(wq1), a2 = (e & 1) ? bf_hi(wq2) : bf_lo(wq2);
                    const float b1 = ((e & 1) ? bf_hi(wk1) : bf_lo(wk1)) * 0.125f, b2 = ((e & 1) ? bf_hi(wk2) : bf_lo(wk2)) * 0.125f;
                    ql[e] = a1 * cs - a2 * sn; qh[e] = a1 * sn + a2 * cs;
                    kl[e] = b1 * cs - b2 * sn; kh[e] = b1 * sn + b2 * cs;
                }
                u32x4 t;
                t.x = pk2(ql[0], ql[1]); t.y = pk2(ql[2], ql[3]); t.z = pk2(ql[4], ql[5]); t.w = pk2(ql[6], ql[7]); *(LAS u32x4*)(lds + L_CQ + (j * TP + 8 * o4) * 2) = t;
                t.x = pk2(qh[0], qh[1]); t.y = pk2(qh[2], qh[3]); t.z = pk2(qh[4], qh[5]); t.w = pk2(qh[6], qh[7]); *(LAS u32x4*)(lds + L_CQ + (j * TP + 32 + 8 * o4) * 2) = t;
                t.x = pk2(kl[0], kl[1]); t.y = pk2(kl[2], kl[3]); t.z = pk2(kl[4], kl[5]); t.w = pk2(kl[6], kl[7]); *(LAS u32x4*)(lds + L_BK + (j * TP + 8 * o4) * 2) = t;
                t.x = pk2(kh[0], kh[1]); t.y = pk2(kh[2], kh[3]); t.z = pk2(kh[4], kh[5]); t.w = pk2(kh[6], kh[7]); *(LAS u32x4*)(lds + L_BK + (j * TP + 32 + 8 * o4) * 2) = t;
                t.x = pk2(kl[0] * wj, kl[1] * wj); t.y = pk2(kl[2] * wj, kl[3] * wj); t.z = pk2(kl[4] * wj, kl[5] * wj); t.w = pk2(kl[6] * wj, kl[7] * wj); *(LAS u32x4*)(lds + L_BKW + (j * TP + 8 * o4) * 2) = t;
                t.x = pk2(kh[0] * wj, kh[1] * wj); t.y = pk2(kh[2] * wj, kh[3] * wj); t.z = pk2(kh[4] * wj, kh[5] * wj); t.w = pk2(kh[6] * wj, kh[7] * wj); *(LAS u32x4*)(lds + L_BKW + (j * TP + 32 + 8 * o4) * 2) = t;
                *(LAS u32x4*)(lds + L_XV + (j * TP + 16 * o4) * 2) = raw[4]; *(LAS u32x4*)(lds + L_XV + (j * TP + 16 * o4 + 8) * 2) = raw[5];
            }
            __syncthreads();
            const int i0 = 32 * it, iTok = i0 + r;
            bf16* orow = PROJ + (m0 + iTok) * NP + (ssd ? (C_Z + 64 * hd) : (C_GR + 128 * hd + 64 * half));
            u32x2 zz[4];
#pragma unroll
            for (int g4 = 0; g4 < 4; ++g4) zz[g4] = *(const u32x2*)(orow + 32 * pt + 8 * g4 + 4 * h);
            if (c + 1 < 16) P3_ISSUE(c + 1);
            __builtin_amdgcn_sched_barrier(0);
            if (ssd && wave == 0 && c + 1 < 16) { P3_SCAN(c + 1); if (c + 2 < 16) P3_DTLOAD(c + 2); }
            bf16x8 cqb[4];
#pragma unroll
            for (int s = 0; s < 4; ++s) cqb[s] = *(const LAS bf16x8*)(lds + L_CQ + ((i0 + r) * TP + 16 * s + 8 * h) * 2);
            const LAS unsigned char* STr = lds + (par ? L_ST1 : L_ST0);
            LAS unsigned char* STw = lds + (par ? L_ST0 : L_ST1);
            f32x16 acc;
#pragma unroll
            for (int i = 0; i < 16; ++i) acc[i] = 0.f;
#pragma unroll
            for (int s = 0; s < 4; ++s) { const bf16x8 sa = *(const LAS bf16x8*)(STr + ((32 * pt + r) * TP + 16 * s + 8 * h) * 2); acc = MFMA32(sa, cqb[s], acc); }
            const float acs_i = ACS[iTok];
            { const float ei = __expf(acs_i);
#pragma unroll
              for (int i = 0; i < 16; ++i) acc[i] *= ei; }
            for (int jt = 0; jt <= it; ++jt) {
                f32x16 g;
#pragma unroll
                for (int i = 0; i < 16; ++i) g[i] = 0.f;
#pragma unroll
                for (int s = 0; s < 4; ++s) { const bf16x8 ka = *(const LAS bf16x8*)(lds + L_BK + ((32 * jt + r) * TP + 16 * s + 8 * h) * 2); g = MFMA32(ka, cqb[s], g); }
                const bool diag = (jt == it);
#pragma unroll
                for (int g4 = 0; g4 < 4; ++g4) {
                    const f32x4 aj = *(const LAS f32x4*)(ACS + 32 * jt + 8 * g4 + 4 * h), dj = *(const LAS f32x4*)(DTJ + 32 * jt + 8 * g4 + 4 * h);
#pragma unroll
                    for (int e = 0; e < 4; ++e) { float v = g[4 * g4 + e] * __expf(acs_i - aj[e]) * dj[e]; if (diag && (8 * g4 + 4 * h + e) > r) v = 0.f; g[4 * g4 + e] = v; }
                }
#pragma unroll
                for (int s2 = 0; s2 < 2; ++s2) {
                    const bf16x8 pf = pack8(g[8 * s2], g[8 * s2 + 1], g[8 * s2 + 2], g[8 * s2 + 3], g[8 * s2 + 4], g[8 * s2 + 5], g[8 * s2 + 6], g[8 * s2 + 7]);
                    const LAS unsigned char* xb = lds + L_XV + ((32 * jt + 16 * s2 + 4 * h + q4) * TP + 32 * pt + 16 * blk16 + 4 * p4) * 2;
                    const bf16x8 xa = tr_pair(xb, xb + 8 * TP * 2);
                    acc = MFMA32(xa, pf, acc);
                }
            }
            {
                float ss = 0.f;
#pragma unroll
                for (int g4 = 0; g4 < 4; ++g4) {
                    const int p = 32 * pt + 8 * g4 + 4 * h;
                    const float z0 = bf_lo(zz[g4].x), z1 = bf_hi(zz[g4].x), z2 = bf_lo(zz[g4].y), z3 = bf_hi(zz[g4].y);
                    float y0 = acc[4 * g4], y1 = acc[4 * g4 + 1], y2 = acc[4 * g4 + 2], y3 = acc[4 * g4 + 3];
                    float o0, o1, o2, o3;
                    if (ssd) {
                        const u32x2 xv = *(const LAS u32x2*)(lds + L_XV + (iTok * TP + p) * 2);
                        const f32x4 mw = *(const f32x4*)(m_norm_w + 64 * hd + p);
                        y0 = (y0 + Dsk * bf_lo(xv.x)) * silu_f(z0); y1 = (y1 + Dsk * bf_hi(xv.x)) * silu_f(z1); y2 = (y2 + Dsk * bf_lo(xv.y)) * silu_f(z2); y3 = (y3 + Dsk * bf_hi(xv.y)) * silu_f(z3);
                        ss += (y0 * y0 + y1 * y1) + (y2 * y2 + y3 * y3);
                        o0 = y0 * mw.x; o1 = y1 * mw.y; o2 = y2 * mw.z; o3 = y3 * mw.w;
                    } else {
                        ss += (y0 * y0 + y1 * y1) + (y2 * y2 + y3 * y3);
                        o0 = y0 * silu_f(z0); o1 = y1 * silu_f(z1); o2 = y2 * silu_f(z2); o3 = y3 * silu_f(z3);
                    }
                    u32x2 ov; ov.x = pk2(o0, o1); ov.y = pk2(o2, o3);
                    if (dry) *(u32x2*)((bf16*)a.out + (m0 + iTok) * 2048 + (ssd ? 64 * hd : 1024 + 128 * hd + 64 * half) + p) = ov; else *(u32x2*)(orow + p) = ov;
                }
                ss += __shfl_xor(ss, 32);
                if (h == 0) { if (ssd) SSQM[(m0 + iTok) * 32 + hd * 2 + pt] = ss; else SSQR[(m0 + iTok) * 32 + hd * 4 + half * 2 + pt] = ss; }
            }
            if (it < 2 && c < 15) {
                const int nt = it;
                const float dec = __expf(ACS[127]);
#pragma unroll
                for (int i = 0; i < 16; ++i) sacc[i] *= dec;
#pragma unroll
                for (int ks = 0; ks < 8; ++ks) {
                    const LAS unsigned char* xb = lds + L_XV + ((16 * ks + 8 * h + q4) * TP + 32 * pt + 16 * blk16 + 4 * p4) * 2;
                    const LAS unsigned char* kb = lds + L_BKW + ((16 * ks + 8 * h + q4) * TP + 32 * nt + 16 * blk16 + 4 * p4) * 2;
                    const bf16x8 xa = tr_pair(xb, xb + 4 * TP * 2), kbf = tr_pair(kb, kb + 4 * TP * 2);
                    sacc = MFMA32(xa, kbf, sacc);
                }
#pragma unroll
                for (int i = 0; i < 16; ++i) { const int p = 32 * pt + crow(i, h);
                    *(LAS unsigned short*)(STw + (p * TP + 32 * nt + r) * 2) = (unsigned short)(pk2(sacc[i], 0.f) & 0xffffu); }
            }
        }
#undef P3_ISSUE
#undef P3_SCAN
#undef P3_DTLOAD
    }
}

constexpr int MP = 1032;
constexpr int L4_MERGED = 0, L4_ASTG = 132096, L4_RM = 150528, L4_RR = 151040, L4_RED = 153088, L4_RS = 155136;
static_assert(L4_RS + 256 <= LDS_BYTES, "P4 LDS map");

template <int SEGSHIFT>
__device__ __forceinline__ void p4_gemmT(f32x16 (&accT)[2][2], const bf16* Abase  , const LAS float* rsc  , int nseg,
                                         const bf16* WF  , int nt0  , LAS unsigned char* lds, int tid, int lane) {
    const int srow = tid >> 3, soct = tid & 7, r = lane & 31, h = lane >> 5;
    const char* ab = (const char*)Abase; const unsigned aoff = (unsigned)((srow * NP + 8 * soct) * 2);
    const char* wb = (const char*)WF + (size_t)nt0 * 65536; const unsigned woff = (unsigned)(lane * 16);
    const int rot = ((int)blockIdx.x >> 3) & 15;
    u32x4 ar[16];
#pragma unroll
    for (int i = 0; i < 16; ++i) ar[i] = *(const u32x4*)(ab + ((rot + i) & 15) * 128 + aoff);
    bf16x8 wc[4][2];
    { const char* wk0 = wb + rot * 4096;
#pragma unroll
      for (int s = 0; s < 4; ++s) { wc[s][0] = *(const bf16x8*)(wk0 + s * 1024 + woff); wc[s][1] = *(const bf16x8*)(wk0 + 65536 + s * 1024 + woff); } }
#pragma unroll
    for (int ki = 0; ki < 16; ++ki) {
        const int kc = (ki + rot) & 15;
        LAS unsigned char* stg = lds + L4_ASTG + (ki & 1) * 9216;
        { const float sc = rsc[srow * nseg + ((kc * 64) >> SEGSHIFT)];
          u32x4 o;
          o.x = pk2(bf_lo(ar[ki].x) * sc, bf_hi(ar[ki].x) * sc); o.y = pk2(bf_lo(ar[ki].y) * sc, bf_hi(ar[ki].y) * sc);
          o.z = pk2(bf_lo(ar[ki].z) * sc, bf_hi(ar[ki].z) * sc); o.w = pk2(bf_lo(ar[ki].w) * sc, bf_hi(ar[ki].w) * sc);
          *(LAS u32x4*)(stg + (srow * TP + 8 * soct) * 2) = o; }
        __syncthreads();
        const int kn = (kc + 1) & 15;
        const char* wk = wb + kn * 4096;
#pragma unroll
        for (int s = 0; s < 4; ++s) {
            const bf16x8 a0 = *(const LAS bf16x8*)(stg + (r * TP + 16 * s + 8 * h) * 2), a1 = *(const LAS bf16x8*)(stg + ((32 + r) * TP + 16 * s + 8 * h) * 2);
            accT[0][0] = MFMA32(wc[s][0], a0, accT[0][0]); accT[0][1] = MFMA32(wc[s][1], a0, accT[0][1]);
            accT[1][0] = MFMA32(wc[s][0], a1, accT[1][0]); accT[1][1] = MFMA32(wc[s][1], a1, accT[1][1]);
            wc[s][0] = *(const bf16x8*)(wk + s * 1024 + woff); wc[s][1] = *(const bf16x8*)(wk + 65536 + s * 1024 + woff);
            __builtin_amdgcn_sched_barrier(0);
        }
    }
    __syncthreads();
}

__device__ __forceinline__ void p4_phase(const Args& a, LAS unsigned char* lds, int tid_in, int lane_in, int wave, int G) {
    const bf16* PROJ = (const bf16*)(a.ws + WS_PROJ);
    const float* SSQM = (const float*)(a.ws + WS_SSQM); const float* SSQR = (const float*)(a.ws + WS_SSQR);
    const float* MOD = (const float*)(a.ws + WS_MOD);
    const bf16* WMF = (const bf16*)(a.ws + WS_WMF); const bf16* WRF = (const bf16*)(a.ws + WS_WRF); const bf16* WOF = (const bf16*)(a.ws + WS_WOF);
    const float* x = a.in[0]; const float* fw = a.in[15]; float* out = a.out;
    LAS float* RM = (LAS float*)(lds + L4_RM); LAS float* RR = (LAS float*)(lds + L4_RR); LAS float* RED = (LAS float*)(lds + L4_RED); LAS float* RS = (LAS float*)(lds + L4_RS);
    for (int blk = blockIdx.x; blk < 256; blk += G) {
        const size_t m0 = (size_t)blk * 64; const int b = blk >> 5;
        int lane = fresh_lane(), tid = wave * 64 + lane, r = lane & 31, h = lane >> 5;
        __syncthreads();
        { const int row = tid >> 3, sub = tid & 7;
          const f32x4 qv = *(const f32x4*)(SSQR + (m0 + row) * 32 + 4 * sub);
          RR[row * 8 + sub] = 1.0f / sqrtf(((qv.x + qv.y) + (qv.z + qv.w)) * (1.f / 128.f) + EPS);
          if (sub < 2) { float s = 0.f;
#pragma unroll
              for (int i = 0; i < 4; ++i) { const f32x4 v = *(const f32x4*)(SSQM + (m0 + row) * 32 + 16 * sub + 4 * i); s += (v.x + v.y) + (v.z + v.w); }
              RM[row * 2 + sub] = 1.0f / sqrtf(s * (1.f / 512.f) + EPS); } }
        __syncthreads();
#ifndef P4_SKIP1
#ifndef P4_REP1
#define P4_REP1 1
#endif
        for (int nh_ = 0; nh_ < 2 * P4_REP1; ++nh_) {
            const int nh = nh_ & 1;
            lane = fresh_lane(); tid = wave * 64 + lane; r = lane & 31; h = lane >> 5;
            const int nt0 = 16 * nh + 2 * wave;
            const bf16* pblk = PROJ + m0 * NP;
            f32x16 accT[2][2];
#pragma unroll
            for (int i = 0; i < 2; ++i)
#pragma unroll
                for (int j = 0; j < 2; ++j)
#pragma unroll
                    for (int e = 0; e < 16; ++e) accT[i][j][e] = 0.f;
            p4_gemmT<9>(accT, pblk + C_Z, RM, 2, WMF, nt0, lds, tid, lane);
            {
                lane = fresh_lane(); r = lane & 31; h = lane >> 5;
                const unsigned lo1 = launder((unsigned)((r * NP + 4 * h) * 2));
                const char* gb = (const char*)(pblk + C_GAM + 32 * nt0);
                const unsigned lm = launder((unsigned)(L4_MERGED + (r * MP + 4 * h) * 2));
#pragma unroll
                for (int rt = 0; rt < 2; ++rt)
#pragma unroll
                    for (int ct = 0; ct < 2; ++ct)
#pragma unroll
                        for (int g4 = 0; g4 < 4; ++g4) {
                            const u32x2 gg = *(const u32x2*)(gb + (lo1 + (unsigned)((32 * rt * NP + 32 * ct + 8 * g4) * 2)));
                            u32x2 ov; ov.x = pk2(accT[rt][ct][4 * g4] * sigm_f(bf_lo(gg.x)), accT[rt][ct][4 * g4 + 1] * sigm_f(bf_hi(gg.x)));
                            ov.y = pk2(accT[rt][ct][4 * g4 + 2] * sigm_f(bf_lo(gg.y)), accT[rt][ct][4 * g4 + 3] * sigm_f(bf_hi(gg.y)));
                            *(LAS u32x2*)(lds + lm + (unsigned)((32 * rt * MP + 32 * (nt0 + ct) + 8 * g4) * 2)) = ov; }
            }
#pragma unroll
            for (int i = 0; i < 2; ++i)
#pragma unroll
                for (int j = 0; j < 2; ++j)
#pragma unroll
                    for (int e = 0; e < 16; ++e) accT[i][j][e] = 0.f;
            lane = fresh_lane(); tid = wave * 64 + lane;
            p4_gemmT<7>(accT, pblk + C_GR, RR, 8, WRF, nt0, lds, tid, lane);
            {
                lane = fresh_lane(); r = lane & 31; h = lane >> 5;
                const unsigned lo1 = launder((unsigned)((r * NP + 4 * h) * 2));
                const char* gb = (const char*)(pblk + C_GAR + 32 * nt0);
                const unsigned lm = launder((unsigned)(L4_MERGED + (r * MP + 4 * h) * 2));
#pragma unroll
                for (int rt = 0; rt < 2; ++rt)
#pragma unroll
                    for (int ct = 0; ct < 2; ++ct)
#pragma unroll
                        for (int g4 = 0; g4 < 4; ++g4) {
                            const u32x2 gg = *(const u32x2*)(gb + (lo1 + (unsigned)((32 * rt * NP + 32 * ct + 8 * g4) * 2)));
                            LAS u32x2* mp = (LAS u32x2*)(lds + lm + (unsigned)((32 * rt * MP + 32 * (nt0 + ct) + 8 * g4) * 2));
                            const u32x2 pm = *mp;
                            const float v0 = bf_lo(pm.x) + accT[rt][ct][4 * g4] * sigm_f(bf_lo(gg.x)), v1 = bf_hi(pm.x) + accT[rt][ct][4 * g4 + 1] * sigm_f(bf_hi(gg.x));
                            const float v2 = bf_lo(pm.y) + accT[rt][ct][4 * g4 + 2] * sigm_f(bf_lo(gg.y)), v3 = bf_hi(pm.y) + accT[rt][ct][4 * g4 + 3] * sigm_f(bf_hi(gg.y));
                            u32x2 ov; ov.x = pk2(v0, v1); ov.y = pk2(v2, v3);
                            *mp = ov; }
            }
        }
#endif
        __syncthreads();
        lane = fresh_lane(); tid = wave * 64 + lane; r = lane & 31; h = lane >> 5;
#ifndef P4_SKIP2
#ifndef P4_REP2
#define P4_REP2 1
#endif
        _Pragma("nounroll") for (int rep2_ = 0; rep2_ < P4_REP2; ++rep2_) {
            if (rep2_) { __syncthreads(); lane = fresh_lane(); tid = wave * 64 + lane; r = lane & 31; h = lane >> 5; }
            f32x16 acc[2][4];
#pragma unroll
            for (int i = 0; i < 2; ++i)
#pragma unroll
                for (int j = 0; j < 4; ++j)
#pragma unroll
                    for (int e = 0; e < 16; ++e) acc[i][j][e] = 0.f;
            const char* wb = (const char*)WOF + (size_t)(4 * wave) * 65536; const unsigned woff = (unsigned)(lane * 16);
            const int rot2 = ((int)blockIdx.x >> 3) & 31;
            bf16x8 wc[2][4];
#pragma unroll
            for (int s = 0; s < 2; ++s)
#pragma unroll
                for (int ct = 0; ct < 4; ++ct) wc[s][ct] = *(const bf16x8*)(wb + ct * 65536 + (2 * rot2 + s) * 1024 + woff);
            for (int ki = 0; ki < 32; ++ki) {
                const int kp = (ki + rot2) & 31, kpn = (kp + 1) & 31;
#pragma unroll
                for (int s = 0; s < 2; ++s) {
                    const int ks = 2 * kp + s;
                    const bf16x8 a0 = *(const LAS bf16x8*)(lds + L4_MERGED + (r * MP + 16 * ks + 8 * h) * 2), a1 = *(const LAS bf16x8*)(lds + L4_MERGED + ((32 + r) * MP + 16 * ks + 8 * h) * 2);
#pragma unroll
                    for (int ct = 0; ct < 4; ++ct) { acc[0][ct] = MFMA32(a0, wc[s][ct], acc[0][ct]); acc[1][ct] = MFMA32(a1, wc[s][ct], acc[1][ct]); }
#pragma unroll
                    for (int ct = 0; ct < 4; ++ct) wc[s][ct] = *(const bf16x8*)(wb + ct * 65536 + (2 * kpn + s) * 1024 + woff);
                    __builtin_amdgcn_sched_barrier(0);
                }
            }
            lane = fresh_lane(); r = lane & 31; h = lane >> 5;
            const char* xblk = (const char*)(x + m0 * D); char* oblk = (char*)(out + m0 * D);
            const unsigned eo = launder((unsigned)(4 * (4 * h * D + 128 * wave + r)));
            const unsigned rb = launder((unsigned)(L4_RED + (4 * h * 8 + wave) * 4));
            float gate[4], fwv[4];
#pragma unroll
            for (int ct = 0; ct < 4; ++ct) { const int n = 32 * (4 * wave + ct) + r; gate[ct] = MOD[b * 3072 + 2048 + n]; fwv[ct] = fw[n]; }
#pragma unroll
            for (int rt = 0; rt < 2; ++rt)
#pragma unroll
                for (int g8 = 0; g8 < 2; ++g8) {
                    float xv[8][4];
#pragma unroll
                    for (int e = 0; e < 8; ++e)
#pragma unroll
                        for (int ct = 0; ct < 4; ++ct) xv[e][ct] = *(const float*)(xblk + (eo + (unsigned)(((32 * rt + (e & 3) + 8 * (2 * g8 + (e >> 2))) * D + 32 * ct) * 4)));
#pragma unroll
                    for (int e = 0; e < 8; ++e) {
                        const int reg = 8 * g8 + e, rowc = 32 * rt + (reg & 3) + 8 * (reg >> 2);
                        float s = 0.f;
#pragma unroll
                        for (int ct = 0; ct < 4; ++ct) { const float v = xv[e][ct] + gate[ct] * acc[rt][ct][reg]; acc[rt][ct][reg] = v; s += v * v; }
                        s += __shfl_xor(s, 16); s += __shfl_xor(s, 8); s += __shfl_xor(s, 4); s += __shfl_xor(s, 2); s += __shfl_xor(s, 1);
                        *(LAS float*)(lds + rb + (unsigned)(rowc * 32)) = s;
                    }
                    asm volatile("" ::: "memory"); __builtin_amdgcn_sched_barrier(0);
                }
            __syncthreads();
            if (tid < 64) { float s = 0.f;
#pragma unroll
                for (int w = 0; w < 8; ++w) s += RED[tid * 8 + w];
                RS[tid] = 1.0f / sqrtf(s * (1.f / D) + EPS); }
            __syncthreads();
            const unsigned eo2 = launder(eo);
            const unsigned sb = launder((unsigned)(L4_RS + 4 * h * 4));
#pragma unroll
            for (int rt = 0; rt < 2; ++rt)
#pragma unroll
                for (int reg = 0; reg < 16; ++reg) {
                    const int rowc = 32 * rt + (reg & 3) + 8 * (reg >> 2); const float rs = *(const LAS float*)(lds + sb + (unsigned)(rowc * 4));
#pragma unroll
                    for (int ct = 0; ct < 4; ++ct) *(float*)(oblk + (eo2 + (unsigned)((rowc * D + 32 * ct) * 4))) = acc[rt][ct][reg] * rs * fwv[ct];
                }
        }
#endif
    }
}

#define XB_TMO      128
#define XB_XCNT(j)  (256  + 64 * (j))
#define XB_XSUB(j)  (1280 + 64 * (j))
#define XB_XGEN(j)  (2304 + 64 * (j))
#define XB_TOP      3328
#define XB_TOPGEN   3392
#define XCD_BAR_WORDS 3456
#define XB_SPIN_CAP (1u << 18)

__device__ __forceinline__ unsigned xb_ld(unsigned* p)              { return __hip_atomic_load(p, __ATOMIC_RELAXED, __HIP_MEMORY_SCOPE_AGENT); }
__device__ __forceinline__ unsigned xb_add(unsigned* p, unsigned v) { return __hip_atomic_fetch_add(p, v, __ATOMIC_RELAXED, __HIP_MEMORY_SCOPE_AGENT); }
__device__ __forceinline__ unsigned xb_xcc_id() { return (unsigned)__builtin_amdgcn_s_getreg((3 << 11) | 20) & 0xFu; }
#define XB_SPIN(cond, bar) do { unsigned _sp = 0; while (cond) { __builtin_amdgcn_s_sleep(1); \
    if ((++_sp & 255u) == 0u) { if (xb_ld(&(bar)[XB_TMO])) break; if (_sp > XB_SPIN_CAP) { atomicAdd(&(bar)[XB_TMO], 1u); break; } } } } while (0)

struct XcdBarrier {
    unsigned* bar; unsigned x;
    volatile LAS unsigned* st;
};

__device__ __forceinline__ XcdBarrier xcd_barrier_post(unsigned* bar, volatile LAS unsigned* st) {
    XcdBarrier b; b.bar = bar; b.x = xb_xcc_id(); b.st = st;
    if (threadIdx.x == 0) (void)xb_add(&bar[XB_XCNT(b.x)], 1u);
    return b;
}
__device__ __forceinline__ void xcd_barrier_complete(unsigned* bar, unsigned x, unsigned& nloc, unsigned& nx) {
    const unsigned G = gridDim.x * gridDim.y * gridDim.z;
    unsigned sum, cnt, mine, sp = 0u;
    for (;;) {
        sum = 0u; cnt = 0u; mine = 0u;
#pragma unroll
        for (unsigned j = 0; j < 16; ++j) { const unsigned c = xb_ld(&bar[XB_XCNT(j)]); sum += c; cnt += (c > 0u) ? 1u : 0u; mine = (j == x) ? c : mine; }
        if (sum == G) break;
        __builtin_amdgcn_s_sleep(1);
        if ((++sp & 255u) == 0u) { if (xb_ld(&bar[XB_TMO])) break; if (sp > XB_SPIN_CAP) { atomicAdd(&bar[XB_TMO], 1u); break; } }
    }
    nloc = mine > 0u ? mine : 1u; nx = cnt > 0u ? cnt : 1u;
}

__device__ __forceinline__ void xcd_barrier(const XcdBarrier& b) {
    asm volatile("s_waitcnt vmcnt(0)" ::: "memory");
    __syncthreads();
    if (threadIdx.x == 0) {
        unsigned* bar = b.bar;
        __builtin_amdgcn_s_waitcnt(0);
        unsigned nloc = b.st[0], nx = b.st[1];
        if (nloc == 0u) { xcd_barrier_complete(bar, b.x, nloc, nx); b.st[0] = nloc; b.st[1] = nx; }
        const unsigned old = xb_add(&bar[XB_XSUB(b.x)], 1u);
        const unsigned gen = old / nloc;
        if (old + 1u == (gen + 1u) * nloc) {
            __builtin_amdgcn_fence(__ATOMIC_RELEASE, "agent");
            asm volatile("s_waitcnt vmcnt(0)" ::: "memory");
            const unsigned og = xb_add(&bar[XB_TOP], 1u);
            const unsigned tg = og / nx;
            if (og + 1u == (tg + 1u) * nx) xb_add(&bar[XB_TOPGEN], 1u);
            else XB_SPIN(xb_ld(&bar[XB_TOPGEN]) == tg, bar);
            __builtin_amdgcn_fence(__ATOMIC_ACQUIRE, "agent");
            xb_add(&bar[XB_XGEN(b.x)], 1u);
            asm volatile("s_waitcnt vmcnt(0)" ::: "memory");
        } else {
            XB_SPIN(xb_ld(&bar[XB_XGEN(b.x)]) == gen, bar);
            __builtin_amdgcn_fence(__ATOMIC_ACQUIRE, "agent");
            asm volatile("s_waitcnt vmcnt(0)" ::: "memory");
        }
    }
    __syncthreads();
}

__global__ void __launch_bounds__(NTHR, 2) hybrid_fwd(Args args) {
    extern __shared__ __attribute__((aligned(16))) unsigned char lds_raw[];
    LAS unsigned char* lds = (LAS unsigned char*)lds_raw;
    const int wave = __builtin_amdgcn_readfirstlane((int)threadIdx.x >> 6), G = gridDim.x; const int tid = 0, lane = 0;
    cg::grid_group grid = cg::this_grid();
    volatile LAS unsigned* misc = (volatile LAS unsigned*)(lds + LDS_MISC);
    if (threadIdx.x < 2) misc[threadIdx.x] = 0u;
    __syncthreads();
    XcdBarrier xbar = xcd_barrier_post((unsigned*)(args.ws + WS_CTL), misc);
    const int lo = args.ph_lo, hi = args.ph_hi;
#ifndef PHMASK
#define PHMASK 31
#endif
#define IN(k) (((PHMASK >> (k)) & 1) && lo <= (k) && (k) < hi)
#define SEAM(k) do { if (IN(k) && IN((k) + 1)) { if (lo < 0) grid.sync(); else xcd_barrier(xbar); } } while (0)
#ifndef REPEAT_MASK
#define REPEAT_MASK 0
#endif
#define REP(k) _Pragma("nounroll") for (int rep_ = 0; rep_ < 1 + ((REPEAT_MASK >> (k)) & 1); ++rep_)
#ifdef EXTRA_SYNCS
    for (int es_ = 0; es_ < EXTRA_SYNCS; ++es_) xcd_barrier(xbar);
#endif
    if (IN(0)) REP(0) { if (rep_) xcd_barrier(xbar); p0_phase(args, lds, tid, lane, wave, G); }
    SEAM(0);
    if (IN(1)) REP(1) { if (rep_) xcd_barrier(xbar); p1_phase(args, lds, tid, lane, wave, G); }
    SEAM(1);
    if (IN(2)) REP(2) {
        if (rep_) xcd_barrier(xbar);
        __syncthreads();
        pg8::Gemm g{(const pg8::bf16_t*)((const unsigned char*)args.out + OUT_H), (const pg8::bf16_t*)((const unsigned char*)args.out + OUT_WINT), MTOK, NP, D};
        pg8::StaticOrder S; S.init(MTOK, NP, G, (int)blockIdx.x);
        pg8::EpiProj E{(pg8::bf16_t*)(args.ws + WS_PROJ), NP};
        pg8::gemm_phase<pg8::EpiProj, pg8::StaticOrder, true, true>(lds, g, S, E, wave);
    }
    SEAM(2);
    if (IN(3)) { if ((REPEAT_MASK >> 3) & 1) { p3_phase(args, lds, tid, lane, wave, G, true); xcd_barrier(xbar); } p3_phase(args, lds, tid, lane, wave, G); }
    SEAM(3);
    if (IN(4)) REP(4) { if (rep_) xcd_barrier(xbar); p4_phase(args, lds, tid, lane, wave, G); }
#undef REP
#undef IN
#undef SEAM
}

extern "C" void kernel_launch(void* const* d_in, const int* in_sizes, int n_in, void* d_out, int out_size, void* d_ws, size_t ws_size, hipStream_t stream) {
    static int grid = 0;
    if (grid == 0) {
        if (n_in != 16 || out_size != MTOK * D || ws_size < WS_END) { fprintf(stderr, "kernel_launch: unexpected shapes (n_in %d out %d ws %zu)\n", n_in, out_size, ws_size); grid = -1; return; }
        int dev = 0, cus = 0, per_cu = 0;
        (void)hipGetDevice(&dev);
        (void)hipDeviceGetAttribute(&cus, hipDeviceAttributeMultiprocessorCount, dev);
        if (hipFuncSetAttribute((const void*)hybrid_fwd, hipFuncAttributeMaxDynamicSharedMemorySize, LDS_BYTES) != hipSuccess) { fprintf(stderr, "kernel_launch: hipFuncSetAttribute failed\n"); grid = -1; return; }
        if (hipOccupancyMaxActiveBlocksPerMultiprocessor(&per_cu, (const void*)hybrid_fwd, NTHR, LDS_BYTES) != hipSuccess || per_cu < 1) { fprintf(stderr, "kernel_launch: occupancy query says %d\n", per_cu); per_cu = 1; }
        (void)hipGetLastError();
        grid = cus * per_cu;
        if (grid > 256) grid = 256;
        if (grid < 1) grid = 1;
    }
    if (grid < 0) return;
    if (hipMemsetAsync((char*)d_ws + WS_CTL, 0, CTL_BYTES, stream) != hipSuccess) { fprintf(stderr, "kernel_launch: memset of the barrier words failed\n"); return; }
    Args a{};
    for (int i = 0; i < 16; ++i) a.in[i] = (const float*)d_in[i];
    a.out = (float*)d_out; a.ws = (unsigned char*)d_ws;
#if N_LAUNCHES == 1
    a.ph_lo = 0; a.ph_hi = NPH;
    void* kargs[] = {&a};
    hipError_t e = hipLaunchCooperativeKernel((const void*)hybrid_fwd, dim3(grid), dim3(NTHR), kargs, LDS_BYTES, stream);
    if (e != hipSuccess) fprintf(stderr, "kernel_launch: cooperative launch failed: %s (grid %d)\n", hipGetErrorString(e), grid);
#else
    for (int p = 0; p < NPH; ++p) {
        a.ph_lo = p; a.ph_hi = p + 1;
        hipLaunchKernelGGL(hybrid_fwd, dim3(grid), dim3(NTHR), LDS_BYTES, stream, a);
    }
#endif
}
```

```cpp
#include <hip/hip_runtime.h>
#include <hip/hip_cooperative_groups.h>
#include <cstdio>
#include <cstdint>
namespace cg = cooperative_groups;
#define N_LAUNCHES 1
#define REPEAT_MASK 0
#define P4_REP2 1
__device__ __forceinline__ unsigned launder(unsigned v) { asm volatile("" : "+v"(v)); return v; }
__device__ __forceinline__ int fresh_lane() { unsigned z; asm volatile("v_mov_b32 %0, 0" : "=v"(z)); return (int)__builtin_amdgcn_mbcnt_hi(~0u, __builtin_amdgcn_mbcnt_lo(~0u, z)); }
namespace pg8 {
#define PG8_LAS __attribute__((address_space(3)))
typedef unsigned short bf16_t;
typedef short bf16x8 __attribute__((ext_vector_type(8)));
typedef float f32x4 __attribute__((ext_vector_type(4)));
typedef unsigned u32x4 __attribute__((ext_vector_type(4)));
constexpr int BM = 256, BK = 64, HALF = 128, HTB = HALF * BK * 2  , STAGE_BYTES = 8 * HTB, NXCD = 8, WGM = 8;

__host__ __device__ __forceinline__ int lds_byte(int r, int c) { const int st = (r >> 4) * 2 + (c >> 5), rr = r & 15, cc = c & 31, ob = rr * 64 + cc * 2; return st * 1024 + (ob ^ (((ob >> 9) & 1) << 5)); }
__host__ __device__ __forceinline__ void stage_rc(int b, int& R, int& C) { const int st = b / 1024, sb = b % 1024, swz = sb ^ (((sb >> 9) & 1) << 5); R = (st >> 1) * 16 + swz / 64; C = (st & 1) * 32 + (swz % 64) / 2; }
__host__ __device__ __forceinline__ int perm32(int rho) { const int n = rho >> 4, i = rho & 15; return 8 * (i >> 2) + 4 * n + (i & 3); }

struct Unit { int pm, pn; };
struct Gemm { const bf16_t* A; const bf16_t* Bt; int M, N, K; };

struct StaticOrder {
    int nM, nN, nwg, G, c;
    __host__ __device__ void init(int M, int N, int G_, int c_) { nM = M / BM; nN = N / BM; nwg = nM * nN; G = G_; c = c_; }
    __host__ __device__ bool next(int i, Unit& u) const {
        const long L = (long)i * G + c; if (L >= nwg) return false;
        int wgid = (int)L; { const int q = nwg / NXCD, r = nwg % NXCD, xcd = wgid % NXCD, off = wgid / NXCD; wgid = (xcd < r ? xcd * (q + 1) : r * (q + 1) + (xcd - r) * q) + off; }
        const int nig = WGM * nN, gid = wgid / nig, fm = gid * WGM, gsz = (nM - fm) < WGM ? (nM - fm) : WGM;
        u.pm = fm + ((wgid % nig) % gsz); u.pn = (wgid % nig) / gsz; return true;
    }
    __device__ __forceinline__ void a_ready(const Unit&) const {}
    __device__ __forceinline__ void done(const Unit&) const {}
};
__device__ __forceinline__ unsigned cvt_pk_bf16(float lo, float hi) { unsigned r; asm volatile("v_cvt_pk_bf16_f32 %0, %1, %2" : "=v"(r) : "v"(lo), "v"(hi)); return r; }
struct EpiProj {
    static constexpr bool PERM = true, AFTER_DRAIN = false;
    bf16_t* O; int ldc;
    __device__ __forceinline__ void operator()(const f32x4 (&acc)[2][2][4][2], const Unit& u, int wr, int wc, int fr, int fq) const {
        const int row0 = u.pm * BM + wr * 64 + fr; const int col0 = u.pn * BM + wc * 32 + 8 * fq;
#pragma unroll
        for (int ai = 0; ai < 2; ++ai)
#pragma unroll
            for (int m = 0; m < 4; ++m) { bf16_t* rowp = O + (size_t)(row0 + ai * HALF + m * 16) * ldc + col0;
#pragma unroll
                for (int bj = 0; bj < 2; ++bj) { const f32x4 v0 = acc[ai][bj][m][0], v1 = acc[ai][bj][m][1];
                    u32x4 w; w.x = cvt_pk_bf16(v0[0], v0[1]); w.y = cvt_pk_bf16(v0[2], v0[3]); w.z = cvt_pk_bf16(v1[0], v1[1]); w.w = cvt_pk_bf16(v1[2], v1[3]);
                    *(u32x4*)(rowp + bj * HALF) = w; } }
    }
    __device__ __forceinline__ void fused(f32x4 (&)[2][2][4][2], const Unit&, int, int, int, int, PG8_LAS unsigned char*, int, int) const {}
};
template <class Epi, class Sched, bool ALIGN_EPI = false, bool SP2 = false>
__device__ __forceinline__ void gemm_phase(PG8_LAS unsigned char* lds, const Gemm g, const Sched& S, const Epi& E, const int wid) {
    const int lane = ::fresh_lane(), tid = wid * 64 + lane, wr = wid >> 2, wc = wid & 3, fr = lane & 15, fq = lane >> 4;
    const int K = g.K, nt = K / BK;
    unsigned voffA[2], voffB[2];
#pragma unroll
    for (int i = 0; i < 2; ++i) { int R, C; stage_rc(tid * 16 + i * 8192, R, C); const int Rb = Epi::PERM ? ((R & ~31) + perm32(R & 31)) : R;
        voffA[i] = (unsigned)(R * K + C) * 2u; voffB[i] = (unsigned)(Rb * K + C) * 2u; }
    const size_t kstep = (size_t)(BK * 2);
    const size_t hstep = (size_t)HALF * K * 2;
    const size_t tstep = 2 * hstep;
    const unsigned ldsw = (unsigned)wid * 1024u;
    const int aoff = lds_byte(wr * 64 + fr, fq * 8), boff = lds_byte(wc * 32 + fr, fq * 8);
#define PG8_SA(b, h) (((b) * 2 + (h)) * HTB)
#define PG8_SB(b, h) ((4 + (b) * 2 + (h)) * HTB)
#define PG8_STAGE(bufoff, gbase, voff) do { _Pragma("unroll") for (int _i = 0; _i < 2; ++_i) \
        __builtin_amdgcn_global_load_lds((const unsigned*)((const char*)(gbase) + (voff)[_i]), (PG8_LAS unsigned*)(lds + (bufoff) + ldsw + _i * 8192), 16, 0, 0); } while (0)
#define PG8_LDA(dst, b, h) do { _Pragma("unroll") for (int m = 0; m < 4; ++m) _Pragma("unroll") for (int k = 0; k < 2; ++k) dst[m][k] = *(const PG8_LAS bf16x8*)(lds + PG8_SA(b, h) + aoff + m * 2048 + k * 1024); } while (0)
#define PG8_LDB(dst, b, h) do { _Pragma("unroll") for (int n = 0; n < 2; ++n) _Pragma("unroll") for (int k = 0; k < 2; ++k) dst[n][k] = *(const PG8_LAS bf16x8*)(lds + PG8_SB(b, h) + boff + n * 2048 + k * 1024); } while (0)
#define PG8_MMA(ai, bj, At, Bt) do { __builtin_amdgcn_s_setprio(1); _Pragma("unroll") for (int m = 0; m < 4; ++m) _Pragma("unroll") for (int n = 0; n < 2; ++n) _Pragma("unroll") for (int k = 0; k < 2; ++k) \
        acc[ai][bj][m][n] = __builtin_amdgcn_mfma_f32_16x16x32_bf16(Bt[n][k], At[m][k], acc[ai][bj][m][n], 0, 0, 0); __builtin_amdgcn_s_setprio(0); } while (0)
#define PG8_WAIT_V(n) asm volatile("s_waitcnt vmcnt(" #n ")" ::: "memory")
#define PG8_WAIT_L(n) asm volatile("s_waitcnt lgkmcnt(" #n ")" ::: "memory")
#define PG8_BAR __builtin_amdgcn_s_barrier()
#define PG8_SCHED __builtin_amdgcn_sched_barrier(0)
    Unit cur, nxt; int ui = 0;
    if (!S.next(0, cur)) return;
    f32x4 acc[2][2][4][2];
#pragma unroll
    for (int a = 0; a < 2; ++a)
#pragma unroll
        for (int b = 0; b < 2; ++b)
#pragma unroll
            for (int m = 0; m < 4; ++m)
#pragma unroll
                for (int n = 0; n < 2; ++n) acc[a][b][m][n] = (f32x4){0.f, 0.f, 0.f, 0.f};
    bf16x8 At[4][2], B0[2][2], B1[2][2];
    const char* cA = (const char*)g.A + (size_t)cur.pm * tstep; const char* cB = (const char*)g.Bt + (size_t)cur.pn * tstep;
    S.a_ready(cur);
    if constexpr (SP2) {
        PG8_STAGE(PG8_SB(0, 0), cB, voffB); PG8_STAGE(PG8_SB(0, 1), cB + hstep, voffB); PG8_STAGE(PG8_SA(0, 0), cA, voffA); PG8_STAGE(PG8_SA(0, 1), cA + hstep, voffA);
        if (wr == 1) PG8_BAR;
        PG8_WAIT_V(2); PG8_BAR;
        PG8_STAGE(PG8_SB(1, 0), cB + kstep, voffB); PG8_STAGE(PG8_SA(1, 0), cA + kstep, voffA); PG8_STAGE(PG8_SB(1, 1), cB + hstep + kstep, voffB);
        PG8_WAIT_V(6); PG8_BAR;
    } else {
        PG8_STAGE(PG8_SB(0, 0), cB, voffB); PG8_STAGE(PG8_SA(0, 0), cA, voffA); PG8_STAGE(PG8_SB(0, 1), cB + hstep, voffB); PG8_STAGE(PG8_SA(0, 1), cA + hstep, voffA);
        if (wr == 1) PG8_BAR;
        PG8_WAIT_V(4); PG8_BAR;
        PG8_STAGE(PG8_SB(1, 0), cB + kstep, voffB); PG8_STAGE(PG8_SA(1, 0), cA + kstep, voffA); PG8_STAGE(PG8_SB(1, 1), cB + hstep + kstep, voffB);
        PG8_WAIT_V(6); PG8_BAR;
    }
    for (;;) {
        const bool has_next = S.next(ui + 1, nxt);
        const char* nA = has_next ? (const char*)g.A + (size_t)nxt.pm * tstep : cA; const char* nB = has_next ? (const char*)g.Bt + (size_t)nxt.pn * tstep : cB;
        for (int t = 0; t < nt; t += 2) {
            const bool last = (t == nt - 2);
            const char* a1 = cA + (size_t)(t + 1) * kstep;
            const char* a2 = last ? nA : cA + (size_t)(t + 2) * kstep; const char* b2 = last ? nB : cB + (size_t)(t + 2) * kstep;
            const char* a3 = a2 + kstep; const char* b3 = b2 + kstep;
            if (last && has_next) S.a_ready(nxt);
            if constexpr (SP2) {
            PG8_LDB(B0, 0, 0); PG8_LDB(B1, 0, 1); PG8_SCHED; PG8_LDA(At, 0, 0); PG8_STAGE(PG8_SA(1, 1), a1 + hstep, voffA);
            PG8_WAIT_V(8); PG8_WAIT_L(0); PG8_BAR; PG8_MMA(0, 0, At, B0); PG8_MMA(0, 1, At, B1); PG8_BAR; PG8_SCHED;
            PG8_LDA(At, 0, 1); PG8_STAGE(PG8_SB(0, 0), b2, voffB); PG8_STAGE(PG8_SB(0, 1), b2 + hstep, voffB); PG8_STAGE(PG8_SA(0, 0), a2, voffA);
            PG8_WAIT_V(8); PG8_WAIT_L(0); PG8_BAR; PG8_MMA(1, 0, At, B0); PG8_MMA(1, 1, At, B1); PG8_BAR; PG8_SCHED;
            PG8_LDB(B0, 1, 0); PG8_LDB(B1, 1, 1); PG8_SCHED; PG8_LDA(At, 1, 0); PG8_STAGE(PG8_SA(0, 1), a2 + hstep, voffA);
            PG8_WAIT_V(8); PG8_WAIT_L(0); PG8_BAR; PG8_MMA(0, 0, At, B0); PG8_MMA(0, 1, At, B1); PG8_BAR; PG8_SCHED;
            PG8_LDA(At, 1, 1); PG8_STAGE(PG8_SB(1, 0), b3, voffB); PG8_STAGE(PG8_SB(1, 1), b3 + hstep, voffB); PG8_STAGE(PG8_SA(1, 0), a3, voffA);
            PG8_WAIT_V(8); PG8_WAIT_L(0); PG8_BAR; PG8_MMA(1, 0, At, B0); PG8_MMA(1, 1, At, B1); PG8_BAR; PG8_SCHED;
            } else {
            PG8_LDB(B0, 0, 0); PG8_SCHED; PG8_LDA(At, 0, 0); PG8_STAGE(PG8_SA(1, 1), a1 + hstep, voffA);
            PG8_WAIT_L(8); PG8_BAR; PG8_WAIT_L(0); PG8_MMA(0, 0, At, B0); PG8_BAR; PG8_SCHED;
            PG8_LDB(B1, 0, 1); PG8_STAGE(PG8_SB(0, 0), b2, voffB);
            PG8_BAR; PG8_WAIT_L(0); PG8_MMA(0, 1, At, B1); PG8_BAR;
            PG8_LDA(At, 0, 1); PG8_STAGE(PG8_SA(0, 0), a2, voffA);
            PG8_BAR; PG8_WAIT_L(0); PG8_MMA(1, 0, At, B0); PG8_BAR; PG8_SCHED;
            PG8_STAGE(PG8_SB(0, 1), b2 + hstep, voffB);
            PG8_WAIT_V(6); PG8_BAR; PG8_MMA(1, 1, At, B1); PG8_BAR;
            PG8_LDB(B0, 1, 0); PG8_SCHED; PG8_LDA(At, 1, 0); PG8_STAGE(PG8_SA(0, 1), a2 + hstep, voffA);
            PG8_WAIT_L(8); PG8_BAR; PG8_WAIT_L(0); PG8_MMA(0, 0, At, B0); PG8_BAR; PG8_SCHED;
            PG8_LDB(B1, 1, 1); PG8_STAGE(PG8_SB(1, 0), b3, voffB);
            PG8_BAR; PG8_WAIT_L(0); PG8_MMA(0, 1, At, B1); PG8_BAR;
            PG8_LDA(At, 1, 1); PG8_STAGE(PG8_SA(1, 0), a3, voffA);
            PG8_BAR; PG8_WAIT_L(0); PG8_MMA(1, 0, At, B0); PG8_BAR; PG8_SCHED;
            PG8_STAGE(PG8_SB(1, 1), b3 + hstep, voffB);
            PG8_WAIT_V(6); PG8_BAR; PG8_MMA(1, 1, At, B1); PG8_BAR;
            }
        }
        if constexpr (ALIGN_EPI) { if (wr == 0) PG8_BAR; }
        if constexpr (!Epi::AFTER_DRAIN) { E(acc, cur, wr, wc, fr, fq); S.done(cur); }
        if (!has_next) break;
#pragma unroll
        for (int a = 0; a < 2; ++a)
#pragma unroll
            for (int b = 0; b < 2; ++b)
#pragma unroll
                for (int m = 0; m < 4; ++m)
#pragma unroll
                    for (int n = 0; n < 2; ++n) acc[a][b][m][n] = (f32x4){0.f, 0.f, 0.f, 0.f};
        cur = nxt; cA = nA; cB = nB; ++ui;
        if constexpr (ALIGN_EPI) { if (wr == 1) PG8_BAR; }
    }
    PG8_WAIT_V(0);
    if constexpr (!ALIGN_EPI) { if (wr == 0) PG8_BAR; }
    PG8_BAR;
    if constexpr (Epi::AFTER_DRAIN) { E.fused(acc, cur, wr, wc, fr, fq, lds, wid, lane); S.done(cur); }
#undef PG8_SA
#undef PG8_SB
#undef PG8_STAGE
#undef PG8_LDA
#undef PG8_LDB
#undef PG8_MMA
#undef PG8_WAIT_V
#undef PG8_WAIT_L
#undef PG8_BAR
#undef PG8_SCHED
}
}

#define LAS __attribute__((address_space(3)))
typedef unsigned short bf16;
typedef short bf16x8 __attribute__((ext_vector_type(8)));
typedef short s16x4 __attribute__((ext_vector_type(4)));
typedef float f32x4 __attribute__((ext_vector_type(4)));
typedef float f32x16 __attribute__((ext_vector_type(16)));
typedef unsigned u32x4 __attribute__((ext_vector_type(4)));
typedef unsigned u32x2 __attribute__((ext_vector_type(2)));
typedef float f32x2_t __attribute__((ext_vector_type(2)));
typedef __bf16 bf16x2_t __attribute__((ext_vector_type(2)));

#ifndef N_LAUNCHES
#define N_LAUNCHES 1
#endif
constexpr int NPH = 5;
constexpr int D = 1024, NB = 8, SEQ = 2048, MTOK = NB * SEQ, NIN = 7440, NP = 7424;
constexpr int C_Z = 0, C_X = 1024, C_B = 2048, C_C = 2176, C_Q = 2304, C_K = 2816, C_V = 3328, C_GR = 4352, C_GAM = 5376, C_GAR = 6400;
constexpr float EPS = 1e-6f;
constexpr size_t MiB = 1u << 20;
constexpr size_t WS_PROJ = 0;
constexpr size_t WS_WMF = 232 * MiB, WS_WRF = 234 * MiB, WS_WOF = 236 * MiB;
constexpr size_t WS_MOD = 238 * MiB;
constexpr size_t WS_DT = 239 * MiB;
constexpr size_t WS_SSQM = 240 * MiB;
constexpr size_t WS_SSQR = 242 * MiB;
constexpr size_t WS_CTL = 244 * MiB, CTL_BYTES = 16384;
constexpr size_t WS_END = 245 * MiB;
constexpr size_t OUT_H = 0, OUT_WINT = 32 * MiB;
constexpr int LDS_BYTES = 155648, LDS_MISC = 155520;
constexpr int NTHR = 512;

struct Args { const float* in[16]; float* out; unsigned char* ws; int ph_lo, ph_hi; };

__device__ __forceinline__ float bf_lo(unsigned u) { return __uint_as_float(u << 16); }
__device__ __forceinline__ float bf_hi(unsigned u) { return __uint_as_float(u & 0xffff0000u); }
__device__ __forceinline__ unsigned pk2(float lo, float hi) { f32x2_t v = {lo, hi}; bf16x2_t b = __builtin_convertvector(v, bf16x2_t); return __builtin_bit_cast(unsigned, b); }
__device__ __forceinline__ float silu_f(float x) { return x * __builtin_amdgcn_rcpf(1.f + __expf(-x)); }
__device__ __forceinline__ float sigm_f(float x) { return __builtin_amdgcn_rcpf(1.f + __expf(-x)); }
__device__ __forceinline__ float wave_sum(float v) {
#pragma unroll
    for (int o = 1; o < 64; o <<= 1) v += __shfl_xor(v, o);
    return v;
}
__device__ __forceinline__ int crow(int reg, int h) { return (reg & 3) + 8 * (reg >> 2) + 4 * h; }
#define MFMA32(a, b, c) __builtin_amdgcn_mfma_f32_32x32x16_bf16((a), (b), (c), 0, 0, 0)
__device__ __forceinline__ s16x4 tr_read(const LAS unsigned char* p) {
    typedef short v4i16_t __attribute__((ext_vector_type(4)));
    return __builtin_bit_cast(s16x4, __builtin_amdgcn_ds_read_tr16_b64_v4i16((LAS v4i16_t*)p));
}
__device__ __forceinline__ bf16x8 tr_pair(const LAS unsigned char* plo, const LAS unsigned char* phi) {
    const s16x4 lo = tr_read(plo), hi = tr_read(phi);
    return __builtin_shufflevector(lo, hi, 0, 1, 2, 3, 4, 5, 6, 7);
}
__device__ __forceinline__ bf16x8 pack8(float a0, float a1, float a2, float a3, float a4, float a5, float a6, float a7) {
    u32x4 p; p.x = pk2(a0, a1); p.y = pk2(a2, a3); p.z = pk2(a4, a5); p.w = pk2(a6, a7);
    return __builtin_bit_cast(bf16x8, p);
}

__device__ __forceinline__ void p0_load_tile(const float* W, int ldw, int k0, int n0, LAS float* scr, int lane) {
    float t[32];
#pragma unroll
    for (int i = 0; i < 32; ++i) t[i] = W[(size_t)(k0 + 2 * i + (lane >> 5)) * ldw + n0 + (lane & 31)];
#pragma unroll
    for (int i = 0; i < 32; ++i) scr[(2 * i + (lane >> 5)) * 33 + (lane & 31)] = t[i];
}
__device__ __forceinline__ void p0_phase(const Args& a, LAS unsigned char* lds, int tid_unused, int lane_unused, int wave, int G) {
    const int lane = fresh_lane(), tid = wave * 64 + lane;
    const float* cvec = a.in[1]; const float* w_ada = a.in[2]; const float* b_ada = a.in[3];
    float* MOD = (float*)(a.ws + WS_MOD);
    LAS float* cT = (LAS float*)lds;
    LAS float* red = (LAS float*)(lds + 32768);
    if ((int)blockIdx.x < 192) {
        { float t[16];
#pragma unroll
          for (int i = 0; i < 16; ++i) t[i] = cvec[tid + 512 * i];
#pragma unroll
          for (int i = 0; i < 16; ++i) { const int idx = tid + 512 * i; cT[(idx & 1023) * 8 + (idx >> 10)] = t[i]; } }
        __syncthreads();
        for (int item = blockIdx.x; item < 192; item += G) {
            const int j0 = item * 16, col = lane & 15, rsub = lane >> 4, kq = wave;
            float w[32];
#pragma unroll
            for (int i = 0; i < 32; ++i) w[i] = w_ada[(size_t)(kq * 128 + 4 * i + rsub) * 3072 + j0 + col];
            float acc[8];
#pragma unroll
            for (int bb = 0; bb < 8; ++bb) acc[bb] = 0.f;
#pragma unroll
            for (int i = 0; i < 32; ++i) { const int k = kq * 128 + 4 * i + rsub;
                const f32x4 c0 = *(const LAS f32x4*)(cT + k * 8), c1 = *(const LAS f32x4*)(cT + k * 8 + 4);
                acc[0] += c0.x * w[i]; acc[1] += c0.y * w[i]; acc[2] += c0.z * w[i]; acc[3] += c0.w * w[i];
                acc[4] += c1.x * w[i]; acc[5] += c1.y * w[i]; acc[6] += c1.z * w[i]; acc[7] += c1.w * w[i]; }
#pragma unroll
            for (int bb = 0; bb < 8; ++bb) { acc[bb] += __shfl_xor(acc[bb], 16); acc[bb] += __shfl_xor(acc[bb], 32); }
            if (lane < 16) {
#pragma unroll
                for (int bb = 0; bb < 8; ++bb) red[(kq * 8 + bb) * 16 + col] = acc[bb]; }
            __syncthreads();
            if (tid < 128) { const int bb = tid >> 4, cc = tid & 15; float sum = 0.f;
#pragma unroll
                for (int q = 0; q < 8; ++q) sum += red[(q * 8 + bb) * 16 + cc];
                MOD[bb * 3072 + j0 + cc] = sum + b_ada[j0 + cc]; }
            __syncthreads();
        }
    }
    LAS float* scr = (LAS float*)(lds + 40960 + wave * 8448);
    const int gw = blockIdx.x * 8 + wave, NGW = G * 8;
    constexpr int I_IN = 16 * (NP / 32), I_W = 16 * 32;
    bf16* WINT = (bf16*)((unsigned char*)a.out + OUT_WINT);
    for (int it = gw; it < I_IN + 3 * I_W; it += NGW) {
        if (it < I_IN) {
            const int nblk = NP / 32, kb = it / nblk, nb = it % nblk, k0 = 64 * kb, n0p = 32 * nb, n0 = n0p + (n0p >= 2304 ? 16 : 0);
            p0_load_tile(a.in[5], NIN, k0, n0, scr, lane);
            const int c = lane & 7;
#pragma unroll
            for (int j = 0; j < 4; ++j) { const int n = (lane >> 3) + 8 * j; const LAS float* s = scr + (8 * c) * 33 + n;
                u32x4 o; o.x = pk2(s[0 * 33], s[1 * 33]); o.y = pk2(s[2 * 33], s[3 * 33]); o.z = pk2(s[4 * 33], s[5 * 33]); o.w = pk2(s[6 * 33], s[7 * 33]);
                *(u32x4*)(WINT + (size_t)(n0p + n) * 1024 + k0 + 8 * c) = o; }
        } else {
            int r_ = it - I_IN; const int which = r_ / I_W; r_ -= which * I_W;
            const float* W = a.in[12 + which];
            bf16* WF = (bf16*)(a.ws + WS_WMF + (size_t)which * 2 * MiB);
            const int nt = r_ & 31, kb = r_ >> 5;
            p0_load_tile(W, 1024, 64 * kb, 32 * nt, scr, lane);
            const int r = lane & 31, h = lane >> 5;
#pragma unroll
            for (int s4 = 0; s4 < 4; ++s4) { const LAS float* s = scr + (16 * s4 + 8 * h) * 33 + r;
                u32x4 o; o.x = pk2(s[0 * 33], s[1 * 33]); o.y = pk2(s[2 * 33], s[3 * 33]); o.z = pk2(s[4 * 33], s[5 * 33]); o.w = pk2(s[6 * 33], s[7 * 33]);
                *(u32x4*)(WF + ((size_t)(nt * 64 + 4 * kb + s4) * 64 + lane) * 8) = o; }
        }
    }
}

__device__ __forceinline__ void p1_phase(const Args& a, LAS unsigned char* lds, int tid_unused, int lane_unused, int wave, int G) {
    const int lane_in = fresh_lane(), tid = wave * 64 + lane_in;
    const float* x = a.in[0]; const float* norm_w = a.in[4]; const float* w_in = a.in[5]; const float* dt_bias = a.in[8];
    const float* MOD = (const float*)(a.ws + WS_MOD);
    float* DT = (float*)(a.ws + WS_DT);
    bf16* H = (bf16*)((unsigned char*)a.out + OUT_H);
    LAS float* wdt = (LAS float*)lds;
    { float t[32];
#pragma unroll
      for (int i = 0; i < 32; ++i) { const int idx = tid + NTHR * i; t[i] = w_in[(size_t)(idx >> 4) * NIN + 2304 + (idx & 15)]; }
#pragma unroll
      for (int i = 0; i < 32; ++i) { const int idx = tid + NTHR * i; wdt[(idx & 15) * 1028 + (idx >> 4)] = t[i]; } }
    __syncthreads();
    for (int blk = blockIdx.x; blk < 256; blk += G) {
        const int b = blk >> 5;
        float gk[16], sh[16];
#pragma unroll
        for (int jj = 0; jj < 4; ++jj) { const int k = 4 * lane_in + 256 * jj;
            const f32x4 nw = *(const f32x4*)(norm_w + k), sc = *(const f32x4*)(MOD + b * 3072 + 1024 + k), sf = *(const f32x4*)(MOD + b * 3072 + k);
#pragma unroll
            for (int e = 0; e < 4; ++e) { gk[4 * jj + e] = nw[e] * (1.f + sc[e]); sh[4 * jj + e] = sf[e]; } }
        f32x4 vn[2][4];
        { const int lane = fresh_lane();
#pragma unroll
          for (int rr = 0; rr < 2; ++rr)
#pragma unroll
              for (int jj = 0; jj < 4; ++jj) vn[rr][jj] = *((const f32x4*)(x + (size_t)(blk * 64 + wave * 8 + rr) * D) + lane + 64 * jj); }
        for (int g = 0; g < 4; ++g) {
            asm volatile("" ::: "memory");
            const int lane = fresh_lane();
            const int m0 = blk * 64 + wave * 8 + g * 2;
            f32x4 v[2][4];
#pragma unroll
            for (int rr = 0; rr < 2; ++rr)
#pragma unroll
                for (int jj = 0; jj < 4; ++jj) v[rr][jj] = vn[rr][jj];
            if (g + 1 < 4) {
#pragma unroll
                for (int rr = 0; rr < 2; ++rr)
#pragma unroll
                    for (int jj = 0; jj < 4; ++jj) vn[rr][jj] = *((const f32x4*)(x + (size_t)(m0 + 2 + rr) * D) + lane + 64 * jj);
            }
            __builtin_amdgcn_sched_barrier(0);
            float hv[2][16];
#pragma unroll
            for (int rr = 0; rr < 2; ++rr) {
                float ss = 0.f;
#pragma unroll
                for (int jj = 0; jj < 4; ++jj) ss += (v[rr][jj].x * v[rr][jj].x + v[rr][jj].y * v[rr][jj].y) + (v[rr][jj].z * v[rr][jj].z + v[rr][jj].w * v[rr][jj].w);
                const float rs = 1.0f / sqrtf(wave_sum(ss) * (1.f / D) + EPS);
                unsigned long long* o8 = (unsigned long long*)(H + (size_t)(m0 + rr) * D) + lane;
#pragma unroll
                for (int jj = 0; jj < 4; ++jj) {
#pragma unroll
                    for (int e = 0; e < 4; ++e) hv[rr][4 * jj + e] = v[rr][jj][e] * rs * gk[4 * jj + e] + sh[4 * jj + e];
                    o8[64 * jj] = (unsigned long long)pk2(hv[rr][4 * jj], hv[rr][4 * jj + 1]) | ((unsigned long long)pk2(hv[rr][4 * jj + 2], hv[rr][4 * jj + 3]) << 32);
                }
            }
            float acc[32];
#pragma unroll
            for (int i = 0; i < 32; ++i) acc[i] = 0.f;
#pragma unroll
            for (int j = 0; j < 16; ++j) {
#pragma unroll
                for (int jj = 0; jj < 4; ++jj) { const f32x4 w = *(const LAS f32x4*)(wdt + j * 1028 + 4 * lane + 256 * jj);
#pragma unroll
                    for (int rr = 0; rr < 2; ++rr) acc[rr * 16 + j] += (hv[rr][4 * jj] * w.x + hv[rr][4 * jj + 1] * w.y) + (hv[rr][4 * jj + 2] * w.z + hv[rr][4 * jj + 3] * w.w); }
                if ((j & 3) == 3) asm volatile("" ::: "memory");
            }
#pragma unroll
            for (int half = 16; half >= 1; half >>= 1) {
                const bool up = (lane & half) != 0;
#pragma unroll
                for (int i = 0; i < half; ++i) { float lo_ = acc[i], hi_ = acc[i + half]; asm volatile("" : "+v"(lo_), "+v"(hi_));
                    const float keep = up ? hi_ : lo_, send = up ? lo_ : hi_; acc[i] = keep + __shfl_xor(send, half); }
            }
            const float tot = acc[0] + __shfl_xor(acc[0], 32);
            const float xr_ = tot + dt_bias[lane & 15];
            const float dtv = xr_ > 20.f ? xr_ : log1pf(__expf(xr_));
            if (lane < 32) DT[(size_t)m0 * 16 + lane] = dtv;
        }
    }
}

constexpr size_t OUT_XBCC = 0;
__device__ __forceinline__ void p3a_phase(const Args& a, int wave, int G) {
    const bf16* PROJ = (const bf16*)(a.ws + WS_PROJ);
    bf16* XBCC = (bf16*)((unsigned char*)a.out + OUT_XBCC);
    const float* conv_w = a.in[6]; const float* conv_b = a.in[7];
    const int lane = fresh_lane(), tid = wave * 64 + lane;
    if (tid >= 480) return;
    const int oct = tid % 160, tgl = tid / 160;
    float cw[4][8], cb[8];
#pragma unroll
    for (int e = 0; e < 8; ++e) { cb[e] = conv_b[8 * oct + e];
#pragma unroll
        for (int k = 0; k < 4; ++k) cw[k][e] = conv_w[k * 1280 + 8 * oct + e]; }
    for (int blk = blockIdx.x; blk < 256; blk += G) {
        for (int tg = tgl; tg < 8; tg += 3) {
            const int m0 = blk * 64 + 8 * tg, ts0 = m0 & (SEQ - 1);
            const char* src = (const char*)(PROJ + (size_t)m0 * NP + C_X + 8 * oct);
            u32x4 raw[11];
#pragma unroll
            for (int i = 0; i < 11; ++i) { const bool ok = (ts0 - 3 + i) >= 0; raw[i] = ok ? *(const u32x4*)(src + ((long)i - 3) * (NP * 2)) : (u32x4){0u, 0u, 0u, 0u}; }
#pragma unroll
            for (int jj = 0; jj < 8; ++jj) {
                float o[8];
#pragma unroll
                for (int e = 0; e < 8; ++e) {
                    float s_ = cb[e];
#pragma unroll
                    for (int k = 0; k < 4; ++k) { const unsigned w = raw[jj + k][e >> 1]; s_ += cw[k][e] * ((e & 1) ? bf_hi(w) : bf_lo(w)); }
                    o[e] = silu_f(s_);
                }
                u32x4 ov; ov.x = pk2(o[0], o[1]); ov.y = pk2(o[2], o[3]); ov.z = pk2(o[4], o[5]); ov.w = pk2(o[6], o[7]);
                *(u32x4*)(XBCC + (size_t)(m0 + jj) * 1280 + 8 * oct) = ov;
            }
        }
    }
}

constexpr int TP = 72;
constexpr int L_CQ = 0, L_BK = 18432, L_BKW = 36864, L_XV = 55296, L_ST0 = 73728, L_ST1 = 82944, L_ACS = 92160, L_DTJ = 93184, L_WJ = 94208, L_CW = 95232;

__device__ __forceinline__ void p3_phase(const Args& a, LAS unsigned char* lds, int tid_in, int lane_in, int wave, int G, const bool dry = false) {
    bf16* PROJ = (bf16*)(a.ws + WS_PROJ);
    const float* DT = (const float*)(a.ws + WS_DT);
    float* SSQM = (float*)(a.ws + WS_SSQM); float* SSQR = (float*)(a.ws + WS_SSQR);
    const float* conv_w = a.in[6]; const float* conv_b = a.in[7]; const float* a_log = a.in[9]; const float* d_skip = a.in[10]; const float* m_norm_w = a.in[11];
    const int pt = wave & 1, it = wave >> 1;
    for (int item = blockIdx.x; item < 256; item += G) {
        const int lane = fresh_lane(), tid = wave * 64 + lane;
        const int r = lane & 31, h = lane >> 5, i16 = lane & 15, q4 = i16 >> 2, p4 = i16 & 3, blk16 = (lane >> 4) & 1;
        const bool ssd = item < 128;
        int b, hd, half;
        if (ssd) { b = item >> 4; hd = item & 15; half = 0; } else { const int t = item - 128; b = t >> 4; hd = (t >> 1) & 7; half = t & 1; }
        const size_t mb = (size_t)b * SEQ;
        __syncthreads();
        for (int idx = tid; idx < 9216 / 4; idx += NTHR) ((LAS unsigned*)(lds + L_ST0))[idx] = 0u;
        const float lg = ssd ? 0.f : log1pf(-exp2f(-5.0f - (float)hd));
        if (!ssd && tid < 256) { const int par = tid >> 7, j = tid & 127;
            ((LAS float*)(lds + L_ACS))[par * 128 + j] = (float)(j + 1) * lg; ((LAS float*)(lds + L_DTJ))[par * 128 + j] = 1.f; ((LAS float*)(lds + L_WJ))[par * 128 + j] = __expf((float)(127 - j) * lg); }
        const float Ah = ssd ? -__expf(a_log[hd]) : 0.f;
        const float Dsk = ssd ? d_skip[hd] : 0.f;
        const int ltile = tid >> 7, loct = tid & 7, ltg = (tid >> 3) & 15;
        int lcol = 0;
        float invf[8];
        if (ssd) {
            lcol = (ltile == 0) ? (64 * hd + 8 * loct) : (ltile == 1 ? (1024 + 64 * (hd >> 3) + 8 * loct) : (1152 + 64 * (hd >> 3) + 8 * loct));
            if (ltile == 3) lcol = 0;
#pragma unroll
            for (int e = 0; e < 8; ++e) invf[e] = 0.f;
        } else {
#pragma unroll
            for (int e = 0; e < 8; ++e) invf[e] = exp2f(-(float)(8 * (tid & 3) + e) * (13.287712379549449f / 32.f));
        }
        f32x16 sacc;
#pragma unroll
        for (int i = 0; i < 16; ++i) sacc[i] = 0.f;
        u32x4 raw[8];
        const int rj = tid >> 2, ro4 = tid & 3;
        const int j0 = 8 * ltg;
        const char* pbase = (const char*)(PROJ + mb * NP);
        const char* xbase = (const char*)((const bf16*)((const unsigned char*)a.out + OUT_XBCC) + mb * 1280);
        const unsigned soff = (unsigned)((j0 * 1280 + lcol) * 2);
        const unsigned roff = (unsigned)((rj * NP) * 2);
#define P3_ISSUE(cc) do { const char* cbp = pbase + (size_t)(cc) * (128 * NP * 2); \
        if (ssd) { const char* xp = xbase + (size_t)(cc) * (128 * 1280 * 2) + soff; _Pragma("unroll") for (int i = 0; i < 8; ++i) raw[i] = *(const u32x4*)(xp + i * (1280 * 2)); } \
        else { const char* rp = cbp + roff; \
            raw[0] = *(const u32x4*)(rp + (C_Q + 64 * hd + 8 * ro4) * 2); raw[1] = *(const u32x4*)(rp + (C_Q + 64 * hd + 32 + 8 * ro4) * 2); \
            raw[2] = *(const u32x4*)(rp + (C_K + 64 * hd + 8 * ro4) * 2); raw[3] = *(const u32x4*)(rp + (C_K + 64 * hd + 32 + 8 * ro4) * 2); \
            raw[4] = *(const u32x4*)(rp + (C_V + 128 * hd + 64 * half + 16 * ro4) * 2); raw[5] = *(const u32x4*)(rp + (C_V + 128 * hd + 64 * half + 16 * ro4 + 8) * 2); } } while (0)
        float dq0 = 0.f, dq1 = 0.f;
#define P3_SCAN(cc) do { LAS float* ACSw = (LAS float*)(lds + L_ACS) + ((cc) & 1) * 128; LAS float* DTJw = (LAS float*)(lds + L_DTJ) + ((cc) & 1) * 128; LAS float* WJw = (LAS float*)(lds + L_WJ) + ((cc) & 1) * 128; \
        const float v0 = dq0 * Ah, v1 = dq1 * Ah, s_ = v0 + v1; float incl = s_; \
        _Pragma("unroll") for (int o = 1; o < 64; o <<= 1) { const float t = __shfl_up(incl, o); if (lane >= o) incl += t; } \
        const float c0 = (incl - s_) + v0, tot = __shfl(incl, 63), c1 = (lane == 63) ? tot : c0 + v1; \
        ACSw[2 * lane] = c0; ACSw[2 * lane + 1] = c1; DTJw[2 * lane] = dq0; DTJw[2 * lane + 1] = dq1; \
        WJw[2 * lane] = dq0 * __expf(tot - c0); WJw[2 * lane + 1] = dq1 * __expf(tot - c1); } while (0)
#define P3_DTLOAD(cc) do { dq0 = DT[(mb + (size_t)(cc) * 128 + 2 * lane) * 16 + hd]; dq1 = DT[(mb + (size_t)(cc) * 128 + 2 * lane + 1) * 16 + hd]; } while (0)
        if (ssd && wave == 0) { P3_DTLOAD(0); P3_SCAN(0); P3_DTLOAD(1); }
        u32x2 zzn[4];
        { const bf16* orow0 = PROJ + (mb + 32 * it + r) * NP + (ssd ? (C_Z + 64 * hd) : (C_GR + 128 * hd + 64 * half));
#pragma unroll
          for (int g4 = 0; g4 < 4; ++g4) zzn[g4] = *(const u32x2*)(orow0 + 32 * pt + 8 * g4 + 4 * h); }
        P3_ISSUE(0);

        for (int c = 0; c < 16; ++c) {
            const int par = c & 1;
            const size_t m0 = mb + (size_t)c * 128;
            LAS float* ACS = (LAS float*)(lds + L_ACS) + par * 128; LAS float* DTJ = (LAS float*)(lds + L_DTJ) + par * 128; LAS float* WJ = (LAS float*)(lds + L_WJ) + par * 128;
            __syncthreads();
#ifndef P3_REPL
#define P3_REPL 1
#endif
            _Pragma("nounroll") for (int repl_ = 0; repl_ < P3_REPL; ++repl_) {
            if (repl_) __syncthreads();
            if (ssd) {
                if (tid < 384) {
                    LAS unsigned char* dst = lds + (ltile == 0 ? L_XV : (ltile == 1 ? L_BK : L_CQ));
#pragma unroll
                    for (int jj = 0; jj < 8; ++jj) {
                        *(LAS u32x4*)(dst + ((j0 + jj) * TP + 8 * loct) * 2) = raw[jj];
                        if (ltile == 1) { const float wj = WJ[j0 + jj]; const u32x4 v = raw[jj];
                            u32x4 ow; ow.x = pk2(bf_lo(v.x) * wj, bf_hi(v.x) * wj); ow.y = pk2(bf_lo(v.y) * wj, bf_hi(v.y) * wj); ow.z = pk2(bf_lo(v.z) * wj, bf_hi(v.z) * wj); ow.w = pk2(bf_lo(v.w) * wj, bf_hi(v.w) * wj);
                            *(LAS u32x4*)(lds + L_BKW + ((j0 + jj) * TP + 8 * loct) * 2) = ow; }
                    }
                }
            } else {
                const int j = rj, o4 = ro4;
                const u32x4 q1 = raw[0], q2 = raw[1], k1 = raw[2], k2 = raw[3];
                const float pos = (float)(c * 128 + j), wj = WJ[j];
                float ql[8], qh[8], kl[8], kh[8];
#pragma unroll
                for (int e = 0; e < 8; ++e) {
                    const float rev = pos * invf[e] * 0.15915494309189535f, fr = rev - floorf(rev);
                    const float cs = __builtin_amdgcn_cosf(fr), sn = __builtin_amdgcn_sinf(fr);
                    const unsigned wq1 = q1[e >> 1], wq2 = q2[e >> 1], wk1 = k1[e >> 1], wk2 = k2[e >> 1];
                    const float a1 = (e & 1) ? bf_hi(wq1) : bf_lo(wq1), a2 = (e & 1) ? bf_hi(wq2) : bf_lo(wq2);
                    const float b1 = ((e & 1) ? bf_hi(wk1) : bf_lo(wk1)) * 0.125f, b2 = ((e & 1) ? bf_hi(wk2) : bf_lo(wk2)) * 0.125f;
                    ql[e] = a1 * cs - a2 * sn; qh[e] = a1 * sn + a2 * cs;
                    kl[e] = b1 * cs - b2 * sn; kh[e] = b1 * sn + b2 * cs;
                }
                u32x4 t;
                t.x = pk2(ql[0], ql[1]); t.y = pk2(ql[2], ql[3]); t.z = pk2(ql[4], ql[5]); t.w = pk2(ql[6], ql[7]); *(LAS u32x4*)(lds + L_CQ + (j * TP + 8 * o4) * 2) = t;
                t.x = pk2(qh[0], qh[1]); t.y = pk2(qh[2], qh[3]); t.z = pk2(qh[4], qh[5]); t.w = pk2(qh[6], qh[7]); *(LAS u32x4*)(lds + L_CQ + (j * TP + 32 + 8 * o4) * 2) = t;
                t.x = pk2(kl[0], kl[1]); t.y = pk2(kl[2], kl[3]); t.z = pk2(kl[4], kl[5]); t.w = pk2(kl[6], kl[7]); *(LAS u32x4*)(lds + L_BK + (j * TP + 8 * o4) * 2) = t;
                t.x = pk2(kh[0], kh[1]); t.y = pk2(kh[2], kh[3]); t.z = pk2(kh[4], kh[5]); t.w = pk2(kh[6], kh[7]); *(LAS u32x4*)(lds + L_BK + (j * TP + 32 + 8 * o4) * 2) = t;
                t.x = pk2(kl[0] * wj, kl[1] * wj); t.y = pk2(kl[2] * wj, kl[3] * wj); t.z = pk2(kl[4] * wj, kl[5] * wj); t.w = pk2(kl[6] * wj, kl[7] * wj); *(LAS u32x4*)(lds + L_BKW + (j * TP + 8 * o4) * 2) = t;
                t.x = pk2(kh[0] * wj, kh[1] * wj); t.y = pk2(kh[2] * wj, kh[3] * wj); t.z = pk2(kh[4] * wj, kh[5] * wj); t.w = pk2(kh[6] * wj, kh[7] * wj); *(LAS u32x4*)(lds + L_BKW + (j * TP + 32 + 8 * o4) * 2) = t;
                *(LAS u32x4*)(lds + L_XV + (j * TP + 16 * o4) * 2) = raw[4]; *(LAS u32x4*)(lds + L_XV + (j * TP + 16 * o4 + 8) * 2) = raw[5];
            }
            }
            __syncthreads();
            const int i0 = 32 * it, iTok = i0 + r;
            bf16* orow = PROJ + (m0 + iTok) * NP + (ssd ? (C_Z + 64 * hd) : (C_GR + 128 * hd + 64 * half));
            u32x2 zz[4];
#pragma unroll
            for (int g4 = 0; g4 < 4; ++g4) zz[g4] = zzn[g4];
            if (c + 1 < 16) {
#pragma unroll
                for (int g4 = 0; g4 < 4; ++g4) zzn[g4] = *(const u32x2*)(orow + 128 * NP + 32 * pt + 8 * g4 + 4 * h);
                P3_ISSUE(c + 1);
            }
            __builtin_amdgcn_sched_barrier(0);
            if (ssd && wave == 0 && c + 1 < 16) { P3_SCAN(c + 1); if (c + 2 < 16) P3_DTLOAD(c + 2); }
#ifndef P3_REPC
#define P3_REPC 1
#endif
            f32x16 acc;
            float acs_i = 0.f;
            LAS unsigned char* STw = lds + (par ? L_ST0 : L_ST1);
            _Pragma("nounroll") for (int repc_ = 0; repc_ < P3_REPC; ++repc_) {
            bf16x8 cqb[4];
#pragma unroll
            for (int s = 0; s < 4; ++s) cqb[s] = *(const LAS bf16x8*)(lds + L_CQ + ((i0 + r) * TP + 16 * s + 8 * h) * 2);
            const LAS unsigned char* STr = lds + (par ? L_ST1 : L_ST0);
#pragma unroll
            for (int i = 0; i < 16; ++i) acc[i] = 0.f;
#pragma unroll
            for (int s = 0; s < 4; ++s) { const bf16x8 sa = *(const LAS bf16x8*)(STr + ((32 * pt + r) * TP + 16 * s + 8 * h) * 2); acc = MFMA32(sa, cqb[s], acc); }
            acs_i = ACS[iTok];
            { const float ei = __expf(acs_i);
#pragma unroll
              for (int i = 0; i < 16; ++i) acc[i] *= ei; }
            for (int jt = 0; jt <= it; ++jt) {
                f32x16 g;
#pragma unroll
                for (int i = 0; i < 16; ++i) g[i] = 0.f;
#pragma unroll
                for (int s = 0; s < 4; ++s) { const bf16x8 ka = *(const LAS bf16x8*)(lds + L_BK + ((32 * jt + r) * TP + 16 * s + 8 * h) * 2); g = MFMA32(ka, cqb[s], g); }
                const bool diag = (jt == it);
#pragma unroll
                for (int g4 = 0; g4 < 4; ++g4) {
                    const f32x4 aj = *(const LAS f32x4*)(ACS + 32 * jt + 8 * g4 + 4 * h), dj = *(const LAS f32x4*)(DTJ + 32 * jt + 8 * g4 + 4 * h);
#pragma unroll
                    for (int e = 0; e < 4; ++e) { float v = g[4 * g4 + e] * __expf(acs_i - aj[e]) * dj[e]; if (diag && (8 * g4 + 4 * h + e) > r) v = 0.f; g[4 * g4 + e] = v; }
                }
#pragma unroll
                for (int s2 = 0; s2 < 2; ++s2) {
                    const bf16x8 pf = pack8(g[8 * s2], g[8 * s2 + 1], g[8 * s2 + 2], g[8 * s2 + 3], g[8 * s2 + 4], g[8 * s2 + 5], g[8 * s2 + 6], g[8 * s2 + 7]);
                    const LAS unsigned char* xb = lds + L_XV + ((32 * jt + 16 * s2 + 4 * h + q4) * TP + 32 * pt + 16 * blk16 + 4 * p4) * 2;
                    const bf16x8 xa = tr_pair(xb, xb + 8 * TP * 2);
                    acc = MFMA32(xa, pf, acc);
                }
            }
            }
            if (it < 2 && c < 15) {
                const int nt = it;
                const float dec = __expf(ACS[127]);
#pragma unroll
                for (int i = 0; i < 16; ++i) sacc[i] *= dec;
#pragma unroll
                for (int ks = 0; ks < 8; ++ks) {
                    const LAS unsigned char* xb = lds + L_XV + ((16 * ks + 8 * h + q4) * TP + 32 * pt + 16 * blk16 + 4 * p4) * 2;
                    const LAS unsigned char* kb = lds + L_BKW + ((16 * ks + 8 * h + q4) * TP + 32 * nt + 16 * blk16 + 4 * p4) * 2;
                    const bf16x8 xa = tr_pair(xb, xb + 4 * TP * 2), kbf = tr_pair(kb, kb + 4 * TP * 2);
                    sacc = MFMA32(xa, kbf, sacc);
                }
#pragma unroll
                for (int i = 0; i < 16; ++i) { const int p = 32 * pt + crow(i, h);
                    *(LAS unsigned short*)(STw + (p * TP + 32 * nt + r) * 2) = (unsigned short)(pk2(sacc[i], 0.f) & 0xffffu); }
            }
            {
                float ss = 0.f;
#pragma unroll
                for (int g4 = 0; g4 < 4; ++g4) {
                    const int p = 32 * pt + 8 * g4 + 4 * h;
                    const float z0 = bf_lo(zz[g4].x), z1 = bf_hi(zz[g4].x), z2 = bf_lo(zz[g4].y), z3 = bf_hi(zz[g4].y);
                    float y0 = acc[4 * g4], y1 = acc[4 * g4 + 1], y2 = acc[4 * g4 + 2], y3 = acc[4 * g4 + 3];
                    float o0, o1, o2, o3;
                    if (ssd) {
                        const u32x2 xv = *(const LAS u32x2*)(lds + L_XV + (iTok * TP + p) * 2);
                        const f32x4 mw = *(const f32x4*)(m_norm_w + 64 * hd + p);
                        y0 = (y0 + Dsk * bf_lo(xv.x)) * silu_f(z0); y1 = (y1 + Dsk * bf_hi(xv.x)) * silu_f(z1); y2 = (y2 + Dsk * bf_lo(xv.y)) * silu_f(z2); y3 = (y3 + Dsk * bf_hi(xv.y)) * silu_f(z3);
                        ss += (y0 * y0 + y1 * y1) + (y2 * y2 + y3 * y3);
                        o0 = y0 * mw.x; o1 = y1 * mw.y; o2 = y2 * mw.z; o3 = y3 * mw.w;
                    } else {
                        ss += (y0 * y0 + y1 * y1) + (y2 * y2 + y3 * y3);
                        o0 = y0 * silu_f(z0); o1 = y1 * silu_f(z1); o2 = y2 * silu_f(z2); o3 = y3 * silu_f(z3);
                    }
                    u32x2 ov; ov.x = pk2(o0, o1); ov.y = pk2(o2, o3);
                    if (dry) *(u32x2*)((bf16*)((unsigned char*)a.out + 40 * MiB) + (m0 + iTok) * 512 + ((64 * hd + 64 * half + p) & 511)) = ov; else *(u32x2*)(orow + p) = ov;
                }
                ss += __shfl_xor(ss, 32);
                if (h == 0) { if (ssd) SSQM[(m0 + iTok) * 32 + hd * 2 + pt] = ss; else SSQR[(m0 + iTok) * 32 + hd * 4 + half * 2 + pt] = ss; }
            }
        }
#undef P3_ISSUE
#undef P3_SCAN
#undef P3_DTLOAD
    }
}

constexpr int MP = 1032;
constexpr int L4_MERGED = 0, L4_ASTG = 132096, L4_RM = 150528, L4_RR = 151040, L4_RED = 153088, L4_RS = 155136;
static_assert(L4_RS + 256 <= LDS_BYTES, "P4 LDS map");

template <int SEGSHIFT>
__device__ __forceinline__ void p4_gemmT(f32x16 (&accT)[2][2], const bf16* Abase  , const LAS float* rsc  , int nseg,
                                         const bf16* WF  , int nt0  , LAS unsigned char* lds, int tid, int lane) {
    const int srow = tid >> 3, soct = tid & 7, r = lane & 31, h = lane >> 5;
    const char* ab = (const char*)Abase; const unsigned aoff = (unsigned)((srow * NP + 8 * soct) * 2);
    const char* wb = (const char*)WF + (size_t)nt0 * 65536; const unsigned woff = (unsigned)(lane * 16);
    const int rot = ((int)blockIdx.x >> 3) & 15;
    u32x4 ar[16];
#pragma unroll
    for (int i = 0; i < 16; ++i) ar[i] = *(const u32x4*)(ab + ((rot + i) & 15) * 128 + aoff);
    bf16x8 wc[4][2];
    { const char* wk0 = wb + rot * 4096;
#pragma unroll
      for (int s = 0; s < 4; ++s) { wc[s][0] = *(const bf16x8*)(wk0 + s * 1024 + woff); wc[s][1] = *(const bf16x8*)(wk0 + 65536 + s * 1024 + woff); } }
#pragma unroll
    for (int ki = 0; ki < 16; ++ki) {
        const int kc = (ki + rot) & 15;
        LAS unsigned char* stg = lds + L4_ASTG + (ki & 1) * 9216;
        { const float sc = rsc[srow * nseg + ((kc * 64) >> SEGSHIFT)];
          u32x4 o;
          o.x = pk2(bf_lo(ar[ki].x) * sc, bf_hi(ar[ki].x) * sc); o.y = pk2(bf_lo(ar[ki].y) * sc, bf_hi(ar[ki].y) * sc);
          o.z = pk2(bf_lo(ar[ki].z) * sc, bf_hi(ar[ki].z) * sc); o.w = pk2(bf_lo(ar[ki].w) * sc, bf_hi(ar[ki].w) * sc);
          *(LAS u32x4*)(stg + (srow * TP + 8 * soct) * 2) = o; }
        __syncthreads();
        const int kn = (kc + 1) & 15;
        const char* wk = wb + kn * 4096;
        bf16x8 a0 = *(const LAS bf16x8*)(stg + (r * TP + 8 * h) * 2), a1 = *(const LAS bf16x8*)(stg + ((32 + r) * TP + 8 * h) * 2);
#pragma unroll
        for (int s = 0; s < 4; ++s) {
            bf16x8 n0 = a0, n1 = a1;
            if (s < 3) { n0 = *(const LAS bf16x8*)(stg + (r * TP + 16 * (s + 1) + 8 * h) * 2); n1 = *(const LAS bf16x8*)(stg + ((32 + r) * TP + 16 * (s + 1) + 8 * h) * 2); }
            accT[0][0] = MFMA32(wc[s][0], a0, accT[0][0]); accT[0][1] = MFMA32(wc[s][1], a0, accT[0][1]);
            accT[1][0] = MFMA32(wc[s][0], a1, accT[1][0]); accT[1][1] = MFMA32(wc[s][1], a1, accT[1][1]);
            wc[s][0] = *(const bf16x8*)(wk + s * 1024 + woff); wc[s][1] = *(const bf16x8*)(wk + 65536 + s * 1024 + woff);
            __builtin_amdgcn_sched_barrier(0);
            a0 = n0; a1 = n1;
        }
    }
    __syncthreads();
}

__device__ __forceinline__ void p4_phase(const Args& a, LAS unsigned char* lds, int tid_in, int lane_in, int wave, int G) {
    const bf16* PROJ = (const bf16*)(a.ws + WS_PROJ);
    const float* SSQM = (const float*)(a.ws + WS_SSQM); const float* SSQR = (const float*)(a.ws + WS_SSQR);
    const float* MOD = (const float*)(a.ws + WS_MOD);
    const bf16* WMF = (const bf16*)(a.ws + WS_WMF); const bf16* WRF = (const bf16*)(a.ws + WS_WRF); const bf16* WOF = (const bf16*)(a.ws + WS_WOF);
    const float* x = a.in[0]; const float* fw = a.in[15]; float* out = a.out;
    LAS float* RM = (LAS float*)(lds + L4_RM); LAS float* RR = (LAS float*)(lds + L4_RR); LAS float* RED = (LAS float*)(lds + L4_RED); LAS float* RS = (LAS float*)(lds + L4_RS);
    for (int blk = blockIdx.x; blk < 256; blk += G) {
        const size_t m0 = (size_t)blk * 64; const int b = blk >> 5;
        int lane = fresh_lane(), tid = wave * 64 + lane, r = lane & 31, h = lane >> 5;
        __syncthreads();
        { const int row = tid >> 3, sub = tid & 7;
          const f32x4 qv = *(const f32x4*)(SSQR + (m0 + row) * 32 + 4 * sub);
          RR[row * 8 + sub] = 1.0f / sqrtf(((qv.x + qv.y) + (qv.z + qv.w)) * (1.f / 128.f) + EPS);
          if (sub < 2) { float s = 0.f;
#pragma unroll
              for (int i = 0; i < 4; ++i) { const f32x4 v = *(const f32x4*)(SSQM + (m0 + row) * 32 + 16 * sub + 4 * i); s += (v.x + v.y) + (v.z + v.w); }
              RM[row * 2 + sub] = 1.0f / sqrtf(s * (1.f / 512.f) + EPS); } }
        __syncthreads();
#ifndef P4_SKIP1
#ifndef P4_REP1
#define P4_REP1 1
#endif
        for (int nh_ = 0; nh_ < 2 * P4_REP1; ++nh_) {
            const int nh = nh_ & 1;
            lane = fresh_lane(); tid = wave * 64 + lane; r = lane & 31; h = lane >> 5;
            const int nt0 = 16 * nh + 2 * wave;
            const bf16* pblk = PROJ + m0 * NP;
            f32x16 accT[2][2];
#pragma unroll
            for (int i = 0; i < 2; ++i)
#pragma unroll
                for (int j = 0; j < 2; ++j)
#pragma unroll
                    for (int e = 0; e < 16; ++e) accT[i][j][e] = 0.f;
            u32x2 gpre[2][2][4];
            { const unsigned lo0 = (unsigned)((r * NP + 4 * h) * 2); const char* gb0 = (const char*)(pblk + C_GAM + 32 * nt0);
#pragma unroll
              for (int rt = 0; rt < 2; ++rt)
#pragma unroll
                  for (int ct = 0; ct < 2; ++ct)
#pragma unroll
                      for (int g4 = 0; g4 < 4; ++g4) gpre[rt][ct][g4] = *(const u32x2*)(gb0 + (lo0 + (unsigned)((32 * rt * NP + 32 * ct + 8 * g4) * 2)));
              __builtin_amdgcn_sched_barrier(0); }
            p4_gemmT<9>(accT, pblk + C_Z, RM, 2, WMF, nt0, lds, tid, lane);
            {
                lane = fresh_lane(); r = lane & 31; h = lane >> 5;
                const unsigned lm = launder((unsigned)(L4_MERGED + (r * MP + 4 * h) * 2));
#pragma unroll
                for (int rt = 0; rt < 2; ++rt)
#pragma unroll
                    for (int ct = 0; ct < 2; ++ct)
#pragma unroll
                        for (int g4 = 0; g4 < 4; ++g4) {
                            const u32x2 gg = gpre[rt][ct][g4];
                            u32x2 ov; ov.x = pk2(accT[rt][ct][4 * g4] * sigm_f(bf_lo(gg.x)), accT[rt][ct][4 * g4 + 1] * sigm_f(bf_hi(gg.x)));
                            ov.y = pk2(accT[rt][ct][4 * g4 + 2] * sigm_f(bf_lo(gg.y)), accT[rt][ct][4 * g4 + 3] * sigm_f(bf_hi(gg.y)));
                            *(LAS u32x2*)(lds + lm + (unsigned)((32 * rt * MP + 32 * (nt0 + ct) + 8 * g4) * 2)) = ov; }
            }
#pragma unroll
            for (int i = 0; i < 2; ++i)
#pragma unroll
                for (int j = 0; j < 2; ++j)
#pragma unroll
                    for (int e = 0; e < 16; ++e) accT[i][j][e] = 0.f;
            lane = fresh_lane(); tid = wave * 64 + lane; r = lane & 31; h = lane >> 5;
            { const unsigned lo0 = (unsigned)((r * NP + 4 * h) * 2); const char* gb0 = (const char*)(pblk + C_GAR + 32 * nt0);
#pragma unroll
              for (int rt = 0; rt < 2; ++rt)
#pragma unroll
                  for (int ct = 0; ct < 2; ++ct)
#pragma unroll
                      for (int g4 = 0; g4 < 4; ++g4) gpre[rt][ct][g4] = *(const u32x2*)(gb0 + (lo0 + (unsigned)((32 * rt * NP + 32 * ct + 8 * g4) * 2)));
              __builtin_amdgcn_sched_barrier(0); }
            p4_gemmT<7>(accT, pblk + C_GR, RR, 8, WRF, nt0, lds, tid, lane);
            {
                lane = fresh_lane(); r = lane & 31; h = lane >> 5;
                const unsigned lm = launder((unsigned)(L4_MERGED + (r * MP + 4 * h) * 2));
#pragma unroll
                for (int rt = 0; rt < 2; ++rt)
#pragma unroll
                    for (int ct = 0; ct < 2; ++ct)
#pragma unroll
                        for (int g4 = 0; g4 < 4; ++g4) {
                            const u32x2 gg = gpre[rt][ct][g4];
                            LAS u32x2* mp = (LAS u32x2*)(lds + lm + (unsigned)((32 * rt * MP + 32 * (nt0 + ct) + 8 * g4) * 2));
                            const u32x2 pm = *mp;
                            const float v0 = bf_lo(pm.x) + accT[rt][ct][4 * g4] * sigm_f(bf_lo(gg.x)), v1 = bf_hi(pm.x) + accT[rt][ct][4 * g4 + 1] * sigm_f(bf_hi(gg.x));
                            const float v2 = bf_lo(pm.y) + accT[rt][ct][4 * g4 + 2] * sigm_f(bf_lo(gg.y)), v3 = bf_hi(pm.y) + accT[rt][ct][4 * g4 + 3] * sigm_f(bf_hi(gg.y));
                            u32x2 ov; ov.x = pk2(v0, v1); ov.y = pk2(v2, v3);
                            *mp = ov; }
            }
        }
#endif
        __syncthreads();
        lane = fresh_lane(); tid = wave * 64 + lane; r = lane & 31; h = lane >> 5;
#ifndef P4_SKIP2
#ifndef P4_REP2
#define P4_REP2 1
#endif
        _Pragma("nounroll") for (int rep2_ = 0; rep2_ < P4_REP2; ++rep2_) {
            if (rep2_) { __syncthreads(); lane = fresh_lane(); tid = wave * 64 + lane; r = lane & 31; h = lane >> 5; }
            f32x16 acc[2][4];
#pragma unroll
            for (int i = 0; i < 2; ++i)
#pragma unroll
                for (int j = 0; j < 4; ++j)
#pragma unroll
                    for (int e = 0; e < 16; ++e) acc[i][j][e] = 0.f;
            const char* wb = (const char*)WOF + (size_t)(4 * wave) * 65536; const unsigned woff = (unsigned)(lane * 16);
            const int rot2 = ((int)blockIdx.x >> 3) & 31;
            bf16x8 wc[2][4];
#pragma unroll
            for (int s = 0; s < 2; ++s)
#pragma unroll
                for (int ct = 0; ct < 4; ++ct) wc[s][ct] = *(const bf16x8*)(wb + ct * 65536 + (2 * rot2 + s) * 1024 + woff);
            const LAS unsigned char* ma = lds + L4_MERGED + (r * MP + 8 * h) * 2;
            bf16x8 a0 = *(const LAS bf16x8*)(ma + (2 * rot2) * 32), a1 = *(const LAS bf16x8*)(ma + 32 * MP * 2 + (2 * rot2) * 32);
            for (int ki = 0; ki < 32; ++ki) {
                const int kp = (ki + rot2) & 31, kpn = (kp + 1) & 31;
#pragma unroll
                for (int s = 0; s < 2; ++s) {
                    const int ksn = (s == 0) ? 2 * kp + 1 : 2 * kpn;
                    const bf16x8 n0 = *(const LAS bf16x8*)(ma + ksn * 32), n1 = *(const LAS bf16x8*)(ma + 32 * MP * 2 + ksn * 32);
#pragma unroll
                    for (int ct = 0; ct < 4; ++ct) { acc[0][ct] = MFMA32(a0, wc[s][ct], acc[0][ct]); acc[1][ct] = MFMA32(a1, wc[s][ct], acc[1][ct]); }
#pragma unroll
                    for (int ct = 0; ct < 4; ++ct) wc[s][ct] = *(const bf16x8*)(wb + ct * 65536 + (2 * kpn + s) * 1024 + woff);
                    __builtin_amdgcn_sched_barrier(0);
                    a0 = n0; a1 = n1;
                }
            }
            lane = fresh_lane(); r = lane & 31; h = lane >> 5;
            const char* xblk = (const char*)(x + m0 * D); char* oblk = (char*)(out + m0 * D);
            const unsigned eo = launder((unsigned)(4 * (4 * h * D + 128 * wave + r)));
            const unsigned rb = launder((unsigned)(L4_RED + (4 * h * 8 + wave) * 4));
            float gate[4], fwv[4];
#pragma unroll
            for (int ct = 0; ct < 4; ++ct) { const int n = 32 * (4 * wave + ct) + r; gate[ct] = MOD[b * 3072 + 2048 + n]; fwv[ct] = fw[n]; }
#pragma unroll
            for (int rt = 0; rt < 2; ++rt)
#pragma unroll
                for (int g8 = 0; g8 < 2; ++g8) {
                    float xv[8][4];
#pragma unroll
                    for (int e = 0; e < 8; ++e)
#pragma unroll
                        for (int ct = 0; ct < 4; ++ct) xv[e][ct] = *(const float*)(xblk + (eo + (unsigned)(((32 * rt + (e & 3) + 8 * (2 * g8 + (e >> 2))) * D + 32 * ct) * 4)));
#pragma unroll
                    for (int e = 0; e < 8; ++e) {
                        const int reg = 8 * g8 + e, rowc = 32 * rt + (reg & 3) + 8 * (reg >> 2);
                        float s = 0.f;
#pragma unroll
                        for (int ct = 0; ct < 4; ++ct) { const float v = xv[e][ct] + gate[ct] * acc[rt][ct][reg]; acc[rt][ct][reg] = v; s += v * v; }
                        s += __shfl_xor(s, 16); s += __shfl_xor(s, 8); s += __shfl_xor(s, 4); s += __shfl_xor(s, 2); s += __shfl_xor(s, 1);
                        *(LAS float*)(lds + rb + (unsigned)(rowc * 32)) = s;
                    }
                    asm volatile("" ::: "memory"); __builtin_amdgcn_sched_barrier(0);
                }
            __syncthreads();
            if (tid < 64) { float s = 0.f;
#pragma unroll
                for (int w = 0; w < 8; ++w) s += RED[tid * 8 + w];
                RS[tid] = 1.0f / sqrtf(s * (1.f / D) + EPS); }
            __syncthreads();
            const unsigned eo2 = launder(eo);
            const unsigned sb = launder((unsigned)(L4_RS + 4 * h * 4));
#pragma unroll
            for (int rt = 0; rt < 2; ++rt)
#pragma unroll
                for (int reg = 0; reg < 16; ++reg) {
                    const int rowc = 32 * rt + (reg & 3) + 8 * (reg >> 2); const float rs = *(const LAS float*)(lds + sb + (unsigned)(rowc * 4));
#pragma unroll
                    for (int ct = 0; ct < 4; ++ct) *(float*)(oblk + (eo2 + (unsigned)((rowc * D + 32 * ct) * 4))) = acc[rt][ct][reg] * rs * fwv[ct];
                }
        }
#endif
    }
}

#define XB_TMO      128
#define XB_XCNT(j)  (256  + 64 * (j))
#define XB_XSUB(j)  (1280 + 64 * (j))
#define XB_XGEN(j)  (2304 + 64 * (j))
#define XB_TOP      3328
#define XB_TOPGEN   3392
#define XCD_BAR_WORDS 3456
#define XB_SPIN_CAP (1u << 18)

__device__ __forceinline__ unsigned xb_ld(unsigned* p)              { return __hip_atomic_load(p, __ATOMIC_RELAXED, __HIP_MEMORY_SCOPE_AGENT); }
__device__ __forceinline__ unsigned xb_add(unsigned* p, unsigned v) { return __hip_atomic_fetch_add(p, v, __ATOMIC_RELAXED, __HIP_MEMORY_SCOPE_AGENT); }
__device__ __forceinline__ unsigned xb_xcc_id() { return (unsigned)__builtin_amdgcn_s_getreg((3 << 11) | 20) & 0xFu; }
#define XB_SPIN(cond, bar) do { unsigned _sp = 0; while (cond) { __builtin_amdgcn_s_sleep(1); \
    if ((++_sp & 255u) == 0u) { if (xb_ld(&(bar)[XB_TMO])) break; if (_sp > XB_SPIN_CAP) { atomicAdd(&(bar)[XB_TMO], 1u); break; } } } } while (0)

struct XcdBarrier {
    unsigned* bar; unsigned x;
    volatile LAS unsigned* st;
};

__device__ __forceinline__ XcdBarrier xcd_barrier_post(unsigned* bar, volatile LAS unsigned* st) {
    XcdBarrier b; b.bar = bar; b.x = xb_xcc_id(); b.st = st;
    if (threadIdx.x == 0) (void)xb_add(&bar[XB_XCNT(b.x)], 1u);
    return b;
}
__device__ __forceinline__ void xcd_barrier_complete(unsigned* bar, unsigned x, unsigned& nloc, unsigned& nx) {
    const unsigned G = gridDim.x * gridDim.y * gridDim.z;
    unsigned sum, cnt, mine, sp = 0u;
    for (;;) {
        sum = 0u; cnt = 0u; mine = 0u;
#pragma unroll
        for (unsigned j = 0; j < 16; ++j) { const unsigned c = xb_ld(&bar[XB_XCNT(j)]); sum += c; cnt += (c > 0u) ? 1u : 0u; mine = (j == x) ? c : mine; }
        if (sum == G) break;
        __builtin_amdgcn_s_sleep(1);
        if ((++sp & 255u) == 0u) { if (xb_ld(&bar[XB_TMO])) break; if (sp > XB_SPIN_CAP) { atomicAdd(&bar[XB_TMO], 1u); break; } }
    }
    nloc = mine > 0u ? mine : 1u; nx = cnt > 0u ? cnt : 1u;
}

__device__ __forceinline__ void xcd_barrier(const XcdBarrier& b) {
    asm volatile("s_waitcnt vmcnt(0)" ::: "memory");
    __syncthreads();
    if (threadIdx.x == 0) {
        unsigned* bar = b.bar;
        __builtin_amdgcn_s_waitcnt(0);
        unsigned nloc = b.st[0], nx = b.st[1];
        if (nloc == 0u) { xcd_barrier_complete(bar, b.x, nloc, nx); b.st[0] = nloc; b.st[1] = nx; }
        const unsigned old = xb_add(&bar[XB_XSUB(b.x)], 1u);
        const unsigned gen = old / nloc;
        if (old + 1u == (gen + 1u) * nloc) {
            __builtin_amdgcn_fence(__ATOMIC_RELEASE, "agent");
            asm volatile("s_waitcnt vmcnt(0)" ::: "memory");
            const unsigned og = xb_add(&bar[XB_TOP], 1u);
            const unsigned tg = og / nx;
            if (og + 1u == (tg + 1u) * nx) xb_add(&bar[XB_TOPGEN], 1u);
            else XB_SPIN(xb_ld(&bar[XB_TOPGEN]) == tg, bar);
            __builtin_amdgcn_fence(__ATOMIC_ACQUIRE, "agent");
            xb_add(&bar[XB_XGEN(b.x)], 1u);
            asm volatile("s_waitcnt vmcnt(0)" ::: "memory");
        } else {
            XB_SPIN(xb_ld(&bar[XB_XGEN(b.x)]) == gen, bar);
            __builtin_amdgcn_fence(__ATOMIC_ACQUIRE, "agent");
            asm volatile("s_waitcnt vmcnt(0)" ::: "memory");
        }
    }
    __syncthreads();
}

__global__ void __launch_bounds__(NTHR, 2) hybrid_fwd(Args args) {
    extern __shared__ __attribute__((aligned(16))) unsigned char lds_raw[];
    LAS unsigned char* lds = (LAS unsigned char*)lds_raw;
    const int wave = __builtin_amdgcn_readfirstlane((int)threadIdx.x >> 6), G = gridDim.x; const int tid = 0, lane = 0;
    cg::grid_group grid = cg::this_grid();
    volatile LAS unsigned* misc = (volatile LAS unsigned*)(lds + LDS_MISC);
    if (threadIdx.x < 2) misc[threadIdx.x] = 0u;
    __syncthreads();
    XcdBarrier xbar = xcd_barrier_post((unsigned*)(args.ws + WS_CTL), misc);
    const int lo = args.ph_lo, hi = args.ph_hi;
#ifndef PHMASK
#define PHMASK 31
#endif
#define IN(k) (((PHMASK >> (k)) & 1) && lo <= (k) && (k) < hi)
#define SEAM(k) do { if (IN(k) && IN((k) + 1)) { if (lo < 0) grid.sync(); else xcd_barrier(xbar); } } while (0)
#ifndef REPEAT_MASK
#define REPEAT_MASK 0
#endif
#define REP(k) _Pragma("nounroll") for (int rep_ = 0; rep_ < 1 + ((REPEAT_MASK >> (k)) & 1); ++rep_)
#ifdef EXTRA_SYNCS
    for (int es_ = 0; es_ < EXTRA_SYNCS; ++es_) xcd_barrier(xbar);
#endif
    if (IN(0)) REP(0) { if (rep_) xcd_barrier(xbar); p0_phase(args, lds, tid, lane, wave, G); }
    SEAM(0);
    if (IN(1)) REP(1) { if (rep_) xcd_barrier(xbar); p1_phase(args, lds, tid, lane, wave, G); }
    SEAM(1);
    if (IN(2)) REP(2) {
        if (rep_) xcd_barrier(xbar);
        __syncthreads();
        pg8::Gemm g{(const pg8::bf16_t*)((const unsigned char*)args.out + OUT_H), (const pg8::bf16_t*)((const unsigned char*)args.out + OUT_WINT), MTOK, NP, D};
        pg8::StaticOrder S; S.init(MTOK, NP, G, (int)blockIdx.x);
        pg8::EpiProj E{(pg8::bf16_t*)(args.ws + WS_PROJ), NP};
        pg8::gemm_phase<pg8::EpiProj, pg8::StaticOrder, true, true>(lds, g, S, E, wave);
    }
    SEAM(2);
    if (IN(3)) { p3a_phase(args, wave, G); xcd_barrier(xbar); if ((REPEAT_MASK >> 3) & 1) { p3_phase(args, lds, tid, lane, wave, G, true); xcd_barrier(xbar); } p3_phase(args, lds, tid, lane, wave, G); }
    SEAM(3);
    if (IN(4)) REP(4) { if (rep_) xcd_barrier(xbar); p4_phase(args, lds, tid, lane, wave, G); }
#undef REP
#undef IN
#undef SEAM
}

extern "C" void kernel_launch(void* const* d_in, const int* in_sizes, int n_in, void* d_out, int out_size, void* d_ws, size_t ws_size, hipStream_t stream) {
    static int grid = 0;
    if (grid == 0) {
        if (n_in != 16 || out_size != MTOK * D || ws_size < WS_END) { fprintf(stderr, "kernel_launch: unexpected shapes (n_in %d out %d ws %zu)\n", n_in, out_size, ws_size); grid = -1; return; }
        int dev = 0, cus = 0, per_cu = 0;
        (void)hipGetDevice(&dev);
        (void)hipDeviceGetAttribute(&cus, hipDeviceAttributeMultiprocessorCount, dev);
        if (hipFuncSetAttribute((const void*)hybrid_fwd, hipFuncAttributeMaxDynamicSharedMemorySize, LDS_BYTES) != hipSuccess) { fprintf(stderr, "kernel_launch: hipFuncSetAttribute failed\n"); grid = -1; return; }
        if (hipOccupancyMaxActiveBlocksPerMultiprocessor(&per_cu, (const void*)hybrid_fwd, NTHR, LDS_BYTES) != hipSuccess || per_cu < 1) { fprintf(stderr, "kernel_launch: occupancy query says %d\n", per_cu); per_cu = 1; }
        (void)hipGetLastError();
        grid = cus * per_cu;
        if (grid > 256) grid = 256;
        if (grid < 1) grid = 1;
    }
    if (grid < 0) return;
    if (hipMemsetAsync((char*)d_ws + WS_CTL, 0, CTL_BYTES, stream) != hipSuccess) { fprintf(stderr, "kernel_launch: memset of the barrier words failed\n"); return; }
    Args a{};
    for (int i = 0; i < 16; ++i) a.in[i] = (const float*)d_in[i];
    a.out = (float*)d_out; a.ws = (unsigned char*)d_ws;
#if N_LAUNCHES == 1
    a.ph_lo = 0; a.ph_hi = NPH;
    void* kargs[] = {&a};
    hipError_t e = hipLaunchCooperativeKernel((const void*)hybrid_fwd, dim3(grid), dim3(NTHR), kargs, LDS_BYTES, stream);
    if (e != hipSuccess) fprintf(stderr, "kernel_launch: cooperative launch failed: %s (grid %d)\n", hipGetErrorString(e), grid);
#else
    for (int p = 0; p < NPH; ++p) {
        a.ph_lo = p; a.ph_hi = p + 1;
        hipLaunchKernelGGL(hybrid_fwd, dim3(grid), dim3(NTHR), LDS_BYTES, stream, a);
    }
#endif
}
```

```cpp
#include <hip/hip_runtime.h>
#include <hip/hip_cooperative_groups.h>
#include <cstdio>
#include <cstdint>
namespace cg = cooperative_groups;
#define N_LAUNCHES 1
#define REPEAT_MASK 0
#define P4_REP2 1
__device__ __forceinline__ unsigned launder(unsigned v) { asm volatile("" : "+v"(v)); return v; }
__device__ __forceinline__ int fresh_lane() { unsigned z; asm volatile("v_mov_b32 %0, 0" : "=v"(z)); return (int)__builtin_amdgcn_mbcnt_hi(~0u, __builtin_amdgcn_mbcnt_lo(~0u, z)); }
namespace pg8 {
#define PG8_LAS __attribute__((address_space(3)))
typedef unsigned short bf16_t;
typedef short bf16x8 __attribute__((ext_vector_type(8)));
typedef float f32x4 __attribute__((ext_vector_type(4)));
typedef unsigned u32x4 __attribute__((ext_vector_type(4)));
constexpr int BM = 256, BK = 64, HALF = 128, HTB = HALF * BK * 2  , STAGE_BYTES = 8 * HTB, NXCD = 8, WGM = 8;

__host__ __device__ __forceinline__ int lds_byte(int r, int c) { const int st = (r >> 4) * 2 + (c >> 5), rr = r & 15, cc = c & 31, ob = rr * 64 + cc * 2; return st * 1024 + (ob ^ (((ob >> 9) & 1) << 5)); }
__host__ __device__ __forceinline__ void stage_rc(int b, int& R, int& C) { const int st = b / 1024, sb = b % 1024, swz = sb ^ (((sb >> 9) & 1) << 5); R = (st >> 1) * 16 + swz / 64; C = (st & 1) * 32 + (swz % 64) / 2; }
__host__ __device__ __forceinline__ int perm32(int rho) { const int n = rho >> 4, i = rho & 15; return 8 * (i >> 2) + 4 * n + (i & 3); }

struct Unit { int pm, pn; };
struct Gemm { const bf16_t* A; const bf16_t* Bt; int M, N, K; };

struct StaticOrder {
    int nM, nN, nwg, G, c;
    __host__ __device__ void init(int M, int N, int G_, int c_) { nM = M / BM; nN = N / BM; nwg = nM * nN; G = G_; c = c_; }
    __host__ __device__ bool next(int i, Unit& u) const {
        const long L = (long)i * G + c; if (L >= nwg) return false;
        int wgid = (int)L; { const int q = nwg / NXCD, r = nwg % NXCD, xcd = wgid % NXCD, off = wgid / NXCD; wgid = (xcd < r ? xcd * (q + 1) : r * (q + 1) + (xcd - r) * q) + off; }
        const int nig = WGM * nN, gid = wgid / nig, fm = gid * WGM, gsz = (nM - fm) < WGM ? (nM - fm) : WGM;
        u.pm = fm + ((wgid % nig) % gsz); u.pn = (wgid % nig) / gsz; return true;
    }
    __device__ __forceinline__ void a_ready(const Unit&) const {}
    __device__ __forceinline__ void done(const Unit&) const {}
};
__device__ __forceinline__ unsigned cvt_pk_bf16(float lo, float hi) { unsigned r; asm volatile("v_cvt_pk_bf16_f32 %0, %1, %2" : "=v"(r) : "v"(lo), "v"(hi)); return r; }
struct EpiProj {
    static constexpr bool PERM = true, AFTER_DRAIN = false;
    bf16_t* O; int ldc;
    __device__ __forceinline__ void operator()(const f32x4 (&acc)[2][2][4][2], const Unit& u, int wr, int wc, int fr, int fq) const {
        const int row0 = u.pm * BM + wr * 64 + fr; const int col0 = u.pn * BM + wc * 32 + 8 * fq;
#pragma unroll
        for (int ai = 0; ai < 2; ++ai)
#pragma unroll
            for (int m = 0; m < 4; ++m) { bf16_t* rowp = O + (size_t)(row0 + ai * HALF + m * 16) * ldc + col0;
#pragma unroll
                for (int bj = 0; bj < 2; ++bj) { const f32x4 v0 = acc[ai][bj][m][0], v1 = acc[ai][bj][m][1];
                    u32x4 w; w.x = cvt_pk_bf16(v0[0], v0[1]); w.y = cvt_pk_bf16(v0[2], v0[3]); w.z = cvt_pk_bf16(v1[0], v1[1]); w.w = cvt_pk_bf16(v1[2], v1[3]);
                    *(u32x4*)(rowp + bj * HALF) = w; } }
    }
    __device__ __forceinline__ void fused(f32x4 (&)[2][2][4][2], const Unit&, int, int, int, int, PG8_LAS unsigned char*, int, int) const {}
};
template <class Epi, class Sched, bool ALIGN_EPI = false, bool SP2 = false>
__device__ __forceinline__ void gemm_phase(PG8_LAS unsigned char* lds, const Gemm g, const Sched& S, const Epi& E, const int wid) {
    const int lane = ::fresh_lane(), tid = wid * 64 + lane, wr = wid >> 2, wc = wid & 3, fr = lane & 15, fq = lane >> 4;
    const int K = g.K, nt = K / BK;
    unsigned voffA[2], voffB[2];
#pragma unroll
    for (int i = 0; i < 2; ++i) { int R, C; stage_rc(tid * 16 + i * 8192, R, C); const int Rb = Epi::PERM ? ((R & ~31) + perm32(R & 31)) : R;
        voffA[i] = (unsigned)(R * K + C) * 2u; voffB[i] = (unsigned)(Rb * K + C) * 2u; }
    const size_t kstep = (size_t)(BK * 2);
    const size_t hstep = (size_t)HALF * K * 2;
    const size_t tstep = 2 * hstep;
    const unsigned ldsw = (unsigned)wid * 1024u;
    const int aoff = lds_byte(wr * 64 + fr, fq * 8), boff = lds_byte(wc * 32 + fr, fq * 8);
#define PG8_SA(b, h) (((b) * 2 + (h)) * HTB)
#define PG8_SB(b, h) ((4 + (b) * 2 + (h)) * HTB)
#define PG8_STAGE(bufoff, gbase, voff) do { _Pragma("unroll") for (int _i = 0; _i < 2; ++_i) \
        __builtin_amdgcn_global_load_lds((const unsigned*)((const char*)(gbase) + (voff)[_i]), (PG8_LAS unsigned*)(lds + (bufoff) + ldsw + _i * 8192), 16, 0, 0); } while (0)
#define PG8_LDA(dst, b, h) do { _Pragma("unroll") for (int m = 0; m < 4; ++m) _Pragma("unroll") for (int k = 0; k < 2; ++k) dst[m][k] = *(const PG8_LAS bf16x8*)(lds + PG8_SA(b, h) + aoff + m * 2048 + k * 1024); } while (0)
#define PG8_LDB(dst, b, h) do { _Pragma("unroll") for (int n = 0; n < 2; ++n) _Pragma("unroll") for (int k = 0; k < 2; ++k) dst[n][k] = *(const PG8_LAS bf16x8*)(lds + PG8_SB(b, h) + boff + n * 2048 + k * 1024); } while (0)
#define PG8_MMA(ai, bj, At, Bt) do { __builtin_amdgcn_s_setprio(1); _Pragma("unroll") for (int m = 0; m < 4; ++m) _Pragma("unroll") for (int n = 0; n < 2; ++n) _Pragma("unroll") for (int k = 0; k < 2; ++k) \
        acc[ai][bj][m][n] = __builtin_amdgcn_mfma_f32_16x16x32_bf16(Bt[n][k], At[m][k], acc[ai][bj][m][n], 0, 0, 0); __builtin_amdgcn_s_setprio(0); } while (0)
#define PG8_WAIT_V(n) asm volatile("s_waitcnt vmcnt(" #n ")" ::: "memory")
#define PG8_WAIT_L(n) asm volatile("s_waitcnt lgkmcnt(" #n ")" ::: "memory")
#define PG8_BAR __builtin_amdgcn_s_barrier()
#define PG8_SCHED __builtin_amdgcn_sched_barrier(0)
    Unit cur, nxt; int ui = 0;
    if (!S.next(0, cur)) return;
    f32x4 acc[2][2][4][2];
#pragma unroll
    for (int a = 0; a < 2; ++a)
#pragma unroll
        for (int b = 0; b < 2; ++b)
#pragma unroll
            for (int m = 0; m < 4; ++m)
#pragma unroll
                for (int n = 0; n < 2; ++n) acc[a][b][m][n] = (f32x4){0.f, 0.f, 0.f, 0.f};
    bf16x8 At[4][2], B0[2][2], B1[2][2];
    const char* cA = (const char*)g.A + (size_t)cur.pm * tstep; const char* cB = (const char*)g.Bt + (size_t)cur.pn * tstep;
    S.a_ready(cur);
    if constexpr (SP2) {
        PG8_STAGE(PG8_SB(0, 0), cB, voffB); PG8_STAGE(PG8_SB(0, 1), cB + hstep, voffB); PG8_STAGE(PG8_SA(0, 0), cA, voffA); PG8_STAGE(PG8_SA(0, 1), cA + hstep, voffA);
        if (wr == 1) PG8_BAR;
        PG8_WAIT_V(2); PG8_BAR;
        PG8_STAGE(PG8_SB(1, 0), cB + kstep, voffB); PG8_STAGE(PG8_SA(1, 0), cA + kstep, voffA); PG8_STAGE(PG8_SB(1, 1), cB + hstep + kstep, voffB);
        PG8_WAIT_V(6); PG8_BAR;
    } else {
        PG8_STAGE(PG8_SB(0, 0), cB, voffB); PG8_STAGE(PG8_SA(0, 0), cA, voffA); PG8_STAGE(PG8_SB(0, 1), cB + hstep, voffB); PG8_STAGE(PG8_SA(0, 1), cA + hstep, voffA);
        if (wr == 1) PG8_BAR;
        PG8_WAIT_V(4); PG8_BAR;
        PG8_STAGE(PG8_SB(1, 0), cB + kstep, voffB); PG8_STAGE(PG8_SA(1, 0), cA + kstep, voffA); PG8_STAGE(PG8_SB(1, 1), cB + hstep + kstep, voffB);
        PG8_WAIT_V(6); PG8_BAR;
    }
    for (;;) {
        const bool has_next = S.next(ui + 1, nxt);
        const char* nA = has_next ? (const char*)g.A + (size_t)nxt.pm * tstep : cA; const char* nB = has_next ? (const char*)g.Bt + (size_t)nxt.pn * tstep : cB;
        for (int t = 0; t < nt; t += 2) {
            const bool last = (t == nt - 2);
            const char* a1 = cA + (size_t)(t + 1) * kstep;
            const char* a2 = last ? nA : cA + (size_t)(t + 2) * kstep; const char* b2 = last ? nB : cB + (size_t)(t + 2) * kstep;
            const char* a3 = a2 + kstep; const char* b3 = b2 + kstep;
            if (last && has_next) S.a_ready(nxt);
            if constexpr (SP2) {
            PG8_LDB(B0, 0, 0); PG8_LDB(B1, 0, 1); PG8_SCHED; PG8_LDA(At, 0, 0); PG8_STAGE(PG8_SA(1, 1), a1 + hstep, voffA);
            PG8_WAIT_V(8); PG8_WAIT_L(0); PG8_BAR; PG8_MMA(0, 0, At, B0); PG8_MMA(0, 1, At, B1); PG8_BAR; PG8_SCHED;
            PG8_LDA(At, 0, 1); PG8_STAGE(PG8_SB(0, 0), b2, voffB); PG8_STAGE(PG8_SB(0, 1), b2 + hstep, voffB); PG8_STAGE(PG8_SA(0, 0), a2, voffA);
            PG8_WAIT_V(8); PG8_WAIT_L(0); PG8_BAR; PG8_MMA(1, 0, At, B0); PG8_MMA(1, 1, At, B1); PG8_BAR; PG8_SCHED;
            PG8_LDB(B0, 1, 0); PG8_LDB(B1, 1, 1); PG8_SCHED; PG8_LDA(At, 1, 0); PG8_STAGE(PG8_SA(0, 1), a2 + hstep, voffA);
            PG8_WAIT_V(8); PG8_WAIT_L(0); PG8_BAR; PG8_MMA(0, 0, At, B0); PG8_MMA(0, 1, At, B1); PG8_BAR; PG8_SCHED;
            PG8_LDA(At, 1, 1); PG8_STAGE(PG8_SB(1, 0), b3, voffB); PG8_STAGE(PG8_SB(1, 1), b3 + hstep, voffB); PG8_STAGE(PG8_SA(1, 0), a3, voffA);
            PG8_WAIT_V(8); PG8_WAIT_L(0); PG8_BAR; PG8_MMA(1, 0, At, B0); PG8_MMA(1, 1, At, B1); PG8_BAR; PG8_SCHED;
            } else {
            PG8_LDB(B0, 0, 0); PG8_SCHED; PG8_LDA(At, 0, 0); PG8_STAGE(PG8_SA(1, 1), a1 + hstep, voffA);
            PG8_WAIT_L(8); PG8_BAR; PG8_WAIT_L(0); PG8_MMA(0, 0, At, B0); PG8_BAR; PG8_SCHED;
            PG8_LDB(B1, 0, 1); PG8_STAGE(PG8_SB(0, 0), b2, voffB);
            PG8_BAR; PG8_WAIT_L(0); PG8_MMA(0, 1, At, B1); PG8_BAR;
            PG8_LDA(At, 0, 1); PG8_STAGE(PG8_SA(0, 0), a2, voffA);
            PG8_BAR; PG8_WAIT_L(0); PG8_MMA(1, 0, At, B0); PG8_BAR; PG8_SCHED;
            PG8_STAGE(PG8_SB(0, 1), b2 + hstep, voffB);
            PG8_WAIT_V(6); PG8_BAR; PG8_MMA(1, 1, At, B1); PG8_BAR;
            PG8_LDB(B0, 1, 0); PG8_SCHED; PG8_LDA(At, 1, 0); PG8_STAGE(PG8_SA(0, 1), a2 + hstep, voffA);
            PG8_WAIT_L(8); PG8_BAR; PG8_WAIT_L(0); PG8_MMA(0, 0, At, B0); PG8_BAR; PG8_SCHED;
            PG8_LDB(B1, 1, 1); PG8_STAGE(PG8_SB(1, 0), b3, voffB);
            PG8_BAR; PG8_WAIT_L(0); PG8_MMA(0, 1, At, B1); PG8_BAR;
            PG8_LDA(At, 1, 1); PG8_STAGE(PG8_SA(1, 0), a3, voffA);
            PG8_BAR; PG8_WAIT_L(0); PG8_MMA(1, 0, At, B0); PG8_BAR; PG8_SCHED;
            PG8_STAGE(PG8_SB(1, 1), b3 + hstep, voffB);
            PG8_WAIT_V(6); PG8_BAR; PG8_MMA(1, 1, At, B1); PG8_BAR;
            }
        }
        if constexpr (ALIGN_EPI) { if (wr == 0) PG8_BAR; }
        if constexpr (!Epi::AFTER_DRAIN) { E(acc, cur, wr, wc, fr, fq); S.done(cur); }
        if (!has_next) break;
#pragma unroll
        for (int a = 0; a < 2; ++a)
#pragma unroll
            for (int b = 0; b < 2; ++b)
#pragma unroll
                for (int m = 0; m < 4; ++m)
#pragma unroll
                    for (int n = 0; n < 2; ++n) acc[a][b][m][n] = (f32x4){0.f, 0.f, 0.f, 0.f};
        cur = nxt; cA = nA; cB = nB; ++ui;
        if constexpr (ALIGN_EPI) { if (wr == 1) PG8_BAR; }
    }
    PG8_WAIT_V(0);
    if constexpr (!ALIGN_EPI) { if (wr == 0) PG8_BAR; }
    PG8_BAR;
    if constexpr (Epi::AFTER_DRAIN) { E.fused(acc, cur, wr, wc, fr, fq, lds, wid, lane); S.done(cur); }
#undef PG8_SA
#undef PG8_SB
#undef PG8_STAGE
#undef PG8_LDA
#undef PG8_LDB
#undef PG8_MMA
#undef PG8_WAIT_V
#undef PG8_WAIT_L
#undef PG8_BAR
#undef PG8_SCHED
}
}

#define LAS __attribute__((address_space(3)))
typedef unsigned short bf16;
typedef short bf16x8 __attribute__((ext_vector_type(8)));
typedef short s16x4 __attribute__((ext_vector_type(4)));
typedef float f32x4 __attribute__((ext_vector_type(4)));
typedef float f32x16 __attribute__((ext_vector_type(16)));
typedef unsigned u32x4 __attribute__((ext_vector_type(4)));
typedef unsigned u32x2 __attribute__((ext_vector_type(2)));
typedef float f32x2_t __attribute__((ext_vector_type(2)));
typedef __bf16 bf16x2_t __attribute__((ext_vector_type(2)));

#ifndef N_LAUNCHES
#define N_LAUNCHES 1
#endif
constexpr int NPH = 5;
constexpr int D = 1024, NB = 8, SEQ = 2048, MTOK = NB * SEQ, NIN = 7440, NP = 7424, NP_MAIN = 7168;
constexpr int C_Z = 0, C_X = 1024, C_B = 2048, C_C = 2176, C_Q = 2304, C_K = 2816, C_V = 3328, C_GR = 4352, C_GAM = 5376, C_GAR = 6400;
constexpr float EPS = 1e-6f;
constexpr size_t MiB = 1u << 20;
constexpr size_t WS_PROJ = 0;
constexpr size_t WS_WMF = 232 * MiB, WS_WRF = 234 * MiB, WS_WOF = 236 * MiB;
constexpr size_t WS_MOD = 238 * MiB;
constexpr size_t WS_DT = 239 * MiB;
constexpr size_t WS_SSQM = 240 * MiB;
constexpr size_t WS_SSQR = 242 * MiB;
constexpr size_t WS_CTL = 244 * MiB, CTL_BYTES = 16384;
constexpr size_t WS_WTF = 245 * MiB;
constexpr size_t WS_END = 246 * MiB;
constexpr size_t OUT_H = 0, OUT_WINT = 32 * MiB;
constexpr int LDS_BYTES = 155648, LDS_MISC = 155520;
constexpr int NTHR = 512;

struct Args { const float* in[16]; float* out; unsigned char* ws; int ph_lo, ph_hi; };

__device__ __forceinline__ float bf_lo(unsigned u) { return __uint_as_float(u << 16); }
__device__ __forceinline__ float bf_hi(unsigned u) { return __uint_as_float(u & 0xffff0000u); }
__device__ __forceinline__ unsigned pk2(float lo, float hi) { f32x2_t v = {lo, hi}; bf16x2_t b = __builtin_convertvector(v, bf16x2_t); return __builtin_bit_cast(unsigned, b); }
__device__ __forceinline__ float silu_f(float x) { return x * __builtin_amdgcn_rcpf(1.f + __expf(-x)); }
__device__ __forceinline__ float sigm_f(float x) { return __builtin_amdgcn_rcpf(1.f + __expf(-x)); }
__device__ __forceinline__ float wave_sum(float v) {
#pragma unroll
    for (int o = 1; o < 64; o <<= 1) v += __shfl_xor(v, o);
    return v;
}
__device__ __forceinline__ int crow(int reg, int h) { return (reg & 3) + 8 * (reg >> 2) + 4 * h; }
#define MFMA32(a, b, c) __builtin_amdgcn_mfma_f32_32x32x16_bf16((a), (b), (c), 0, 0, 0)
__device__ __forceinline__ s16x4 tr_read(const LAS unsigned char* p) {
    typedef short v4i16_t __attribute__((ext_vector_type(4)));
    return __builtin_bit_cast(s16x4, __builtin_amdgcn_ds_read_tr16_b64_v4i16((LAS v4i16_t*)p));
}
__device__ __forceinline__ bf16x8 tr_pair(const LAS unsigned char* plo, const LAS unsigned char* phi) {
    const s16x4 lo = tr_read(plo), hi = tr_read(phi);
    return __builtin_shufflevector(lo, hi, 0, 1, 2, 3, 4, 5, 6, 7);
}
__device__ __forceinline__ bf16x8 pack8(float a0, float a1, float a2, float a3, float a4, float a5, float a6, float a7) {
    u32x4 p; p.x = pk2(a0, a1); p.y = pk2(a2, a3); p.z = pk2(a4, a5); p.w = pk2(a6, a7);
    return __builtin_bit_cast(bf16x8, p);
}

__device__ __forceinline__ void p0_load_tile(const float* W, int ldw, int k0, int n0, LAS float* scr, int lane) {
    float t[32];
#pragma unroll
    for (int i = 0; i < 32; ++i) t[i] = W[(size_t)(k0 + 2 * i + (lane >> 5)) * ldw + n0 + (lane & 31)];
#pragma unroll
    for (int i = 0; i < 32; ++i) scr[(2 * i + (lane >> 5)) * 33 + (lane & 31)] = t[i];
}
__device__ __forceinline__ void p0_phase(const Args& a, LAS unsigned char* lds, int tid_unused, int lane_unused, int wave, int G) {
    const int lane = fresh_lane(), tid = wave * 64 + lane;
    const float* cvec = a.in[1]; const float* w_ada = a.in[2]; const float* b_ada = a.in[3];
    float* MOD = (float*)(a.ws + WS_MOD);
    LAS float* cT = (LAS float*)lds;
    LAS float* red = (LAS float*)(lds + 32768);
    if ((int)blockIdx.x < 192) {
        { float t[16];
#pragma unroll
          for (int i = 0; i < 16; ++i) t[i] = cvec[tid + 512 * i];
#pragma unroll
          for (int i = 0; i < 16; ++i) { const int idx = tid + 512 * i; cT[(idx & 1023) * 8 + (idx >> 10)] = t[i]; } }
        __syncthreads();
        for (int item = blockIdx.x; item < 192; item += G) {
            const int j0 = item * 16, col = lane & 15, rsub = lane >> 4, kq = wave;
            float w[32];
#pragma unroll
            for (int i = 0; i < 32; ++i) w[i] = w_ada[(size_t)(kq * 128 + 4 * i + rsub) * 3072 + j0 + col];
            float acc[8];
#pragma unroll
            for (int bb = 0; bb < 8; ++bb) acc[bb] = 0.f;
#pragma unroll
            for (int i = 0; i < 32; ++i) { const int k = kq * 128 + 4 * i + rsub;
                const f32x4 c0 = *(const LAS f32x4*)(cT + k * 8), c1 = *(const LAS f32x4*)(cT + k * 8 + 4);
                acc[0] += c0.x * w[i]; acc[1] += c0.y * w[i]; acc[2] += c0.z * w[i]; acc[3] += c0.w * w[i];
                acc[4] += c1.x * w[i]; acc[5] += c1.y * w[i]; acc[6] += c1.z * w[i]; acc[7] += c1.w * w[i]; }
#pragma unroll
            for (int bb = 0; bb < 8; ++bb) { acc[bb] += __shfl_xor(acc[bb], 16); acc[bb] += __shfl_xor(acc[bb], 32); }
            if (lane < 16) {
#pragma unroll
                for (int bb = 0; bb < 8; ++bb) red[(kq * 8 + bb) * 16 + col] = acc[bb]; }
            __syncthreads();
            if (tid < 128) { const int bb = tid >> 4, cc = tid & 15; float sum = 0.f;
#pragma unroll
                for (int q = 0; q < 8; ++q) sum += red[(q * 8 + bb) * 16 + cc];
                MOD[bb * 3072 + j0 + cc] = sum + b_ada[j0 + cc]; }
            __syncthreads();
        }
    }
    LAS float* scr = (LAS float*)(lds + 40960 + wave * 8448);
    const int gw = blockIdx.x * 8 + wave, NGW = G * 8;
    constexpr int I_IN = 16 * (NP / 32), I_W = 16 * 32;
    bf16* WINT = (bf16*)((unsigned char*)a.out + OUT_WINT);
    for (int it = gw; it < I_IN + 3 * I_W + 128; it += NGW) {
        if (it >= I_IN + 3 * I_W) {
            const int r_ = it - (I_IN + 3 * I_W), nt = r_ & 7, kb = r_ >> 3;
            p0_load_tile(a.in[5], NIN, 64 * kb, NP_MAIN + 16 + 32 * nt, scr, lane);
            bf16* WF = (bf16*)(a.ws + WS_WTF);
            const int r = lane & 31, h = lane >> 5;
#pragma unroll
            for (int s4 = 0; s4 < 4; ++s4) { const LAS float* s = scr + (16 * s4 + 8 * h) * 33 + r;
                u32x4 o; o.x = pk2(s[0 * 33], s[1 * 33]); o.y = pk2(s[2 * 33], s[3 * 33]); o.z = pk2(s[4 * 33], s[5 * 33]); o.w = pk2(s[6 * 33], s[7 * 33]);
                *(u32x4*)(WF + ((size_t)(nt * 64 + 4 * kb + s4) * 64 + lane) * 8) = o; }
        } else if (it < I_IN) {
            const int nblk = NP / 32, kb = it / nblk, nb = it % nblk, k0 = 64 * kb, n0p = 32 * nb, n0 = n0p + (n0p >= 2304 ? 16 : 0);
            p0_load_tile(a.in[5], NIN, k0, n0, scr, lane);
            const int c = lane & 7;
#pragma unroll
            for (int j = 0; j < 4; ++j) { const int n = (lane >> 3) + 8 * j; const LAS float* s = scr + (8 * c) * 33 + n;
                u32x4 o; o.x = pk2(s[0 * 33], s[1 * 33]); o.y = pk2(s[2 * 33], s[3 * 33]); o.z = pk2(s[4 * 33], s[5 * 33]); o.w = pk2(s[6 * 33], s[7 * 33]);
                *(u32x4*)(WINT + (size_t)(n0p + n) * 1024 + k0 + 8 * c) = o; }
        } else {
            int r_ = it - I_IN; const int which = r_ / I_W; r_ -= which * I_W;
            const float* W = a.in[12 + which];
            bf16* WF = (bf16*)(a.ws + WS_WMF + (size_t)which * 2 * MiB);
            const int nt = r_ & 31, kb = r_ >> 5;
            p0_load_tile(W, 1024, 64 * kb, 32 * nt, scr, lane);
            const int r = lane & 31, h = lane >> 5;
#pragma unroll
            for (int s4 = 0; s4 < 4; ++s4) { const LAS float* s = scr + (16 * s4 + 8 * h) * 33 + r;
                f32x4 m0 = (f32x4){1.f, 1.f, 1.f, 1.f}, m1 = m0;
                if (which == 0) { m0 = *(const f32x4*)(a.in[11] + 64 * kb + 16 * s4 + 8 * h); m1 = *(const f32x4*)(a.in[11] + 64 * kb + 16 * s4 + 8 * h + 4); }
                u32x4 o; o.x = pk2(s[0 * 33] * m0.x, s[1 * 33] * m0.y); o.y = pk2(s[2 * 33] * m0.z, s[3 * 33] * m0.w); o.z = pk2(s[4 * 33] * m1.x, s[5 * 33] * m1.y); o.w = pk2(s[6 * 33] * m1.z, s[7 * 33] * m1.w);
                *(u32x4*)(WF + ((size_t)(nt * 64 + 4 * kb + s4) * 64 + lane) * 8) = o; }
        }
    }
}

__device__ __forceinline__ void p1_phase(const Args& a, LAS unsigned char* lds, int tid_unused, int lane_unused, int wave, int G) {
    const int lane_in = fresh_lane(), tid = wave * 64 + lane_in;
    const float* x = a.in[0]; const float* norm_w = a.in[4]; const float* w_in = a.in[5]; const float* dt_bias = a.in[8];
    const float* MOD = (const float*)(a.ws + WS_MOD);
    float* DT = (float*)(a.ws + WS_DT);
    bf16* H = (bf16*)((unsigned char*)a.out + OUT_H);
    LAS float* wdt = (LAS float*)lds;
    { float t[32];
#pragma unroll
      for (int i = 0; i < 32; ++i) { const int idx = tid + NTHR * i; t[i] = w_in[(size_t)(idx >> 4) * NIN + 2304 + (idx & 15)]; }
#pragma unroll
      for (int i = 0; i < 32; ++i) { const int idx = tid + NTHR * i; wdt[(idx & 15) * 1028 + (idx >> 4)] = t[i]; } }
    __syncthreads();
    for (int blk = blockIdx.x; blk < 256; blk += G) {
        const int b = blk >> 5;
        float gk[16], sh[16];
#pragma unroll
        for (int jj = 0; jj < 4; ++jj) { const int k = 4 * lane_in + 256 * jj;
            const f32x4 nw = *(const f32x4*)(norm_w + k), sc = *(const f32x4*)(MOD + b * 3072 + 1024 + k), sf = *(const f32x4*)(MOD + b * 3072 + k);
#pragma unroll
            for (int e = 0; e < 4; ++e) { gk[4 * jj + e] = nw[e] * (1.f + sc[e]); sh[4 * jj + e] = sf[e]; } }
        f32x4 vn[2][4];
        { const int lane = fresh_lane();
#pragma unroll
          for (int rr = 0; rr < 2; ++rr)
#pragma unroll
              for (int jj = 0; jj < 4; ++jj) vn[rr][jj] = *((const f32x4*)(x + (size_t)(blk * 64 + wave * 8 + rr) * D) + lane + 64 * jj); }
        for (int g = 0; g < 4; ++g) {
            asm volatile("" ::: "memory");
            const int lane = fresh_lane();
            const int m0 = blk * 64 + wave * 8 + g * 2;
            f32x4 v[2][4];
#pragma unroll
            for (int rr = 0; rr < 2; ++rr)
#pragma unroll
                for (int jj = 0; jj < 4; ++jj) v[rr][jj] = vn[rr][jj];
            if (g + 1 < 4) {
#pragma unroll
                for (int rr = 0; rr < 2; ++rr)
#pragma unroll
                    for (int jj = 0; jj < 4; ++jj) vn[rr][jj] = *((const f32x4*)(x + (size_t)(m0 + 2 + rr) * D) + lane + 64 * jj);
            }
            __builtin_amdgcn_sched_barrier(0);
            float hv[2][16];
#pragma unroll
            for (int rr = 0; rr < 2; ++rr) {
                float ss = 0.f;
#pragma unroll
                for (int jj = 0; jj < 4; ++jj) ss += (v[rr][jj].x * v[rr][jj].x + v[rr][jj].y * v[rr][jj].y) + (v[rr][jj].z * v[rr][jj].z + v[rr][jj].w * v[rr][jj].w);
                const float rs = 1.0f / sqrtf(wave_sum(ss) * (1.f / D) + EPS);
                unsigned long long* o8 = (unsigned long long*)(H + (size_t)(m0 + rr) * D) + lane;
#pragma unroll
                for (int jj = 0; jj < 4; ++jj) {
#pragma unroll
                    for (int e = 0; e < 4; ++e) hv[rr][4 * jj + e] = v[rr][jj][e] * rs * gk[4 * jj + e] + sh[4 * jj + e];
                    o8[64 * jj] = (unsigned long long)pk2(hv[rr][4 * jj], hv[rr][4 * jj + 1]) | ((unsigned long long)pk2(hv[rr][4 * jj + 2], hv[rr][4 * jj + 3]) << 32);
                }
            }
            float acc[32];
#pragma unroll
            for (int i = 0; i < 32; ++i) acc[i] = 0.f;
#pragma unroll
            for (int j = 0; j < 16; ++j) {
#pragma unroll
                for (int jj = 0; jj < 4; ++jj) { const f32x4 w = *(const LAS f32x4*)(wdt + j * 1028 + 4 * lane + 256 * jj);
#pragma unroll
                    for (int rr = 0; rr < 2; ++rr) acc[rr * 16 + j] += (hv[rr][4 * jj] * w.x + hv[rr][4 * jj + 1] * w.y) + (hv[rr][4 * jj + 2] * w.z + hv[rr][4 * jj + 3] * w.w); }
                if ((j & 3) == 3) asm volatile("" ::: "memory");
            }
#pragma unroll
            for (int half = 16; half >= 1; half >>= 1) {
                const bool up = (lane & half) != 0;
#pragma unroll
                for (int i = 0; i < half; ++i) { float lo_ = acc[i], hi_ = acc[i + half]; asm volatile("" : "+v"(lo_), "+v"(hi_));
                    const float keep = up ? hi_ : lo_, send = up ? lo_ : hi_; acc[i] = keep + __shfl_xor(send, half); }
            }
            const float tot = acc[0] + __shfl_xor(acc[0], 32);
            const float xr_ = tot + dt_bias[lane & 15];
            const float dtv = xr_ > 20.f ? xr_ : log1pf(__expf(xr_));
            if (lane < 32) DT[(size_t)m0 * 16 + lane] = dtv;
        }
    }
}

constexpr size_t OUT_XBCC = 0;
__device__ __forceinline__ void p3a_phase(const Args& a, int wave, int G) {
    const bf16* PROJ = (const bf16*)(a.ws + WS_PROJ);
    bf16* XBCC = (bf16*)((unsigned char*)a.out + OUT_XBCC);
    const float* conv_w = a.in[6]; const float* conv_b = a.in[7];
    const int lane = fresh_lane(), tid = wave * 64 + lane;
    if (tid >= 480) return;
    const int oct = tid % 160, tgl = tid / 160;
    float cw[4][8], cb[8];
#pragma unroll
    for (int e = 0; e < 8; ++e) { cb[e] = conv_b[8 * oct + e];
#pragma unroll
        for (int k = 0; k < 4; ++k) cw[k][e] = conv_w[k * 1280 + 8 * oct + e]; }
    for (int blk = blockIdx.x; blk < 256; blk += G) {
        for (int tg = tgl; tg < 8; tg += 3) {
            const int m0 = blk * 64 + 8 * tg, ts0 = m0 & (SEQ - 1);
            const char* src = (const char*)(PROJ + (size_t)m0 * NP + C_X + 8 * oct);
            u32x4 raw[11];
#pragma unroll
            for (int i = 0; i < 11; ++i) { const bool ok = (ts0 - 3 + i) >= 0; raw[i] = ok ? *(const u32x4*)(src + ((long)i - 3) * (NP * 2)) : (u32x4){0u, 0u, 0u, 0u}; }
#pragma unroll
            for (int jj = 0; jj < 8; ++jj) {
                float o[8];
#pragma unroll
                for (int e = 0; e < 8; ++e) {
                    float s_ = cb[e];
#pragma unroll
                    for (int k = 0; k < 4; ++k) { const unsigned w = raw[jj + k][e >> 1]; s_ += cw[k][e] * ((e & 1) ? bf_hi(w) : bf_lo(w)); }
                    o[e] = silu_f(s_);
                }
                u32x4 ov; ov.x = pk2(o[0], o[1]); ov.y = pk2(o[2], o[3]); ov.z = pk2(o[4], o[5]); ov.w = pk2(o[6], o[7]);
                *(u32x4*)(XBCC + (size_t)(m0 + jj) * 1280 + 8 * oct) = ov;
            }
        }
    }
}

constexpr int TP = 72;
constexpr int L_CQ = 0, L_BK = 18432, L_BKW = 36864, L_XV = 55296, L_ST0 = 73728, L_ST1 = 82944, L_ACS = 92160, L_DTJ = 93184, L_WJ = 94208, L_CW = 95232;

__device__ __forceinline__ void p3_phase(const Args& a, LAS unsigned char* lds, int tid_in, int lane_in, int wave, int G, const bool dry = false) {
    bf16* PROJ = (bf16*)(a.ws + WS_PROJ);
    const float* DT = (const float*)(a.ws + WS_DT);
    float* SSQM = (float*)(a.ws + WS_SSQM); float* SSQR = (float*)(a.ws + WS_SSQR);
    const float* conv_w = a.in[6]; const float* conv_b = a.in[7]; const float* a_log = a.in[9]; const float* d_skip = a.in[10]; const float* m_norm_w = a.in[11];
    const int pt = wave & 1, it = wave >> 1;
#ifdef PROBE_SEL
    unsigned long long t0_ = 0ull; unsigned tacc_ = 0u;
    const bool probing = ((int)blockIdx.x == PROBE_BLK && wave == PROBE_WAVE);
#define TB(k) do { if (PROBE_SEL == (k) && probing) t0_ = __builtin_amdgcn_s_memrealtime(); } while (0)
#define TE(k) do { if (PROBE_SEL == (k) && probing) tacc_ += (unsigned)(__builtin_amdgcn_s_memrealtime() - t0_); } while (0)
#else
#define TB(k) do {} while (0)
#define TE(k) do {} while (0)
#endif
    for (int item = blockIdx.x; item < 256; item += G) {
        const int lane = fresh_lane(), tid = wave * 64 + lane;
        const int r = lane & 31, h = lane >> 5, i16 = lane & 15, q4 = i16 >> 2, p4 = i16 & 3, blk16 = (lane >> 4) & 1;
        const bool ssd = item < 128;
        int b, hd, half;
        if (ssd) { b = item >> 4; hd = item & 15; half = 0; } else { const int t = item - 128; b = t >> 4; hd = (t >> 1) & 7; half = t & 1; }
        const size_t mb = (size_t)b * SEQ;
        __syncthreads();
        for (int idx = tid; idx < 9216 / 4; idx += NTHR) ((LAS unsigned*)(lds + L_ST0))[idx] = 0u;
        const float lg = ssd ? 0.f : log1pf(-exp2f(-5.0f - (float)hd));
        if (!ssd && tid < 256) { const int par = tid >> 7, j = tid & 127;
            ((LAS float*)(lds + L_ACS))[par * 128 + j] = (float)(j + 1) * lg * 1.4426950408889634f; ((LAS float*)(lds + L_DTJ))[par * 128 + j] = (float)(j + 1) * lg * 1.4426950408889634f; ((LAS float*)(lds + L_WJ))[par * 128 + j] = __expf((float)(127 - j) * lg); }
        const float Ah = ssd ? -__expf(a_log[hd]) : 0.f;
        const float Dsk = ssd ? d_skip[hd] : 0.f;
        const int ltile = 3 - (tid >> 7), loct = tid & 7, ltg = (tid >> 3) & 15;
        int lcol = 0;
        float invf[8];
        if (ssd) {
            lcol = (ltile == 0) ? (64 * hd + 8 * loct) : (ltile == 1 ? (1024 + 64 * (hd >> 3) + 8 * loct) : (1152 + 64 * (hd >> 3) + 8 * loct));
            if (ltile == 3) lcol = 1024 + 64 * (hd >> 3) + 8 * loct;
#pragma unroll
            for (int e = 0; e < 8; ++e) invf[e] = 0.f;
        } else {
#pragma unroll
            for (int e = 0; e < 8; ++e) invf[e] = exp2f(-(float)(8 * (tid & 3) + e) * (13.287712379549449f / 32.f));
        }
        f32x16 sacc;
#pragma unroll
        for (int i = 0; i < 16; ++i) sacc[i] = 0.f;
        u32x4 raw[8];
        const int rj = tid >> 2, ro4 = tid & 3;
        const int j0 = 8 * ltg;
        const char* pbase = (const char*)(PROJ + mb * NP);
        const char* xbase = (const char*)((const bf16*)((const unsigned char*)a.out + OUT_XBCC) + mb * 1280);
        const unsigned soff = (unsigned)((j0 * 1280 + lcol) * 2);
        const unsigned roff = (unsigned)((rj * NP) * 2);
#define P3_ISSUE(cc) do { const char* cbp = pbase + (size_t)(cc) * (128 * NP * 2); \
        if (ssd) { const char* xp = xbase + (size_t)(cc) * (128 * 1280 * 2) + soff; _Pragma("unroll") for (int i = 0; i < 8; ++i) raw[i] = *(const u32x4*)(xp + i * (1280 * 2)); } \
        else { const char* rp = cbp + roff; \
            raw[0] = *(const u32x4*)(rp + (C_Q + 64 * hd + 8 * ro4) * 2); raw[1] = *(const u32x4*)(rp + (C_Q + 64 * hd + 32 + 8 * ro4) * 2); \
            raw[2] = *(const u32x4*)(rp + (C_K + 64 * hd + 8 * ro4) * 2); raw[3] = *(const u32x4*)(rp + (C_K + 64 * hd + 32 + 8 * ro4) * 2); \
            raw[4] = *(const u32x4*)(rp + (C_V + 128 * hd + 64 * half + 16 * ro4) * 2); raw[5] = *(const u32x4*)(rp + (C_V + 128 * hd + 64 * half + 16 * ro4 + 8) * 2); } } while (0)
        float dq0 = 0.f, dq1 = 0.f;
#define P3_SCAN(cc) do { LAS float* ACSw = (LAS float*)(lds + L_ACS) + ((cc) & 1) * 128; LAS float* DTJw = (LAS float*)(lds + L_DTJ) + ((cc) & 1) * 128; LAS float* WJw = (LAS float*)(lds + L_WJ) + ((cc) & 1) * 128; \
        const float v0 = dq0 * Ah, v1 = dq1 * Ah, s_ = v0 + v1; float incl = s_; \
        _Pragma("unroll") for (int o = 1; o < 64; o <<= 1) { const float t = __shfl_up(incl, o); if (lane >= o) incl += t; } \
        const float c0 = (incl - s_) + v0, tot = __shfl(incl, 63), c1 = (lane == 63) ? tot : c0 + v1; \
        ACSw[2 * lane] = c0 * 1.4426950408889634f; ACSw[2 * lane + 1] = c1 * 1.4426950408889634f; \
        DTJw[2 * lane] = c0 * 1.4426950408889634f - __log2f(dq0); DTJw[2 * lane + 1] = c1 * 1.4426950408889634f - __log2f(dq1); \
        WJw[2 * lane] = dq0 * __expf(tot - c0); WJw[2 * lane + 1] = dq1 * __expf(tot - c1); } while (0)
#define P3_DTLOAD(cc) do { dq0 = DT[(mb + (size_t)(cc) * 128 + 2 * lane) * 16 + hd]; dq1 = DT[(mb + (size_t)(cc) * 128 + 2 * lane + 1) * 16 + hd]; } while (0)
        if (ssd && wave == 0) { P3_DTLOAD(0); P3_SCAN(0); P3_DTLOAD(1); }
        u32x2 zzn[4];
        { const bf16* orow0 = PROJ + (mb + 32 * it + r) * NP + (ssd ? (C_Z + 64 * hd) : (C_GR + 128 * hd + 64 * half));
#pragma unroll
          for (int g4 = 0; g4 < 4; ++g4) zzn[g4] = *(const u32x2*)(orow0 + 32 * pt + 8 * g4 + 4 * h); }
        P3_ISSUE(0);

        TB(1);
        for (int c = 0; c < 16; ++c) {
            const int par = c & 1;
            const size_t m0 = mb + (size_t)c * 128;
            LAS float* ACS = (LAS float*)(lds + L_ACS) + par * 128; LAS float* DTJ = (LAS float*)(lds + L_DTJ) + par * 128; LAS float* WJ = (LAS float*)(lds + L_WJ) + par * 128;
            TB(5);
            __syncthreads();
            TE(5); TB(2);
#ifndef P3_REPL
#define P3_REPL 1
#endif
            _Pragma("nounroll") for (int repl_ = 0; repl_ < P3_REPL; ++repl_) {
            if (repl_) __syncthreads();
            if (ssd) {
                {
                    LAS unsigned char* dst = lds + (ltile == 0 ? L_XV : (ltile == 1 ? L_BK : (ltile == 2 ? L_CQ : L_BKW)));
#pragma unroll
                    for (int jj = 0; jj < 8; ++jj) {
                        u32x4 v = raw[jj];
                        if (ltile == 3) { const float wj = WJ[j0 + jj];
                            v.x = pk2(bf_lo(v.x) * wj, bf_hi(v.x) * wj); v.y = pk2(bf_lo(v.y) * wj, bf_hi(v.y) * wj); v.z = pk2(bf_lo(v.z) * wj, bf_hi(v.z) * wj); v.w = pk2(bf_lo(v.w) * wj, bf_hi(v.w) * wj); }
                        *(LAS u32x4*)(dst + ((j0 + jj) * TP + 8 * loct) * 2) = v;
                    }
                }
            } else {
                const int j = rj, o4 = ro4;
                const u32x4 q1 = raw[0], q2 = raw[1], k1 = raw[2], k2 = raw[3];
                const float pos = (float)(c * 128 + j), wj = WJ[j];
                float ql[8], qh[8], kl[8], kh[8];
#pragma unroll
                for (int e = 0; e < 8; ++e) {
                    const float rev = pos * invf[e] * 0.15915494309189535f, fr = rev - floorf(rev);
                    const float cs = __builtin_amdgcn_cosf(fr), sn = __builtin_amdgcn_sinf(fr);
                    const unsigned wq1 = q1[e >> 1], wq2 = q2[e >> 1], wk1 = k1[e >> 1], wk2 = k2[e >> 1];
                    const float a1 = (e & 1) ? bf_hi(wq1) : bf_lo(wq1), a2 = (e & 1) ? bf_hi(wq2) : bf_lo(wq2);
                    const float b1 = ((e & 1) ? bf_hi(wk1) : bf_lo(wk1)) * 0.125f, b2 = ((e & 1) ? bf_hi(wk2) : bf_lo(wk2)) * 0.125f;
                    ql[e] = a1 * cs - a2 * sn; qh[e] = a1 * sn + a2 * cs;
                    kl[e] = b1 * cs - b2 * sn; kh[e] = b1 * sn + b2 * cs;
                }
                u32x4 t;
                t.x = pk2(ql[0], ql[1]); t.y = pk2(ql[2], ql[3]); t.z = pk2(ql[4], ql[5]); t.w = pk2(ql[6], ql[7]); *(LAS u32x4*)(lds + L_CQ + (j * TP + 8 * o4) * 2) = t;
                t.x = pk2(qh[0], qh[1]); t.y = pk2(qh[2], qh[3]); t.z = pk2(qh[4], qh[5]); t.w = pk2(qh[6], qh[7]); *(LAS u32x4*)(lds + L_CQ + (j * TP + 32 + 8 * o4) * 2) = t;
                t.x = pk2(kl[0], kl[1]); t.y = pk2(kl[2], kl[3]); t.z = pk2(kl[4], kl[5]); t.w = pk2(kl[6], kl[7]); *(LAS u32x4*)(lds + L_BK + (j * TP + 8 * o4) * 2) = t;
                t.x = pk2(kh[0], kh[1]); t.y = pk2(kh[2], kh[3]); t.z = pk2(kh[4], kh[5]); t.w = pk2(kh[6], kh[7]); *(LAS u32x4*)(lds + L_BK + (j * TP + 32 + 8 * o4) * 2) = t;
                t.x = pk2(kl[0] * wj, kl[1] * wj); t.y = pk2(kl[2] * wj, kl[3] * wj); t.z = pk2(kl[4] * wj, kl[5] * wj); t.w = pk2(kl[6] * wj, kl[7] * wj); *(LAS u32x4*)(lds + L_BKW + (j * TP + 8 * o4) * 2) = t;
                t.x = pk2(kh[0] * wj, kh[1] * wj); t.y = pk2(kh[2] * wj, kh[3] * wj); t.z = pk2(kh[4] * wj, kh[5] * wj); t.w = pk2(kh[6] * wj, kh[7] * wj); *(LAS u32x4*)(lds + L_BKW + (j * TP + 32 + 8 * o4) * 2) = t;
                *(LAS u32x4*)(lds + L_XV + (j * TP + 16 * o4) * 2) = raw[4]; *(LAS u32x4*)(lds + L_XV + (j * TP + 16 * o4 + 8) * 2) = raw[5];
            }
            }
            TE(2); TB(6);
            __syncthreads();
            TE(6); TB(3);
            const int i0 = 32 * it, iTok = i0 + r;
            bf16* orow = PROJ + (m0 + iTok) * NP + (ssd ? (C_Z + 64 * hd) : (C_GR + 128 * hd + 64 * half));
            u32x2 zz[4];
#pragma unroll
            for (int g4 = 0; g4 < 4; ++g4) zz[g4] = zzn[g4];
            if (c + 1 < 16) {
#pragma unroll
                for (int g4 = 0; g4 < 4; ++g4) zzn[g4] = *(const u32x2*)(orow + 128 * NP + 32 * pt + 8 * g4 + 4 * h);
                P3_ISSUE(c + 1);
            }
            __builtin_amdgcn_sched_barrier(0);
            if (ssd && wave == 0 && c + 1 < 16) { P3_SCAN(c + 1); if (c + 2 < 16) P3_DTLOAD(c + 2); }
#ifndef P3_REPC
#define P3_REPC 1
#endif
            f32x16 acc;
            float acs_i = 0.f;
            LAS unsigned char* STw = lds + (par ? L_ST0 : L_ST1);
            _Pragma("nounroll") for (int repc_ = 0; repc_ < P3_REPC; ++repc_) {
            bf16x8 cqb[4];
#pragma unroll
            for (int s = 0; s < 4; ++s) cqb[s] = *(const LAS bf16x8*)(lds + L_CQ + ((i0 + r) * TP + 16 * s + 8 * h) * 2);
            const LAS unsigned char* STr = lds + (par ? L_ST1 : L_ST0);
#pragma unroll
            for (int i = 0; i < 16; ++i) acc[i] = 0.f;
#pragma unroll
            for (int s = 0; s < 4; ++s) { const bf16x8 sa = *(const LAS bf16x8*)(STr + ((32 * pt + r) * TP + 16 * s + 8 * h) * 2); acc = MFMA32(sa, cqb[s], acc); }
            acs_i = ACS[iTok];
            { const float ei = __builtin_amdgcn_exp2f(acs_i);
#pragma unroll
              for (int i = 0; i < 16; ++i) acc[i] *= ei; }
            bf16x8 kf[4];
#pragma unroll
            for (int s = 0; s < 4; ++s) kf[s] = *(const LAS bf16x8*)(lds + L_BK + (r * TP + 16 * s + 8 * h) * 2);
            for (int jt = 0; jt <= it; ++jt) {
                f32x16 g;
#pragma unroll
                for (int i = 0; i < 16; ++i) g[i] = 0.f;
#pragma unroll
                for (int s = 0; s < 4; ++s) g = MFMA32(kf[s], cqb[s], g);
                f32x4 bj[4]; bf16x8 xf[2];
#pragma unroll
                for (int g4 = 0; g4 < 4; ++g4) bj[g4] = *(const LAS f32x4*)(DTJ + 32 * jt + 8 * g4 + 4 * h);
#pragma unroll
                for (int s2 = 0; s2 < 2; ++s2) { const LAS unsigned char* xb = lds + L_XV + ((32 * jt + 16 * s2 + 4 * h + q4) * TP + 32 * pt + 16 * blk16 + 4 * p4) * 2; xf[s2] = tr_pair(xb, xb + 8 * TP * 2); }
#pragma unroll
                for (int s = 0; s < 4; ++s) kf[s] = *(const LAS bf16x8*)(lds + L_BK + ((32 * (jt + 1) + r) * TP + 16 * s + 8 * h) * 2);
                __builtin_amdgcn_sched_barrier(0);
                const bool diag = (jt == it);
#pragma unroll
                for (int g4 = 0; g4 < 4; ++g4) {
#pragma unroll
                    for (int e = 0; e < 4; ++e) { float v = g[4 * g4 + e] * __builtin_amdgcn_exp2f(acs_i - bj[g4][e]); if (diag && (8 * g4 + 4 * h + e) > r) v = 0.f; g[4 * g4 + e] = v; }
                }
#pragma unroll
                for (int s2 = 0; s2 < 2; ++s2) {
                    const bf16x8 pf = pack8(g[8 * s2], g[8 * s2 + 1], g[8 * s2 + 2], g[8 * s2 + 3], g[8 * s2 + 4], g[8 * s2 + 5], g[8 * s2 + 6], g[8 * s2 + 7]);
                    acc = MFMA32(xf[s2], pf, acc);
                }
            }
            }
            TE(3); TB(4);
            if (it < 2 && c < 15) {
                const int nt = it;
                const float dec = __builtin_amdgcn_exp2f(ACS[127]);
#pragma unroll
                for (int i = 0; i < 16; ++i) sacc[i] *= dec;
                f32x16 sacc2;
#pragma unroll
                for (int i = 0; i < 16; ++i) sacc2[i] = 0.f;
#pragma unroll
                for (int ks = 0; ks < 8; ++ks) {
                    const LAS unsigned char* xb = lds + L_XV + ((16 * ks + 8 * h + q4) * TP + 32 * pt + 16 * blk16 + 4 * p4) * 2;
                    const LAS unsigned char* kb = lds + L_BKW + ((16 * ks + 8 * h + q4) * TP + 32 * nt + 16 * blk16 + 4 * p4) * 2;
                    const bf16x8 xa = tr_pair(xb, xb + 4 * TP * 2), kbf = tr_pair(kb, kb + 4 * TP * 2);
                    if (ks & 1) sacc2 = MFMA32(xa, kbf, sacc2); else sacc = MFMA32(xa, kbf, sacc);
                }
#pragma unroll
                for (int i = 0; i < 16; ++i) sacc[i] += sacc2[i];
#pragma unroll
                for (int i = 0; i < 16; ++i) { const int p = 32 * pt + crow(i, h);
                    *(LAS unsigned short*)(STw + (p * TP + 32 * nt + r) * 2) = (unsigned short)(pk2(sacc[i], 0.f) & 0xffffu); }
            }
            {
                float ss = 0.f;
#pragma unroll
                for (int g4 = 0; g4 < 4; ++g4) {
                    const int p = 32 * pt + 8 * g4 + 4 * h;
                    const float z0 = bf_lo(zz[g4].x), z1 = bf_hi(zz[g4].x), z2 = bf_lo(zz[g4].y), z3 = bf_hi(zz[g4].y);
                    float y0 = acc[4 * g4], y1 = acc[4 * g4 + 1], y2 = acc[4 * g4 + 2], y3 = acc[4 * g4 + 3];
                    float o0, o1, o2, o3;
                    if (ssd) {
                        const u32x2 xv = *(const LAS u32x2*)(lds + L_XV + (iTok * TP + p) * 2);
                        y0 = (y0 + Dsk * bf_lo(xv.x)) * silu_f(z0); y1 = (y1 + Dsk * bf_hi(xv.x)) * silu_f(z1); y2 = (y2 + Dsk * bf_lo(xv.y)) * silu_f(z2); y3 = (y3 + Dsk * bf_hi(xv.y)) * silu_f(z3);
                        ss += (y0 * y0 + y1 * y1) + (y2 * y2 + y3 * y3);
                        o0 = y0; o1 = y1; o2 = y2; o3 = y3;
                    } else {
                        ss += (y0 * y0 + y1 * y1) + (y2 * y2 + y3 * y3);
                        o0 = y0 * silu_f(z0); o1 = y1 * silu_f(z1); o2 = y2 * silu_f(z2); o3 = y3 * silu_f(z3);
                    }
                    u32x2 ov; ov.x = pk2(o0, o1); ov.y = pk2(o2, o3);
                    if (dry) *(u32x2*)((bf16*)((unsigned char*)a.out + 40 * MiB) + (m0 + iTok) * 512 + ((64 * hd + 64 * half + p) & 511)) = ov; else *(u32x2*)(orow + p) = ov;
                }
                ss += __shfl_xor(ss, 32);
                if (h == 0) { if (ssd) SSQM[(m0 + iTok) * 32 + hd * 2 + pt] = ss; else SSQR[(m0 + iTok) * 32 + hd * 4 + half * 2 + pt] = ss; }
            }
            TE(4);
        }
        TE(1);
#undef P3_ISSUE
#undef P3_SCAN
#undef P3_DTLOAD
    }
#ifdef PROBE_SEL
    if (probing && fresh_lane() == 0) ((unsigned*)(a.ws + WS_CTL))[4000] = tacc_;
#endif
#undef TB
#undef TE
}

constexpr int MP = 1032;
constexpr int L4_MERGED = 0, L4_ASTG = 132096, L4_RM = 150528, L4_RR = 151040, L4_RED = 153088, L4_RS = 155136;
static_assert(L4_RS + 256 <= LDS_BYTES, "P4 LDS map");

__device__ __forceinline__ void p4_panel_load(u32x4 (&ar)[16], const bf16* Abase, int tid) {
    const int srow = tid >> 3, soct = tid & 7; const int rot = ((int)blockIdx.x >> 3) & 15;
    const char* ab = (const char*)Abase; const unsigned aoff = (unsigned)((srow * NP + 8 * soct) * 2);
#pragma unroll
    for (int i = 0; i < 16; ++i) ar[i] = *(const u32x4*)(ab + ((rot + i) & 15) * 128 + aoff);
}
template <int SEGSHIFT>
__device__ __forceinline__ void p4_gemmT(f32x16 (&accT)[2][2], u32x4 (&ar)[16], const bf16* Anext  , const LAS float* rsc  , int nseg,
                                         const bf16* WF  , int nt0  , LAS unsigned char* lds, int tid, int lane) {
    const int srow = tid >> 3, soct = tid & 7, r = lane & 31, h = lane >> 5;
    const char* wb = (const char*)WF + (size_t)nt0 * 65536; const unsigned woff = (unsigned)(lane * 16);
    const int rot = ((int)blockIdx.x >> 3) & 15;
    bf16x8 wc[4][2];
    { const char* wk0 = wb + rot * 4096;
#pragma unroll
      for (int s = 0; s < 4; ++s) { wc[s][0] = *(const bf16x8*)(wk0 + s * 1024 + woff); wc[s][1] = *(const bf16x8*)(wk0 + 65536 + s * 1024 + woff); } }
#define P4_STAGE_WRITE(ki_) do { const int kc_ = ((ki_) + rot) & 15; const float sc = rsc[srow * nseg + ((kc_ * 64) >> SEGSHIFT)]; \
        u32x4 o; \
        o.x = pk2(bf_lo(ar[ki_].x) * sc, bf_hi(ar[ki_].x) * sc); o.y = pk2(bf_lo(ar[ki_].y) * sc, bf_hi(ar[ki_].y) * sc); \
        o.z = pk2(bf_lo(ar[ki_].z) * sc, bf_hi(ar[ki_].z) * sc); o.w = pk2(bf_lo(ar[ki_].w) * sc, bf_hi(ar[ki_].w) * sc); \
        *(LAS u32x4*)(lds + L4_ASTG + ((ki_) & 1) * 9216 + (srow * TP + 8 * soct) * 2) = o; } while (0)
    P4_STAGE_WRITE(0);
#pragma unroll
    for (int ki = 0; ki < 16; ++ki) {
        const int kc = (ki + rot) & 15;
        LAS unsigned char* stg = lds + L4_ASTG + (ki & 1) * 9216;
        __syncthreads();
        if (ki + 1 < 16) P4_STAGE_WRITE(ki + 1);
        const int kn = (kc + 1) & 15;
        const char* wk = wb + kn * 4096;
        bf16x8 a0 = *(const LAS bf16x8*)(stg + (r * TP + 8 * h) * 2), a1 = *(const LAS bf16x8*)(stg + ((32 + r) * TP + 8 * h) * 2);
#pragma unroll
        for (int s = 0; s < 4; ++s) {
            bf16x8 n0 = a0, n1 = a1;
            if (s < 3) { n0 = *(const LAS bf16x8*)(stg + (r * TP + 16 * (s + 1) + 8 * h) * 2); n1 = *(const LAS bf16x8*)(stg + ((32 + r) * TP + 16 * (s + 1) + 8 * h) * 2); }
            accT[0][0] = MFMA32(wc[s][0], a0, accT[0][0]); accT[0][1] = MFMA32(wc[s][1], a0, accT[0][1]);
            accT[1][0] = MFMA32(wc[s][0], a1, accT[1][0]); accT[1][1] = MFMA32(wc[s][1], a1, accT[1][1]);
            wc[s][0] = *(const bf16x8*)(wk + s * 1024 + woff); wc[s][1] = *(const bf16x8*)(wk + 65536 + s * 1024 + woff);
            __builtin_amdgcn_sched_barrier(0);
            a0 = n0; a1 = n1;
        }
    }
#undef P4_STAGE_WRITE
    p4_panel_load(ar, Anext, tid);
    __builtin_amdgcn_sched_barrier(0);
    __syncthreads();
}


__device__ __forceinline__ void tail_gemmT(f32x16 (&accT)[2], const bf16* Abase  , const bf16* WF  , int nt  , LAS unsigned char* lds, int tid, int lane) {
    const int srow = tid >> 3, soct = tid & 7, r = lane & 31, h = lane >> 5;
    const char* ab = (const char*)Abase; const unsigned aoff = (unsigned)((srow * 1024 + 8 * soct) * 2);
    const char* wb = (const char*)WF + (size_t)nt * 65536; const unsigned woff = (unsigned)(lane * 16);
    const int rot = ((int)blockIdx.x >> 3) & 15;
    u32x4 ar[16];
#pragma unroll
    for (int i = 0; i < 16; ++i) ar[i] = *(const u32x4*)(ab + ((rot + i) & 15) * 128 + aoff);
    bf16x8 wc[4];
    { const char* wk0 = wb + rot * 4096;
#pragma unroll
      for (int s = 0; s < 4; ++s) wc[s] = *(const bf16x8*)(wk0 + s * 1024 + woff); }
#pragma unroll
    for (int ki = 0; ki < 16; ++ki) {
        const int kc = (ki + rot) & 15;
        LAS unsigned char* stg = lds + L4_ASTG + (ki & 1) * 9216;
        *(LAS u32x4*)(stg + (srow * TP + 8 * soct) * 2) = ar[ki];
        __syncthreads();
        const char* wk = wb + ((kc + 1) & 15) * 4096;
#pragma unroll
        for (int s = 0; s < 4; ++s) {
            const bf16x8 a0 = *(const LAS bf16x8*)(stg + (r * TP + 16 * s + 8 * h) * 2), a1 = *(const LAS bf16x8*)(stg + ((32 + r) * TP + 16 * s + 8 * h) * 2);
            accT[0] = MFMA32(wc[s], a0, accT[0]); accT[1] = MFMA32(wc[s], a1, accT[1]);
            wc[s] = *(const bf16x8*)(wk + s * 1024 + woff);
            __builtin_amdgcn_sched_barrier(0);
        }
    }
    __syncthreads();
}

__device__ __forceinline__ void p4_phase(const Args& a, LAS unsigned char* lds, int tid_in, int lane_in, int wave, int G) {
    const bf16* PROJ = (const bf16*)(a.ws + WS_PROJ);
    const float* SSQM = (const float*)(a.ws + WS_SSQM); const float* SSQR = (const float*)(a.ws + WS_SSQR);
    const float* MOD = (const float*)(a.ws + WS_MOD);
    const bf16* WMF = (const bf16*)(a.ws + WS_WMF); const bf16* WRF = (const bf16*)(a.ws + WS_WRF); const bf16* WOF = (const bf16*)(a.ws + WS_WOF);
    const float* x = a.in[0]; const float* fw = a.in[15]; float* out = a.out;
    LAS float* RM = (LAS float*)(lds + L4_RM); LAS float* RR = (LAS float*)(lds + L4_RR); LAS float* RED = (LAS float*)(lds + L4_RED); LAS float* RS = (LAS float*)(lds + L4_RS);
    for (int blk = blockIdx.x; blk < 256; blk += G) {
        const size_t m0 = (size_t)blk * 64; const int b = blk >> 5;
        int lane = fresh_lane(), tid = wave * 64 + lane, r = lane & 31, h = lane >> 5;
        u32x4 ar[16];
        p4_panel_load(ar, PROJ + m0 * NP + C_Z, tid);
        __syncthreads();
        { const int row = tid >> 3, sub = tid & 7;
          const f32x4 qv = *(const f32x4*)(SSQR + (m0 + row) * 32 + 4 * sub);
          RR[row * 8 + sub] = 1.0f / sqrtf(((qv.x + qv.y) + (qv.z + qv.w)) * (1.f / 128.f) + EPS);
          if (sub < 2) { float s = 0.f;
#pragma unroll
              for (int i = 0; i < 4; ++i) { const f32x4 v = *(const f32x4*)(SSQM + (m0 + row) * 32 + 16 * sub + 4 * i); s += (v.x + v.y) + (v.z + v.w); }
              RM[row * 2 + sub] = 1.0f / sqrtf(s * (1.f / 512.f) + EPS); } }
        __syncthreads();
#ifndef P4_SKIP1
#ifndef P4_REP1
#define P4_REP1 1
#endif
        for (int nh_ = 0; nh_ < 2 * P4_REP1; ++nh_) {
            const int nh = nh_ & 1;
            lane = fresh_lane(); tid = wave * 64 + lane; r = lane & 31; h = lane >> 5;
            const int nt0 = 16 * nh + 2 * wave;
            const bf16* pblk = PROJ + m0 * NP;
            f32x16 accT[2][2];
#pragma unroll
            for (int i = 0; i < 2; ++i)
#pragma unroll
                for (int j = 0; j < 2; ++j)
#pragma unroll
                    for (int e = 0; e < 16; ++e) accT[i][j][e] = 0.f;
            u32x2 gpre[2][2][4];
            { const unsigned lo0 = (unsigned)((r * NP + 4 * h) * 2); const char* gb0 = (const char*)(pblk + C_GAM + 32 * nt0);
#pragma unroll
              for (int rt = 0; rt < 2; ++rt)
#pragma unroll
                  for (int ct = 0; ct < 2; ++ct)
#pragma unroll
                      for (int g4 = 0; g4 < 4; ++g4) gpre[rt][ct][g4] = *(const u32x2*)(gb0 + (lo0 + (unsigned)((32 * rt * NP + 32 * ct + 8 * g4) * 2)));
              __builtin_amdgcn_sched_barrier(0); }
            p4_gemmT<9>(accT, ar, pblk + C_GR, RM, 2, WMF, nt0, lds, tid, lane);
            {
                lane = fresh_lane(); r = lane & 31; h = lane >> 5;
                const unsigned lm = launder((unsigned)(L4_MERGED + (r * MP + 4 * h) * 2));
#pragma unroll
                for (int rt = 0; rt < 2; ++rt)
#pragma unroll
                    for (int ct = 0; ct < 2; ++ct)
#pragma unroll
                        for (int g4 = 0; g4 < 4; ++g4) {
                            const u32x2 gg = gpre[rt][ct][g4];
                            u32x2 ov; ov.x = pk2(accT[rt][ct][4 * g4] * sigm_f(bf_lo(gg.x)), accT[rt][ct][4 * g4 + 1] * sigm_f(bf_hi(gg.x)));
                            ov.y = pk2(accT[rt][ct][4 * g4 + 2] * sigm_f(bf_lo(gg.y)), accT[rt][ct][4 * g4 + 3] * sigm_f(bf_hi(gg.y)));
                            *(LAS u32x2*)(lds + lm + (unsigned)((32 * rt * MP + 32 * (nt0 + ct) + 8 * g4) * 2)) = ov; }
            }
#pragma unroll
            for (int i = 0; i < 2; ++i)
#pragma unroll
                for (int j = 0; j < 2; ++j)
#pragma unroll
                    for (int e = 0; e < 16; ++e) accT[i][j][e] = 0.f;
            lane = fresh_lane(); tid = wave * 64 + lane; r = lane & 31; h = lane >> 5;
            { const unsigned lo0 = (unsigned)((r * NP + 4 * h) * 2); const char* gb0 = (const char*)(pblk + C_GAR + 32 * nt0);
#pragma unroll
              for (int rt = 0; rt < 2; ++rt)
#pragma unroll
                  for (int ct = 0; ct < 2; ++ct)
#pragma unroll
                      for (int g4 = 0; g4 < 4; ++g4) gpre[rt][ct][g4] = *(const u32x2*)(gb0 + (lo0 + (unsigned)((32 * rt * NP + 32 * ct + 8 * g4) * 2)));
              __builtin_amdgcn_sched_barrier(0); }
            p4_gemmT<7>(accT, ar, pblk + C_Z, RR, 8, WRF, nt0, lds, tid, lane);
            {
                lane = fresh_lane(); r = lane & 31; h = lane >> 5;
                const unsigned lm = launder((unsigned)(L4_MERGED + (r * MP + 4 * h) * 2));
#pragma unroll
                for (int rt = 0; rt < 2; ++rt)
#pragma unroll
                    for (int ct = 0; ct < 2; ++ct)
#pragma unroll
                        for (int g4 = 0; g4 < 4; ++g4) {
                            const u32x2 gg = gpre[rt][ct][g4];
                            LAS u32x2* mp = (LAS u32x2*)(lds + lm + (unsigned)((32 * rt * MP + 32 * (nt0 + ct) + 8 * g4) * 2));
                            const u32x2 pm = *mp;
                            const float v0 = bf_lo(pm.x) + accT[rt][ct][4 * g4] * sigm_f(bf_lo(gg.x)), v1 = bf_hi(pm.x) + accT[rt][ct][4 * g4 + 1] * sigm_f(bf_hi(gg.x));
                            const float v2 = bf_lo(pm.y) + accT[rt][ct][4 * g4 + 2] * sigm_f(bf_lo(gg.y)), v3 = bf_hi(pm.y) + accT[rt][ct][4 * g4 + 3] * sigm_f(bf_hi(gg.y));
                            u32x2 ov; ov.x = pk2(v0, v1); ov.y = pk2(v2, v3);
                            *mp = ov; }
            }
        }
#endif
        __syncthreads();
        lane = fresh_lane(); tid = wave * 64 + lane; r = lane & 31; h = lane >> 5;
#ifndef P4_SKIP2
#ifndef P4_REP2
#define P4_REP2 1
#endif
        _Pragma("nounroll") for (int rep2_ = 0; rep2_ < P4_REP2; ++rep2_) {
            if (rep2_) { __syncthreads(); lane = fresh_lane(); tid = wave * 64 + lane; r = lane & 31; h = lane >> 5; }
            f32x16 acc[2][4];
#pragma unroll
            for (int i = 0; i < 2; ++i)
#pragma unroll
                for (int j = 0; j < 4; ++j)
#pragma unroll
                    for (int e = 0; e < 16; ++e) acc[i][j][e] = 0.f;
            const char* wb = (const char*)WOF + (size_t)(4 * wave) * 65536; const unsigned woff = (unsigned)(lane * 16);
            const int rot2 = ((int)blockIdx.x >> 3) & 31;
            bf16x8 wc[2][4];
#pragma unroll
            for (int s = 0; s < 2; ++s)
#pragma unroll
                for (int ct = 0; ct < 4; ++ct) wc[s][ct] = *(const bf16x8*)(wb + ct * 65536 + (2 * rot2 + s) * 1024 + woff);
            const LAS unsigned char* ma = lds + L4_MERGED + (r * MP + 8 * h) * 2;
            bf16x8 a0 = *(const LAS bf16x8*)(ma + (2 * rot2) * 32), a1 = *(const LAS bf16x8*)(ma + 32 * MP * 2 + (2 * rot2) * 32);
            for (int ki = 0; ki < 32; ++ki) {
                const int kp = (ki + rot2) & 31, kpn = (kp + 1) & 31;
#pragma unroll
                for (int s = 0; s < 2; ++s) {
                    const int ksn = (s == 0) ? 2 * kp + 1 : 2 * kpn;
                    const bf16x8 n0 = *(const LAS bf16x8*)(ma + ksn * 32), n1 = *(const LAS bf16x8*)(ma + 32 * MP * 2 + ksn * 32);
#pragma unroll
                    for (int ct = 0; ct < 4; ++ct) { acc[0][ct] = MFMA32(a0, wc[s][ct], acc[0][ct]); acc[1][ct] = MFMA32(a1, wc[s][ct], acc[1][ct]); }
#pragma unroll
                    for (int ct = 0; ct < 4; ++ct) wc[s][ct] = *(const bf16x8*)(wb + ct * 65536 + (2 * kpn + s) * 1024 + woff);
                    __builtin_amdgcn_sched_barrier(0);
                    a0 = n0; a1 = n1;
                }
            }
            lane = fresh_lane(); r = lane & 31; h = lane >> 5;
            const char* xblk = (const char*)(x + m0 * D); char* oblk = (char*)(out + m0 * D);
            const unsigned eo = launder((unsigned)(4 * (4 * h * D + 128 * wave + r)));
            const unsigned rb = launder((unsigned)(L4_RED + (4 * h * 8 + wave) * 4));
            float gate[4], fwv[4];
#pragma unroll
            for (int ct = 0; ct < 4; ++ct) { const int n = 32 * (4 * wave + ct) + r; gate[ct] = MOD[b * 3072 + 2048 + n]; fwv[ct] = fw[n]; }
            float xv[2][8][4];
#define P4_XLOAD(buf, bidx) do { _Pragma("unroll") for (int e = 0; e < 8; ++e) _Pragma("unroll") for (int ct = 0; ct < 4; ++ct) \
                xv[buf][e][ct] = *(const float*)(xblk + (eo + (unsigned)(((32 * ((bidx) >> 1) + (e & 3) + 8 * (2 * ((bidx) & 1) + (e >> 2))) * D + 32 * ct) * 4))); } while (0)
            P4_XLOAD(0, 0);
#pragma unroll
            for (int bi = 0; bi < 4; ++bi) {
                const int rt = bi >> 1, g8 = bi & 1;
                if (bi + 1 < 4) P4_XLOAD((bi + 1) & 1, bi + 1);
                __builtin_amdgcn_sched_barrier(0);
#pragma unroll
                for (int e = 0; e < 8; ++e) {
                    const int reg = 8 * g8 + e, rowc = 32 * rt + (reg & 3) + 8 * (reg >> 2);
                    float s = 0.f;
#pragma unroll
                    for (int ct = 0; ct < 4; ++ct) { const float v = xv[bi & 1][e][ct] + gate[ct] * acc[rt][ct][reg]; acc[rt][ct][reg] = v; s += v * v; }
                    s += __shfl_xor(s, 16); s += __shfl_xor(s, 8); s += __shfl_xor(s, 4); s += __shfl_xor(s, 2); s += __shfl_xor(s, 1);
                    *(LAS float*)(lds + rb + (unsigned)(rowc * 32)) = s;
                }
                asm volatile("" ::: "memory"); __builtin_amdgcn_sched_barrier(0);
            }
#undef P4_XLOAD
            __syncthreads();
            if (tid < 64) { float s = 0.f;
#pragma unroll
                for (int w = 0; w < 8; ++w) s += RED[tid * 8 + w];
                RS[tid] = 1.0f / sqrtf(s * (1.f / D) + EPS); }
            __syncthreads();
            const unsigned eo2 = launder(eo);
            const unsigned sb = launder((unsigned)(L4_RS + 4 * h * 4));
#pragma unroll
            for (int rt = 0; rt < 2; ++rt)
#pragma unroll
                for (int reg = 0; reg < 16; ++reg) {
                    const int rowc = 32 * rt + (reg & 3) + 8 * (reg >> 2); const float rs = *(const LAS float*)(lds + sb + (unsigned)(rowc * 4));
#pragma unroll
                    for (int ct = 0; ct < 4; ++ct) *(float*)(oblk + (eo2 + (unsigned)((rowc * D + 32 * ct) * 4))) = acc[rt][ct][reg] * rs * fwv[ct];
                }
        }
#endif
    }
}

#define XB_TMO      128
#define XB_XCNT(j)  (256  + 64 * (j))
#define XB_XSUB(j)  (1280 + 64 * (j))
#define XB_XGEN(j)  (2304 + 64 * (j))
#define XB_TOP      3328
#define XB_TOPGEN   3392
#define XCD_BAR_WORDS 3456
#define XB_SPIN_CAP (1u << 18)

__device__ __forceinline__ unsigned xb_ld(unsigned* p)              { return __hip_atomic_load(p, __ATOMIC_RELAXED, __HIP_MEMORY_SCOPE_AGENT); }
__device__ __forceinline__ unsigned xb_add(unsigned* p, unsigned v) { return __hip_atomic_fetch_add(p, v, __ATOMIC_RELAXED, __HIP_MEMORY_SCOPE_AGENT); }
__device__ __forceinline__ unsigned xb_xcc_id() { return (unsigned)__builtin_amdgcn_s_getreg((3 << 11) | 20) & 0xFu; }
#define XB_SPIN(cond, bar) do { unsigned _sp = 0; while (cond) { __builtin_amdgcn_s_sleep(1); \
    if ((++_sp & 255u) == 0u) { if (xb_ld(&(bar)[XB_TMO])) break; if (_sp > XB_SPIN_CAP) { atomicAdd(&(bar)[XB_TMO], 1u); break; } } } } while (0)

struct XcdBarrier {
    unsigned* bar; unsigned x;
    volatile LAS unsigned* st;
};

__device__ __forceinline__ XcdBarrier xcd_barrier_post(unsigned* bar, volatile LAS unsigned* st, const int wave_) {
    XcdBarrier b; b.bar = bar; b.x = xb_xcc_id(); b.st = st;
    if (wave_ == 0 && fresh_lane() == 0) (void)xb_add(&bar[XB_XCNT(b.x)], 1u);
    return b;
}
__device__ __forceinline__ void xcd_barrier_complete(unsigned* bar, unsigned x, unsigned& nloc, unsigned& nx) {
    const unsigned G = gridDim.x * gridDim.y * gridDim.z;
    unsigned sum, cnt, mine, sp = 0u;
    for (;;) {
        sum = 0u; cnt = 0u; mine = 0u;
#pragma unroll
        for (unsigned j = 0; j < 16; ++j) { const unsigned c = xb_ld(&bar[XB_XCNT(j)]); sum += c; cnt += (c > 0u) ? 1u : 0u; mine = (j == x) ? c : mine; }
        if (sum == G) break;
        __builtin_amdgcn_s_sleep(1);
        if ((++sp & 255u) == 0u) { if (xb_ld(&bar[XB_TMO])) break; if (sp > XB_SPIN_CAP) { atomicAdd(&bar[XB_TMO], 1u); break; } }
    }
    nloc = mine > 0u ? mine : 1u; nx = cnt > 0u ? cnt : 1u;
}

__device__ __forceinline__ void xcd_barrier(const XcdBarrier& b, const int wave_) {
    asm volatile("s_waitcnt vmcnt(0)" ::: "memory");
    __syncthreads();
    if (wave_ == 0 && fresh_lane() == 0) {
        unsigned* bar = b.bar;
        __builtin_amdgcn_s_waitcnt(0);
        unsigned nloc = b.st[0], nx = b.st[1];
        if (nloc == 0u) { xcd_barrier_complete(bar, b.x, nloc, nx); b.st[0] = nloc; b.st[1] = nx; }
        const unsigned old = xb_add(&bar[XB_XSUB(b.x)], 1u);
        const unsigned gen = old / nloc;
        if (old + 1u == (gen + 1u) * nloc) {
            __builtin_amdgcn_fence(__ATOMIC_RELEASE, "agent");
            asm volatile("s_waitcnt vmcnt(0)" ::: "memory");
            const unsigned og = xb_add(&bar[XB_TOP], 1u);
            const unsigned tg = og / nx;
            if (og + 1u == (tg + 1u) * nx) xb_add(&bar[XB_TOPGEN], 1u);
            else XB_SPIN(xb_ld(&bar[XB_TOPGEN]) == tg, bar);
            __builtin_amdgcn_fence(__ATOMIC_ACQUIRE, "agent");
            xb_add(&bar[XB_XGEN(b.x)], 1u);
            asm volatile("s_waitcnt vmcnt(0)" ::: "memory");
        } else {
            XB_SPIN(xb_ld(&bar[XB_XGEN(b.x)]) == gen, bar);
            __builtin_amdgcn_fence(__ATOMIC_ACQUIRE, "agent");
            asm volatile("s_waitcnt vmcnt(0)" ::: "memory");
        }
    }
    __syncthreads();
}

#ifdef SELF_CLEAN_BARRIER
__device__ unsigned g_bar[4096];
#endif
__global__ void __launch_bounds__(NTHR, 2) hybrid_fwd(Args args) {
    extern __shared__ __attribute__((aligned(16))) unsigned char lds_raw[];
    LAS unsigned char* lds = (LAS unsigned char*)lds_raw;
    const int wave = __builtin_amdgcn_readfirstlane((int)threadIdx.x >> 6), G = gridDim.x; const int tid = 0, lane = 0;
    cg::grid_group grid = cg::this_grid();
    volatile LAS unsigned* misc = (volatile LAS unsigned*)(lds + LDS_MISC);
    if (threadIdx.x < 2) misc[threadIdx.x] = 0u;
    __syncthreads();
    if (args.ph_lo < 0) grid.sync();
    #ifdef SELF_CLEAN_BARRIER
    XcdBarrier xbar = xcd_barrier_post(g_bar, misc, wave);
#else
    XcdBarrier xbar = xcd_barrier_post((unsigned*)(args.ws + WS_CTL), misc, wave);
#endif
    const int lo = args.ph_lo, hi = args.ph_hi;
#ifndef PHMASK
#define PHMASK 31
#endif
#define IN(k) (((PHMASK >> (k)) & 1) && lo <= (k) && (k) < hi)
#define SEAM(k) do { if (IN(k) && IN((k) + 1)) xcd_barrier(xbar, wave); } while (0)
#ifndef REPEAT_MASK
#define REPEAT_MASK 0
#endif
#ifdef PROBE_PH
    unsigned long long pt0_ = 0ull; unsigned pacc_ = 0u;
#define PB(k) do { if (PROBE_PH == (k)) pt0_ = __builtin_amdgcn_s_memrealtime(); } while (0)
#define PE(k) do { if (PROBE_PH == (k)) pacc_ += (unsigned)(__builtin_amdgcn_s_memrealtime() - pt0_); } while (0)
#else
#define PB(k) do {} while (0)
#define PE(k) do {} while (0)
#endif
    PB(20);
#define REP(k) _Pragma("nounroll") for (int rep_ = 0; rep_ < 1 + ((REPEAT_MASK >> (k)) & 1); ++rep_)
#ifdef EXTRA_SYNCS
    for (int es_ = 0; es_ < EXTRA_SYNCS; ++es_) xcd_barrier(xbar, wave);
#endif
    PB(0);
    if (IN(0)) REP(0) { if (rep_) xcd_barrier(xbar, wave); p0_phase(args, lds, tid, lane, wave, G); }
    PE(0); PB(10); SEAM(0); PE(10); PB(1);
    if (IN(1)) REP(1) { if (rep_) xcd_barrier(xbar, wave); p1_phase(args, lds, tid, lane, wave, G); }
    PE(1); PB(11); SEAM(1); PE(11); PB(2);
    if (IN(2)) REP(2) {
        if (rep_) xcd_barrier(xbar, wave);
        __syncthreads();
        pg8::Gemm g{(const pg8::bf16_t*)((const unsigned char*)args.out + OUT_H), (const pg8::bf16_t*)((const unsigned char*)args.out + OUT_WINT), MTOK, NP_MAIN, D};
        pg8::StaticOrder S; S.init(MTOK, NP_MAIN, G, (int)blockIdx.x);
        pg8::EpiProj E{(pg8::bf16_t*)(args.ws + WS_PROJ), NP};
        pg8::gemm_phase<pg8::EpiProj, pg8::StaticOrder, true, true>(lds, g, S, E, wave);
        for (int blk = blockIdx.x; blk < 256; blk += G) {
            const int lane_ = fresh_lane(), tid_ = wave * 64 + lane_;
            f32x16 accT[2];
#pragma unroll
            for (int i = 0; i < 2; ++i)
#pragma unroll
                for (int e = 0; e < 16; ++e) accT[i][e] = 0.f;
            tail_gemmT(accT, (const bf16*)((const unsigned char*)args.out + OUT_H) + (size_t)blk * 64 * 1024, (const bf16*)(args.ws + WS_WTF), wave, lds, tid_, lane_);
            const int l2 = fresh_lane(), r2 = l2 & 31, h2 = l2 >> 5;
            bf16* prow = (bf16*)(args.ws + WS_PROJ) + ((size_t)blk * 64 + r2) * NP + NP_MAIN + 32 * wave + 4 * h2;
#pragma unroll
            for (int rt = 0; rt < 2; ++rt)
#pragma unroll
                for (int g4 = 0; g4 < 4; ++g4) { u32x2 ov; ov.x = pk2(accT[rt][4 * g4], accT[rt][4 * g4 + 1]); ov.y = pk2(accT[rt][4 * g4 + 2], accT[rt][4 * g4 + 3]);
                    *(u32x2*)(prow + (size_t)rt * 32 * NP + 8 * g4) = ov; }
        }
    }
    PE(2); PB(12); SEAM(2); PE(12); PB(3);
    if (IN(3)) { p3a_phase(args, wave, G); PE(3); PB(13); xcd_barrier(xbar, wave); PE(13); PB(4); if ((REPEAT_MASK >> 3) & 1) { p3_phase(args, lds, tid, lane, wave, G, true); xcd_barrier(xbar, wave); } p3_phase(args, lds, tid, lane, wave, G); }
    PE(4); PB(14); SEAM(3); PE(14); PB(5);
    if (IN(4)) REP(4) { if (rep_) xcd_barrier(xbar, wave); p4_phase(args, lds, tid, lane, wave, G); }
#undef REP
    PE(5); PE(20);
#if defined(SELF_CLEAN_BARRIER) && !defined(PROBE_PH)
    {
        __syncthreads();
        if (wave == 0) {
            const int l_ = fresh_lane();
            unsigned last_ = 0u;
            if (l_ == 0) last_ = (__hip_atomic_fetch_add(&g_bar[4032], 1u, __ATOMIC_RELAXED, __HIP_MEMORY_SCOPE_AGENT) == (unsigned)G - 1u) ? 1u : 0u;
            last_ = (unsigned)__builtin_amdgcn_readfirstlane((int)last_);
            if (last_) {
                if (l_ < 16) { __hip_atomic_store(&g_bar[XB_XCNT(l_)], 0u, __ATOMIC_RELAXED, __HIP_MEMORY_SCOPE_AGENT); __hip_atomic_store(&g_bar[XB_XSUB(l_)], 0u, __ATOMIC_RELAXED, __HIP_MEMORY_SCOPE_AGENT); __hip_atomic_store(&g_bar[XB_XGEN(l_)], 0u, __ATOMIC_RELAXED, __HIP_MEMORY_SCOPE_AGENT); }
                if (l_ == 16) { __hip_atomic_store(&g_bar[XB_TOP], 0u, __ATOMIC_RELAXED, __HIP_MEMORY_SCOPE_AGENT); __hip_atomic_store(&g_bar[XB_TOPGEN], 0u, __ATOMIC_RELAXED, __HIP_MEMORY_SCOPE_AGENT);
                                __hip_atomic_store(&g_bar[XB_TMO], 0u, __ATOMIC_RELAXED, __HIP_MEMORY_SCOPE_AGENT); __hip_atomic_store(&g_bar[4032], 0u, __ATOMIC_RELAXED, __HIP_MEMORY_SCOPE_AGENT); }
            }
        }
    }
#endif
#ifdef PROBE_PH
    if (blockIdx.x == PROBE_PBLK && wave == 0 && fresh_lane() == 0) ((unsigned*)(args.ws + WS_CTL))[4001] = pacc_;
    if (blockIdx.x == 0) { xcd_barrier(xbar, wave); } else { xcd_barrier(xbar, wave); }
    if (blockIdx.x == 0 && wave == 0 && fresh_lane() == 0) { asm volatile("s_waitcnt vmcnt(0)" ::: "memory"); args.out[0] = 30.0f * floorf(0.01f * (float)__hip_atomic_load((unsigned*)(args.ws + WS_CTL) + 4001, __ATOMIC_RELAXED, __HIP_MEMORY_SCOPE_AGENT) / 30.0f + 0.5f); }
#endif
#ifdef PROBE_SEL
    if (blockIdx.x == 0 && wave == 0 && fresh_lane() == 0) { asm volatile("s_waitcnt vmcnt(0)" ::: "memory"); args.out[0] = 0.01f * (float)((volatile unsigned*)(args.ws + WS_CTL))[4000]; }
#endif
#undef IN
#undef SEAM
}

extern "C" void kernel_launch(void* const* d_in, const int* in_sizes, int n_in, void* d_out, int out_size, void* d_ws, size_t ws_size, hipStream_t stream) {
    static int grid = 0;
    if (grid == 0) {
        if (n_in != 16 || out_size != MTOK * D || ws_size < WS_END) { fprintf(stderr, "kernel_launch: unexpected shapes (n_in %d out %d ws %zu)\n", n_in, out_size, ws_size); grid = -1; return; }
        int dev = 0, cus = 0, per_cu = 0;
        (void)hipGetDevice(&dev);
        (void)hipDeviceGetAttribute(&cus, hipDeviceAttributeMultiprocessorCount, dev);
        if (hipFuncSetAttribute((const void*)hybrid_fwd, hipFuncAttributeMaxDynamicSharedMemorySize, LDS_BYTES) != hipSuccess) { fprintf(stderr, "kernel_launch: hipFuncSetAttribute failed\n"); grid = -1; return; }
        if (hipOccupancyMaxActiveBlocksPerMultiprocessor(&per_cu, (const void*)hybrid_fwd, NTHR, LDS_BYTES) != hipSuccess || per_cu < 1) { fprintf(stderr, "kernel_launch: occupancy query says %d\n", per_cu); per_cu = 1; }
        (void)hipGetLastError();
        grid = cus * per_cu;
        if (grid > 256) grid = 256;
        if (grid < 1) grid = 1;
    }
    if (grid < 0) return;
#ifndef SELF_CLEAN_BARRIER
    if (hipMemsetAsync((char*)d_ws + WS_CTL, 0, CTL_BYTES, stream) != hipSuccess) { fprintf(stderr, "kernel_launch: memset of the barrier words failed\n"); return; }
#endif
    Args a{};
    for (int i = 0; i < 16; ++i) a.in[i] = (const float*)d_in[i];
    a.out = (float*)d_out; a.ws = (unsigned char*)d_ws;
#if N_LAUNCHES == 1
    a.ph_lo = 0; a.ph_hi = NPH;
    void* kargs[] = {&a};
    hipError_t e = hipLaunchCooperativeKernel((const void*)hybrid_fwd, dim3(grid), dim3(NTHR), kargs, LDS_BYTES, stream);
    if (e != hipSuccess) fprintf(stderr, "kernel_launch: cooperative launch failed: %s (grid %d)\n", hipGetErrorString(e), grid);
#else
    for (int p = 0; p < NPH; ++p) {
        a.ph_lo = p; a.ph_hi = p + 1;
        hipLaunchKernelGGL(hybrid_fwd, dim3(grid), dim3(NTHR), LDS_BYTES, stream, a);
    }
#endif
}
```

```cpp
#include <hip/hip_runtime.h>
#include <hip/hip_cooperative_groups.h>
#include <cstdio>
#include <cstdint>
namespace cg = cooperative_groups;
#define N_LAUNCHES 1
#define REPEAT_MASK 0
#define P4_REP2 1
__device__ __forceinline__ unsigned launder(unsigned v) { asm volatile("" : "+v"(v)); return v; }
__device__ __forceinline__ int fresh_lane() { unsigned z; asm volatile("v_mov_b32 %0, 0" : "=v"(z)); return (int)__builtin_amdgcn_mbcnt_hi(~0u, __builtin_amdgcn_mbcnt_lo(~0u, z)); }
namespace pg8 {
#define PG8_LAS __attribute__((address_space(3)))
typedef unsigned short bf16_t;
typedef short bf16x8 __attribute__((ext_vector_type(8)));
typedef float f32x4 __attribute__((ext_vector_type(4)));
typedef unsigned u32x4 __attribute__((ext_vector_type(4)));
constexpr int BM = 256, BK = 64, HALF = 128, HTB = HALF * BK * 2  , STAGE_BYTES = 8 * HTB, NXCD = 8, WGM = 8;

__host__ __device__ __forceinline__ int lds_byte(int r, int c) { const int st = (r >> 4) * 2 + (c >> 5), rr = r & 15, cc = c & 31, ob = rr * 64 + cc * 2; return st * 1024 + (ob ^ (((ob >> 9) & 1) << 5)); }
__host__ __device__ __forceinline__ void stage_rc(int b, int& R, int& C) { const int st = b / 1024, sb = b % 1024, swz = sb ^ (((sb >> 9) & 1) << 5); R = (st >> 1) * 16 + swz / 64; C = (st & 1) * 32 + (swz % 64) / 2; }
__host__ __device__ __forceinline__ int perm32(int rho) { const int n = rho >> 4, i = rho & 15; return 8 * (i >> 2) + 4 * n + (i & 3); }

struct Unit { int pm, pn; };
struct Gemm { const bf16_t* A; const bf16_t* Bt; int M, N, K; };

struct StaticOrder {
    int nM, nN, nwg, G, c;
    __host__ __device__ void init(int M, int N, int G_, int c_) { nM = M / BM; nN = N / BM; nwg = nM * nN; G = G_; c = c_; }
    __host__ __device__ bool next(int i, Unit& u) const {
        const long L = (long)i * G + c; if (L >= nwg) return false;
        int wgid = (int)L; { const int q = nwg / NXCD, r = nwg % NXCD, xcd = wgid % NXCD, off = wgid / NXCD; wgid = (xcd < r ? xcd * (q + 1) : r * (q + 1) + (xcd - r) * q) + off; }
        const int nig = WGM * nN, gid = wgid / nig, fm = gid * WGM, gsz = (nM - fm) < WGM ? (nM - fm) : WGM;
        u.pm = fm + ((wgid % nig) % gsz); u.pn = (wgid % nig) / gsz; return true;
    }
    __device__ __forceinline__ void a_ready(const Unit&) const {}
    __device__ __forceinline__ void done(const Unit&) const {}
};
__device__ __forceinline__ unsigned cvt_pk_bf16(float lo, float hi) { unsigned r; asm volatile("v_cvt_pk_bf16_f32 %0, %1, %2" : "=v"(r) : "v"(lo), "v"(hi)); return r; }
struct EpiProj {
    static constexpr bool PERM = true, AFTER_DRAIN = false;
    bf16_t* O; int ldc;
    __device__ __forceinline__ void operator()(const f32x4 (&acc)[2][2][4][2], const Unit& u, int wr, int wc, int fr, int fq) const {
        const int row0 = u.pm * BM + wr * 64 + fr; const int col0 = u.pn * BM + wc * 32 + 8 * fq;
#pragma unroll
        for (int ai = 0; ai < 2; ++ai)
#pragma unroll
            for (int m = 0; m < 4; ++m) { bf16_t* rowp = O + (size_t)(row0 + ai * HALF + m * 16) * ldc + col0;
#pragma unroll
                for (int bj = 0; bj < 2; ++bj) { const f32x4 v0 = acc[ai][bj][m][0], v1 = acc[ai][bj][m][1];
                    u32x4 w; w.x = cvt_pk_bf16(v0[0], v0[1]); w.y = cvt_pk_bf16(v0[2], v0[3]); w.z = cvt_pk_bf16(v1[0], v1[1]); w.w = cvt_pk_bf16(v1[2], v1[3]);
                    *(u32x4*)(rowp + bj * HALF) = w; } }
    }
    __device__ __forceinline__ void fused(f32x4 (&)[2][2][4][2], const Unit&, int, int, int, int, PG8_LAS unsigned char*, int, int) const {}
};
template <class Epi, class Sched, bool ALIGN_EPI = false, bool SP2 = false>
__device__ __forceinline__ void gemm_phase(PG8_LAS unsigned char* lds, const Gemm g, const Sched& S, const Epi& E, const int wid) {
    const int lane = ::fresh_lane(), tid = wid * 64 + lane, wr = wid >> 2, wc = wid & 3, fr = lane & 15, fq = lane >> 4;
    const int K = g.K, nt = K / BK;
    unsigned voffA[2], voffB[2];
#pragma unroll
    for (int i = 0; i < 2; ++i) { int R, C; stage_rc(tid * 16 + i * 8192, R, C); const int Rb = Epi::PERM ? ((R & ~31) + perm32(R & 31)) : R;
        voffA[i] = (unsigned)(R * K + C) * 2u; voffB[i] = (unsigned)(Rb * K + C) * 2u; }
    const size_t kstep = (size_t)(BK * 2);
    const size_t hstep = (size_t)HALF * K * 2;
    const size_t tstep = 2 * hstep;
    const unsigned ldsw = (unsigned)wid * 1024u;
    const int aoff = lds_byte(wr * 64 + fr, fq * 8), boff = lds_byte(wc * 32 + fr, fq * 8);
#define PG8_SA(b, h) (((b) * 2 + (h)) * HTB)
#define PG8_SB(b, h) ((4 + (b) * 2 + (h)) * HTB)
#define PG8_STAGE(bufoff, gbase, voff) do { _Pragma("unroll") for (int _i = 0; _i < 2; ++_i) \
        __builtin_amdgcn_global_load_lds((const unsigned*)((const char*)(gbase) + (voff)[_i]), (PG8_LAS unsigned*)(lds + (bufoff) + ldsw + _i * 8192), 16, 0, 0); } while (0)
#define PG8_LDA(dst, b, h) do { _Pragma("unroll") for (int m = 0; m < 4; ++m) _Pragma("unroll") for (int k = 0; k < 2; ++k) dst[m][k] = *(const PG8_LAS bf16x8*)(lds + PG8_SA(b, h) + aoff + m * 2048 + k * 1024); } while (0)
#define PG8_LDB(dst, b, h) do { _Pragma("unroll") for (int n = 0; n < 2; ++n) _Pragma("unroll") for (int k = 0; k < 2; ++k) dst[n][k] = *(const PG8_LAS bf16x8*)(lds + PG8_SB(b, h) + boff + n * 2048 + k * 1024); } while (0)
#define PG8_MMA(ai, bj, At, Bt) do { __builtin_amdgcn_s_setprio(1); _Pragma("unroll") for (int m = 0; m < 4; ++m) _Pragma("unroll") for (int n = 0; n < 2; ++n) _Pragma("unroll") for (int k = 0; k < 2; ++k) \
        acc[ai][bj][m][n] = __builtin_amdgcn_mfma_f32_16x16x32_bf16(Bt[n][k], At[m][k], acc[ai][bj][m][n], 0, 0, 0); __builtin_amdgcn_s_setprio(0); } while (0)
#define PG8_WAIT_V(n) asm volatile("s_waitcnt vmcnt(" #n ")" ::: "memory")
#define PG8_WAIT_L(n) asm volatile("s_waitcnt lgkmcnt(" #n ")" ::: "memory")
#define PG8_BAR __builtin_amdgcn_s_barrier()
#define PG8_SCHED __builtin_amdgcn_sched_barrier(0)
    Unit cur, nxt; int ui = 0;
    if (!S.next(0, cur)) return;
    f32x4 acc[2][2][4][2];
#pragma unroll
    for (int a = 0; a < 2; ++a)
#pragma unroll
        for (int b = 0; b < 2; ++b)
#pragma unroll
            for (int m = 0; m < 4; ++m)
#pragma unroll
                for (int n = 0; n < 2; ++n) acc[a][b][m][n] = (f32x4){0.f, 0.f, 0.f, 0.f};
    bf16x8 At[4][2], B0[2][2], B1[2][2];
    const char* cA = (const char*)g.A + (size_t)cur.pm * tstep; const char* cB = (const char*)g.Bt + (size_t)cur.pn * tstep;
    S.a_ready(cur);
    if constexpr (SP2) {
        PG8_STAGE(PG8_SB(0, 0), cB, voffB); PG8_STAGE(PG8_SB(0, 1), cB + hstep, voffB); PG8_STAGE(PG8_SA(0, 0), cA, voffA); PG8_STAGE(PG8_SA(0, 1), cA + hstep, voffA);
        if (wr == 1) PG8_BAR;
        PG8_WAIT_V(2); PG8_BAR;
        PG8_STAGE(PG8_SB(1, 0), cB + kstep, voffB); PG8_STAGE(PG8_SA(1, 0), cA + kstep, voffA); PG8_STAGE(PG8_SB(1, 1), cB + hstep + kstep, voffB);
        PG8_WAIT_V(6); PG8_BAR;
    } else {
        PG8_STAGE(PG8_SB(0, 0), cB, voffB); PG8_STAGE(PG8_SA(0, 0), cA, voffA); PG8_STAGE(PG8_SB(0, 1), cB + hstep, voffB); PG8_STAGE(PG8_SA(0, 1), cA + hstep, voffA);
        if (wr == 1) PG8_BAR;
        PG8_WAIT_V(4); PG8_BAR;
        PG8_STAGE(PG8_SB(1, 0), cB + kstep, voffB); PG8_STAGE(PG8_SA(1, 0), cA + kstep, voffA); PG8_STAGE(PG8_SB(1, 1), cB + hstep + kstep, voffB);
        PG8_WAIT_V(6); PG8_BAR;
    }
    for (;;) {
        const bool has_next = S.next(ui + 1, nxt);
        const char* nA = has_next ? (const char*)g.A + (size_t)nxt.pm * tstep : cA; const char* nB = has_next ? (const char*)g.Bt + (size_t)nxt.pn * tstep : cB;
        for (int t = 0; t < nt; t += 2) {
            const bool last = (t == nt - 2);
            const char* a1 = cA + (size_t)(t + 1) * kstep;
            const char* a2 = last ? nA : cA + (size_t)(t + 2) * kstep; const char* b2 = last ? nB : cB + (size_t)(t + 2) * kstep;
            const char* a3 = a2 + kstep; const char* b3 = b2 + kstep;
            if (last && has_next) S.a_ready(nxt);
            if constexpr (SP2) {
            PG8_LDB(B0, 0, 0); PG8_LDB(B1, 0, 1); PG8_SCHED; PG8_LDA(At, 0, 0); PG8_STAGE(PG8_SA(1, 1), a1 + hstep, voffA);
            PG8_WAIT_V(8); PG8_WAIT_L(0); PG8_BAR; PG8_MMA(0, 0, At, B0); PG8_MMA(0, 1, At, B1); PG8_BAR; PG8_SCHED;
            PG8_LDA(At, 0, 1); PG8_STAGE(PG8_SB(0, 0), b2, voffB); PG8_STAGE(PG8_SB(0, 1), b2 + hstep, voffB); PG8_STAGE(PG8_SA(0, 0), a2, voffA);
            PG8_WAIT_V(8); PG8_WAIT_L(0); PG8_BAR; PG8_MMA(1, 0, At, B0); PG8_MMA(1, 1, At, B1); PG8_BAR; PG8_SCHED;
            PG8_LDB(B0, 1, 0); PG8_LDB(B1, 1, 1); PG8_SCHED; PG8_LDA(At, 1, 0); PG8_STAGE(PG8_SA(0, 1), a2 + hstep, voffA);
            PG8_WAIT_V(8); PG8_WAIT_L(0); PG8_BAR; PG8_MMA(0, 0, At, B0); PG8_MMA(0, 1, At, B1); PG8_BAR; PG8_SCHED;
            PG8_LDA(At, 1, 1); PG8_STAGE(PG8_SB(1, 0), b3, voffB); PG8_STAGE(PG8_SB(1, 1), b3 + hstep, voffB); PG8_STAGE(PG8_SA(1, 0), a3, voffA);
            PG8_WAIT_V(8); PG8_WAIT_L(0); PG8_BAR; PG8_MMA(1, 0, At, B0); PG8_MMA(1, 1, At, B1); PG8_BAR; PG8_SCHED;
            } else {
            PG8_LDB(B0, 0, 0); PG8_SCHED; PG8_LDA(At, 0, 0); PG8_STAGE(PG8_SA(1, 1), a1 + hstep, voffA);
            PG8_WAIT_L(8); PG8_BAR; PG8_WAIT_L(0); PG8_MMA(0, 0, At, B0); PG8_BAR; PG8_SCHED;
            PG8_LDB(B1, 0, 1); PG8_STAGE(PG8_SB(0, 0), b2, voffB);
            PG8_BAR; PG8_WAIT_L(0); PG8_MMA(0, 1, At, B1); PG8_BAR;
            PG8_LDA(At, 0, 1); PG8_STAGE(PG8_SA(0, 0), a2, voffA);
            PG8_BAR; PG8_WAIT_L(0); PG8_MMA(1, 0, At, B0); PG8_BAR; PG8_SCHED;
            PG8_STAGE(PG8_SB(0, 1), b2 + hstep, voffB);
            PG8_WAIT_V(6); PG8_BAR; PG8_MMA(1, 1, At, B1); PG8_BAR;
            PG8_LDB(B0, 1, 0); PG8_SCHED; PG8_LDA(At, 1, 0); PG8_STAGE(PG8_SA(0, 1), a2 + hstep, voffA);
            PG8_WAIT_L(8); PG8_BAR; PG8_WAIT_L(0); PG8_MMA(0, 0, At, B0); PG8_BAR; PG8_SCHED;
            PG8_LDB(B1, 1, 1); PG8_STAGE(PG8_SB(1, 0), b3, voffB);
            PG8_BAR; PG8_WAIT_L(0); PG8_MMA(0, 1, At, B1); PG8_BAR;
            PG8_LDA(At, 1, 1); PG8_STAGE(PG8_SA(1, 0), a3, voffA);
            PG8_BAR; PG8_WAIT_L(0); PG8_MMA(1, 0, At, B0); PG8_BAR; PG8_SCHED;
            PG8_STAGE(PG8_SB(1, 1), b3 + hstep, voffB);
            PG8_WAIT_V(6); PG8_BAR; PG8_MMA(1, 1, At, B1); PG8_BAR;
            }
        }
        if constexpr (ALIGN_EPI) { if (wr == 0) PG8_BAR; }
        if constexpr (!Epi::AFTER_DRAIN) { E(acc, cur, wr, wc, fr, fq); S.done(cur); }
        if (!has_next) break;
#pragma unroll
        for (int a = 0; a < 2; ++a)
#pragma unroll
            for (int b = 0; b < 2; ++b)
#pragma unroll
                for (int m = 0; m < 4; ++m)
#pragma unroll
                    for (int n = 0; n < 2; ++n) acc[a][b][m][n] = (f32x4){0.f, 0.f, 0.f, 0.f};
        cur = nxt; cA = nA; cB = nB; ++ui;
        if constexpr (ALIGN_EPI) { if (wr == 1) PG8_BAR; }
    }
    PG8_WAIT_V(0);
    if constexpr (!ALIGN_EPI) { if (wr == 0) PG8_BAR; }
    PG8_BAR;
    if constexpr (Epi::AFTER_DRAIN) { E.fused(acc, cur, wr, wc, fr, fq, lds, wid, lane); S.done(cur); }
#undef PG8_SA
#undef PG8_SB
#undef PG8_STAGE
#undef PG8_LDA
#undef PG8_LDB
#undef PG8_MMA
#undef PG8_WAIT_V
#undef PG8_WAIT_L
#undef PG8_BAR
#undef PG8_SCHED
}
}

#define LAS __attribute__((address_space(3)))
typedef unsigned short bf16;
typedef short bf16x8 __attribute__((ext_vector_type(8)));
typedef short s16x4 __attribute__((ext_vector_type(4)));
typedef float f32x4 __attribute__((ext_vector_type(4)));
typedef float f32x16 __attribute__((ext_vector_type(16)));
typedef unsigned u32x4 __attribute__((ext_vector_type(4)));
typedef unsigned u32x2 __attribute__((ext_vector_type(2)));
typedef float f32x2_t __attribute__((ext_vector_type(2)));
typedef __bf16 bf16x2_t __attribute__((ext_vector_type(2)));

#ifndef N_LAUNCHES
#define N_LAUNCHES 1
#endif
constexpr int NPH = 5;
constexpr int D = 1024, NB = 8, SEQ = 2048, MTOK = NB * SEQ, NIN = 7440, NP = 7424, NP_MAIN = 7168;
constexpr int C_Z = 0, C_X = 1024, C_B = 2048, C_C = 2176, C_Q = 2304, C_K = 2816, C_V = 3328, C_GR = 4352, C_GAM = 5376, C_GAR = 6400;
constexpr float EPS = 1e-6f;
constexpr size_t MiB = 1u << 20;
constexpr size_t WS_PROJ = 0;
constexpr size_t WS_WMF = 232 * MiB, WS_WRF = 234 * MiB, WS_WOF = 236 * MiB;
constexpr size_t WS_MOD = 238 * MiB;
constexpr size_t WS_DT = 239 * MiB;
constexpr size_t WS_SSQM = 240 * MiB;
constexpr size_t WS_SSQR = 242 * MiB;
constexpr size_t WS_CTL = 244 * MiB, CTL_BYTES = 16384;
constexpr size_t WS_WTF = 245 * MiB;
constexpr size_t WS_END = 246 * MiB;
constexpr size_t OUT_H = 0, OUT_WINT = 32 * MiB;
constexpr int LDS_BYTES = 155648, LDS_MISC = 155520;
constexpr int NTHR = 512;

struct Args { const float* in[16]; float* out; unsigned char* ws; int ph_lo, ph_hi; };

__device__ __forceinline__ float bf_lo(unsigned u) { return __uint_as_float(u << 16); }
__device__ __forceinline__ float bf_hi(unsigned u) { return __uint_as_float(u & 0xffff0000u); }
__device__ __forceinline__ unsigned pk2(float lo, float hi) { f32x2_t v = {lo, hi}; bf16x2_t b = __builtin_convertvector(v, bf16x2_t); return __builtin_bit_cast(unsigned, b); }
__device__ __forceinline__ float silu_f(float x) { return x * __builtin_amdgcn_rcpf(1.f + __expf(-x)); }
__device__ __forceinline__ float sigm_f(float x) { return __builtin_amdgcn_rcpf(1.f + __expf(-x)); }
__device__ __forceinline__ float wave_sum(float v) {
#pragma unroll
    for (int o = 1; o < 64; o <<= 1) v += __shfl_xor(v, o);
    return v;
}
__device__ __forceinline__ int crow(int reg, int h) { return (reg & 3) + 8 * (reg >> 2) + 4 * h; }
#define MFMA32(a, b, c) __builtin_amdgcn_mfma_f32_32x32x16_bf16((a), (b), (c), 0, 0, 0)
#define MFMA16(a, b, c) __builtin_amdgcn_mfma_f32_16x16x32_bf16((a), (b), (c), 0, 0, 0)
__device__ __forceinline__ s16x4 tr_read(const LAS unsigned char* p) {
    typedef short v4i16_t __attribute__((ext_vector_type(4)));
    return __builtin_bit_cast(s16x4, __builtin_amdgcn_ds_read_tr16_b64_v4i16((LAS v4i16_t*)p));
}
__device__ __forceinline__ bf16x8 tr_pair(const LAS unsigned char* plo, const LAS unsigned char* phi) {
    const s16x4 lo = tr_read(plo), hi = tr_read(phi);
    return __builtin_shufflevector(lo, hi, 0, 1, 2, 3, 4, 5, 6, 7);
}
__device__ __forceinline__ bf16x8 pack8(float a0, float a1, float a2, float a3, float a4, float a5, float a6, float a7) {
    u32x4 p; p.x = pk2(a0, a1); p.y = pk2(a2, a3); p.z = pk2(a4, a5); p.w = pk2(a6, a7);
    return __builtin_bit_cast(bf16x8, p);
}

__device__ __forceinline__ void p0_load_tile(const float* W, int ldw, int k0, int n0, LAS float* scr, int lane) {
    float t[32];
#pragma unroll
    for (int i = 0; i < 32; ++i) t[i] = W[(size_t)(k0 + 2 * i + (lane >> 5)) * ldw + n0 + (lane & 31)];
#pragma unroll
    for (int i = 0; i < 32; ++i) scr[(2 * i + (lane >> 5)) * 33 + (lane & 31)] = t[i];
}
__device__ __forceinline__ void p0_phase(const Args& a, LAS unsigned char* lds, int tid_unused, int lane_unused, int wave, int G) {
    const int lane = fresh_lane(), tid = wave * 64 + lane;
    const float* cvec = a.in[1]; const float* w_ada = a.in[2]; const float* b_ada = a.in[3];
    float* MOD = (float*)(a.ws + WS_MOD);
    LAS float* cT = (LAS float*)lds;
    LAS float* red = (LAS float*)(lds + 32768);
    if ((int)blockIdx.x < 192) {
        { float t[16];
#pragma unroll
          for (int i = 0; i < 16; ++i) t[i] = cvec[tid + 512 * i];
#pragma unroll
          for (int i = 0; i < 16; ++i) { const int idx = tid + 512 * i; cT[(idx & 1023) * 8 + (idx >> 10)] = t[i]; } }
        __syncthreads();
        for (int item = blockIdx.x; item < 192; item += G) {
            const int j0 = item * 16, col = lane & 15, rsub = lane >> 4, kq = wave;
            float w[32];
#pragma unroll
            for (int i = 0; i < 32; ++i) w[i] = w_ada[(size_t)(kq * 128 + 4 * i + rsub) * 3072 + j0 + col];
            float acc[8];
#pragma unroll
            for (int bb = 0; bb < 8; ++bb) acc[bb] = 0.f;
#pragma unroll
            for (int i = 0; i < 32; ++i) { const int k = kq * 128 + 4 * i + rsub;
                const f32x4 c0 = *(const LAS f32x4*)(cT + k * 8), c1 = *(const LAS f32x4*)(cT + k * 8 + 4);
                acc[0] += c0.x * w[i]; acc[1] += c0.y * w[i]; acc[2] += c0.z * w[i]; acc[3] += c0.w * w[i];
                acc[4] += c1.x * w[i]; acc[5] += c1.y * w[i]; acc[6] += c1.z * w[i]; acc[7] += c1.w * w[i]; }
#pragma unroll
            for (int bb = 0; bb < 8; ++bb) { acc[bb] += __shfl_xor(acc[bb], 16); acc[bb] += __shfl_xor(acc[bb], 32); }
            if (lane < 16) {
#pragma unroll
                for (int bb = 0; bb < 8; ++bb) red[(kq * 8 + bb) * 16 + col] = acc[bb]; }
            __syncthreads();
            if (tid < 128) { const int bb = tid >> 4, cc = tid & 15; float sum = 0.f;
#pragma unroll
                for (int q = 0; q < 8; ++q) sum += red[(q * 8 + bb) * 16 + cc];
                MOD[bb * 3072 + j0 + cc] = sum + b_ada[j0 + cc]; }
            __syncthreads();
        }
    }
    LAS float* scr = (LAS float*)(lds + 40960 + wave * 8448);
    const int gw = blockIdx.x * 8 + wave, NGW = G * 8;
    constexpr int I_IN = 16 * (NP / 32), I_W = 16 * 32;
    bf16* WINT = (bf16*)((unsigned char*)a.out + OUT_WINT);
    for (int it = gw; it < I_IN + 3 * I_W + 128; it += NGW) {
        if (it >= I_IN + 3 * I_W) {
            const int r_ = it - (I_IN + 3 * I_W), nt = r_ & 7, kb = r_ >> 3;
            p0_load_tile(a.in[5], NIN, 64 * kb, NP_MAIN + 16 + 32 * nt, scr, lane);
            bf16* WF = (bf16*)(a.ws + WS_WTF);
            const int r = lane & 31, h = lane >> 5;
#pragma unroll
            for (int s4 = 0; s4 < 4; ++s4) { const LAS float* s = scr + (16 * s4 + 8 * h) * 33 + r;
                u32x4 o; o.x = pk2(s[0 * 33], s[1 * 33]); o.y = pk2(s[2 * 33], s[3 * 33]); o.z = pk2(s[4 * 33], s[5 * 33]); o.w = pk2(s[6 * 33], s[7 * 33]);
                *(u32x4*)(WF + ((size_t)(nt * 64 + 4 * kb + s4) * 64 + lane) * 8) = o; }
        } else if (it < I_IN) {
            const int nblk = NP / 32, kb = it / nblk, nb = it % nblk, k0 = 64 * kb, n0p = 32 * nb, n0 = n0p + (n0p >= 2304 ? 16 : 0);
            p0_load_tile(a.in[5], NIN, k0, n0, scr, lane);
            const int c = lane & 7;
#pragma unroll
            for (int j = 0; j < 4; ++j) { const int n = (lane >> 3) + 8 * j; const LAS float* s = scr + (8 * c) * 33 + n;
                u32x4 o; o.x = pk2(s[0 * 33], s[1 * 33]); o.y = pk2(s[2 * 33], s[3 * 33]); o.z = pk2(s[4 * 33], s[5 * 33]); o.w = pk2(s[6 * 33], s[7 * 33]);
                *(u32x4*)(WINT + (size_t)(n0p + n) * 1024 + k0 + 8 * c) = o; }
        } else {
            int r_ = it - I_IN; const int which = r_ / I_W; r_ -= which * I_W;
            const float* W = a.in[12 + which];
            bf16* WF = (bf16*)(a.ws + WS_WMF + (size_t)which * 2 * MiB);
            const int nt = r_ & 31, kb = r_ >> 5;
            p0_load_tile(W, 1024, 64 * kb, 32 * nt, scr, lane);
            const int r = lane & 31, h = lane >> 5;
#pragma unroll
            for (int s4 = 0; s4 < 4; ++s4) { const LAS float* s = scr + (16 * s4 + 8 * h) * 33 + r;
                f32x4 m0 = (f32x4){1.f, 1.f, 1.f, 1.f}, m1 = m0;
                if (which == 0) { m0 = *(const f32x4*)(a.in[11] + 64 * kb + 16 * s4 + 8 * h); m1 = *(const f32x4*)(a.in[11] + 64 * kb + 16 * s4 + 8 * h + 4); }
                u32x4 o; o.x = pk2(s[0 * 33] * m0.x, s[1 * 33] * m0.y); o.y = pk2(s[2 * 33] * m0.z, s[3 * 33] * m0.w); o.z = pk2(s[4 * 33] * m1.x, s[5 * 33] * m1.y); o.w = pk2(s[6 * 33] * m1.z, s[7 * 33] * m1.w);
                *(u32x4*)(WF + ((size_t)(nt * 64 + 4 * kb + s4) * 64 + lane) * 8) = o; }
        }
    }
}

__device__ __forceinline__ void p1_phase(const Args& a, LAS unsigned char* lds, int tid_unused, int lane_unused, int wave, int G) {
    const int lane_in = fresh_lane(), tid = wave * 64 + lane_in;
    const float* x = a.in[0]; const float* norm_w = a.in[4]; const float* w_in = a.in[5]; const float* dt_bias = a.in[8];
    const float* MOD = (const float*)(a.ws + WS_MOD);
    float* DT = (float*)(a.ws + WS_DT);
    bf16* H = (bf16*)((unsigned char*)a.out + OUT_H);
    LAS float* wdt = (LAS float*)lds;
    { float t[32];
#pragma unroll
      for (int i = 0; i < 32; ++i) { const int idx = tid + NTHR * i; t[i] = w_in[(size_t)(idx >> 4) * NIN + 2304 + (idx & 15)]; }
#pragma unroll
      for (int i = 0; i < 32; ++i) { const int idx = tid + NTHR * i; wdt[(idx & 15) * 1028 + (idx >> 4)] = t[i]; } }
    __syncthreads();
    for (int blk = blockIdx.x; blk < 256; blk += G) {
        const int b = blk >> 5;
        float gk[16], sh[16];
#pragma unroll
        for (int jj = 0; jj < 4; ++jj) { const int k = 4 * lane_in + 256 * jj;
            const f32x4 nw = *(const f32x4*)(norm_w + k), sc = *(const f32x4*)(MOD + b * 3072 + 1024 + k), sf = *(const f32x4*)(MOD + b * 3072 + k);
#pragma unroll
            for (int e = 0; e < 4; ++e) { gk[4 * jj + e] = nw[e] * (1.f + sc[e]); sh[4 * jj + e] = sf[e]; } }
        f32x4 vn[2][4];
        { const int lane = fresh_lane();
#pragma unroll
          for (int rr = 0; rr < 2; ++rr)
#pragma unroll
              for (int jj = 0; jj < 4; ++jj) vn[rr][jj] = *((const f32x4*)(x + (size_t)(blk * 64 + wave * 8 + rr) * D) + lane + 64 * jj); }
        for (int g = 0; g < 4; ++g) {
            asm volatile("" ::: "memory");
            const int lane = fresh_lane();
            const int m0 = blk * 64 + wave * 8 + g * 2;
            f32x4 v[2][4];
#pragma unroll
            for (int rr = 0; rr < 2; ++rr)
#pragma unroll
                for (int jj = 0; jj < 4; ++jj) v[rr][jj] = vn[rr][jj];
            if (g + 1 < 4) {
#pragma unroll
                for (int rr = 0; rr < 2; ++rr)
#pragma unroll
                    for (int jj = 0; jj < 4; ++jj) vn[rr][jj] = *((const f32x4*)(x + (size_t)(m0 + 2 + rr) * D) + lane + 64 * jj);
            }
            __builtin_amdgcn_sched_barrier(0);
            float hv[2][16];
#pragma unroll
            for (int rr = 0; rr < 2; ++rr) {
                float ss = 0.f;
#pragma unroll
                for (int jj = 0; jj < 4; ++jj) ss += (v[rr][jj].x * v[rr][jj].x + v[rr][jj].y * v[rr][jj].y) + (v[rr][jj].z * v[rr][jj].z + v[rr][jj].w * v[rr][jj].w);
                const float rs = 1.0f / sqrtf(wave_sum(ss) * (1.f / D) + EPS);
                unsigned long long* o8 = (unsigned long long*)(H + (size_t)(m0 + rr) * D) + lane;
#pragma unroll
                for (int jj = 0; jj < 4; ++jj) {
#pragma unroll
                    for (int e = 0; e < 4; ++e) hv[rr][4 * jj + e] = v[rr][jj][e] * rs * gk[4 * jj + e] + sh[4 * jj + e];
                    o8[64 * jj] = (unsigned long long)pk2(hv[rr][4 * jj], hv[rr][4 * jj + 1]) | ((unsigned long long)pk2(hv[rr][4 * jj + 2], hv[rr][4 * jj + 3]) << 32);
                }
            }
            float acc[32];
#pragma unroll
            for (int i = 0; i < 32; ++i) acc[i] = 0.f;
#pragma unroll
            for (int j = 0; j < 16; ++j) {
#pragma unroll
                for (int jj = 0; jj < 4; ++jj) { const f32x4 w = *(const LAS f32x4*)(wdt + j * 1028 + 4 * lane + 256 * jj);
#pragma unroll
                    for (int rr = 0; rr < 2; ++rr) acc[rr * 16 + j] += (hv[rr][4 * jj] * w.x + hv[rr][4 * jj + 1] * w.y) + (hv[rr][4 * jj + 2] * w.z + hv[rr][4 * jj + 3] * w.w); }
                if ((j & 3) == 3) asm volatile("" ::: "memory");
            }
#pragma unroll
            for (int half = 16; half >= 1; half >>= 1) {
                const bool up = (lane & half) != 0;
#pragma unroll
                for (int i = 0; i < half; ++i) { float lo_ = acc[i], hi_ = acc[i + half]; asm volatile("" : "+v"(lo_), "+v"(hi_));
                    const float keep = up ? hi_ : lo_, send = up ? lo_ : hi_; acc[i] = keep + __shfl_xor(send, half); }
            }
            const float tot = acc[0] + __shfl_xor(acc[0], 32);
            const float xr_ = tot + dt_bias[lane & 15];
            const float dtv = xr_ > 20.f ? xr_ : log1pf(__expf(xr_));
            if (lane < 32) DT[(size_t)m0 * 16 + lane] = dtv;
        }
    }
}

constexpr size_t OUT_XBCC = 0;
__device__ __forceinline__ void p3a_phase(const Args& a, int wave, int G) {
    const bf16* PROJ = (const bf16*)(a.ws + WS_PROJ);
    bf16* XBCC = (bf16*)((unsigned char*)a.out + OUT_XBCC);
    const float* conv_w = a.in[6]; const float* conv_b = a.in[7];
    const int lane = fresh_lane(), tid = wave * 64 + lane;
    if (tid >= 480) return;
    const int oct = tid % 160, tgl = tid / 160;
    float cw[4][8], cb[8];
#pragma unroll
    for (int e = 0; e < 8; ++e) { cb[e] = conv_b[8 * oct + e];
#pragma unroll
        for (int k = 0; k < 4; ++k) cw[k][e] = conv_w[k * 1280 + 8 * oct + e]; }
    for (int blk = blockIdx.x; blk < 256; blk += G) {
        for (int tg = tgl; tg < 8; tg += 3) {
            const int m0 = blk * 64 + 8 * tg, ts0 = m0 & (SEQ - 1);
            const char* src = (const char*)(PROJ + (size_t)m0 * NP + C_X + 8 * oct);
            u32x4 raw[11];
#pragma unroll
            for (int i = 0; i < 11; ++i) { const bool ok = (ts0 - 3 + i) >= 0; raw[i] = ok ? *(const u32x4*)(src + ((long)i - 3) * (NP * 2)) : (u32x4){0u, 0u, 0u, 0u}; }
#pragma unroll
            for (int jj = 0; jj < 8; ++jj) {
                float o[8];
#pragma unroll
                for (int e = 0; e < 8; ++e) {
                    float s_ = cb[e];
#pragma unroll
                    for (int k = 0; k < 4; ++k) { const unsigned w = raw[jj + k][e >> 1]; s_ += cw[k][e] * ((e & 1) ? bf_hi(w) : bf_lo(w)); }
                    o[e] = silu_f(s_);
                }
                u32x4 ov; ov.x = pk2(o[0], o[1]); ov.y = pk2(o[2], o[3]); ov.z = pk2(o[4], o[5]); ov.w = pk2(o[6], o[7]);
                *(u32x4*)(XBCC + (size_t)(m0 + jj) * 1280 + 8 * oct) = ov;
            }
        }
    }
}

constexpr int TP = 72;
constexpr int L_CQ = 0, L_BK = 18432, L_BKW = 36864, L_XV = 55296, L_ST0 = 73728, L_ST1 = 82944, L_ACS = 92160, L_DTJ = 93184, L_WJ = 94208, L_CW = 95232;

__device__ __forceinline__ void p3_phase(const Args& a, LAS unsigned char* lds, int tid_in, int lane_in, int wave, int G, const bool dry = false) {
    bf16* PROJ = (bf16*)(a.ws + WS_PROJ);
    const float* DT = (const float*)(a.ws + WS_DT);
    float* SSQM = (float*)(a.ws + WS_SSQM); float* SSQR = (float*)(a.ws + WS_SSQR);
    const float* conv_w = a.in[6]; const float* conv_b = a.in[7]; const float* a_log = a.in[9]; const float* d_skip = a.in[10]; const float* m_norm_w = a.in[11];
    const int pt = wave & 1, it = wave >> 1;
#ifdef PROBE_SEL
    unsigned long long t0_ = 0ull; unsigned tacc_ = 0u;
    const bool probing = ((int)blockIdx.x == PROBE_BLK && wave == PROBE_WAVE);
#define TB(k) do { if (PROBE_SEL == (k) && probing) t0_ = __builtin_amdgcn_s_memrealtime(); } while (0)
#define TE(k) do { if (PROBE_SEL == (k) && probing) tacc_ += (unsigned)(__builtin_amdgcn_s_memrealtime() - t0_); } while (0)
#else
#define TB(k) do {} while (0)
#define TE(k) do {} while (0)
#endif
    for (int item = blockIdx.x; item < 256; item += G) {
        const int lane = fresh_lane(), tid = wave * 64 + lane;
        const int r = lane & 31, h = lane >> 5, i16 = lane & 15, q4 = i16 >> 2, p4 = i16 & 3, blk16 = (lane >> 4) & 1;
        const bool ssd = item < 128;
        int b, hd, half;
        if (ssd) { b = item >> 4; hd = item & 15; half = 0; } else { const int t = item - 128; b = t >> 4; hd = (t >> 1) & 7; half = t & 1; }
        const size_t mb = (size_t)b * SEQ;
        __syncthreads();
        for (int idx = tid; idx < 9216 / 4; idx += NTHR) ((LAS unsigned*)(lds + L_ST0))[idx] = 0u;
        const float lg = ssd ? 0.f : log1pf(-exp2f(-5.0f - (float)hd));
        if (!ssd && tid < 256) { const int par = tid >> 7, j = tid & 127;
            ((LAS float*)(lds + L_ACS))[par * 128 + j] = (float)(j + 1) * lg * 1.4426950408889634f; ((LAS float*)(lds + L_DTJ))[par * 128 + j] = (float)(j + 1) * lg * 1.4426950408889634f; ((LAS float*)(lds + L_WJ))[par * 128 + j] = __expf((float)(127 - j) * lg); }
        const float Ah = ssd ? -__expf(a_log[hd]) : 0.f;
        const float Dsk = ssd ? d_skip[hd] : 0.f;
        const int ltile = 3 - (tid >> 7), loct = tid & 7, ltg = (tid >> 3) & 15;
        int lcol = 0;
        float invf[8];
        if (ssd) {
            lcol = (ltile == 0) ? (64 * hd + 8 * loct) : (ltile == 1 ? (1024 + 64 * (hd >> 3) + 8 * loct) : (1152 + 64 * (hd >> 3) + 8 * loct));
            if (ltile == 3) lcol = 1024 + 64 * (hd >> 3) + 8 * loct;
#pragma unroll
            for (int e = 0; e < 8; ++e) invf[e] = 0.f;
        } else {
#pragma unroll
            for (int e = 0; e < 8; ++e) invf[e] = exp2f(-(float)(8 * (tid & 3) + e) * (13.287712379549449f / 32.f));
        }
        f32x16 sacc;
#pragma unroll
        for (int i = 0; i < 16; ++i) sacc[i] = 0.f;
        u32x4 raw[8];
        const int rj = tid >> 2, ro4 = tid & 3;
        const int j0 = 8 * ltg;
        const char* pbase = (const char*)(PROJ + mb * NP);
        const char* xbase = (const char*)((const bf16*)((const unsigned char*)a.out + OUT_XBCC) + mb * 1280);
        const unsigned soff = (unsigned)((j0 * 1280 + lcol) * 2);
        const unsigned roff = (unsigned)((rj * NP) * 2);
#define P3_ISSUE(cc) do { const char* cbp = pbase + (size_t)(cc) * (128 * NP * 2); \
        if (ssd) { const char* xp = xbase + (size_t)(cc) * (128 * 1280 * 2) + soff; _Pragma("unroll") for (int i = 0; i < 8; ++i) raw[i] = *(const u32x4*)(xp + i * (1280 * 2)); } \
        else { const char* rp = cbp + roff; \
            raw[0] = *(const u32x4*)(rp + (C_Q + 64 * hd + 8 * ro4) * 2); raw[1] = *(const u32x4*)(rp + (C_Q + 64 * hd + 32 + 8 * ro4) * 2); \
            raw[2] = *(const u32x4*)(rp + (C_K + 64 * hd + 8 * ro4) * 2); raw[3] = *(const u32x4*)(rp + (C_K + 64 * hd + 32 + 8 * ro4) * 2); \
            raw[4] = *(const u32x4*)(rp + (C_V + 128 * hd + 64 * half + 16 * ro4) * 2); raw[5] = *(const u32x4*)(rp + (C_V + 128 * hd + 64 * half + 16 * ro4 + 8) * 2); } } while (0)
        float dq0 = 0.f, dq1 = 0.f;
#define P3_SCAN(cc) do { LAS float* ACSw = (LAS float*)(lds + L_ACS) + ((cc) & 1) * 128; LAS float* DTJw = (LAS float*)(lds + L_DTJ) + ((cc) & 1) * 128; LAS float* WJw = (LAS float*)(lds + L_WJ) + ((cc) & 1) * 128; \
        const float v0 = dq0 * Ah, v1 = dq1 * Ah, s_ = v0 + v1; float incl = s_; \
        _Pragma("unroll") for (int o = 1; o < 64; o <<= 1) { const float t = __shfl_up(incl, o); if (lane >= o) incl += t; } \
        const float c0 = (incl - s_) + v0, tot = __shfl(incl, 63), c1 = (lane == 63) ? tot : c0 + v1; \
        ACSw[2 * lane] = c0 * 1.4426950408889634f; ACSw[2 * lane + 1] = c1 * 1.4426950408889634f; \
        DTJw[2 * lane] = c0 * 1.4426950408889634f - __log2f(dq0); DTJw[2 * lane + 1] = c1 * 1.4426950408889634f - __log2f(dq1); \
        WJw[2 * lane] = dq0 * __expf(tot - c0); WJw[2 * lane + 1] = dq1 * __expf(tot - c1); } while (0)
#define P3_DTLOAD(cc) do { dq0 = DT[(mb + (size_t)(cc) * 128 + 2 * lane) * 16 + hd]; dq1 = DT[(mb + (size_t)(cc) * 128 + 2 * lane + 1) * 16 + hd]; } while (0)
        if (ssd && wave == 0) { P3_DTLOAD(0); P3_SCAN(0); P3_DTLOAD(1); }
        u32x2 zzn[4];
        { const bf16* orow0 = PROJ + (mb + 16 * wave + i16) * NP + (ssd ? (C_Z + 64 * hd) : (C_GR + 128 * hd + 64 * half));
#pragma unroll
          for (int g4 = 0; g4 < 4; ++g4) zzn[g4] = *(const u32x2*)(orow0 + 16 * g4 + 4 * (lane >> 4)); }
        P3_ISSUE(0);

        TB(1);
        for (int c = 0; c < 16; ++c) {
            const int par = c & 1;
            const size_t m0 = mb + (size_t)c * 128;
            LAS float* ACS = (LAS float*)(lds + L_ACS) + par * 128; LAS float* DTJ = (LAS float*)(lds + L_DTJ) + par * 128; LAS float* WJ = (LAS float*)(lds + L_WJ) + par * 128;
            TB(5);
            __syncthreads();
            TE(5); TB(2);
#ifndef P3_REPL
#define P3_REPL 1
#endif
            _Pragma("nounroll") for (int repl_ = 0; repl_ < P3_REPL; ++repl_) {
            if (repl_) __syncthreads();
            if (ssd) {
                {
                    LAS unsigned char* dst = lds + (ltile == 0 ? L_XV : (ltile == 1 ? L_BK : (ltile == 2 ? L_CQ : L_BKW)));
#pragma unroll
                    for (int jj = 0; jj < 8; ++jj) {
                        u32x4 v = raw[jj];
                        if (ltile == 3) { const float wj = WJ[j0 + jj];
                            v.x = pk2(bf_lo(v.x) * wj, bf_hi(v.x) * wj); v.y = pk2(bf_lo(v.y) * wj, bf_hi(v.y) * wj); v.z = pk2(bf_lo(v.z) * wj, bf_hi(v.z) * wj); v.w = pk2(bf_lo(v.w) * wj, bf_hi(v.w) * wj); }
                        *(LAS u32x4*)(dst + ((j0 + jj) * TP + 8 * loct) * 2) = v;
                    }
                }
            } else {
                const int j = rj, o4 = ro4;
                const u32x4 q1 = raw[0], q2 = raw[1], k1 = raw[2], k2 = raw[3];
                const float pos = (float)(c * 128 + j), wj = WJ[j];
                float ql[8], qh[8], kl[8], kh[8];
#pragma unroll
                for (int e = 0; e < 8; ++e) {
                    const float rev = pos * invf[e] * 0.15915494309189535f, fr = rev - floorf(rev);
                    const float cs = __builtin_amdgcn_cosf(fr), sn = __builtin_amdgcn_sinf(fr);
                    const unsigned wq1 = q1[e >> 1], wq2 = q2[e >> 1], wk1 = k1[e >> 1], wk2 = k2[e >> 1];
                    const float a1 = (e & 1) ? bf_hi(wq1) : bf_lo(wq1), a2 = (e & 1) ? bf_hi(wq2) : bf_lo(wq2);
                    const float b1 = ((e & 1) ? bf_hi(wk1) : bf_lo(wk1)) * 0.125f, b2 = ((e & 1) ? bf_hi(wk2) : bf_lo(wk2)) * 0.125f;
                    ql[e] = a1 * cs - a2 * sn; qh[e] = a1 * sn + a2 * cs;
                    kl[e] = b1 * cs - b2 * sn; kh[e] = b1 * sn + b2 * cs;
                }
                u32x4 t;
                t.x = pk2(ql[0], ql[1]); t.y = pk2(ql[2], ql[3]); t.z = pk2(ql[4], ql[5]); t.w = pk2(ql[6], ql[7]); *(LAS u32x4*)(lds + L_CQ + (j * TP + 8 * o4) * 2) = t;
                t.x = pk2(qh[0], qh[1]); t.y = pk2(qh[2], qh[3]); t.z = pk2(qh[4], qh[5]); t.w = pk2(qh[6], qh[7]); *(LAS u32x4*)(lds + L_CQ + (j * TP + 32 + 8 * o4) * 2) = t;
                t.x = pk2(kl[0], kl[1]); t.y = pk2(kl[2], kl[3]); t.z = pk2(kl[4], kl[5]); t.w = pk2(kl[6], kl[7]); *(LAS u32x4*)(lds + L_BK + (j * TP + 8 * o4) * 2) = t;
                t.x = pk2(kh[0], kh[1]); t.y = pk2(kh[2], kh[3]); t.z = pk2(kh[4], kh[5]); t.w = pk2(kh[6], kh[7]); *(LAS u32x4*)(lds + L_BK + (j * TP + 32 + 8 * o4) * 2) = t;
                t.x = pk2(kl[0] * wj, kl[1] * wj); t.y = pk2(kl[2] * wj, kl[3] * wj); t.z = pk2(kl[4] * wj, kl[5] * wj); t.w = pk2(kl[6] * wj, kl[7] * wj); *(LAS u32x4*)(lds + L_BKW + (j * TP + 8 * o4) * 2) = t;
                t.x = pk2(kh[0] * wj, kh[1] * wj); t.y = pk2(kh[2] * wj, kh[3] * wj); t.z = pk2(kh[4] * wj, kh[5] * wj); t.w = pk2(kh[6] * wj, kh[7] * wj); *(LAS u32x4*)(lds + L_BKW + (j * TP + 32 + 8 * o4) * 2) = t;
                *(LAS u32x4*)(lds + L_XV + (j * TP + 16 * o4) * 2) = raw[4]; *(LAS u32x4*)(lds + L_XV + (j * TP + 16 * o4 + 8) * 2) = raw[5];
            }
            }
            TE(2); TB(6);
            __syncthreads();
            TE(6); TB(3);
            const int q16 = lane >> 4, iTok = 16 * wave + i16;
            bf16* orow = PROJ + (m0 + iTok) * NP + (ssd ? (C_Z + 64 * hd) : (C_GR + 128 * hd + 64 * half));
            u32x2 zz[4];
#pragma unroll
            for (int g4 = 0; g4 < 4; ++g4) zz[g4] = zzn[g4];
            if (c + 1 < 16) {
#pragma unroll
                for (int g4 = 0; g4 < 4; ++g4) zzn[g4] = *(const u32x2*)(orow + 128 * NP + 16 * g4 + 4 * q16);
                P3_ISSUE(c + 1);
            }
            __builtin_amdgcn_sched_barrier(0);
            if (ssd && wave == 0 && c + 1 < 16) { P3_SCAN(c + 1); if (c + 2 < 16) P3_DTLOAD(c + 2); }
#ifndef P3_REPC
#define P3_REPC 1
#endif
            f32x16 acc;
            float acs_i = 0.f;
            LAS unsigned char* STw = lds + (par ? L_ST0 : L_ST1);
            _Pragma("nounroll") for (int repc_ = 0; repc_ < P3_REPC; ++repc_) {
            bf16x8 cqb[2];
#pragma unroll
            for (int s = 0; s < 2; ++s) cqb[s] = *(const LAS bf16x8*)(lds + L_CQ + (iTok * TP + 32 * s + 8 * q16) * 2);
            const LAS unsigned char* STr = lds + (par ? L_ST1 : L_ST0);
#pragma unroll
            for (int i = 0; i < 16; ++i) acc[i] = 0.f;
            f32x4 ya[4];
#pragma unroll
            for (int p4t = 0; p4t < 4; ++p4t) { ya[p4t] = (f32x4){0.f, 0.f, 0.f, 0.f};
#pragma unroll
                for (int s = 0; s < 2; ++s) { const bf16x8 sa = *(const LAS bf16x8*)(STr + ((16 * p4t + i16) * TP + 32 * s + 8 * q16) * 2); ya[p4t] = MFMA16(sa, cqb[s], ya[p4t]); } }
            acs_i = ACS[iTok];
            { const float ei = __builtin_amdgcn_exp2f(acs_i);
#pragma unroll
              for (int p4t = 0; p4t < 4; ++p4t) ya[p4t] = ya[p4t] * ei; }
            const int nblk = (wave >> 1) + 1;
            for (int jb = 0; jb < nblk; ++jb) {
                const int j0 = 32 * jb;
                f32x4 t0 = (f32x4){0.f, 0.f, 0.f, 0.f}, t1 = t0;
#pragma unroll
                for (int s = 0; s < 2; ++s) {
                    const bf16x8 k0 = *(const LAS bf16x8*)(lds + L_BK + ((j0 + i16) * TP + 32 * s + 8 * q16) * 2), k1 = *(const LAS bf16x8*)(lds + L_BK + ((j0 + 16 + i16) * TP + 32 * s + 8 * q16) * 2);
                    t0 = MFMA16(k0, cqb[s], t0); t1 = MFMA16(k1, cqb[s], t1);
                }
                const f32x4 b0 = *(const LAS f32x4*)(DTJ + j0 + 4 * q16), b1 = *(const LAS f32x4*)(DTJ + j0 + 16 + 4 * q16);
                bf16x8 xa[4];
#pragma unroll
                for (int p4t = 0; p4t < 4; ++p4t) { const LAS unsigned char* xb = lds + L_XV + ((j0 + 4 * q16 + q4) * TP + 16 * p4t + 4 * p4) * 2; xa[p4t] = tr_pair(xb, xb + 16 * TP * 2); }
                __builtin_amdgcn_sched_barrier(0);
                const bool lastb = (jb == nblk - 1);
                float pv[8];
#pragma unroll
                for (int e = 0; e < 4; ++e) {
                    float v0 = t0[e] * __builtin_amdgcn_exp2f(acs_i - b0[e]), v1 = t1[e] * __builtin_amdgcn_exp2f(acs_i - b1[e]);
                    if (lastb && (j0 + 4 * q16 + e) > iTok) v0 = 0.f;
                    if (lastb && (j0 + 16 + 4 * q16 + e) > iTok) v1 = 0.f;
                    pv[e] = v0; pv[4 + e] = v1;
                }
                const bf16x8 pf = pack8(pv[0], pv[1], pv[2], pv[3], pv[4], pv[5], pv[6], pv[7]);
#pragma unroll
                for (int p4t = 0; p4t < 4; ++p4t) ya[p4t] = MFMA16(xa[p4t], pf, ya[p4t]);
            }
#pragma unroll
            for (int p4t = 0; p4t < 4; ++p4t)
#pragma unroll
                for (int e = 0; e < 4; ++e) acc[4 * p4t + e] = ya[p4t][e];
            }
            TE(3); TB(4);
            if (it < 2 && c < 15) {
                const int nt = it;
                const float dec = __builtin_amdgcn_exp2f(ACS[127]);
#pragma unroll
                for (int i = 0; i < 16; ++i) sacc[i] *= dec;
                f32x16 sacc2;
#pragma unroll
                for (int i = 0; i < 16; ++i) sacc2[i] = 0.f;
#pragma unroll
                for (int ks = 0; ks < 8; ++ks) {
                    const LAS unsigned char* xb = lds + L_XV + ((16 * ks + 8 * h + q4) * TP + 32 * pt + 16 * blk16 + 4 * p4) * 2;
                    const LAS unsigned char* kb = lds + L_BKW + ((16 * ks + 8 * h + q4) * TP + 32 * nt + 16 * blk16 + 4 * p4) * 2;
                    const bf16x8 xa = tr_pair(xb, xb + 4 * TP * 2), kbf = tr_pair(kb, kb + 4 * TP * 2);
                    if (ks & 1) sacc2 = MFMA32(xa, kbf, sacc2); else sacc = MFMA32(xa, kbf, sacc);
                }
#pragma unroll
                for (int i = 0; i < 16; ++i) sacc[i] += sacc2[i];
#pragma unroll
                for (int i = 0; i < 16; ++i) { const int p = 32 * pt + crow(i, h);
                    *(LAS unsigned short*)(STw + (p * TP + 32 * nt + r) * 2) = (unsigned short)(pk2(sacc[i], 0.f) & 0xffffu); }
            }
            {
                float ss = 0.f;
#pragma unroll
                for (int g4 = 0; g4 < 4; ++g4) {
                    const int p = 16 * g4 + 4 * q16;
                    const float z0 = bf_lo(zz[g4].x), z1 = bf_hi(zz[g4].x), z2 = bf_lo(zz[g4].y), z3 = bf_hi(zz[g4].y);
                    float y0 = acc[4 * g4], y1 = acc[4 * g4 + 1], y2 = acc[4 * g4 + 2], y3 = acc[4 * g4 + 3];
                    float o0, o1, o2, o3;
                    if (ssd) {
                        const u32x2 xv = *(const LAS u32x2*)(lds + L_XV + (iTok * TP + p) * 2);
                        y0 = (y0 + Dsk * bf_lo(xv.x)) * silu_f(z0); y1 = (y1 + Dsk * bf_hi(xv.x)) * silu_f(z1); y2 = (y2 + Dsk * bf_lo(xv.y)) * silu_f(z2); y3 = (y3 + Dsk * bf_hi(xv.y)) * silu_f(z3);
                        ss += (y0 * y0 + y1 * y1) + (y2 * y2 + y3 * y3);
                        o0 = y0; o1 = y1; o2 = y2; o3 = y3;
                    } else {
                        ss += (y0 * y0 + y1 * y1) + (y2 * y2 + y3 * y3);
                        o0 = y0 * silu_f(z0); o1 = y1 * silu_f(z1); o2 = y2 * silu_f(z2); o3 = y3 * silu_f(z3);
                    }
                    u32x2 ov; ov.x = pk2(o0, o1); ov.y = pk2(o2, o3);
                    if (dry) *(u32x2*)((bf16*)((unsigned char*)a.out + 40 * MiB) + (m0 + iTok) * 512 + ((64 * hd + 64 * half + p) & 511)) = ov; else *(u32x2*)(orow + p) = ov;
                }
                ss += __shfl_xor(ss, 16); ss += __shfl_xor(ss, 32);
                if (q16 < 2) { const float sv = (q16 == 0) ? ss : 0.f;
                    if (ssd) SSQM[(m0 + iTok) * 32 + hd * 2 + q16] = sv; else SSQR[(m0 + iTok) * 32 + hd * 4 + half * 2 + q16] = sv; }
            }
            TE(4);
        }
        TE(1);
#undef P3_ISSUE
#undef P3_SCAN
#undef P3_DTLOAD
    }
#ifdef PROBE_SEL
    if (probing && fresh_lane() == 0) ((unsigned*)(a.ws + WS_CTL))[4000] = tacc_;
#endif
#undef TB
#undef TE
}

constexpr int MP = 1032;
constexpr int L4_MERGED = 0, L4_ASTG = 132096, L4_RM = 150528, L4_RR = 151040, L4_RED = 153088, L4_RS = 155136;
static_assert(L4_RS + 256 <= LDS_BYTES, "P4 LDS map");

__device__ __forceinline__ void p4_panel_load(u32x4 (&ar)[16], const bf16* Abase, int tid) {
    const int srow = tid >> 3, soct = tid & 7; const int rot = ((int)blockIdx.x >> 3) & 15;
    const char* ab = (const char*)Abase; const unsigned aoff = (unsigned)((srow * NP + 8 * soct) * 2);
#pragma unroll
    for (int i = 0; i < 16; ++i) ar[i] = *(const u32x4*)(ab + ((rot + i) & 15) * 128 + aoff);
}
template <int SEGSHIFT>
__device__ __forceinline__ void p4_gemmT(f32x16 (&accT)[2][2], u32x4 (&ar)[16], const bf16* Anext  , const LAS float* rsc  , int nseg,
                                         const bf16* WF  , int nt0  , LAS unsigned char* lds, int tid, int lane) {
    const int srow = tid >> 3, soct = tid & 7, r = lane & 31, h = lane >> 5;
    const char* wb = (const char*)WF + (size_t)nt0 * 65536; const unsigned woff = (unsigned)(lane * 16);
    const int rot = ((int)blockIdx.x >> 3) & 15;
    bf16x8 wc[4][2];
    { const char* wk0 = wb + rot * 4096;
#pragma unroll
      for (int s = 0; s < 4; ++s) { wc[s][0] = *(const bf16x8*)(wk0 + s * 1024 + woff); wc[s][1] = *(const bf16x8*)(wk0 + 65536 + s * 1024 + woff); } }
#define P4_STAGE_WRITE(ki_) do { const int kc_ = ((ki_) + rot) & 15; const float sc = rsc[srow * nseg + ((kc_ * 64) >> SEGSHIFT)]; \
        u32x4 o; \
        o.x = pk2(bf_lo(ar[ki_].x) * sc, bf_hi(ar[ki_].x) * sc); o.y = pk2(bf_lo(ar[ki_].y) * sc, bf_hi(ar[ki_].y) * sc); \
        o.z = pk2(bf_lo(ar[ki_].z) * sc, bf_hi(ar[ki_].z) * sc); o.w = pk2(bf_lo(ar[ki_].w) * sc, bf_hi(ar[ki_].w) * sc); \
        *(LAS u32x4*)(lds + L4_ASTG + ((ki_) & 1) * 9216 + (srow * TP + 8 * soct) * 2) = o; } while (0)
    P4_STAGE_WRITE(0);
#pragma unroll
    for (int ki = 0; ki < 16; ++ki) {
        const int kc = (ki + rot) & 15;
        LAS unsigned char* stg = lds + L4_ASTG + (ki & 1) * 9216;
        __syncthreads();
        if (ki + 1 < 16) P4_STAGE_WRITE(ki + 1);
        const int kn = (kc + 1) & 15;
        const char* wk = wb + kn * 4096;
        bf16x8 a0 = *(const LAS bf16x8*)(stg + (r * TP + 8 * h) * 2), a1 = *(const LAS bf16x8*)(stg + ((32 + r) * TP + 8 * h) * 2);
#pragma unroll
        for (int s = 0; s < 4; ++s) {
            bf16x8 n0 = a0, n1 = a1;
            if (s < 3) { n0 = *(const LAS bf16x8*)(stg + (r * TP + 16 * (s + 1) + 8 * h) * 2); n1 = *(const LAS bf16x8*)(stg + ((32 + r) * TP + 16 * (s + 1) + 8 * h) * 2); }
            accT[0][0] = MFMA32(wc[s][0], a0, accT[0][0]); accT[0][1] = MFMA32(wc[s][1], a0, accT[0][1]);
            accT[1][0] = MFMA32(wc[s][0], a1, accT[1][0]); accT[1][1] = MFMA32(wc[s][1], a1, accT[1][1]);
            wc[s][0] = *(const bf16x8*)(wk + s * 1024 + woff); wc[s][1] = *(const bf16x8*)(wk + 65536 + s * 1024 + woff);
            __builtin_amdgcn_sched_barrier(0);
            a0 = n0; a1 = n1;
        }
    }
#undef P4_STAGE_WRITE
    p4_panel_load(ar, Anext, tid);
    __builtin_amdgcn_sched_barrier(0);
    __syncthreads();
}


__device__ __forceinline__ void tail_gemmT(f32x16 (&accT)[2], const bf16* Abase  , const bf16* WF  , int nt  , LAS unsigned char* lds, int tid, int lane) {
    const int srow = tid >> 3, soct = tid & 7, r = lane & 31, h = lane >> 5;
    const char* ab = (const char*)Abase; const unsigned aoff = (unsigned)((srow * 1024 + 8 * soct) * 2);
    const char* wb = (const char*)WF + (size_t)nt * 65536; const unsigned woff = (unsigned)(lane * 16);
    const int rot = ((int)blockIdx.x >> 3) & 15;
    u32x4 ar[16];
#pragma unroll
    for (int i = 0; i < 16; ++i) ar[i] = *(const u32x4*)(ab + ((rot + i) & 15) * 128 + aoff);
    bf16x8 wc[4];
    { const char* wk0 = wb + rot * 4096;
#pragma unroll
      for (int s = 0; s < 4; ++s) wc[s] = *(const bf16x8*)(wk0 + s * 1024 + woff); }
#pragma unroll
    for (int ki = 0; ki < 16; ++ki) {
        const int kc = (ki + rot) & 15;
        LAS unsigned char* stg = lds + L4_ASTG + (ki & 1) * 9216;
        *(LAS u32x4*)(stg + (srow * TP + 8 * soct) * 2) = ar[ki];
        __syncthreads();
        const char* wk = wb + ((kc + 1) & 15) * 4096;
#pragma unroll
        for (int s = 0; s < 4; ++s) {
            const bf16x8 a0 = *(const LAS bf16x8*)(stg + (r * TP + 16 * s + 8 * h) * 2), a1 = *(const LAS bf16x8*)(stg + ((32 + r) * TP + 16 * s + 8 * h) * 2);
            accT[0] = MFMA32(wc[s], a0, accT[0]); accT[1] = MFMA32(wc[s], a1, accT[1]);
            wc[s] = *(const bf16x8*)(wk + s * 1024 + woff);
            __builtin_amdgcn_sched_barrier(0);
        }
    }
    __syncthreads();
}

__device__ __forceinline__ void p4_phase(const Args& a, LAS unsigned char* lds, int tid_in, int lane_in, int wave, int G) {
    const bf16* PROJ = (const bf16*)(a.ws + WS_PROJ);
    const float* SSQM = (const float*)(a.ws + WS_SSQM); const float* SSQR = (const float*)(a.ws + WS_SSQR);
    const float* MOD = (const float*)(a.ws + WS_MOD);
    const bf16* WMF = (const bf16*)(a.ws + WS_WMF); const bf16* WRF = (const bf16*)(a.ws + WS_WRF); const bf16* WOF = (const bf16*)(a.ws + WS_WOF);
    const float* x = a.in[0]; const float* fw = a.in[15]; float* out = a.out;
    LAS float* RM = (LAS float*)(lds + L4_RM); LAS float* RR = (LAS float*)(lds + L4_RR); LAS float* RED = (LAS float*)(lds + L4_RED); LAS float* RS = (LAS float*)(lds + L4_RS);
    for (int blk = blockIdx.x; blk < 256; blk += G) {
        const size_t m0 = (size_t)blk * 64; const int b = blk >> 5;
        int lane = fresh_lane(), tid = wave * 64 + lane, r = lane & 31, h = lane >> 5;
        u32x4 ar[16];
        p4_panel_load(ar, PROJ + m0 * NP + C_Z, tid);
        __syncthreads();
        { const int row = tid >> 3, sub = tid & 7;
          const f32x4 qv = *(const f32x4*)(SSQR + (m0 + row) * 32 + 4 * sub);
          RR[row * 8 + sub] = 1.0f / sqrtf(((qv.x + qv.y) + (qv.z + qv.w)) * (1.f / 128.f) + EPS);
          if (sub < 2) { float s = 0.f;
#pragma unroll
              for (int i = 0; i < 4; ++i) { const f32x4 v = *(const f32x4*)(SSQM + (m0 + row) * 32 + 16 * sub + 4 * i); s += (v.x + v.y) + (v.z + v.w); }
              RM[row * 2 + sub] = 1.0f / sqrtf(s * (1.f / 512.f) + EPS); } }
        __syncthreads();
#ifndef P4_SKIP1
#ifndef P4_REP1
#define P4_REP1 1
#endif
        for (int nh_ = 0; nh_ < 2 * P4_REP1; ++nh_) {
            const int nh = nh_ & 1;
            lane = fresh_lane(); tid = wave * 64 + lane; r = lane & 31; h = lane >> 5;
            const int nt0 = 16 * nh + 2 * wave;
            const bf16* pblk = PROJ + m0 * NP;
            f32x16 accT[2][2];
#pragma unroll
            for (int i = 0; i < 2; ++i)
#pragma unroll
                for (int j = 0; j < 2; ++j)
#pragma unroll
                    for (int e = 0; e < 16; ++e) accT[i][j][e] = 0.f;
            u32x2 gpre[2][2][4];
            { const unsigned lo0 = (unsigned)((r * NP + 4 * h) * 2); const char* gb0 = (const char*)(pblk + C_GAM + 32 * nt0);
#pragma unroll
              for (int rt = 0; rt < 2; ++rt)
#pragma unroll
                  for (int ct = 0; ct < 2; ++ct)
#pragma unroll
                      for (int g4 = 0; g4 < 4; ++g4) gpre[rt][ct][g4] = *(const u32x2*)(gb0 + (lo0 + (unsigned)((32 * rt * NP + 32 * ct + 8 * g4) * 2)));
              __builtin_amdgcn_sched_barrier(0); }
            p4_gemmT<9>(accT, ar, pblk + C_GR, RM, 2, WMF, nt0, lds, tid, lane);
            {
                lane = fresh_lane(); r = lane & 31; h = lane >> 5;
                const unsigned lm = launder((unsigned)(L4_MERGED + (r * MP + 4 * h) * 2));
#pragma unroll
                for (int rt = 0; rt < 2; ++rt)
#pragma unroll
                    for (int ct = 0; ct < 2; ++ct)
#pragma unroll
                        for (int g4 = 0; g4 < 4; ++g4) {
                            const u32x2 gg = gpre[rt][ct][g4];
                            u32x2 ov; ov.x = pk2(accT[rt][ct][4 * g4] * sigm_f(bf_lo(gg.x)), accT[rt][ct][4 * g4 + 1] * sigm_f(bf_hi(gg.x)));
                            ov.y = pk2(accT[rt][ct][4 * g4 + 2] * sigm_f(bf_lo(gg.y)), accT[rt][ct][4 * g4 + 3] * sigm_f(bf_hi(gg.y)));
                            *(LAS u32x2*)(lds + lm + (unsigned)((32 * rt * MP + 32 * (nt0 + ct) + 8 * g4) * 2)) = ov; }
            }
#pragma unroll
            for (int i = 0; i < 2; ++i)
#pragma unroll
                for (int j = 0; j < 2; ++j)
#pragma unroll
                    for (int e = 0; e < 16; ++e) accT[i][j][e] = 0.f;
            lane = fresh_lane(); tid = wave * 64 + lane; r = lane & 31; h = lane >> 5;
            { const unsigned lo0 = (unsigned)((r * NP + 4 * h) * 2); const char* gb0 = (const char*)(pblk + C_GAR + 32 * nt0);
#pragma unroll
              for (int rt = 0; rt < 2; ++rt)
#pragma unroll
                  for (int ct = 0; ct < 2; ++ct)
#pragma unroll
                      for (int g4 = 0; g4 < 4; ++g4) gpre[rt][ct][g4] = *(const u32x2*)(gb0 + (lo0 + (unsigned)((32 * rt * NP + 32 * ct + 8 * g4) * 2)));
              __builtin_amdgcn_sched_barrier(0); }
            p4_gemmT<7>(accT, ar, pblk + C_Z, RR, 8, WRF, nt0, lds, tid, lane);
            {
                lane = fresh_lane(); r = lane & 31; h = lane >> 5;
                const unsigned lm = launder((unsigned)(L4_MERGED + (r * MP + 4 * h) * 2));
#pragma unroll
                for (int rt = 0; rt < 2; ++rt)
#pragma unroll
                    for (int ct = 0; ct < 2; ++ct)
#pragma unroll
                        for (int g4 = 0; g4 < 4; ++g4) {
                            const u32x2 gg = gpre[rt][ct][g4];
                            LAS u32x2* mp = (LAS u32x2*)(lds + lm + (unsigned)((32 * rt * MP + 32 * (nt0 + ct) + 8 * g4) * 2));
                            const u32x2 pm = *mp;
                            const float v0 = bf_lo(pm.x) + accT[rt][ct][4 * g4] * sigm_f(bf_lo(gg.x)), v1 = bf_hi(pm.x) + accT[rt][ct][4 * g4 + 1] * sigm_f(bf_hi(gg.x));
                            const float v2 = bf_lo(pm.y) + accT[rt][ct][4 * g4 + 2] * sigm_f(bf_lo(gg.y)), v3 = bf_hi(pm.y) + accT[rt][ct][4 * g4 + 3] * sigm_f(bf_hi(gg.y));
                            u32x2 ov; ov.x = pk2(v0, v1); ov.y = pk2(v2, v3);
                            *mp = ov; }
            }
        }
#endif
        __syncthreads();
        lane = fresh_lane(); tid = wave * 64 + lane; r = lane & 31; h = lane >> 5;
#ifndef P4_SKIP2
#ifndef P4_REP2
#define P4_REP2 1
#endif
        _Pragma("nounroll") for (int rep2_ = 0; rep2_ < P4_REP2; ++rep2_) {
            if (rep2_) { __syncthreads(); lane = fresh_lane(); tid = wave * 64 + lane; r = lane & 31; h = lane >> 5; }
            f32x16 acc[2][4];
#pragma unroll
            for (int i = 0; i < 2; ++i)
#pragma unroll
                for (int j = 0; j < 4; ++j)
#pragma unroll
                    for (int e = 0; e < 16; ++e) acc[i][j][e] = 0.f;
            const char* wb = (const char*)WOF + (size_t)(4 * wave) * 65536; const unsigned woff = (unsigned)(lane * 16);
            const int rot2 = ((int)blockIdx.x >> 3) & 31;
            bf16x8 wc[2][4];
#pragma unroll
            for (int s = 0; s < 2; ++s)
#pragma unroll
                for (int ct = 0; ct < 4; ++ct) wc[s][ct] = *(const bf16x8*)(wb + ct * 65536 + (2 * rot2 + s) * 1024 + woff);
            const LAS unsigned char* ma = lds + L4_MERGED + (r * MP + 8 * h) * 2;
            bf16x8 a0 = *(const LAS bf16x8*)(ma + (2 * rot2) * 32), a1 = *(const LAS bf16x8*)(ma + 32 * MP * 2 + (2 * rot2) * 32);
            for (int ki = 0; ki < 32; ++ki) {
                const int kp = (ki + rot2) & 31, kpn = (kp + 1) & 31;
#pragma unroll
                for (int s = 0; s < 2; ++s) {
                    const int ksn = (s == 0) ? 2 * kp + 1 : 2 * kpn;
                    const bf16x8 n0 = *(const LAS bf16x8*)(ma + ksn * 32), n1 = *(const LAS bf16x8*)(ma + 32 * MP * 2 + ksn * 32);
#pragma unroll
                    for (int ct = 0; ct < 4; ++ct) { acc[0][ct] = MFMA32(a0, wc[s][ct], acc[0][ct]); acc[1][ct] = MFMA32(a1, wc[s][ct], acc[1][ct]); }
#pragma unroll
                    for (int ct = 0; ct < 4; ++ct) wc[s][ct] = *(const bf16x8*)(wb + ct * 65536 + (2 * kpn + s) * 1024 + woff);
                    __builtin_amdgcn_sched_barrier(0);
                    a0 = n0; a1 = n1;
                }
            }
            lane = fresh_lane(); r = lane & 31; h = lane >> 5;
            const char* xblk = (const char*)(x + m0 * D); char* oblk = (char*)(out + m0 * D);
            const unsigned eo = launder((unsigned)(4 * (4 * h * D + 128 * wave + r)));
            const unsigned rb = launder((unsigned)(L4_RED + (4 * h * 8 + wave) * 4));
            float gate[4], fwv[4];
#pragma unroll
            for (int ct = 0; ct < 4; ++ct) { const int n = 32 * (4 * wave + ct) + r; gate[ct] = MOD[b * 3072 + 2048 + n]; fwv[ct] = fw[n]; }
            float xv[2][8][4];
#define P4_XLOAD(buf, bidx) do { _Pragma("unroll") for (int e = 0; e < 8; ++e) _Pragma("unroll") for (int ct = 0; ct < 4; ++ct) \
                xv[buf][e][ct] = *(const float*)(xblk + (eo + (unsigned)(((32 * ((bidx) >> 1) + (e & 3) + 8 * (2 * ((bidx) & 1) + (e >> 2))) * D + 32 * ct) * 4))); } while (0)
            P4_XLOAD(0, 0);
#pragma unroll
            for (int bi = 0; bi < 4; ++bi) {
                const int rt = bi >> 1, g8 = bi & 1;
                if (bi + 1 < 4) P4_XLOAD((bi + 1) & 1, bi + 1);
                __builtin_amdgcn_sched_barrier(0);
#pragma unroll
                for (int e = 0; e < 8; ++e) {
                    const int reg = 8 * g8 + e, rowc = 32 * rt + (reg & 3) + 8 * (reg >> 2);
                    float s = 0.f;
#pragma unroll
                    for (int ct = 0; ct < 4; ++ct) { const float v = xv[bi & 1][e][ct] + gate[ct] * acc[rt][ct][reg]; acc[rt][ct][reg] = v; s += v * v; }
                    s += __shfl_xor(s, 16); s += __shfl_xor(s, 8); s += __shfl_xor(s, 4); s += __shfl_xor(s, 2); s += __shfl_xor(s, 1);
                    *(LAS float*)(lds + rb + (unsigned)(rowc * 32)) = s;
                }
                asm volatile("" ::: "memory"); __builtin_amdgcn_sched_barrier(0);
            }
#undef P4_XLOAD
            __syncthreads();
            if (tid < 64) { float s = 0.f;
#pragma unroll
                for (int w = 0; w < 8; ++w) s += RED[tid * 8 + w];
                RS[tid] = 1.0f / sqrtf(s * (1.f / D) + EPS); }
            __syncthreads();
            const unsigned eo2 = launder(eo);
            const unsigned sb = launder((unsigned)(L4_RS + 4 * h * 4));
#pragma unroll
            for (int rt = 0; rt < 2; ++rt)
#pragma unroll
                for (int reg = 0; reg < 16; ++reg) {
                    const int rowc = 32 * rt + (reg & 3) + 8 * (reg >> 2); const float rs = *(const LAS float*)(lds + sb + (unsigned)(rowc * 4));
#pragma unroll
                    for (int ct = 0; ct < 4; ++ct) *(float*)(oblk + (eo2 + (unsigned)((rowc * D + 32 * ct) * 4))) = acc[rt][ct][reg] * rs * fwv[ct];
                }
        }
#endif
    }
}

#define XB_TMO      128
#define XB_XCNT(j)  (256  + 64 * (j))
#define XB_XSUB(j)  (1280 + 64 * (j))
#define XB_XGEN(j)  (2304 + 64 * (j))
#define XB_TOP      3328
#define XB_TOPGEN   3392
#define XCD_BAR_WORDS 3456
#define XB_SPIN_CAP (1u << 18)

__device__ __forceinline__ unsigned xb_ld(unsigned* p)              { return __hip_atomic_load(p, __ATOMIC_RELAXED, __HIP_MEMORY_SCOPE_AGENT); }
__device__ __forceinline__ unsigned xb_add(unsigned* p, unsigned v) { return __hip_atomic_fetch_add(p, v, __ATOMIC_RELAXED, __HIP_MEMORY_SCOPE_AGENT); }
__device__ __forceinline__ unsigned xb_xcc_id() { return (unsigned)__builtin_amdgcn_s_getreg((3 << 11) | 20) & 0xFu; }
#define XB_SPIN(cond, bar) do { unsigned _sp = 0; while (cond) { __builtin_amdgcn_s_sleep(1); \
    if ((++_sp & 255u) == 0u) { if (xb_ld(&(bar)[XB_TMO])) break; if (_sp > XB_SPIN_CAP) { atomicAdd(&(bar)[XB_TMO], 1u); break; } } } } while (0)

struct XcdBarrier {
    unsigned* bar; unsigned x;
    volatile LAS unsigned* st;
};

__device__ __forceinline__ XcdBarrier xcd_barrier_post(unsigned* bar, volatile LAS unsigned* st, const int wave_) {
    XcdBarrier b; b.bar = bar; b.x = xb_xcc_id(); b.st = st;
    if (wave_ == 0 && fresh_lane() == 0) (void)xb_add(&bar[XB_XCNT(b.x)], 1u);
    return b;
}
__device__ __forceinline__ void xcd_barrier_complete(unsigned* bar, unsigned x, unsigned& nloc, unsigned& nx) {
    const unsigned G = gridDim.x * gridDim.y * gridDim.z;
    unsigned sum, cnt, mine, sp = 0u;
    for (;;) {
        sum = 0u; cnt = 0u; mine = 0u;
#pragma unroll
        for (unsigned j = 0; j < 16; ++j) { const unsigned c = xb_ld(&bar[XB_XCNT(j)]); sum += c; cnt += (c > 0u) ? 1u : 0u; mine = (j == x) ? c : mine; }
        if (sum == G) break;
        __builtin_amdgcn_s_sleep(1);
        if ((++sp & 255u) == 0u) { if (xb_ld(&bar[XB_TMO])) break; if (sp > XB_SPIN_CAP) { atomicAdd(&bar[XB_TMO], 1u); break; } }
    }
    nloc = mine > 0u ? mine : 1u; nx = cnt > 0u ? cnt : 1u;
}

__device__ __forceinline__ void xcd_barrier(const XcdBarrier& b, const int wave_) {
    asm volatile("s_waitcnt vmcnt(0)" ::: "memory");
    __syncthreads();
    if (wave_ == 0 && fresh_lane() == 0) {
        unsigned* bar = b.bar;
        __builtin_amdgcn_s_waitcnt(0);
        unsigned nloc = b.st[0], nx = b.st[1];
        if (nloc == 0u) { xcd_barrier_complete(bar, b.x, nloc, nx); b.st[0] = nloc; b.st[1] = nx; }
        const unsigned old = xb_add(&bar[XB_XSUB(b.x)], 1u);
        const unsigned gen = old / nloc;
        if (old + 1u == (gen + 1u) * nloc) {
            __builtin_amdgcn_fence(__ATOMIC_RELEASE, "agent");
            asm volatile("s_waitcnt vmcnt(0)" ::: "memory");
            const unsigned og = xb_add(&bar[XB_TOP], 1u);
            const unsigned tg = og / nx;
            if (og + 1u == (tg + 1u) * nx) xb_add(&bar[XB_TOPGEN], 1u);
            else XB_SPIN(xb_ld(&bar[XB_TOPGEN]) == tg, bar);
            __builtin_amdgcn_fence(__ATOMIC_ACQUIRE, "agent");
            xb_add(&bar[XB_XGEN(b.x)], 1u);
            asm volatile("s_waitcnt vmcnt(0)" ::: "memory");
        } else {
            XB_SPIN(xb_ld(&bar[XB_XGEN(b.x)]) == gen, bar);
            __builtin_amdgcn_fence(__ATOMIC_ACQUIRE, "agent");
            asm volatile("s_waitcnt vmcnt(0)" ::: "memory");
        }
    }
    __syncthreads();
}

#ifdef SELF_CLEAN_BARRIER
__device__ unsigned g_bar[4096];
#endif
__global__ void __launch_bounds__(NTHR, 2) hybrid_fwd(Args args) {
    extern __shared__ __attribute__((aligned(16))) unsigned char lds_raw[];
    LAS unsigned char* lds = (LAS unsigned char*)lds_raw;
    const int wave = __builtin_amdgcn_readfirstlane((int)threadIdx.x >> 6), G = gridDim.x; const int tid = 0, lane = 0;
    cg::grid_group grid = cg::this_grid();
    volatile LAS unsigned* misc = (volatile LAS unsigned*)(lds + LDS_MISC);
    if (threadIdx.x < 2) misc[threadIdx.x] = 0u;
    __syncthreads();
    if (args.ph_lo < 0) grid.sync();
    #ifdef SELF_CLEAN_BARRIER
    XcdBarrier xbar = xcd_barrier_post(g_bar, misc, wave);
#else
    XcdBarrier xbar = xcd_barrier_post((unsigned*)(args.ws + WS_CTL), misc, wave);
#endif
    const int lo = args.ph_lo, hi = args.ph_hi;
#ifndef PHMASK
#define PHMASK 31
#endif
#define IN(k) (((PHMASK >> (k)) & 1) && lo <= (k) && (k) < hi)
#define SEAM(k) do { if (IN(k) && IN((k) + 1)) xcd_barrier(xbar, wave); } while (0)
#ifndef REPEAT_MASK
#define REPEAT_MASK 0
#endif
#ifdef PROBE_PH
    unsigned long long pt0_ = 0ull; unsigned pacc_ = 0u;
#define PB(k) do { if (PROBE_PH == (k)) pt0_ = __builtin_amdgcn_s_memrealtime(); } while (0)
#define PE(k) do { if (PROBE_PH == (k)) pacc_ += (unsigned)(__builtin_amdgcn_s_memrealtime() - pt0_); } while (0)
#else
#define PB(k) do {} while (0)
#define PE(k) do {} while (0)
#endif
    PB(20);
#define REP(k) _Pragma("nounroll") for (int rep_ = 0; rep_ < 1 + ((REPEAT_MASK >> (k)) & 1); ++rep_)
#ifdef EXTRA_SYNCS
    for (int es_ = 0; es_ < EXTRA_SYNCS; ++es_) xcd_barrier(xbar, wave);
#endif
    PB(0);
    if (IN(0)) REP(0) { if (rep_) xcd_barrier(xbar, wave); p0_phase(args, lds, tid, lane, wave, G); }
    PE(0); PB(10); SEAM(0); PE(10); PB(1);
    if (IN(1)) REP(1) { if (rep_) xcd_barrier(xbar, wave); p1_phase(args, lds, tid, lane, wave, G); }
    PE(1); PB(11); SEAM(1); PE(11); PB(2);
    if (IN(2)) REP(2) {
        if (rep_) xcd_barrier(xbar, wave);
        __syncthreads();
        pg8::Gemm g{(const pg8::bf16_t*)((const unsigned char*)args.out + OUT_H), (const pg8::bf16_t*)((const unsigned char*)args.out + OUT_WINT), MTOK, NP_MAIN, D};
        pg8::StaticOrder S; S.init(MTOK, NP_MAIN, G, (int)blockIdx.x);
        pg8::EpiProj E{(pg8::bf16_t*)(args.ws + WS_PROJ), NP};
        pg8::gemm_phase<pg8::EpiProj, pg8::StaticOrder, true, true>(lds, g, S, E, wave);
        for (int blk = blockIdx.x; blk < 256; blk += G) {
            const int lane_ = fresh_lane(), tid_ = wave * 64 + lane_;
            f32x16 accT[2];
#pragma unroll
            for (int i = 0; i < 2; ++i)
#pragma unroll
                for (int e = 0; e < 16; ++e) accT[i][e] = 0.f;
            tail_gemmT(accT, (const bf16*)((const unsigned char*)args.out + OUT_H) + (size_t)blk * 64 * 1024, (const bf16*)(args.ws + WS_WTF), wave, lds, tid_, lane_);
            const int l2 = fresh_lane(), r2 = l2 & 31, h2 = l2 >> 5;
            bf16* prow = (bf16*)(args.ws + WS_PROJ) + ((size_t)blk * 64 + r2) * NP + NP_MAIN + 32 * wave + 4 * h2;
#pragma unroll
            for (int rt = 0; rt < 2; ++rt)
#pragma unroll
                for (int g4 = 0; g4 < 4; ++g4) { u32x2 ov; ov.x = pk2(accT[rt][4 * g4], accT[rt][4 * g4 + 1]); ov.y = pk2(accT[rt][4 * g4 + 2], accT[rt][4 * g4 + 3]);
                    *(u32x2*)(prow + (size_t)rt * 32 * NP + 8 * g4) = ov; }
        }
    }
    PE(2); PB(12); SEAM(2); PE(12); PB(3);
    if (IN(3)) { p3a_phase(args, wave, G); PE(3); PB(13); xcd_barrier(xbar, wave); PE(13); PB(4); if ((REPEAT_MASK >> 3) & 1) { p3_phase(args, lds, tid, lane, wave, G, true); xcd_barrier(xbar, wave); } p3_phase(args, lds, tid, lane, wave, G); }
    PE(4); PB(14); SEAM(3); PE(14); PB(5);
    if (IN(4)) REP(4) { if (rep_) xcd_barrier(xbar, wave); p4_phase(args, lds, tid, lane, wave, G); }
#undef REP
    PE(5); PE(20);
#if defined(SELF_CLEAN_BARRIER) && !defined(PROBE_PH)
    {
        __syncthreads();
        if (wave == 0) {
            const int l_ = fresh_lane();
            unsigned last_ = 0u;
            if (l_ == 0) last_ = (__hip_atomic_fetch_add(&g_bar[4032], 1u, __ATOMIC_RELAXED, __HIP_MEMORY_SCOPE_AGENT) == (unsigned)G - 1u) ? 1u : 0u;
            last_ = (unsigned)__builtin_amdgcn_readfirstlane((int)last_);
            if (last_) {
                if (l_ < 16) { __hip_atomic_store(&g_bar[XB_XCNT(l_)], 0u, __ATOMIC_RELAXED, __HIP_MEMORY_SCOPE_AGENT); __hip_atomic_store(&g_bar[XB_XSUB(l_)], 0u, __ATOMIC_RELAXED, __HIP_MEMORY_SCOPE_AGENT); __hip_atomic_store(&g_bar[XB_XGEN(l_)], 0u, __ATOMIC_RELAXED, __HIP_MEMORY_SCOPE_AGENT); }
                if (l_ == 16) { __hip_atomic_store(&g_bar[XB_TOP], 0u, __ATOMIC_RELAXED, __HIP_MEMORY_SCOPE_AGENT); __hip_atomic_store(&g_bar[XB_TOPGEN], 0u, __ATOMIC_RELAXED, __HIP_MEMORY_SCOPE_AGENT);
                                __hip_atomic_store(&g_bar[XB_TMO], 0u, __ATOMIC_RELAXED, __HIP_MEMORY_SCOPE_AGENT); __hip_atomic_store(&g_bar[4032], 0u, __ATOMIC_RELAXED, __HIP_MEMORY_SCOPE_AGENT); }
            }
        }
    }
#endif
#ifdef PROBE_PH
    if (blockIdx.x == PROBE_PBLK && wave == 0 && fresh_lane() == 0) ((unsigned*)(args.ws + WS_CTL))[4001] = pacc_;
    if (blockIdx.x == 0) { xcd_barrier(xbar, wave); } else { xcd_barrier(xbar, wave); }
    if (blockIdx.x == 0 && wave == 0 && fresh_lane() == 0) { asm volatile("s_waitcnt vmcnt(0)" ::: "memory"); args.out[0] = 30.0f * floorf(0.01f * (float)__hip_atomic_load((unsigned*)(args.ws + WS_CTL) + 4001, __ATOMIC_RELAXED, __HIP_MEMORY_SCOPE_AGENT) / 30.0f + 0.5f); }
#endif
#ifdef PROBE_SEL
    if (blockIdx.x == 0 && wave == 0 && fresh_lane() == 0) { asm volatile("s_waitcnt vmcnt(0)" ::: "memory"); args.out[0] = 0.01f * (float)((volatile unsigned*)(args.ws + WS_CTL))[4000]; }
#endif
#undef IN
#undef SEAM
}

extern "C" void kernel_launch(void* const* d_in, const int* in_sizes, int n_in, void* d_out, int out_size, void* d_ws, size_t ws_size, hipStream_t stream) {
    static int grid = 0;
    if (grid == 0) {
        if (n_in != 16 || out_size != MTOK * D || ws_size < WS_END) { fprintf(stderr, "kernel_launch: unexpected shapes (n_in %d out %d ws %zu)\n", n_in, out_size, ws_size); grid = -1; return; }
        int dev = 0, cus = 0, per_cu = 0;
        (void)hipGetDevice(&dev);
        (void)hipDeviceGetAttribute(&cus, hipDeviceAttributeMultiprocessorCount, dev);
        if (hipFuncSetAttribute((const void*)hybrid_fwd, hipFuncAttributeMaxDynamicSharedMemorySize, LDS_BYTES) != hipSuccess) { fprintf(stderr, "kernel_launch: hipFuncSetAttribute failed\n"); grid = -1; return; }
        if (hipOccupancyMaxActiveBlocksPerMultiprocessor(&per_cu, (const void*)hybrid_fwd, NTHR, LDS_BYTES) != hipSuccess || per_cu < 1) { fprintf(stderr, "kernel_launch: occupancy query says %d\n", per_cu); per_cu = 1; }
        (void)hipGetLastError();
        grid = cus * per_cu;
        if (grid > 256) grid = 256;
        if (grid < 1) grid = 1;
    }
    if (grid < 0) return;
#ifndef SELF_CLEAN_BARRIER
    if (hipMemsetAsync((char*)d_ws + WS_CTL, 0, CTL_BYTES, stream) != hipSuccess) { fprintf(stderr, "kernel_launch: memset of the barrier words failed\n"); return; }
#endif
    Args a{};
    for (int i = 0; i < 16; ++i) a.in[i] = (const float*)d_in[i];
    a.out = (float*)d_out; a.ws = (unsigned char*)d_ws;
#if N_LAUNCHES == 1
    a.ph_lo = 0; a.ph_hi = NPH;
    void* kargs[] = {&a};
    hipError_t e = hipLaunchCooperativeKernel((const void*)hybrid_fwd, dim3(grid), dim3(NTHR), kargs, LDS_BYTES, stream);
    if (e != hipSuccess) fprintf(stderr, "kernel_launch: cooperative launch failed: %s (grid %d)\n", hipGetErrorString(e), grid);
#else
    for (int p = 0; p < NPH; ++p) {
        a.ph_lo = p; a.ph_hi = p + 1;
        hipLaunchKernelGGL(hybrid_fwd, dim3(grid), dim3(NTHR), LDS_BYTES, stream, a);
    }
#endif
}
```

```cpp
#include <hip/hip_runtime.h>
#include <hip/hip_cooperative_groups.h>
#include <cstdio>
#include <cstdint>
namespace cg = cooperative_groups;
#define N_LAUNCHES 1
#define REPEAT_MASK 0
#define P4_REP2 1
__device__ __forceinline__ unsigned launder(unsigned v) { asm volatile("" : "+v"(v)); return v; }
__device__ __forceinline__ int fresh_lane() { unsigned z; asm volatile("v_mov_b32 %0, 0" : "=v"(z)); return (int)__builtin_amdgcn_mbcnt_hi(~0u, __builtin_amdgcn_mbcnt_lo(~0u, z)); }
namespace pg8 {
#define PG8_LAS __attribute__((address_space(3)))
typedef unsigned short bf16_t;
typedef short bf16x8 __attribute__((ext_vector_type(8)));
typedef float f32x4 __attribute__((ext_vector_type(4)));
typedef unsigned u32x4 __attribute__((ext_vector_type(4)));
constexpr int BM = 256, BK = 64, HALF = 128, HTB = HALF * BK * 2  , STAGE_BYTES = 8 * HTB, NXCD = 8, WGM = 8;

__host__ __device__ __forceinline__ int lds_byte(int r, int c) { const int st = (r >> 4) * 2 + (c >> 5), rr = r & 15, cc = c & 31, ob = rr * 64 + cc * 2; return st * 1024 + (ob ^ (((ob >> 9) & 1) << 5)); }
__host__ __device__ __forceinline__ void stage_rc(int b, int& R, int& C) { const int st = b / 1024, sb = b % 1024, swz = sb ^ (((sb >> 9) & 1) << 5); R = (st >> 1) * 16 + swz / 64; C = (st & 1) * 32 + (swz % 64) / 2; }
__host__ __device__ __forceinline__ int perm32(int rho) { const int n = rho >> 4, i = rho & 15; return 8 * (i >> 2) + 4 * n + (i & 3); }

struct Unit { int pm, pn; };
struct Gemm { const bf16_t* A; const bf16_t* Bt; int M, N, K; };

struct StaticOrder {
    int nM, nN, nwg, G, c;
    __host__ __device__ void init(int M, int N, int G_, int c_) { nM = M / BM; nN = N / BM; nwg = nM * nN; G = G_; c = c_; }
    __host__ __device__ bool next(int i, Unit& u) const {
        const long L = (long)i * G + c; if (L >= nwg) return false;
        int wgid = (int)L; { const int q = nwg / NXCD, r = nwg % NXCD, xcd = wgid % NXCD, off = wgid / NXCD; wgid = (xcd < r ? xcd * (q + 1) : r * (q + 1) + (xcd - r) * q) + off; }
        const int nig = WGM * nN, gid = wgid / nig, fm = gid * WGM, gsz = (nM - fm) < WGM ? (nM - fm) : WGM;
        u.pm = fm + ((wgid % nig) % gsz); u.pn = (wgid % nig) / gsz; return true;
    }
    __device__ __forceinline__ void a_ready(const Unit&) const {}
    __device__ __forceinline__ void done(const Unit&) const {}
};
__device__ __forceinline__ unsigned cvt_pk_bf16(float lo, float hi) { unsigned r; asm volatile("v_cvt_pk_bf16_f32 %0, %1, %2" : "=v"(r) : "v"(lo), "v"(hi)); return r; }
struct EpiProj {
    static constexpr bool PERM = true, AFTER_DRAIN = false;
    bf16_t* O; int ldc;
    __device__ __forceinline__ void operator()(const f32x4 (&acc)[2][2][4][2], const Unit& u, int wr, int wc, int fr, int fq) const {
        const int row0 = u.pm * BM + wr * 64 + fr; const int col0 = u.pn * BM + wc * 32 + 8 * fq;
#pragma unroll
        for (int ai = 0; ai < 2; ++ai)
#pragma unroll
            for (int m = 0; m < 4; ++m) { bf16_t* rowp = O + (size_t)(row0 + ai * HALF + m * 16) * ldc + col0;
#pragma unroll
                for (int bj = 0; bj < 2; ++bj) { const f32x4 v0 = acc[ai][bj][m][0], v1 = acc[ai][bj][m][1];
                    u32x4 w; w.x = cvt_pk_bf16(v0[0], v0[1]); w.y = cvt_pk_bf16(v0[2], v0[3]); w.z = cvt_pk_bf16(v1[0], v1[1]); w.w = cvt_pk_bf16(v1[2], v1[3]);
                    *(u32x4*)(rowp + bj * HALF) = w; } }
    }
    __device__ __forceinline__ void fused(f32x4 (&)[2][2][4][2], const Unit&, int, int, int, int, PG8_LAS unsigned char*, int, int) const {}
};
template <class Epi, class Sched, bool ALIGN_EPI = false, bool SP2 = false>
__device__ __forceinline__ void gemm_phase(PG8_LAS unsigned char* lds, const Gemm g, const Sched& S, const Epi& E, const int wid) {
    const int lane = ::fresh_lane(), tid = wid * 64 + lane, wr = wid >> 2, wc = wid & 3, fr = lane & 15, fq = lane >> 4;
    const int K = g.K, nt = K / BK;
    unsigned voffA[2], voffB[2];
#pragma unroll
    for (int i = 0; i < 2; ++i) { int R, C; stage_rc(tid * 16 + i * 8192, R, C); const int Rb = Epi::PERM ? ((R & ~31) + perm32(R & 31)) : R;
        voffA[i] = (unsigned)(R * K + C) * 2u; voffB[i] = (unsigned)(Rb * K + C) * 2u; }
    const size_t kstep = (size_t)(BK * 2);
    const size_t hstep = (size_t)HALF * K * 2;
    const size_t tstep = 2 * hstep;
    const unsigned ldsw = (unsigned)wid * 1024u;
    const int aoff = lds_byte(wr * 64 + fr, fq * 8), boff = lds_byte(wc * 32 + fr, fq * 8);
#define PG8_SA(b, h) (((b) * 2 + (h)) * HTB)
#define PG8_SB(b, h) ((4 + (b) * 2 + (h)) * HTB)
#define PG8_STAGE(bufoff, gbase, voff) do { _Pragma("unroll") for (int _i = 0; _i < 2; ++_i) \
        __builtin_amdgcn_global_load_lds((const unsigned*)((const char*)(gbase) + (voff)[_i]), (PG8_LAS unsigned*)(lds + (bufoff) + ldsw + _i * 8192), 16, 0, 0); } while (0)
#define PG8_LDA(dst, b, h) do { _Pragma("unroll") for (int m = 0; m < 4; ++m) _Pragma("unroll") for (int k = 0; k < 2; ++k) dst[m][k] = *(const PG8_LAS bf16x8*)(lds + PG8_SA(b, h) + aoff + m * 2048 + k * 1024); } while (0)
#define PG8_LDB(dst, b, h) do { _Pragma("unroll") for (int n = 0; n < 2; ++n) _Pragma("unroll") for (int k = 0; k < 2; ++k) dst[n][k] = *(const PG8_LAS bf16x8*)(lds + PG8_SB(b, h) + boff + n * 2048 + k * 1024); } while (0)
#define PG8_MMA(ai, bj, At, Bt) do { __builtin_amdgcn_s_setprio(1); _Pragma("unroll") for (int m = 0; m < 4; ++m) _Pragma("unroll") for (int n = 0; n < 2; ++n) _Pragma("unroll") for (int k = 0; k < 2; ++k) \
        acc[ai][bj][m][n] = __builtin_amdgcn_mfma_f32_16x16x32_bf16(Bt[n][k], At[m][k], acc[ai][bj][m][n], 0, 0, 0); __builtin_amdgcn_s_setprio(0); } while (0)
#define PG8_WAIT_V(n) asm volatile("s_waitcnt vmcnt(" #n ")" ::: "memory")
#define PG8_WAIT_L(n) asm volatile("s_waitcnt lgkmcnt(" #n ")" ::: "memory")
#define PG8_BAR __builtin_amdgcn_s_barrier()
#define PG8_SCHED __builtin_amdgcn_sched_barrier(0)
    Unit cur, nxt; int ui = 0;
    if (!S.next(0, cur)) return;
    f32x4 acc[2][2][4][2];
#pragma unroll
    for (int a = 0; a < 2; ++a)
#pragma unroll
        for (int b = 0; b < 2; ++b)
#pragma unroll
            for (int m = 0; m < 4; ++m)
#pragma unroll
                for (int n = 0; n < 2; ++n) acc[a][b][m][n] = (f32x4){0.f, 0.f, 0.f, 0.f};
    bf16x8 At[4][2], B0[2][2], B1[2][2];
    const char* cA = (const char*)g.A + (size_t)cur.pm * tstep; const char* cB = (const char*)g.Bt + (size_t)cur.pn * tstep;
    S.a_ready(cur);
    if constexpr (SP2) {
        PG8_STAGE(PG8_SB(0, 0), cB, voffB); PG8_STAGE(PG8_SB(0, 1), cB + hstep, voffB); PG8_STAGE(PG8_SA(0, 0), cA, voffA); PG8_STAGE(PG8_SA(0, 1), cA + hstep, voffA);
        if (wr == 1) PG8_BAR;
        PG8_WAIT_V(2); PG8_BAR;
        PG8_STAGE(PG8_SB(1, 0), cB + kstep, voffB); PG8_STAGE(PG8_SA(1, 0), cA + kstep, voffA); PG8_STAGE(PG8_SB(1, 1), cB + hstep + kstep, voffB);
        PG8_WAIT_V(6); PG8_BAR;
    } else {
        PG8_STAGE(PG8_SB(0, 0), cB, voffB); PG8_STAGE(PG8_SA(0, 0), cA, voffA); PG8_STAGE(PG8_SB(0, 1), cB + hstep, voffB); PG8_STAGE(PG8_SA(0, 1), cA + hstep, voffA);
        if (wr == 1) PG8_BAR;
        PG8_WAIT_V(4); PG8_BAR;
        PG8_STAGE(PG8_SB(1, 0), cB + kstep, voffB); PG8_STAGE(PG8_SA(1, 0), cA + kstep, voffA); PG8_STAGE(PG8_SB(1, 1), cB + hstep + kstep, voffB);
        PG8_WAIT_V(6); PG8_BAR;
    }
    for (;;) {
        const bool has_next = S.next(ui + 1, nxt);
        const char* nA = has_next ? (const char*)g.A + (size_t)nxt.pm * tstep : cA; const char* nB = has_next ? (const char*)g.Bt + (size_t)nxt.pn * tstep : cB;
        for (int t = 0; t < nt; t += 2) {
            const bool last = (t == nt - 2);
            const char* a1 = cA + (size_t)(t + 1) * kstep;
            const char* a2 = last ? nA : cA + (size_t)(t + 2) * kstep; const char* b2 = last ? nB : cB + (size_t)(t + 2) * kstep;
            const char* a3 = a2 + kstep; const char* b3 = b2 + kstep;
            if (last && has_next) S.a_ready(nxt);
            if constexpr (SP2) {
            PG8_LDB(B0, 0, 0); PG8_LDB(B1, 0, 1); PG8_SCHED; PG8_LDA(At, 0, 0); PG8_STAGE(PG8_SA(1, 1), a1 + hstep, voffA);
            PG8_WAIT_V(8); PG8_WAIT_L(0); PG8_BAR; PG8_MMA(0, 0, At, B0); PG8_MMA(0, 1, At, B1); PG8_BAR; PG8_SCHED;
            PG8_LDA(At, 0, 1); PG8_STAGE(PG8_SB(0, 0), b2, voffB); PG8_STAGE(PG8_SB(0, 1), b2 + hstep, voffB); PG8_STAGE(PG8_SA(0, 0), a2, voffA);
            PG8_WAIT_V(8); PG8_WAIT_L(0); PG8_BAR; PG8_MMA(1, 0, At, B0); PG8_MMA(1, 1, At, B1); PG8_BAR; PG8_SCHED;
            PG8_LDB(B0, 1, 0); PG8_LDB(B1, 1, 1); PG8_SCHED; PG8_LDA(At, 1, 0); PG8_STAGE(PG8_SA(0, 1), a2 + hstep, voffA);
            PG8_WAIT_V(8); PG8_WAIT_L(0); PG8_BAR; PG8_MMA(0, 0, At, B0); PG8_MMA(0, 1, At, B1); PG8_BAR; PG8_SCHED;
            PG8_LDA(At, 1, 1); PG8_STAGE(PG8_SB(1, 0), b3, voffB); PG8_STAGE(PG8_SB(1, 1), b3 + hstep, voffB); PG8_STAGE(PG8_SA(1, 0), a3, voffA);
            PG8_WAIT_V(8); PG8_WAIT_L(0); PG8_BAR; PG8_MMA(1, 0, At, B0); PG8_MMA(1, 1, At, B1); PG8_BAR; PG8_SCHED;
            } else {
            PG8_LDB(B0, 0, 0); PG8_SCHED; PG8_LDA(At, 0, 0); PG8_STAGE(PG8_SA(1, 1), a1 + hstep, voffA);
            PG8_WAIT_L(8); PG8_BAR; PG8_WAIT_L(0); PG8_MMA(0, 0, At, B0); PG8_BAR; PG8_SCHED;
            PG8_LDB(B1, 0, 1); PG8_STAGE(PG8_SB(0, 0), b2, voffB);
            PG8_BAR; PG8_WAIT_L(0); PG8_MMA(0, 1, At, B1); PG8_BAR;
            PG8_LDA(At, 0, 1); PG8_STAGE(PG8_SA(0, 0), a2, voffA);
            PG8_BAR; PG8_WAIT_L(0); PG8_MMA(1, 0, At, B0); PG8_BAR; PG8_SCHED;
            PG8_STAGE(PG8_SB(0, 1), b2 + hstep, voffB);
            PG8_WAIT_V(6); PG8_BAR; PG8_MMA(1, 1, At, B1); PG8_BAR;
            PG8_LDB(B0, 1, 0); PG8_SCHED; PG8_LDA(At, 1, 0); PG8_STAGE(PG8_SA(0, 1), a2 + hstep, voffA);
            PG8_WAIT_L(8); PG8_BAR; PG8_WAIT_L(0); PG8_MMA(0, 0, At, B0); PG8_BAR; PG8_SCHED;
            PG8_LDB(B1, 1, 1); PG8_STAGE(PG8_SB(1, 0), b3, voffB);
            PG8_BAR; PG8_WAIT_L(0); PG8_MMA(0, 1, At, B1); PG8_BAR;
            PG8_LDA(At, 1, 1); PG8_STAGE(PG8_SA(1, 0), a3, voffA);
            PG8_BAR; PG8_WAIT_L(0); PG8_MMA(1, 0, At, B0); PG8_BAR; PG8_SCHED;
            PG8_STAGE(PG8_SB(1, 1), b3 + hstep, voffB);
            PG8_WAIT_V(6); PG8_BAR; PG8_MMA(1, 1, At, B1); PG8_BAR;
            }
        }
        if constexpr (ALIGN_EPI) { if (wr == 0) PG8_BAR; }
        if constexpr (!Epi::AFTER_DRAIN) { E(acc, cur, wr, wc, fr, fq); S.done(cur); }
        if (!has_next) break;
#pragma unroll
        for (int a = 0; a < 2; ++a)
#pragma unroll
            for (int b = 0; b < 2; ++b)
#pragma unroll
                for (int m = 0; m < 4; ++m)
#pragma unroll
                    for (int n = 0; n < 2; ++n) acc[a][b][m][n] = (f32x4){0.f, 0.f, 0.f, 0.f};
        cur = nxt; cA = nA; cB = nB; ++ui;
        if constexpr (ALIGN_EPI) { if (wr == 1) PG8_BAR; }
    }
    PG8_WAIT_V(0);
    if constexpr (!ALIGN_EPI) { if (wr == 0) PG8_BAR; }
    PG8_BAR;
    if constexpr (Epi::AFTER_DRAIN) { E.fused(acc, cur, wr, wc, fr, fq, lds, wid, lane); S.done(cur); }
#undef PG8_SA
#undef PG8_SB
#undef PG8_STAGE
#undef PG8_LDA
#undef PG8_LDB
#undef PG8_MMA
#undef PG8_WAIT_V
#undef PG8_WAIT_L
#undef PG8_BAR
#undef PG8_SCHED
}
}

#define LAS __attribute__((address_space(3)))
typedef unsigned short bf16;
typedef short bf16x8 __attribute__((ext_vector_type(8)));
typedef short s16x4 __attribute__((ext_vector_type(4)));
typedef float f32x4 __attribute__((ext_vector_type(4)));
typedef float f32x16 __attribute__((ext_vector_type(16)));
typedef unsigned u32x4 __attribute__((ext_vector_type(4)));
typedef unsigned u32x2 __attribute__((ext_vector_type(2)));
typedef float f32x2_t __attribute__((ext_vector_type(2)));
typedef __bf16 bf16x2_t __attribute__((ext_vector_type(2)));

#ifndef N_LAUNCHES
#define N_LAUNCHES 1
#endif
constexpr int NPH = 5;
constexpr int D = 1024, NB = 8, SEQ = 2048, MTOK = NB * SEQ, NIN = 7440, NP = 7424, NP_MAIN = 7168;
constexpr int C_Z = 0, C_X = 1024, C_B = 2048, C_C = 2176, C_Q = 2304, C_K = 2816, C_V = 3328, C_GR = 4352, C_GAM = 5376, C_GAR = 6400;
constexpr float EPS = 1e-6f;
constexpr size_t MiB = 1u << 20;
constexpr size_t WS_PROJ = 0;
constexpr size_t WS_WMF = 232 * MiB, WS_WRF = 234 * MiB, WS_WOF = 236 * MiB;
constexpr size_t WS_MOD = 238 * MiB;
constexpr size_t WS_DT = 239 * MiB;
constexpr size_t WS_SSQM = 240 * MiB;
constexpr size_t WS_SSQR = 242 * MiB;
constexpr size_t WS_CTL = 244 * MiB, CTL_BYTES = 16384;
constexpr size_t WS_WTF = 245 * MiB;
constexpr size_t WS_END = 246 * MiB;
constexpr size_t OUT_H = 0, OUT_WINT = 32 * MiB;
constexpr int LDS_BYTES = 155648, LDS_MISC = 155520;
constexpr int NTHR = 512;

struct Args { const float* in[16]; float* out; unsigned char* ws; int ph_lo, ph_hi; };

__device__ __forceinline__ float bf_lo(unsigned u) { return __uint_as_float(u << 16); }
__device__ __forceinline__ float bf_hi(unsigned u) { return __uint_as_float(u & 0xffff0000u); }
__device__ __forceinline__ unsigned pk2(float lo, float hi) { f32x2_t v = {lo, hi}; bf16x2_t b = __builtin_convertvector(v, bf16x2_t); return __builtin_bit_cast(unsigned, b); }
__device__ __forceinline__ float silu_f(float x) { return x * __builtin_amdgcn_rcpf(1.f + __expf(-x)); }
__device__ __forceinline__ float sigm_f(float x) { return __builtin_amdgcn_rcpf(1.f + __expf(-x)); }
__device__ __forceinline__ float wave_sum(float v) {
#pragma unroll
    for (int o = 1; o < 64; o <<= 1) v += __shfl_xor(v, o);
    return v;
}
__device__ __forceinline__ int crow(int reg, int h) { return (reg & 3) + 8 * (reg >> 2) + 4 * h; }
#define MFMA32(a, b, c) __builtin_amdgcn_mfma_f32_32x32x16_bf16((a), (b), (c), 0, 0, 0)
#define MFMA16(a, b, c) __builtin_amdgcn_mfma_f32_16x16x32_bf16((a), (b), (c), 0, 0, 0)
__device__ __forceinline__ s16x4 tr_read(const LAS unsigned char* p) {
    typedef short v4i16_t __attribute__((ext_vector_type(4)));
    return __builtin_bit_cast(s16x4, __builtin_amdgcn_ds_read_tr16_b64_v4i16((LAS v4i16_t*)p));
}
__device__ __forceinline__ bf16x8 tr_pair(const LAS unsigned char* plo, const LAS unsigned char* phi) {
    const s16x4 lo = tr_read(plo), hi = tr_read(phi);
    return __builtin_shufflevector(lo, hi, 0, 1, 2, 3, 4, 5, 6, 7);
}
__device__ __forceinline__ bf16x8 pack8(float a0, float a1, float a2, float a3, float a4, float a5, float a6, float a7) {
    u32x4 p; p.x = pk2(a0, a1); p.y = pk2(a2, a3); p.z = pk2(a4, a5); p.w = pk2(a6, a7);
    return __builtin_bit_cast(bf16x8, p);
}

__device__ __forceinline__ void p0_load_tile(const float* W, int ldw, int k0, int n0, LAS float* scr, int lane) {
    float t[32];
#pragma unroll
    for (int i = 0; i < 32; ++i) t[i] = W[(size_t)(k0 + 2 * i + (lane >> 5)) * ldw + n0 + (lane & 31)];
#pragma unroll
    for (int i = 0; i < 32; ++i) scr[(2 * i + (lane >> 5)) * 33 + (lane & 31)] = t[i];
}
__device__ __forceinline__ void p0_phase(const Args& a, LAS unsigned char* lds, int tid_unused, int lane_unused, int wave, int G) {
    const int lane = fresh_lane(), tid = wave * 64 + lane;
    const float* cvec = a.in[1]; const float* w_ada = a.in[2]; const float* b_ada = a.in[3];
    float* MOD = (float*)(a.ws + WS_MOD);
    LAS float* cT = (LAS float*)lds;
    LAS float* red = (LAS float*)(lds + 32768);
    if ((int)blockIdx.x < 192) {
        { float t[16];
#pragma unroll
          for (int i = 0; i < 16; ++i) t[i] = cvec[tid + 512 * i];
#pragma unroll
          for (int i = 0; i < 16; ++i) { const int idx = tid + 512 * i; cT[(idx & 1023) * 8 + (idx >> 10)] = t[i]; } }
        __syncthreads();
        for (int item = blockIdx.x; item < 192; item += G) {
            const int j0 = item * 16, col = lane & 15, rsub = lane >> 4, kq = wave;
            float w[32];
#pragma unroll
            for (int i = 0; i < 32; ++i) w[i] = w_ada[(size_t)(kq * 128 + 4 * i + rsub) * 3072 + j0 + col];
            float acc[8];
#pragma unroll
            for (int bb = 0; bb < 8; ++bb) acc[bb] = 0.f;
#pragma unroll
            for (int i = 0; i < 32; ++i) { const int k = kq * 128 + 4 * i + rsub;
                const f32x4 c0 = *(const LAS f32x4*)(cT + k * 8), c1 = *(const LAS f32x4*)(cT + k * 8 + 4);
                acc[0] += c0.x * w[i]; acc[1] += c0.y * w[i]; acc[2] += c0.z * w[i]; acc[3] += c0.w * w[i];
                acc[4] += c1.x * w[i]; acc[5] += c1.y * w[i]; acc[6] += c1.z * w[i]; acc[7] += c1.w * w[i]; }
#pragma unroll
            for (int bb = 0; bb < 8; ++bb) { acc[bb] += __shfl_xor(acc[bb], 16); acc[bb] += __shfl_xor(acc[bb], 32); }
            if (lane < 16) {
#pragma unroll
                for (int bb = 0; bb < 8; ++bb) red[(kq * 8 + bb) * 16 + col] = acc[bb]; }
            __syncthreads();
            if (tid < 128) { const int bb = tid >> 4, cc = tid & 15; float sum = 0.f;
#pragma unroll
                for (int q = 0; q < 8; ++q) sum += red[(q * 8 + bb) * 16 + cc];
                MOD[bb * 3072 + j0 + cc] = sum + b_ada[j0 + cc]; }
            __syncthreads();
        }
    }
    LAS float* scr = (LAS float*)(lds + 40960 + wave * 8448);
    const int gw = blockIdx.x * 8 + wave, NGW = G * 8;
    constexpr int I_IN = 16 * (NP / 32), I_W = 16 * 32;
    bf16* WINT = (bf16*)((unsigned char*)a.out + OUT_WINT);
    for (int it = gw; it < I_IN + 3 * I_W + 128; it += NGW) {
        if (it >= I_IN + 3 * I_W) {
            const int r_ = it - (I_IN + 3 * I_W), nt = r_ & 7, kb = r_ >> 3;
            p0_load_tile(a.in[5], NIN, 64 * kb, NP_MAIN + 16 + 32 * nt, scr, lane);
            bf16* WF = (bf16*)(a.ws + WS_WTF);
            const int r = lane & 31, h = lane >> 5;
#pragma unroll
            for (int s4 = 0; s4 < 4; ++s4) { const LAS float* s = scr + (16 * s4 + 8 * h) * 33 + r;
                u32x4 o; o.x = pk2(s[0 * 33], s[1 * 33]); o.y = pk2(s[2 * 33], s[3 * 33]); o.z = pk2(s[4 * 33], s[5 * 33]); o.w = pk2(s[6 * 33], s[7 * 33]);
                *(u32x4*)(WF + ((size_t)(nt * 64 + 4 * kb + s4) * 64 + lane) * 8) = o; }
        } else if (it < I_IN) {
            const int nblk = NP / 32, kb = it / nblk, nb = it % nblk, k0 = 64 * kb, n0p = 32 * nb, n0 = n0p + (n0p >= 2304 ? 16 : 0);
            p0_load_tile(a.in[5], NIN, k0, n0, scr, lane);
            const int c = lane & 7;
#pragma unroll
            for (int j = 0; j < 4; ++j) { const int n = (lane >> 3) + 8 * j; const LAS float* s = scr + (8 * c) * 33 + n;
                u32x4 o; o.x = pk2(s[0 * 33], s[1 * 33]); o.y = pk2(s[2 * 33], s[3 * 33]); o.z = pk2(s[4 * 33], s[5 * 33]); o.w = pk2(s[6 * 33], s[7 * 33]);
                *(u32x4*)(WINT + (size_t)(n0p + n) * 1024 + k0 + 8 * c) = o; }
        } else {
            int r_ = it - I_IN; const int which = r_ / I_W; r_ -= which * I_W;
            const float* W = a.in[12 + which];
            bf16* WF = (bf16*)(a.ws + WS_WMF + (size_t)which * 2 * MiB);
            const int nt = r_ & 31, kb = r_ >> 5;
            p0_load_tile(W, 1024, 64 * kb, 32 * nt, scr, lane);
            const int r = lane & 31, h = lane >> 5;
#pragma unroll
            for (int s4 = 0; s4 < 4; ++s4) { const LAS float* s = scr + (16 * s4 + 8 * h) * 33 + r;
                f32x4 m0 = (f32x4){1.f, 1.f, 1.f, 1.f}, m1 = m0;
                if (which == 0) { m0 = *(const f32x4*)(a.in[11] + 64 * kb + 16 * s4 + 8 * h); m1 = *(const f32x4*)(a.in[11] + 64 * kb + 16 * s4 + 8 * h + 4); }
                u32x4 o; o.x = pk2(s[0 * 33] * m0.x, s[1 * 33] * m0.y); o.y = pk2(s[2 * 33] * m0.z, s[3 * 33] * m0.w); o.z = pk2(s[4 * 33] * m1.x, s[5 * 33] * m1.y); o.w = pk2(s[6 * 33] * m1.z, s[7 * 33] * m1.w);
                *(u32x4*)(WF + ((size_t)(nt * 64 + 4 * kb + s4) * 64 + lane) * 8) = o; }
        }
    }
}

__device__ __forceinline__ void p1_phase(const Args& a, LAS unsigned char* lds, int tid_unused, int lane_unused, int wave, int G) {
    const int lane_in = fresh_lane(), tid = wave * 64 + lane_in;
    const float* x = a.in[0]; const float* norm_w = a.in[4]; const float* w_in = a.in[5]; const float* dt_bias = a.in[8];
    const float* MOD = (const float*)(a.ws + WS_MOD);
    float* DT = (float*)(a.ws + WS_DT);
    bf16* H = (bf16*)((unsigned char*)a.out + OUT_H);
    LAS float* wdt = (LAS float*)lds;
    { float t[32];
#pragma unroll
      for (int i = 0; i < 32; ++i) { const int idx = tid + NTHR * i; t[i] = w_in[(size_t)(idx >> 4) * NIN + 2304 + (idx & 15)]; }
#pragma unroll
      for (int i = 0; i < 32; ++i) { const int idx = tid + NTHR * i; wdt[(idx & 15) * 1028 + (idx >> 4)] = t[i]; } }
    __syncthreads();
    for (int blk = blockIdx.x; blk < 256; blk += G) {
        const int b = blk >> 5;
        float gk[16], sh[16];
#pragma unroll
        for (int jj = 0; jj < 4; ++jj) { const int k = 4 * lane_in + 256 * jj;
            const f32x4 nw = *(const f32x4*)(norm_w + k), sc = *(const f32x4*)(MOD + b * 3072 + 1024 + k), sf = *(const f32x4*)(MOD + b * 3072 + k);
#pragma unroll
            for (int e = 0; e < 4; ++e) { gk[4 * jj + e] = nw[e] * (1.f + sc[e]); sh[4 * jj + e] = sf[e]; } }
        f32x4 vn[2][4];
        { const int lane = fresh_lane();
#pragma unroll
          for (int rr = 0; rr < 2; ++rr)
#pragma unroll
              for (int jj = 0; jj < 4; ++jj) vn[rr][jj] = *((const f32x4*)(x + (size_t)(blk * 64 + wave * 8 + rr) * D) + lane + 64 * jj); }
        for (int g = 0; g < 4; ++g) {
            asm volatile("" ::: "memory");
            const int lane = fresh_lane();
            const int m0 = blk * 64 + wave * 8 + g * 2;
            f32x4 v[2][4];
#pragma unroll
            for (int rr = 0; rr < 2; ++rr)
#pragma unroll
                for (int jj = 0; jj < 4; ++jj) v[rr][jj] = vn[rr][jj];
            if (g + 1 < 4) {
#pragma unroll
                for (int rr = 0; rr < 2; ++rr)
#pragma unroll
                    for (int jj = 0; jj < 4; ++jj) vn[rr][jj] = *((const f32x4*)(x + (size_t)(m0 + 2 + rr) * D) + lane + 64 * jj);
            }
            __builtin_amdgcn_sched_barrier(0);
            float hv[2][16];
#pragma unroll
            for (int rr = 0; rr < 2; ++rr) {
                float ss = 0.f;
#pragma unroll
                for (int jj = 0; jj < 4; ++jj) ss += (v[rr][jj].x * v[rr][jj].x + v[rr][jj].y * v[rr][jj].y) + (v[rr][jj].z * v[rr][jj].z + v[rr][jj].w * v[rr][jj].w);
                const float rs = 1.0f / sqrtf(wave_sum(ss) * (1.f / D) + EPS);
                unsigned long long* o8 = (unsigned long long*)(H + (size_t)(m0 + rr) * D) + lane;
#pragma unroll
                for (int jj = 0; jj < 4; ++jj) {
#pragma unroll
                    for (int e = 0; e < 4; ++e) hv[rr][4 * jj + e] = v[rr][jj][e] * rs * gk[4 * jj + e] + sh[4 * jj + e];
                    o8[64 * jj] = (unsigned long long)pk2(hv[rr][4 * jj], hv[rr][4 * jj + 1]) | ((unsigned long long)pk2(hv[rr][4 * jj + 2], hv[rr][4 * jj + 3]) << 32);
                }
            }
            float acc[32];
#pragma unroll
            for (int i = 0; i < 32; ++i) acc[i] = 0.f;
#pragma unroll
            for (int j = 0; j < 16; ++j) {
#pragma unroll
                for (int jj = 0; jj < 4; ++jj) { const f32x4 w = *(const LAS f32x4*)(wdt + j * 1028 + 4 * lane + 256 * jj);
#pragma unroll
                    for (int rr = 0; rr < 2; ++rr) acc[rr * 16 + j] += (hv[rr][4 * jj] * w.x + hv[rr][4 * jj + 1] * w.y) + (hv[rr][4 * jj + 2] * w.z + hv[rr][4 * jj + 3] * w.w); }
                if ((j & 3) == 3) asm volatile("" ::: "memory");
            }
#pragma unroll
            for (int half = 16; half >= 1; half >>= 1) {
                const bool up = (lane & half) != 0;
#pragma unroll
                for (int i = 0; i < half; ++i) { float lo_ = acc[i], hi_ = acc[i + half]; asm volatile("" : "+v"(lo_), "+v"(hi_));
                    const float keep = up ? hi_ : lo_, send = up ? lo_ : hi_; acc[i] = keep + __shfl_xor(send, half); }
            }
            const float tot = acc[0] + __shfl_xor(acc[0], 32);
            const float xr_ = tot + dt_bias[lane & 15];
            const float dtv = xr_ > 20.f ? xr_ : log1pf(__expf(xr_));
            if (lane < 32) DT[(size_t)m0 * 16 + lane] = dtv;
        }
    }
}

constexpr size_t OUT_XBCC = 0;
__device__ __forceinline__ void p3a_phase(const Args& a, int wave, int G) {
    const bf16* PROJ = (const bf16*)(a.ws + WS_PROJ);
    bf16* XBCC = (bf16*)((unsigned char*)a.out + OUT_XBCC);
    const float* conv_w = a.in[6]; const float* conv_b = a.in[7];
    const int lane = fresh_lane(), tid = wave * 64 + lane;
    if (tid >= 480) return;
    const int oct = tid % 160, tgl = tid / 160;
    float cw[4][8], cb[8];
#pragma unroll
    for (int e = 0; e < 8; ++e) { cb[e] = conv_b[8 * oct + e];
#pragma unroll
        for (int k = 0; k < 4; ++k) cw[k][e] = conv_w[k * 1280 + 8 * oct + e]; }
    for (int blk = blockIdx.x; blk < 256; blk += G) {
        for (int tg = tgl; tg < 8; tg += 3) {
            const int m0 = blk * 64 + 8 * tg, ts0 = m0 & (SEQ - 1);
            const char* src = (const char*)(PROJ + (size_t)m0 * NP + C_X + 8 * oct);
            u32x4 raw[11];
#pragma unroll
            for (int i = 0; i < 11; ++i) { const bool ok = (ts0 - 3 + i) >= 0; raw[i] = ok ? *(const u32x4*)(src + ((long)i - 3) * (NP * 2)) : (u32x4){0u, 0u, 0u, 0u}; }
#pragma unroll
            for (int jj = 0; jj < 8; ++jj) {
                float o[8];
#pragma unroll
                for (int e = 0; e < 8; ++e) {
                    float s_ = cb[e];
#pragma unroll
                    for (int k = 0; k < 4; ++k) { const unsigned w = raw[jj + k][e >> 1]; s_ += cw[k][e] * ((e & 1) ? bf_hi(w) : bf_lo(w)); }
                    o[e] = silu_f(s_);
                }
                u32x4 ov; ov.x = pk2(o[0], o[1]); ov.y = pk2(o[2], o[3]); ov.z = pk2(o[4], o[5]); ov.w = pk2(o[6], o[7]);
                *(u32x4*)(XBCC + (size_t)(m0 + jj) * 1280 + 8 * oct) = ov;
            }
        }
    }
}

constexpr int TP = 72;
constexpr int L_CQ = 0, L_BK = 18432, L_BKW = 36864, L_XV = 55296, L_ST0 = 73728, L_ST1 = 82944, L_ACS = 92160, L_DTJ = 93184, L_WJ = 94208, L_CW = 95232;

__device__ __forceinline__ void p3_phase(const Args& a, LAS unsigned char* lds, int tid_in, int lane_in, int wave, int G, const bool dry = false) {
    bf16* PROJ = (bf16*)(a.ws + WS_PROJ);
    const float* DT = (const float*)(a.ws + WS_DT);
    float* SSQM = (float*)(a.ws + WS_SSQM); float* SSQR = (float*)(a.ws + WS_SSQR);
    const float* conv_w = a.in[6]; const float* conv_b = a.in[7]; const float* a_log = a.in[9]; const float* d_skip = a.in[10]; const float* m_norm_w = a.in[11];
    const int pt = wave & 1, it = wave >> 1;
#ifdef PROBE_SEL
    unsigned long long t0_ = 0ull; unsigned tacc_ = 0u;
    const bool probing = ((int)blockIdx.x == PROBE_BLK && wave == PROBE_WAVE);
#define TB(k) do { if (PROBE_SEL == (k) && probing) t0_ = __builtin_amdgcn_s_memrealtime(); } while (0)
#define TE(k) do { if (PROBE_SEL == (k) && probing) tacc_ += (unsigned)(__builtin_amdgcn_s_memrealtime() - t0_); } while (0)
#else
#define TB(k) do {} while (0)
#define TE(k) do {} while (0)
#endif
    for (int item = blockIdx.x; item < 256; item += G) {
        const int lane = fresh_lane(), tid = wave * 64 + lane;
        const int r = lane & 31, h = lane >> 5, i16 = lane & 15, q4 = i16 >> 2, p4 = i16 & 3, blk16 = (lane >> 4) & 1;
        const bool ssd = item < 128;
        int b, hd, half;
        if (ssd) { b = item >> 4; hd = item & 15; half = 0; } else { const int t = item - 128; b = t >> 4; hd = (t >> 1) & 7; half = t & 1; }
        const size_t mb = (size_t)b * SEQ;
        __syncthreads();
        for (int idx = tid; idx < 9216 / 4; idx += NTHR) ((LAS unsigned*)(lds + L_ST0))[idx] = 0u;
        const float lg = ssd ? 0.f : log1pf(-exp2f(-5.0f - (float)hd));
        if (!ssd && tid < 256) { const int par = tid >> 7, j = tid & 127;
            ((LAS float*)(lds + L_ACS))[par * 128 + j] = (float)(j + 1) * lg * 1.4426950408889634f; ((LAS float*)(lds + L_DTJ))[par * 128 + j] = (float)(j + 1) * lg * 1.4426950408889634f; ((LAS float*)(lds + L_WJ))[par * 128 + j] = __expf((float)(127 - j) * lg); }
        const float Ah = ssd ? -__expf(a_log[hd]) : 0.f;
        const float Dsk = ssd ? d_skip[hd] : 0.f;
        const int ltile = 3 - (tid >> 7), loct = tid & 7, ltg = (tid >> 3) & 15;
        int lcol = 0;
        float invf[8];
        if (ssd) {
            lcol = (ltile == 0) ? (64 * hd + 8 * loct) : (ltile == 1 ? (1024 + 64 * (hd >> 3) + 8 * loct) : (1152 + 64 * (hd >> 3) + 8 * loct));
            if (ltile == 3) lcol = 1024 + 64 * (hd >> 3) + 8 * loct;
#pragma unroll
            for (int e = 0; e < 8; ++e) invf[e] = 0.f;
        } else {
#pragma unroll
            for (int e = 0; e < 8; ++e) invf[e] = exp2f(-(float)(8 * (tid & 3) + e) * (13.287712379549449f / 32.f));
        }
        f32x16 sacc;
#pragma unroll
        for (int i = 0; i < 16; ++i) sacc[i] = 0.f;
        u32x4 raw[8];
        const int rj = tid >> 2, ro4 = tid & 3;
        const int j0 = 8 * ltg;
        const char* pbase = (const char*)(PROJ + mb * NP);
        const char* xbase = (const char*)((const bf16*)((const unsigned char*)a.out + OUT_XBCC) + mb * 1280);
        const unsigned soff = (unsigned)((j0 * 1280 + lcol) * 2);
        const unsigned roff = (unsigned)((rj * NP) * 2);
#define P3_ISSUE(cc) do { const char* cbp = pbase + (size_t)(cc) * (128 * NP * 2); \
        if (ssd) { const char* xp = xbase + (size_t)(cc) * (128 * 1280 * 2) + soff; _Pragma("unroll") for (int i = 0; i < 8; ++i) raw[i] = *(const u32x4*)(xp + i * (1280 * 2)); } \
        else { const char* rp = cbp + roff; \
            raw[0] = *(const u32x4*)(rp + (C_Q + 64 * hd + 8 * ro4) * 2); raw[1] = *(const u32x4*)(rp + (C_Q + 64 * hd + 32 + 8 * ro4) * 2); \
            raw[2] = *(const u32x4*)(rp + (C_K + 64 * hd + 8 * ro4) * 2); raw[3] = *(const u32x4*)(rp + (C_K + 64 * hd + 32 + 8 * ro4) * 2); \
            raw[4] = *(const u32x4*)(rp + (C_V + 128 * hd + 64 * half + 16 * ro4) * 2); raw[5] = *(const u32x4*)(rp + (C_V + 128 * hd + 64 * half + 16 * ro4 + 8) * 2); } } while (0)
        float dq0 = 0.f, dq1 = 0.f;
#define P3_SCAN(cc) do { LAS float* ACSw = (LAS float*)(lds + L_ACS) + ((cc) & 1) * 128; LAS float* DTJw = (LAS float*)(lds + L_DTJ) + ((cc) & 1) * 128; LAS float* WJw = (LAS float*)(lds + L_WJ) + ((cc) & 1) * 128; \
        const float v0 = dq0 * Ah, v1 = dq1 * Ah, s_ = v0 + v1; float incl = s_; \
        _Pragma("unroll") for (int o = 1; o < 64; o <<= 1) { const float t = __shfl_up(incl, o); if (lane >= o) incl += t; } \
        const float c0 = (incl - s_) + v0, tot = __shfl(incl, 63), c1 = (lane == 63) ? tot : c0 + v1; \
        ACSw[2 * lane] = c0 * 1.4426950408889634f; ACSw[2 * lane + 1] = c1 * 1.4426950408889634f; \
        DTJw[2 * lane] = c0 * 1.4426950408889634f - __log2f(dq0); DTJw[2 * lane + 1] = c1 * 1.4426950408889634f - __log2f(dq1); \
        WJw[2 * lane] = dq0 * __expf(tot - c0); WJw[2 * lane + 1] = dq1 * __expf(tot - c1); } while (0)
#define P3_DTLOAD(cc) do { dq0 = DT[(mb + (size_t)(cc) * 128 + 2 * lane) * 16 + hd]; dq1 = DT[(mb + (size_t)(cc) * 128 + 2 * lane + 1) * 16 + hd]; } while (0)
        if (ssd && wave == 0) { P3_DTLOAD(0); P3_SCAN(0); P3_DTLOAD(1); }
        u32x2 zzn[4];
        { const bf16* orow0 = PROJ + (mb + 16 * wave + i16) * NP + (ssd ? (C_Z + 64 * hd) : (C_GR + 128 * hd + 64 * half));
#pragma unroll
          for (int g4 = 0; g4 < 4; ++g4) zzn[g4] = *(const u32x2*)(orow0 + 16 * g4 + 4 * (lane >> 4)); }
        P3_ISSUE(0);

        TB(1);
        for (int c = 0; c < 16; ++c) {
            const int par = c & 1;
            const size_t m0 = mb + (size_t)c * 128;
            LAS float* ACS = (LAS float*)(lds + L_ACS) + par * 128; LAS float* DTJ = (LAS float*)(lds + L_DTJ) + par * 128; LAS float* WJ = (LAS float*)(lds + L_WJ) + par * 128;
            TB(5);
            __syncthreads();
            TE(5); TB(2);
#ifndef P3_REPL
#define P3_REPL 1
#endif
            _Pragma("nounroll") for (int repl_ = 0; repl_ < P3_REPL; ++repl_) {
            if (repl_) __syncthreads();
            if (ssd) {
                {
                    LAS unsigned char* dst = lds + (ltile == 0 ? L_XV : (ltile == 1 ? L_BK : (ltile == 2 ? L_CQ : L_BKW)));
#pragma unroll
                    for (int jj = 0; jj < 8; ++jj) {
                        u32x4 v = raw[jj];
                        if (ltile == 3) { const float wj = WJ[j0 + jj];
                            v.x = pk2(bf_lo(v.x) * wj, bf_hi(v.x) * wj); v.y = pk2(bf_lo(v.y) * wj, bf_hi(v.y) * wj); v.z = pk2(bf_lo(v.z) * wj, bf_hi(v.z) * wj); v.w = pk2(bf_lo(v.w) * wj, bf_hi(v.w) * wj); }
                        *(LAS u32x4*)(dst + ((j0 + jj) * TP + 8 * loct) * 2) = v;
                    }
                }
            } else {
                const int j = rj, o4 = ro4;
                const u32x4 q1 = raw[0], q2 = raw[1], k1 = raw[2], k2 = raw[3];
                const float pos = (float)(c * 128 + j), wj = WJ[j];
                float ql[8], qh[8], kl[8], kh[8];
#pragma unroll
                for (int e = 0; e < 8; ++e) {
                    const float rev = pos * invf[e] * 0.15915494309189535f, fr = rev - floorf(rev);
                    const float cs = __builtin_amdgcn_cosf(fr), sn = __builtin_amdgcn_sinf(fr);
                    const unsigned wq1 = q1[e >> 1], wq2 = q2[e >> 1], wk1 = k1[e >> 1], wk2 = k2[e >> 1];
                    const float a1 = (e & 1) ? bf_hi(wq1) : bf_lo(wq1), a2 = (e & 1) ? bf_hi(wq2) : bf_lo(wq2);
                    const float b1 = ((e & 1) ? bf_hi(wk1) : bf_lo(wk1)) * 0.125f, b2 = ((e & 1) ? bf_hi(wk2) : bf_lo(wk2)) * 0.125f;
                    ql[e] = a1 * cs - a2 * sn; qh[e] = a1 * sn + a2 * cs;
                    kl[e] = b1 * cs - b2 * sn; kh[e] = b1 * sn + b2 * cs;
                }
                u32x4 t;
                t.x = pk2(ql[0], ql[1]); t.y = pk2(ql[2], ql[3]); t.z = pk2(ql[4], ql[5]); t.w = pk2(ql[6], ql[7]); *(LAS u32x4*)(lds + L_CQ + (j * TP + 8 * o4) * 2) = t;
                t.x = pk2(qh[0], qh[1]); t.y = pk2(qh[2], qh[3]); t.z = pk2(qh[4], qh[5]); t.w = pk2(qh[6], qh[7]); *(LAS u32x4*)(lds + L_CQ + (j * TP + 32 + 8 * o4) * 2) = t;
                t.x = pk2(kl[0], kl[1]); t.y = pk2(kl[2], kl[3]); t.z = pk2(kl[4], kl[5]); t.w = pk2(kl[6], kl[7]); *(LAS u32x4*)(lds + L_BK + (j * TP + 8 * o4) * 2) = t;
                t.x = pk2(kh[0], kh[1]); t.y = pk2(kh[2], kh[3]); t.z = pk2(kh[4], kh[5]); t.w = pk2(kh[6], kh[7]); *(LAS u32x4*)(lds + L_BK + (j * TP + 32 + 8 * o4) * 2) = t;
                t.x = pk2(kl[0] * wj, kl[1] * wj); t.y = pk2(kl[2] * wj, kl[3] * wj); t.z = pk2(kl[4] * wj, kl[5] * wj); t.w = pk2(kl[6] * wj, kl[7] * wj); *(LAS u32x4*)(lds + L_BKW + (j * TP + 8 * o4) * 2) = t;
                t.x = pk2(kh[0] * wj, kh[1] * wj); t.y = pk2(kh[2] * wj, kh[3] * wj); t.z = pk2(kh[4] * wj, kh[5] * wj); t.w = pk2(kh[6] * wj, kh[7] * wj); *(LAS u32x4*)(lds + L_BKW + (j * TP + 32 + 8 * o4) * 2) = t;
                *(LAS u32x4*)(lds + L_XV + (j * TP + 16 * o4) * 2) = raw[4]; *(LAS u32x4*)(lds + L_XV + (j * TP + 16 * o4 + 8) * 2) = raw[5];
            }
            }
            TE(2); TB(6);
            __syncthreads();
            TE(6); TB(3);
            const int q16 = lane >> 4, iTok = 16 * wave + i16;
            bf16* orow = PROJ + (m0 + iTok) * NP + (ssd ? (C_Z + 64 * hd) : (C_GR + 128 * hd + 64 * half));
            u32x2 zz[4];
#pragma unroll
            for (int g4 = 0; g4 < 4; ++g4) zz[g4] = zzn[g4];
            if (c + 1 < 16) {
#pragma unroll
                for (int g4 = 0; g4 < 4; ++g4) zzn[g4] = *(const u32x2*)(orow + 128 * NP + 16 * g4 + 4 * q16);
                P3_ISSUE(c + 1);
            }
            __builtin_amdgcn_sched_barrier(0);
            if (ssd && wave == 0 && c + 1 < 16) { P3_SCAN(c + 1); if (c + 2 < 16) P3_DTLOAD(c + 2); }
#ifndef P3_REPC
#define P3_REPC 1
#endif
            f32x16 acc;
            float acs_i = 0.f;
            LAS unsigned char* STw = lds + (par ? L_ST0 : L_ST1);
            _Pragma("nounroll") for (int repc_ = 0; repc_ < P3_REPC; ++repc_) {
            bf16x8 cqb[2];
#pragma unroll
            for (int s = 0; s < 2; ++s) cqb[s] = *(const LAS bf16x8*)(lds + L_CQ + (iTok * TP + 32 * s + 8 * q16) * 2);
            const LAS unsigned char* STr = lds + (par ? L_ST1 : L_ST0);
#pragma unroll
            for (int i = 0; i < 16; ++i) acc[i] = 0.f;
            f32x4 ya[4];
#pragma unroll
            for (int p4t = 0; p4t < 4; ++p4t) { ya[p4t] = (f32x4){0.f, 0.f, 0.f, 0.f};
#pragma unroll
                for (int s = 0; s < 2; ++s) { const bf16x8 sa = *(const LAS bf16x8*)(STr + ((16 * p4t + i16) * TP + 32 * s + 8 * q16) * 2); ya[p4t] = MFMA16(sa, cqb[s], ya[p4t]); } }
            acs_i = ACS[iTok];
            { const float ei = __builtin_amdgcn_exp2f(acs_i);
#pragma unroll
              for (int p4t = 0; p4t < 4; ++p4t) ya[p4t] = ya[p4t] * ei; }
            const int nblk = (wave >> 1) + 1;
            bf16x8 kq0[2], kq1[2];
#pragma unroll
            for (int s = 0; s < 2; ++s) { kq0[s] = *(const LAS bf16x8*)(lds + L_BK + (i16 * TP + 32 * s + 8 * q16) * 2); kq1[s] = *(const LAS bf16x8*)(lds + L_BK + ((16 + i16) * TP + 32 * s + 8 * q16) * 2); }
            for (int jb = 0; jb < nblk; ++jb) {
                const int j0 = 32 * jb;
                f32x4 t0 = (f32x4){0.f, 0.f, 0.f, 0.f}, t1 = t0;
#pragma unroll
                for (int s = 0; s < 2; ++s) { t0 = MFMA16(kq0[s], cqb[s], t0); t1 = MFMA16(kq1[s], cqb[s], t1); }
#pragma unroll
                for (int s = 0; s < 2; ++s) { kq0[s] = *(const LAS bf16x8*)(lds + L_BK + ((j0 + 32 + i16) * TP + 32 * s + 8 * q16) * 2); kq1[s] = *(const LAS bf16x8*)(lds + L_BK + ((j0 + 48 + i16) * TP + 32 * s + 8 * q16) * 2); }
                const f32x4 b0 = *(const LAS f32x4*)(DTJ + j0 + 4 * q16), b1 = *(const LAS f32x4*)(DTJ + j0 + 16 + 4 * q16);
                bf16x8 xa[4];
#pragma unroll
                for (int p4t = 0; p4t < 4; ++p4t) { const LAS unsigned char* xb = lds + L_XV + ((j0 + 4 * q16 + q4) * TP + 16 * p4t + 4 * p4) * 2; xa[p4t] = tr_pair(xb, xb + 16 * TP * 2); }
                __builtin_amdgcn_sched_barrier(0);
                const bool lastb = (jb == nblk - 1);
                float pv[8];
#pragma unroll
                for (int e = 0; e < 4; ++e) {
                    float v0 = t0[e] * __builtin_amdgcn_exp2f(acs_i - b0[e]), v1 = t1[e] * __builtin_amdgcn_exp2f(acs_i - b1[e]);
                    if (lastb && (j0 + 4 * q16 + e) > iTok) v0 = 0.f;
                    if (lastb && (j0 + 16 + 4 * q16 + e) > iTok) v1 = 0.f;
                    pv[e] = v0; pv[4 + e] = v1;
                }
                const bf16x8 pf = pack8(pv[0], pv[1], pv[2], pv[3], pv[4], pv[5], pv[6], pv[7]);
#pragma unroll
                for (int p4t = 0; p4t < 4; ++p4t) ya[p4t] = MFMA16(xa[p4t], pf, ya[p4t]);
            }
#pragma unroll
            for (int p4t = 0; p4t < 4; ++p4t)
#pragma unroll
                for (int e = 0; e < 4; ++e) acc[4 * p4t + e] = ya[p4t][e];
            }
            TE(3); TB(4);
            if (it < 2 && c < 15) {
                const int nt = it;
                const float dec = __builtin_amdgcn_exp2f(ACS[127]);
#pragma unroll
                for (int i = 0; i < 16; ++i) sacc[i] *= dec;
                f32x16 sacc2;
#pragma unroll
                for (int i = 0; i < 16; ++i) sacc2[i] = 0.f;
#pragma unroll
                for (int ks = 0; ks < 8; ++ks) {
                    const LAS unsigned char* xb = lds + L_XV + ((16 * ks + 8 * h + q4) * TP + 32 * pt + 16 * blk16 + 4 * p4) * 2;
                    const LAS unsigned char* kb = lds + L_BKW + ((16 * ks + 8 * h + q4) * TP + 32 * nt + 16 * blk16 + 4 * p4) * 2;
                    const bf16x8 xa = tr_pair(xb, xb + 4 * TP * 2), kbf = tr_pair(kb, kb + 4 * TP * 2);
                    if (ks & 1) sacc2 = MFMA32(xa, kbf, sacc2); else sacc = MFMA32(xa, kbf, sacc);
                }
#pragma unroll
                for (int i = 0; i < 16; ++i) sacc[i] += sacc2[i];
#pragma unroll
                for (int i = 0; i < 16; ++i) { const int p = 32 * pt + crow(i, h);
                    *(LAS unsigned short*)(STw + (p * TP + 32 * nt + r) * 2) = (unsigned short)(pk2(sacc[i], 0.f) & 0xffffu); }
            }
            {
                float ss = 0.f;
#pragma unroll
                for (int g4 = 0; g4 < 4; ++g4) {
                    const int p = 16 * g4 + 4 * q16;
                    const float z0 = bf_lo(zz[g4].x), z1 = bf_hi(zz[g4].x), z2 = bf_lo(zz[g4].y), z3 = bf_hi(zz[g4].y);
                    float y0 = acc[4 * g4], y1 = acc[4 * g4 + 1], y2 = acc[4 * g4 + 2], y3 = acc[4 * g4 + 3];
                    float o0, o1, o2, o3;
                    if (ssd) {
                        const u32x2 xv = *(const LAS u32x2*)(lds + L_XV + (iTok * TP + p) * 2);
                        y0 = (y0 + Dsk * bf_lo(xv.x)) * silu_f(z0); y1 = (y1 + Dsk * bf_hi(xv.x)) * silu_f(z1); y2 = (y2 + Dsk * bf_lo(xv.y)) * silu_f(z2); y3 = (y3 + Dsk * bf_hi(xv.y)) * silu_f(z3);
                        ss += (y0 * y0 + y1 * y1) + (y2 * y2 + y3 * y3);
                        o0 = y0; o1 = y1; o2 = y2; o3 = y3;
                    } else {
                        ss += (y0 * y0 + y1 * y1) + (y2 * y2 + y3 * y3);
                        o0 = y0 * silu_f(z0); o1 = y1 * silu_f(z1); o2 = y2 * silu_f(z2); o3 = y3 * silu_f(z3);
                    }
                    u32x2 ov; ov.x = pk2(o0, o1); ov.y = pk2(o2, o3);
                    if (dry) *(u32x2*)((bf16*)((unsigned char*)a.out + 40 * MiB) + (m0 + iTok) * 512 + ((64 * hd + 64 * half + p) & 511)) = ov; else *(u32x2*)(orow + p) = ov;
                }
                ss += __shfl_xor(ss, 16); ss += __shfl_xor(ss, 32);
                if (q16 < 2) { const float sv = (q16 == 0) ? ss : 0.f;
                    if (ssd) SSQM[(m0 + iTok) * 32 + hd * 2 + q16] = sv; else SSQR[(m0 + iTok) * 32 + hd * 4 + half * 2 + q16] = sv; }
            }
            TE(4);
        }
        TE(1);
#undef P3_ISSUE
#undef P3_SCAN
#undef P3_DTLOAD
    }
#ifdef PROBE_SEL
    if (probing && fresh_lane() == 0) ((unsigned*)(a.ws + WS_CTL))[4000] = tacc_;
#endif
#undef TB
#undef TE
}

constexpr int MP = 1032;
constexpr int L4_MERGED = 0, L4_ASTG = 132096, L4_RM = 150528, L4_RR = 151040, L4_RED = 153088, L4_RS = 155136;
static_assert(L4_RS + 256 <= LDS_BYTES, "P4 LDS map");

__device__ __forceinline__ void p4_panel_load(u32x4 (&ar)[16], const bf16* Abase, int tid) {
    const int srow = tid >> 3, soct = tid & 7; const int rot = ((int)blockIdx.x >> 3) & 15;
    const char* ab = (const char*)Abase; const unsigned aoff = (unsigned)((srow * NP + 8 * soct) * 2);
#pragma unroll
    for (int i = 0; i < 16; ++i) ar[i] = *(const u32x4*)(ab + ((rot + i) & 15) * 128 + aoff);
}
template <int SEGSHIFT>
__device__ __forceinline__ void p4_gemmT(f32x16 (&accT)[2][2], u32x4 (&ar)[16], const bf16* Anext  , const LAS float* rsc  , int nseg,
                                         const bf16* WF  , int nt0  , LAS unsigned char* lds, int tid, int lane) {
    const int srow = tid >> 3, soct = tid & 7, r = lane & 31, h = lane >> 5;
    const char* wb = (const char*)WF + (size_t)nt0 * 65536; const unsigned woff = (unsigned)(lane * 16);
    const int rot = ((int)blockIdx.x >> 3) & 15;
    bf16x8 wc[4][2];
    { const char* wk0 = wb + rot * 4096;
#pragma unroll
      for (int s = 0; s < 4; ++s) { wc[s][0] = *(const bf16x8*)(wk0 + s * 1024 + woff); wc[s][1] = *(const bf16x8*)(wk0 + 65536 + s * 1024 + woff); } }
#define P4_STAGE_WRITE(ki_) do { const int kc_ = ((ki_) + rot) & 15; const float sc = rsc[srow * nseg + ((kc_ * 64) >> SEGSHIFT)]; \
        u32x4 o; \
        o.x = pk2(bf_lo(ar[ki_].x) * sc, bf_hi(ar[ki_].x) * sc); o.y = pk2(bf_lo(ar[ki_].y) * sc, bf_hi(ar[ki_].y) * sc); \
        o.z = pk2(bf_lo(ar[ki_].z) * sc, bf_hi(ar[ki_].z) * sc); o.w = pk2(bf_lo(ar[ki_].w) * sc, bf_hi(ar[ki_].w) * sc); \
        *(LAS u32x4*)(lds + L4_ASTG + ((ki_) & 1) * 9216 + (srow * TP + 8 * soct) * 2) = o; } while (0)
    P4_STAGE_WRITE(0);
#pragma unroll
    for (int ki = 0; ki < 16; ++ki) {
        const int kc = (ki + rot) & 15;
        LAS unsigned char* stg = lds + L4_ASTG + (ki & 1) * 9216;
        __syncthreads();
        if (ki + 1 < 16) P4_STAGE_WRITE(ki + 1);
        const int kn = (kc + 1) & 15;
        const char* wk = wb + kn * 4096;
        bf16x8 a0 = *(const LAS bf16x8*)(stg + (r * TP + 8 * h) * 2), a1 = *(const LAS bf16x8*)(stg + ((32 + r) * TP + 8 * h) * 2);
#pragma unroll
        for (int s = 0; s < 4; ++s) {
            bf16x8 n0 = a0, n1 = a1;
            if (s < 3) { n0 = *(const LAS bf16x8*)(stg + (r * TP + 16 * (s + 1) + 8 * h) * 2); n1 = *(const LAS bf16x8*)(stg + ((32 + r) * TP + 16 * (s + 1) + 8 * h) * 2); }
            accT[0][0] = MFMA32(wc[s][0], a0, accT[0][0]); accT[0][1] = MFMA32(wc[s][1], a0, accT[0][1]);
            accT[1][0] = MFMA32(wc[s][0], a1, accT[1][0]); accT[1][1] = MFMA32(wc[s][1], a1, accT[1][1]);
            wc[s][0] = *(const bf16x8*)(wk + s * 1024 + woff); wc[s][1] = *(const bf16x8*)(wk + 65536 + s * 1024 + woff);
            __builtin_amdgcn_sched_barrier(0);
            a0 = n0; a1 = n1;
        }
    }
#undef P4_STAGE_WRITE
    p4_panel_load(ar, Anext, tid);
    __builtin_amdgcn_sched_barrier(0);
    __syncthreads();
}


__device__ __forceinline__ void tail_gemmT(f32x16 (&accT)[2], const bf16* Abase  , const bf16* WF  , int nt  , LAS unsigned char* lds, int tid, int lane) {
    const int srow = tid >> 3, soct = tid & 7, r = lane & 31, h = lane >> 5;
    const char* ab = (const char*)Abase; const unsigned aoff = (unsigned)((srow * 1024 + 8 * soct) * 2);
    const char* wb = (const char*)WF + (size_t)nt * 65536; const unsigned woff = (unsigned)(lane * 16);
    const int rot = ((int)blockIdx.x >> 3) & 15;
    u32x4 ar[16];
#pragma unroll
    for (int i = 0; i < 16; ++i) ar[i] = *(const u32x4*)(ab + ((rot + i) & 15) * 128 + aoff);
    bf16x8 wc[4];
    { const char* wk0 = wb + rot * 4096;
#pragma unroll
      for (int s = 0; s < 4; ++s) wc[s] = *(const bf16x8*)(wk0 + s * 1024 + woff); }
#pragma unroll
    for (int ki = 0; ki < 16; ++ki) {
        const int kc = (ki + rot) & 15;
        LAS unsigned char* stg = lds + L4_ASTG + (ki & 1) * 9216;
        *(LAS u32x4*)(stg + (srow * TP + 8 * soct) * 2) = ar[ki];
        __syncthreads();
        const char* wk = wb + ((kc + 1) & 15) * 4096;
#pragma unroll
        for (int s = 0; s < 4; ++s) {
            const bf16x8 a0 = *(const LAS bf16x8*)(stg + (r * TP + 16 * s + 8 * h) * 2), a1 = *(const LAS bf16x8*)(stg + ((32 + r) * TP + 16 * s + 8 * h) * 2);
            accT[0] = MFMA32(wc[s], a0, accT[0]); accT[1] = MFMA32(wc[s], a1, accT[1]);
            wc[s] = *(const bf16x8*)(wk + s * 1024 + woff);
            __builtin_amdgcn_sched_barrier(0);
        }
    }
    __syncthreads();
}

__device__ __forceinline__ void p4_phase(const Args& a, LAS unsigned char* lds, int tid_in, int lane_in, int wave, int G) {
    const bf16* PROJ = (const bf16*)(a.ws + WS_PROJ);
    const float* SSQM = (const float*)(a.ws + WS_SSQM); const float* SSQR = (const float*)(a.ws + WS_SSQR);
    const float* MOD = (const float*)(a.ws + WS_MOD);
    const bf16* WMF = (const bf16*)(a.ws + WS_WMF); const bf16* WRF = (const bf16*)(a.ws + WS_WRF); const bf16* WOF = (const bf16*)(a.ws + WS_WOF);
    const float* x = a.in[0]; const float* fw = a.in[15]; float* out = a.out;
    LAS float* RM = (LAS float*)(lds + L4_RM); LAS float* RR = (LAS float*)(lds + L4_RR); LAS float* RED = (LAS float*)(lds + L4_RED); LAS float* RS = (LAS float*)(lds + L4_RS);
    for (int blk = blockIdx.x; blk < 256; blk += G) {
        const size_t m0 = (size_t)blk * 64; const int b = blk >> 5;
        int lane = fresh_lane(), tid = wave * 64 + lane, r = lane & 31, h = lane >> 5;
        u32x4 ar[16];
        p4_panel_load(ar, PROJ + m0 * NP + C_Z, tid);
        __syncthreads();
        { const int row = tid >> 3, sub = tid & 7;
          const f32x4 qv = *(const f32x4*)(SSQR + (m0 + row) * 32 + 4 * sub);
          RR[row * 8 + sub] = 1.0f / sqrtf(((qv.x + qv.y) + (qv.z + qv.w)) * (1.f / 128.f) + EPS);
          if (sub < 2) { float s = 0.f;
#pragma unroll
              for (int i = 0; i < 4; ++i) { const f32x4 v = *(const f32x4*)(SSQM + (m0 + row) * 32 + 16 * sub + 4 * i); s += (v.x + v.y) + (v.z + v.w); }
              RM[row * 2 + sub] = 1.0f / sqrtf(s * (1.f / 512.f) + EPS); } }
        __syncthreads();
#ifndef P4_SKIP1
#ifndef P4_REP1
#define P4_REP1 1
#endif
        for (int nh_ = 0; nh_ < 2 * P4_REP1; ++nh_) {
            const int nh = nh_ & 1;
            lane = fresh_lane(); tid = wave * 64 + lane; r = lane & 31; h = lane >> 5;
            const int nt0 = 16 * nh + 2 * wave;
            const bf16* pblk = PROJ + m0 * NP;
            f32x16 accT[2][2];
#pragma unroll
            for (int i = 0; i < 2; ++i)
#pragma unroll
                for (int j = 0; j < 2; ++j)
#pragma unroll
                    for (int e = 0; e < 16; ++e) accT[i][j][e] = 0.f;
            u32x2 gpre[2][2][4];
            { const unsigned lo0 = (unsigned)((r * NP + 4 * h) * 2); const char* gb0 = (const char*)(pblk + C_GAM + 32 * nt0);
#pragma unroll
              for (int rt = 0; rt < 2; ++rt)
#pragma unroll
                  for (int ct = 0; ct < 2; ++ct)
#pragma unroll
                      for (int g4 = 0; g4 < 4; ++g4) gpre[rt][ct][g4] = *(const u32x2*)(gb0 + (lo0 + (unsigned)((32 * rt * NP + 32 * ct + 8 * g4) * 2)));
              __builtin_amdgcn_sched_barrier(0); }
            p4_gemmT<9>(accT, ar, pblk + C_GR, RM, 2, WMF, nt0, lds, tid, lane);
            {
                lane = fresh_lane(); r = lane & 31; h = lane >> 5;
                const unsigned lm = launder((unsigned)(L4_MERGED + (r * MP + 4 * h) * 2));
#pragma unroll
                for (int rt = 0; rt < 2; ++rt)
#pragma unroll
                    for (int ct = 0; ct < 2; ++ct)
#pragma unroll
                        for (int g4 = 0; g4 < 4; ++g4) {
                            const u32x2 gg = gpre[rt][ct][g4];
                            u32x2 ov; ov.x = pk2(accT[rt][ct][4 * g4] * sigm_f(bf_lo(gg.x)), accT[rt][ct][4 * g4 + 1] * sigm_f(bf_hi(gg.x)));
                            ov.y = pk2(accT[rt][ct][4 * g4 + 2] * sigm_f(bf_lo(gg.y)), accT[rt][ct][4 * g4 + 3] * sigm_f(bf_hi(gg.y)));
                            *(LAS u32x2*)(lds + lm + (unsigned)((32 * rt * MP + 32 * (nt0 + ct) + 8 * g4) * 2)) = ov; }
            }
#pragma unroll
            for (int i = 0; i < 2; ++i)
#pragma unroll
                for (int j = 0; j < 2; ++j)
#pragma unroll
                    for (int e = 0; e < 16; ++e) accT[i][j][e] = 0.f;
            lane = fresh_lane(); tid = wave * 64 + lane; r = lane & 31; h = lane >> 5;
            { const unsigned lo0 = (unsigned)((r * NP + 4 * h) * 2); const char* gb0 = (const char*)(pblk + C_GAR + 32 * nt0);
#pragma unroll
              for (int rt = 0; rt < 2; ++rt)
#pragma unroll
                  for (int ct = 0; ct < 2; ++ct)
#pragma unroll
                      for (int g4 = 0; g4 < 4; ++g4) gpre[rt][ct][g4] = *(const u32x2*)(gb0 + (lo0 + (unsigned)((32 * rt * NP + 32 * ct + 8 * g4) * 2)));
              __builtin_amdgcn_sched_barrier(0); }
            p4_gemmT<7>(accT, ar, pblk + C_Z, RR, 8, WRF, nt0, lds, tid, lane);
            {
                lane = fresh_lane(); r = lane & 31; h = lane >> 5;
                const unsigned lm = launder((unsigned)(L4_MERGED + (r * MP + 4 * h) * 2));
#pragma unroll
                for (int rt = 0; rt < 2; ++rt)
#pragma unroll
                    for (int ct = 0; ct < 2; ++ct)
#pragma unroll
                        for (int g4 = 0; g4 < 4; ++g4) {
                            const u32x2 gg = gpre[rt][ct][g4];
                            LAS u32x2* mp = (LAS u32x2*)(lds + lm + (unsigned)((32 * rt * MP + 32 * (nt0 + ct) + 8 * g4) * 2));
                            const u32x2 pm = *mp;
                            const float v0 = bf_lo(pm.x) + accT[rt][ct][4 * g4] * sigm_f(bf_lo(gg.x)), v1 = bf_hi(pm.x) + accT[rt][ct][4 * g4 + 1] * sigm_f(bf_hi(gg.x));
                            const float v2 = bf_lo(pm.y) + accT[rt][ct][4 * g4 + 2] * sigm_f(bf_lo(gg.y)), v3 = bf_hi(pm.y) + accT[rt][ct][4 * g4 + 3] * sigm_f(bf_hi(gg.y));
                            u32x2 ov; ov.x = pk2(v0, v1); ov.y = pk2(v2, v3);
                            *mp = ov; }
            }
        }
#endif
        __syncthreads();
        lane = fresh_lane(); tid = wave * 64 + lane; r = lane & 31; h = lane >> 5;
#ifndef P4_SKIP2
#ifndef P4_REP2
#define P4_REP2 1
#endif
        _Pragma("nounroll") for (int rep2_ = 0; rep2_ < P4_REP2; ++rep2_) {
            if (rep2_) { __syncthreads(); lane = fresh_lane(); tid = wave * 64 + lane; r = lane & 31; h = lane >> 5; }
            f32x16 acc[2][4];
#pragma unroll
            for (int i = 0; i < 2; ++i)
#pragma unroll
                for (int j = 0; j < 4; ++j)
#pragma unroll
                    for (int e = 0; e < 16; ++e) acc[i][j][e] = 0.f;
            const char* wb = (const char*)WOF + (size_t)(4 * wave) * 65536; const unsigned woff = (unsigned)(lane * 16);
            const int rot2 = ((int)blockIdx.x >> 3) & 31;
            bf16x8 wc[2][4];
#pragma unroll
            for (int s = 0; s < 2; ++s)
#pragma unroll
                for (int ct = 0; ct < 4; ++ct) wc[s][ct] = *(const bf16x8*)(wb + ct * 65536 + (2 * rot2 + s) * 1024 + woff);
            const LAS unsigned char* ma = lds + L4_MERGED + (r * MP + 8 * h) * 2;
            bf16x8 a0 = *(const LAS bf16x8*)(ma + (2 * rot2) * 32), a1 = *(const LAS bf16x8*)(ma + 32 * MP * 2 + (2 * rot2) * 32);
            for (int ki = 0; ki < 32; ++ki) {
                const int kp = (ki + rot2) & 31, kpn = (kp + 1) & 31;
#pragma unroll
                for (int s = 0; s < 2; ++s) {
                    const int ksn = (s == 0) ? 2 * kp + 1 : 2 * kpn;
                    const bf16x8 n0 = *(const LAS bf16x8*)(ma + ksn * 32), n1 = *(const LAS bf16x8*)(ma + 32 * MP * 2 + ksn * 32);
#pragma unroll
                    for (int ct = 0; ct < 4; ++ct) { acc[0][ct] = MFMA32(a0, wc[s][ct], acc[0][ct]); acc[1][ct] = MFMA32(a1, wc[s][ct], acc[1][ct]); }
#pragma unroll
                    for (int ct = 0; ct < 4; ++ct) wc[s][ct] = *(const bf16x8*)(wb + ct * 65536 + (2 * kpn + s) * 1024 + woff);
                    __builtin_amdgcn_sched_barrier(0);
                    a0 = n0; a1 = n1;
                }
            }
            lane = fresh_lane(); r = lane & 31; h = lane >> 5;
            const char* xblk = (const char*)(x + m0 * D); char* oblk = (char*)(out + m0 * D);
            const unsigned eo = launder((unsigned)(4 * (4 * h * D + 128 * wave + r)));
            const unsigned rb = launder((unsigned)(L4_RED + (4 * h * 8 + wave) * 4));
            float gate[4], fwv[4];
#pragma unroll
            for (int ct = 0; ct < 4; ++ct) { const int n = 32 * (4 * wave + ct) + r; gate[ct] = MOD[b * 3072 + 2048 + n]; fwv[ct] = fw[n]; }
            float xv[2][8][4];
#define P4_XLOAD(buf, bidx) do { _Pragma("unroll") for (int e = 0; e < 8; ++e) _Pragma("unroll") for (int ct = 0; ct < 4; ++ct) \
                xv[buf][e][ct] = *(const float*)(xblk + (eo + (unsigned)(((32 * ((bidx) >> 1) + (e & 3) + 8 * (2 * ((bidx) & 1) + (e >> 2))) * D + 32 * ct) * 4))); } while (0)
            P4_XLOAD(0, 0);
#pragma unroll
            for (int bi = 0; bi < 4; ++bi) {
                const int rt = bi >> 1, g8 = bi & 1;
                if (bi + 1 < 4) P4_XLOAD((bi + 1) & 1, bi + 1);
                __builtin_amdgcn_sched_barrier(0);
#pragma unroll
                for (int e = 0; e < 8; ++e) {
                    const int reg = 8 * g8 + e, rowc = 32 * rt + (reg & 3) + 8 * (reg >> 2);
                    float s = 0.f;
#pragma unroll
                    for (int ct = 0; ct < 4; ++ct) { const float v = xv[bi & 1][e][ct] + gate[ct] * acc[rt][ct][reg]; acc[rt][ct][reg] = v; s += v * v; }
                    s += __shfl_xor(s, 16); s += __shfl_xor(s, 8); s += __shfl_xor(s, 4); s += __shfl_xor(s, 2); s += __shfl_xor(s, 1);
                    *(LAS float*)(lds + rb + (unsigned)(rowc * 32)) = s;
                }
                asm volatile("" ::: "memory"); __builtin_amdgcn_sched_barrier(0);
            }
#undef P4_XLOAD
            __syncthreads();
            if (tid < 64) { float s = 0.f;
#pragma unroll
                for (int w = 0; w < 8; ++w) s += RED[tid * 8 + w];
                RS[tid] = 1.0f / sqrtf(s * (1.f / D) + EPS); }
            __syncthreads();
            const unsigned eo2 = launder(eo);
            const unsigned sb = launder((unsigned)(L4_RS + 4 * h * 4));
#pragma unroll
            for (int rt = 0; rt < 2; ++rt)
#pragma unroll
                for (int reg = 0; reg < 16; ++reg) {
                    const int rowc = 32 * rt + (reg & 3) + 8 * (reg >> 2); const float rs = *(const LAS float*)(lds + sb + (unsigned)(rowc * 4));
#pragma unroll
                    for (int ct = 0; ct < 4; ++ct) *(float*)(oblk + (eo2 + (unsigned)((rowc * D + 32 * ct) * 4))) = acc[rt][ct][reg] * rs * fwv[ct];
                }
        }
#endif
    }
}

#define XB_TMO      128
#define XB_XCNT(j)  (256  + 64 * (j))
#define XB_XSUB(j)  (1280 + 64 * (j))
#define XB_XGEN(j)  (2304 + 64 * (j))
#define XB_TOP      3328
#define XB_TOPGEN   3392
#define XCD_BAR_WORDS 3456
#define XB_SPIN_CAP (1u << 18)

__device__ __forceinline__ unsigned xb_ld(unsigned* p)              { return __hip_atomic_load(p, __ATOMIC_RELAXED, __HIP_MEMORY_SCOPE_AGENT); }
__device__ __forceinline__ unsigned xb_add(unsigned* p, unsigned v) { return __hip_atomic_fetch_add(p, v, __ATOMIC_RELAXED, __HIP_MEMORY_SCOPE_AGENT); }
__device__ __forceinline__ unsigned xb_xcc_id() { return (unsigned)__builtin_amdgcn_s_getreg((3 << 11) | 20) & 0xFu; }
#define XB_SPIN(cond, bar) do { unsigned _sp = 0; while (cond) { __builtin_amdgcn_s_sleep(1); \
    if ((++_sp & 255u) == 0u) { if (xb_ld(&(bar)[XB_TMO])) break; if (_sp > XB_SPIN_CAP) { atomicAdd(&(bar)[XB_TMO], 1u); break; } } } } while (0)

struct XcdBarrier {
    unsigned* bar; unsigned x;
    volatile LAS unsigned* st;
};

__device__ __forceinline__ XcdBarrier xcd_barrier_post(unsigned* bar, volatile LAS unsigned* st, const int wave_) {
    XcdBarrier b; b.bar = bar; b.x = xb_xcc_id(); b.st = st;
    if (wave_ == 0 && fresh_lane() == 0) (void)xb_add(&bar[XB_XCNT(b.x)], 1u);
    return b;
}
__device__ __forceinline__ void xcd_barrier_complete(unsigned* bar, unsigned x, unsigned& nloc, unsigned& nx) {
    const unsigned G = gridDim.x * gridDim.y * gridDim.z;
    unsigned sum, cnt, mine, sp = 0u;
    for (;;) {
        sum = 0u; cnt = 0u; mine = 0u;
#pragma unroll
        for (unsigned j = 0; j < 16; ++j) { const unsigned c = xb_ld(&bar[XB_XCNT(j)]); sum += c; cnt += (c > 0u) ? 1u : 0u; mine = (j == x) ? c : mine; }
        if (sum == G) break;
        __builtin_amdgcn_s_sleep(1);
        if ((++sp & 255u) == 0u) { if (xb_ld(&bar[XB_TMO])) break; if (sp > XB_SPIN_CAP) { atomicAdd(&bar[XB_TMO], 1u); break; } }
    }
    nloc = mine > 0u ? mine : 1u; nx = cnt > 0u ? cnt : 1u;
}

__device__ __forceinline__ void xcd_barrier(const XcdBarrier& b, const int wave_) {
    asm volatile("s_waitcnt vmcnt(0)" ::: "memory");
    __syncthreads();
    if (wave_ == 0 && fresh_lane() == 0) {
        unsigned* bar = b.bar;
        __builtin_amdgcn_s_waitcnt(0);
        unsigned nloc = b.st[0], nx = b.st[1];
        if (nloc == 0u) { xcd_barrier_complete(bar, b.x, nloc, nx); b.st[0] = nloc; b.st[1] = nx; }
        const unsigned old = xb_add(&bar[XB_XSUB(b.x)], 1u);
        const unsigned gen = old / nloc;
        if (old + 1u == (gen + 1u) * nloc) {
            __builtin_amdgcn_fence(__ATOMIC_RELEASE, "agent");
            asm volatile("s_waitcnt vmcnt(0)" ::: "memory");
            const unsigned og = xb_add(&bar[XB_TOP], 1u);
            const unsigned tg = og / nx;
            if (og + 1u == (tg + 1u) * nx) xb_add(&bar[XB_TOPGEN], 1u);
            else XB_SPIN(xb_ld(&bar[XB_TOPGEN]) == tg, bar);
            __builtin_amdgcn_fence(__ATOMIC_ACQUIRE, "agent");
            xb_add(&bar[XB_XGEN(b.x)], 1u);
            asm volatile("s_waitcnt vmcnt(0)" ::: "memory");
        } else {
            XB_SPIN(xb_ld(&bar[XB_XGEN(b.x)]) == gen, bar);
            __builtin_amdgcn_fence(__ATOMIC_ACQUIRE, "agent");
            asm volatile("s_waitcnt vmcnt(0)" ::: "memory");
        }
    }
    __syncthreads();
}

#ifdef SELF_CLEAN_BARRIER
__device__ unsigned g_bar[4096];
#endif
__global__ void __launch_bounds__(NTHR, 2) hybrid_fwd(Args args) {
    extern __shared__ __attribute__((aligned(16))) unsigned char lds_raw[];
    LAS unsigned char* lds = (LAS unsigned char*)lds_raw;
    const int wave = __builtin_amdgcn_readfirstlane((int)threadIdx.x >> 6), G = gridDim.x; const int tid = 0, lane = 0;
    cg::grid_group grid = cg::this_grid();
    volatile LAS unsigned* misc = (volatile LAS unsigned*)(lds + LDS_MISC);
    if (threadIdx.x < 2) misc[threadIdx.x] = 0u;
    __syncthreads();
    if (args.ph_lo < 0) grid.sync();
    #ifdef SELF_CLEAN_BARRIER
    XcdBarrier xbar = xcd_barrier_post(g_bar, misc, wave);
#else
    XcdBarrier xbar = xcd_barrier_post((unsigned*)(args.ws + WS_CTL), misc, wave);
#endif
    const int lo = args.ph_lo, hi = args.ph_hi;
#ifndef PHMASK
#define PHMASK 31
#endif
#define IN(k) (((PHMASK >> (k)) & 1) && lo <= (k) && (k) < hi)
#define SEAM(k) do { if (IN(k) && IN((k) + 1)) xcd_barrier(xbar, wave); } while (0)
#ifndef REPEAT_MASK
#define REPEAT_MASK 0
#endif
#ifdef PROBE_PH
    unsigned long long pt0_ = 0ull; unsigned pacc_ = 0u;
#define PB(k) do { if (PROBE_PH == (k)) pt0_ = __builtin_amdgcn_s_memrealtime(); } while (0)
#define PE(k) do { if (PROBE_PH == (k)) pacc_ += (unsigned)(__builtin_amdgcn_s_memrealtime() - pt0_); } while (0)
#else
#define PB(k) do {} while (0)
#define PE(k) do {} while (0)
#endif
    PB(20);
#define REP(k) _Pragma("nounroll") for (int rep_ = 0; rep_ < 1 + ((REPEAT_MASK >> (k)) & 1); ++rep_)
#ifdef EXTRA_SYNCS
    for (int es_ = 0; es_ < EXTRA_SYNCS; ++es_) xcd_barrier(xbar, wave);
#endif
    PB(0);
    if (IN(0)) REP(0) { if (rep_) xcd_barrier(xbar, wave); p0_phase(args, lds, tid, lane, wave, G); }
    PE(0); PB(10); SEAM(0); PE(10); PB(1);
    if (IN(1)) REP(1) { if (rep_) xcd_barrier(xbar, wave); p1_phase(args, lds, tid, lane, wave, G); }
    PE(1); PB(11); SEAM(1); PE(11); PB(2);
    if (IN(2)) REP(2) {
        if (rep_) xcd_barrier(xbar, wave);
        __syncthreads();
        pg8::Gemm g{(const pg8::bf16_t*)((const unsigned char*)args.out + OUT_H), (const pg8::bf16_t*)((const unsigned char*)args.out + OUT_WINT), MTOK, NP_MAIN, D};
        pg8::StaticOrder S; S.init(MTOK, NP_MAIN, G, (int)blockIdx.x);
        pg8::EpiProj E{(pg8::bf16_t*)(args.ws + WS_PROJ), NP};
        pg8::gemm_phase<pg8::EpiProj, pg8::StaticOrder, true, true>(lds, g, S, E, wave);
        for (int blk = blockIdx.x; blk < 256; blk += G) {
            const int lane_ = fresh_lane(), tid_ = wave * 64 + lane_;
            f32x16 accT[2];
#pragma unroll
            for (int i = 0; i < 2; ++i)
#pragma unroll
                for (int e = 0; e < 16; ++e) accT[i][e] = 0.f;
            tail_gemmT(accT, (const bf16*)((const unsigned char*)args.out + OUT_H) + (size_t)blk * 64 * 1024, (const bf16*)(args.ws + WS_WTF), wave, lds, tid_, lane_);
            const int l2 = fresh_lane(), r2 = l2 & 31, h2 = l2 >> 5;
            bf16* prow = (bf16*)(args.ws + WS_PROJ) + ((size_t)blk * 64 + r2) * NP + NP_MAIN + 32 * wave + 4 * h2;
#pragma unroll
            for (int rt = 0; rt < 2; ++rt)
#pragma unroll
                for (int g4 = 0; g4 < 4; ++g4) { u32x2 ov; ov.x = pk2(accT[rt][4 * g4], accT[rt][4 * g4 + 1]); ov.y = pk2(accT[rt][4 * g4 + 2], accT[rt][4 * g4 + 3]);
                    *(u32x2*)(prow + (size_t)rt * 32 * NP + 8 * g4) = ov; }
        }
    }
    PE(2); PB(12); SEAM(2); PE(12); PB(3);
    if (IN(3)) { p3a_phase(args, wave, G); PE(3); PB(13); xcd_barrier(xbar, wave); PE(13); PB(4); if ((REPEAT_MASK >> 3) & 1) { p3_phase(args, lds, tid, lane, wave, G, true); xcd_barrier(xbar, wave); } p3_phase(args, lds, tid, lane, wave, G); }
    PE(4); PB(14); SEAM(3); PE(14); PB(5);
    if (IN(4)) REP(4) { if (rep_) xcd_barrier(xbar, wave); p4_phase(args, lds, tid, lane, wave, G); }
#undef REP
    PE(5); PE(20);
#if defined(SELF_CLEAN_BARRIER) && !defined(PROBE_PH)
    {
        __syncthreads();
        if (wave == 0) {
            const int l_ = fresh_lane();
            unsigned last_ = 0u;
            if (l_ == 0) last_ = (__hip_atomic_fetch_add(&g_bar[4032], 1u, __ATOMIC_RELAXED, __HIP_MEMORY_SCOPE_AGENT) == (unsigned)G - 1u) ? 1u : 0u;
            last_ = (unsigned)__builtin_amdgcn_readfirstlane((int)last_);
            if (last_) {
                if (l_ < 16) { __hip_atomic_store(&g_bar[XB_XCNT(l_)], 0u, __ATOMIC_RELAXED, __HIP_MEMORY_SCOPE_AGENT); __hip_atomic_store(&g_bar[XB_XSUB(l_)], 0u, __ATOMIC_RELAXED, __HIP_MEMORY_SCOPE_AGENT); __hip_atomic_store(&g_bar[XB_XGEN(l_)], 0u, __ATOMIC_RELAXED, __HIP_MEMORY_SCOPE_AGENT); }
                if (l_ == 16) { __hip_atomic_store(&g_bar[XB_TOP], 0u, __ATOMIC_RELAXED, __HIP_MEMORY_SCOPE_AGENT); __hip_atomic_store(&g_bar[XB_TOPGEN], 0u, __ATOMIC_RELAXED, __HIP_MEMORY_SCOPE_AGENT);
                                __hip_atomic_store(&g_bar[XB_TMO], 0u, __ATOMIC_RELAXED, __HIP_MEMORY_SCOPE_AGENT); __hip_atomic_store(&g_bar[4032], 0u, __ATOMIC_RELAXED, __HIP_MEMORY_SCOPE_AGENT); }
            }
        }
    }
#endif
#ifdef PROBE_PH
    if (blockIdx.x == PROBE_PBLK && wave == 0 && fresh_lane() == 0) ((unsigned*)(args.ws + WS_CTL))[4001] = pacc_;
    if (blockIdx.x == 0) { xcd_barrier(xbar, wave); } else { xcd_barrier(xbar, wave); }
    if (blockIdx.x == 0 && wave == 0 && fresh_lane() == 0) { asm volatile("s_waitcnt vmcnt(0)" ::: "memory"); args.out[0] = 50.0f * floorf(0.01f * (float)__hip_atomic_load((unsigned*)(args.ws + WS_CTL) + 4001, __ATOMIC_RELAXED, __HIP_MEMORY_SCOPE_AGENT) / 50.0f + 0.5f); }
#endif
#ifdef PROBE_SEL
    if (blockIdx.x == 0 && wave == 0 && fresh_lane() == 0) { asm volatile("s_waitcnt vmcnt(0)" ::: "memory"); args.out[0] = 0.01f * (float)((volatile unsigned*)(args.ws + WS_CTL))[4000]; }
#endif
#undef IN
#undef SEAM
}

extern "C" void kernel_launch(void* const* d_in, const int* in_sizes, int n_in, void* d_out, int out_size, void* d_ws, size_t ws_size, hipStream_t stream) {
    static int grid = 0;
    if (grid == 0) {
        if (n_in != 16 || out_size != MTOK * D || ws_size < WS_END) { fprintf(stderr, "kernel_launch: unexpected shapes (n_in %d out %d ws %zu)\n", n_in, out_size, ws_size); grid = -1; return; }
        int dev = 0, cus = 0, per_cu = 0;
        (void)hipGetDevice(&dev);
        (void)hipDeviceGetAttribute(&cus, hipDeviceAttributeMultiprocessorCount, dev);
        if (hipFuncSetAttribute((const void*)hybrid_fwd, hipFuncAttributeMaxDynamicSharedMemorySize, LDS_BYTES) != hipSuccess) { fprintf(stderr, "kernel_launch: hipFuncSetAttribute failed\n"); grid = -1; return; }
        if (hipOccupancyMaxActiveBlocksPerMultiprocessor(&per_cu, (const void*)hybrid_fwd, NTHR, LDS_BYTES) != hipSuccess || per_cu < 1) { fprintf(stderr, "kernel_launch: occupancy query says %d\n", per_cu); per_cu = 1; }
        (void)hipGetLastError();
        grid = cus * per_cu;
        if (grid > 256) grid = 256;
        if (grid < 1) grid = 1;
    }
    if (grid < 0) return;
#ifndef SELF_CLEAN_BARRIER
    if (hipMemsetAsync((char*)d_ws + WS_CTL, 0, CTL_BYTES, stream) != hipSuccess) { fprintf(stderr, "kernel_launch: memset of the barrier words failed\n"); return; }
#endif
    Args a{};
    for (int i = 0; i < 16; ++i) a.in[i] = (const float*)d_in[i];
    a.out = (float*)d_out; a.ws = (unsigned char*)d_ws;
#if N_LAUNCHES == 1
    a.ph_lo = 0; a.ph_hi = NPH;
    void* kargs[] = {&a};
    hipError_t e = hipLaunchCooperativeKernel((const void*)hybrid_fwd, dim3(grid), dim3(NTHR), kargs, LDS_BYTES, stream);
    if (e != hipSuccess) fprintf(stderr, "kernel_launch: cooperative launch failed: %s (grid %d)\n", hipGetErrorString(e), grid);
#else
    for (int p = 0; p < NPH; ++p) {
        a.ph_lo = p; a.ph_hi = p + 1;
        hipLaunchKernelGGL(hybrid_fwd, dim3(grid), dim3(NTHR), LDS_BYTES, stream, a);
    }
#endif
}
```

```cpp
#include <hip/hip_runtime.h>
#include <hip/hip_cooperative_groups.h>
#include <cstdio>
#include <cstdint>
namespace cg = cooperative_groups;
#define N_LAUNCHES 1
#define REPEAT_MASK 0
#define P4_REP2 1
__device__ __forceinline__ unsigned launder(unsigned v) { asm volatile("" : "+v"(v)); return v; }
__device__ __forceinline__ int fresh_lane() { unsigned z; asm volatile("v_mov_b32 %0, 0" : "=v"(z)); return (int)__builtin_amdgcn_mbcnt_hi(~0u, __builtin_amdgcn_mbcnt_lo(~0u, z)); }
namespace pg8 {
#define PG8_LAS __attribute__((address_space(3)))
typedef unsigned short bf16_t;
typedef short bf16x8 __attribute__((ext_vector_type(8)));
typedef float f32x4 __attribute__((ext_vector_type(4)));
typedef unsigned u32x4 __attribute__((ext_vector_type(4)));
constexpr int BM = 256, BK = 64, HALF = 128, HTB = HALF * BK * 2  , STAGE_BYTES = 8 * HTB, NXCD = 8, WGM = 8;

__host__ __device__ __forceinline__ int lds_byte(int r, int c) { const int st = (r >> 4) * 2 + (c >> 5), rr = r & 15, cc = c & 31, ob = rr * 64 + cc * 2; return st * 1024 + (ob ^ (((ob >> 9) & 1) << 5)); }
__host__ __device__ __forceinline__ void stage_rc(int b, int& R, int& C) { const int st = b / 1024, sb = b % 1024, swz = sb ^ (((sb >> 9) & 1) << 5); R = (st >> 1) * 16 + swz / 64; C = (st & 1) * 32 + (swz % 64) / 2; }
__host__ __device__ __forceinline__ int perm32(int rho) { const int n = rho >> 4, i = rho & 15; return 8 * (i >> 2) + 4 * n + (i & 3); }

struct Unit { int pm, pn; };
struct Gemm { const bf16_t* A; const bf16_t* Bt; int M, N, K; };

struct StaticOrder {
    int nM, nN, nwg, G, c;
    __host__ __device__ void init(int M, int N, int G_, int c_) { nM = M / BM; nN = N / BM; nwg = nM * nN; G = G_; c = c_; }
    __host__ __device__ bool next(int i, Unit& u) const {
        const long L = (long)i * G + c; if (L >= nwg) return false;
        int wgid = (int)L; { const int q = nwg / NXCD, r = nwg % NXCD, xcd = wgid % NXCD, off = wgid / NXCD; wgid = (xcd < r ? xcd * (q + 1) : r * (q + 1) + (xcd - r) * q) + off; }
        const int nig = WGM * nN, gid = wgid / nig, fm = gid * WGM, gsz = (nM - fm) < WGM ? (nM - fm) : WGM;
        u.pm = fm + ((wgid % nig) % gsz); u.pn = (wgid % nig) / gsz; return true;
    }
    __device__ __forceinline__ void a_ready(const Unit&) const {}
    __device__ __forceinline__ void done(const Unit&) const {}
};
__device__ __forceinline__ unsigned cvt_pk_bf16(float lo, float hi) { unsigned r; asm volatile("v_cvt_pk_bf16_f32 %0, %1, %2" : "=v"(r) : "v"(lo), "v"(hi)); return r; }
struct EpiProj {
    static constexpr bool PERM = true, AFTER_DRAIN = false;
    bf16_t* O; int ldc;
    __device__ __forceinline__ void operator()(const f32x4 (&acc)[2][2][4][2], const Unit& u, int wr, int wc, int fr, int fq) const {
        const int row0 = u.pm * BM + wr * 64 + fr; const int col0 = u.pn * BM + wc * 32 + 8 * fq;
#pragma unroll
        for (int ai = 0; ai < 2; ++ai)
#pragma unroll
            for (int m = 0; m < 4; ++m) { bf16_t* rowp = O + (size_t)(row0 + ai * HALF + m * 16) * ldc + col0;
#pragma unroll
                for (int bj = 0; bj < 2; ++bj) { const f32x4 v0 = acc[ai][bj][m][0], v1 = acc[ai][bj][m][1];
                    u32x4 w; w.x = cvt_pk_bf16(v0[0], v0[1]); w.y = cvt_pk_bf16(v0[2], v0[3]); w.z = cvt_pk_bf16(v1[0], v1[1]); w.w = cvt_pk_bf16(v1[2], v1[3]);
                    *(u32x4*)(rowp + bj * HALF) = w; } }
    }
    __device__ __forceinline__ void fused(f32x4 (&)[2][2][4][2], const Unit&, int, int, int, int, PG8_LAS unsigned char*, int, int) const {}
};
template <class Epi, class Sched, bool ALIGN_EPI = false, bool SP2 = false>
__device__ __forceinline__ void gemm_phase(PG8_LAS unsigned char* lds, const Gemm g, const Sched& S, const Epi& E, const int wid) {
    const int lane = ::fresh_lane(), tid = wid * 64 + lane, wr = wid >> 2, wc = wid & 3, fr = lane & 15, fq = lane >> 4;
    const int K = g.K, nt = K / BK;
    unsigned voffA[2], voffB[2];
#pragma unroll
    for (int i = 0; i < 2; ++i) { int R, C; stage_rc(tid * 16 + i * 8192, R, C); const int Rb = Epi::PERM ? ((R & ~31) + perm32(R & 31)) : R;
        voffA[i] = (unsigned)(R * K + C) * 2u; voffB[i] = (unsigned)(Rb * K + C) * 2u; }
    const size_t kstep = (size_t)(BK * 2);
    const size_t hstep = (size_t)HALF * K * 2;
    const size_t tstep = 2 * hstep;
    const unsigned ldsw = (unsigned)wid * 1024u;
    const int aoff = lds_byte(wr * 64 + fr, fq * 8), boff = lds_byte(wc * 32 + fr, fq * 8);
#define PG8_SA(b, h) (((b) * 2 + (h)) * HTB)
#define PG8_SB(b, h) ((4 + (b) * 2 + (h)) * HTB)
#define PG8_STAGE(bufoff, gbase, voff) do { _Pragma("unroll") for (int _i = 0; _i < 2; ++_i) \
        __builtin_amdgcn_global_load_lds((const unsigned*)((const char*)(gbase) + (voff)[_i]), (PG8_LAS unsigned*)(lds + (bufoff) + ldsw + _i * 8192), 16, 0, 0); } while (0)
#define PG8_LDA(dst, b, h) do { _Pragma("unroll") for (int m = 0; m < 4; ++m) _Pragma("unroll") for (int k = 0; k < 2; ++k) dst[m][k] = *(const PG8_LAS bf16x8*)(lds + PG8_SA(b, h) + aoff + m * 2048 + k * 1024); } while (0)
#define PG8_LDB(dst, b, h) do { _Pragma("unroll") for (int n = 0; n < 2; ++n) _Pragma("unroll") for (int k = 0; k < 2; ++k) dst[n][k] = *(const PG8_LAS bf16x8*)(lds + PG8_SB(b, h) + boff + n * 2048 + k * 1024); } while (0)
#define PG8_MMA(ai, bj, At, Bt) do { __builtin_amdgcn_s_setprio(1); _Pragma("unroll") for (int m = 0; m < 4; ++m) _Pragma("unroll") for (int n = 0; n < 2; ++n) _Pragma("unroll") for (int k = 0; k < 2; ++k) \
        acc[ai][bj][m][n] = __builtin_amdgcn_mfma_f32_16x16x32_bf16(Bt[n][k], At[m][k], acc[ai][bj][m][n], 0, 0, 0); __builtin_amdgcn_s_setprio(0); } while (0)
#define PG8_WAIT_V(n) asm volatile("s_waitcnt vmcnt(" #n ")" ::: "memory")
#define PG8_WAIT_L(n) asm volatile("s_waitcnt lgkmcnt(" #n ")" ::: "memory")
#define PG8_BAR __builtin_amdgcn_s_barrier()
#define PG8_SCHED __builtin_amdgcn_sched_barrier(0)
    Unit cur, nxt; int ui = 0;
    if (!S.next(0, cur)) return;
    f32x4 acc[2][2][4][2];
#pragma unroll
    for (int a = 0; a < 2; ++a)
#pragma unroll
        for (int b = 0; b < 2; ++b)
#pragma unroll
            for (int m = 0; m < 4; ++m)
#pragma unroll
                for (int n = 0; n < 2; ++n) acc[a][b][m][n] = (f32x4){0.f, 0.f, 0.f, 0.f};
    bf16x8 At[4][2], B0[2][2], B1[2][2];
    const char* cA = (const char*)g.A + (size_t)cur.pm * tstep; const char* cB = (const char*)g.Bt + (size_t)cur.pn * tstep;
    S.a_ready(cur);
    if constexpr (SP2) {
        PG8_STAGE(PG8_SB(0, 0), cB, voffB); PG8_STAGE(PG8_SB(0, 1), cB + hstep, voffB); PG8_STAGE(PG8_SA(0, 0), cA, voffA); PG8_STAGE(PG8_SA(0, 1), cA + hstep, voffA);
        if (wr == 1) PG8_BAR;
        PG8_WAIT_V(2); PG8_BAR;
        PG8_STAGE(PG8_SB(1, 0), cB + kstep, voffB); PG8_STAGE(PG8_SA(1, 0), cA + kstep, voffA); PG8_STAGE(PG8_SB(1, 1), cB + hstep + kstep, voffB);
        PG8_WAIT_V(6); PG8_BAR;
    } else {
        PG8_STAGE(PG8_SB(0, 0), cB, voffB); PG8_STAGE(PG8_SA(0, 0), cA, voffA); PG8_STAGE(PG8_SB(0, 1), cB + hstep, voffB); PG8_STAGE(PG8_SA(0, 1), cA + hstep, voffA);
        if (wr == 1) PG8_BAR;
        PG8_WAIT_V(4); PG8_BAR;
        PG8_STAGE(PG8_SB(1, 0), cB + kstep, voffB); PG8_STAGE(PG8_SA(1, 0), cA + kstep, voffA); PG8_STAGE(PG8_SB(1, 1), cB + hstep + kstep, voffB);
        PG8_WAIT_V(6); PG8_BAR;
    }
    for (;;) {
        const bool has_next = S.next(ui + 1, nxt);
        const char* nA = has_next ? (const char*)g.A + (size_t)nxt.pm * tstep : cA; const char* nB = has_next ? (const char*)g.Bt + (size_t)nxt.pn * tstep : cB;
        for (int t = 0; t < nt; t += 2) {
            const bool last = (t == nt - 2);
            const char* a1 = cA + (size_t)(t + 1) * kstep;
            const char* a2 = last ? nA : cA + (size_t)(t + 2) * kstep; const char* b2 = last ? nB : cB + (size_t)(t + 2) * kstep;
            const char* a3 = a2 + kstep; const char* b3 = b2 + kstep;
            if (last && has_next) S.a_ready(nxt);
            if constexpr (SP2) {
            PG8_LDB(B0, 0, 0); PG8_LDB(B1, 0, 1); PG8_SCHED; PG8_LDA(At, 0, 0); PG8_STAGE(PG8_SA(1, 1), a1 + hstep, voffA);
            PG8_WAIT_V(8); PG8_WAIT_L(0); PG8_BAR; PG8_MMA(0, 0, At, B0); PG8_MMA(0, 1, At, B1); PG8_BAR; PG8_SCHED;
            PG8_LDA(At, 0, 1); PG8_STAGE(PG8_SB(0, 0), b2, voffB); PG8_STAGE(PG8_SB(0, 1), b2 + hstep, voffB); PG8_STAGE(PG8_SA(0, 0), a2, voffA);
            PG8_WAIT_V(8); PG8_WAIT_L(0); PG8_BAR; PG8_MMA(1, 0, At, B0); PG8_MMA(1, 1, At, B1); PG8_BAR; PG8_SCHED;
            PG8_LDB(B0, 1, 0); PG8_LDB(B1, 1, 1); PG8_SCHED; PG8_LDA(At, 1, 0); PG8_STAGE(PG8_SA(0, 1), a2 + hstep, voffA);
            PG8_WAIT_V(8); PG8_WAIT_L(0); PG8_BAR; PG8_MMA(0, 0, At, B0); PG8_MMA(0, 1, At, B1); PG8_BAR; PG8_SCHED;
            PG8_LDA(At, 1, 1); PG8_STAGE(PG8_SB(1, 0), b3, voffB); PG8_STAGE(PG8_SB(1, 1), b3 + hstep, voffB); PG8_STAGE(PG8_SA(1, 0), a3, voffA);
            PG8_WAIT_V(8); PG8_WAIT_L(0); PG8_BAR; PG8_MMA(1, 0, At, B0); PG8_MMA(1, 1, At, B1); PG8_BAR; PG8_SCHED;
            } else {
            PG8_LDB(B0, 0, 0); PG8_SCHED; PG8_LDA(At, 0, 0); PG8_STAGE(PG8_SA(1, 1), a1 + hstep, voffA);
            PG8_WAIT_L(8); PG8_BAR; PG8_WAIT_L(0); PG8_MMA(0, 0, At, B0); PG8_BAR; PG8_SCHED;
            PG8_LDB(B1, 0, 1); PG8_STAGE(PG8_SB(0, 0), b2, voffB);
            PG8_BAR; PG8_WAIT_L(0); PG8_MMA(0, 1, At, B1); PG8_BAR;
            PG8_LDA(At, 0, 1); PG8_STAGE(PG8_SA(0, 0), a2, voffA);
            PG8_BAR; PG8_WAIT_L(0); PG8_MMA(1, 0, At, B0); PG8_BAR; PG8_SCHED;
            PG8_STAGE(PG8_SB(0, 1), b2 + hstep, voffB);
            PG8_WAIT_V(6); PG8_BAR; PG8_MMA(1, 1, At, B1); PG8_BAR;
            PG8_LDB(B0, 1, 0); PG8_SCHED; PG8_LDA(At, 1, 0); PG8_STAGE(PG8_SA(0, 1), a2 + hstep, voffA);
            PG8_WAIT_L(8); PG8_BAR; PG8_WAIT_L(0); PG8_MMA(0, 0, At, B0); PG8_BAR; PG8_SCHED;
            PG8_LDB(B1, 1, 1); PG8_STAGE(PG8_SB(1, 0), b3, voffB);
            PG8_BAR; PG8_WAIT_L(0); PG8_MMA(0, 1, At, B1); PG8_BAR;
            PG8_LDA(At, 1, 1); PG8_STAGE(PG8_SA(1, 0), a3, voffA);
            PG8_BAR; PG8_WAIT_L(0); PG8_MMA(1, 0, At, B0); PG8_BAR; PG8_SCHED;
            PG8_STAGE(PG8_SB(1, 1), b3 + hstep, voffB);
            PG8_WAIT_V(6); PG8_BAR; PG8_MMA(1, 1, At, B1); PG8_BAR;
            }
        }
        if constexpr (ALIGN_EPI) { if (wr == 0) PG8_BAR; }
        if constexpr (!Epi::AFTER_DRAIN) { E(acc, cur, wr, wc, fr, fq); S.done(cur); }
        if (!has_next) break;
#pragma unroll
        for (int a = 0; a < 2; ++a)
#pragma unroll
            for (int b = 0; b < 2; ++b)
#pragma unroll
                for (int m = 0; m < 4; ++m)
#pragma unroll
                    for (int n = 0; n < 2; ++n) acc[a][b][m][n] = (f32x4){0.f, 0.f, 0.f, 0.f};
        cur = nxt; cA = nA; cB = nB; ++ui;
        if constexpr (ALIGN_EPI) { if (wr == 1) PG8_BAR; }
    }
    PG8_WAIT_V(0);
    if constexpr (!ALIGN_EPI) { if (wr == 0) PG8_BAR; }
    PG8_BAR;
    if constexpr (Epi::AFTER_DRAIN) { E.fused(acc, cur, wr, wc, fr, fq, lds, wid, lane); S.done(cur); }
#undef PG8_SA
#undef PG8_SB
#undef PG8_STAGE
#undef PG8_LDA
#undef PG8_LDB
#undef PG8_MMA
#undef PG8_WAIT_V
#undef PG8_WAIT_L
#undef PG8_BAR
#undef PG8_SCHED
}
}

#define LAS __attribute__((address_space(3)))
typedef unsigned short bf16;
typedef short bf16x8 __attribute__((ext_vector_type(8)));
typedef short s16x4 __attribute__((ext_vector_type(4)));
typedef float f32x4 __attribute__((ext_vector_type(4)));
typedef float f32x16 __attribute__((ext_vector_type(16)));
typedef unsigned u32x4 __attribute__((ext_vector_type(4)));
typedef unsigned u32x2 __attribute__((ext_vector_type(2)));
typedef float f32x2_t __attribute__((ext_vector_type(2)));
typedef __bf16 bf16x2_t __attribute__((ext_vector_type(2)));

#ifndef N_LAUNCHES
#define N_LAUNCHES 1
#endif
constexpr int NPH = 5;
constexpr int D = 1024, NB = 8, SEQ = 2048, MTOK = NB * SEQ, NIN = 7440, NP = 7424, NP_MAIN = 7168;
constexpr int C_Z = 0, C_X = 1024, C_B = 2048, C_C = 2176, C_Q = 2304, C_K = 2816, C_V = 3328, C_GR = 4352, C_GAM = 5376, C_GAR = 6400;
constexpr float EPS = 1e-6f;
constexpr size_t MiB = 1u << 20;
constexpr size_t WS_PROJ = 0;
constexpr size_t WS_WMF = 232 * MiB, WS_WRF = 234 * MiB, WS_WOF = 236 * MiB;
constexpr size_t WS_MOD = 238 * MiB;
constexpr size_t WS_DT = 239 * MiB;
constexpr size_t WS_SSQM = 240 * MiB;
constexpr size_t WS_SSQR = 242 * MiB;
constexpr size_t WS_CTL = 244 * MiB, CTL_BYTES = 16384;
constexpr size_t WS_WTF = 245 * MiB;
constexpr size_t WS_END = 246 * MiB;
constexpr size_t OUT_H = 0, OUT_WINT = 32 * MiB;
constexpr int LDS_BYTES = 155648, LDS_MISC = 155520;
constexpr int NTHR = 512;

struct Args { const float* in[16]; float* out; unsigned char* ws; int ph_lo, ph_hi; };

__device__ __forceinline__ float bf_lo(unsigned u) { return __uint_as_float(u << 16); }
__device__ __forceinline__ float bf_hi(unsigned u) { return __uint_as_float(u & 0xffff0000u); }
__device__ __forceinline__ unsigned pk2(float lo, float hi) { f32x2_t v = {lo, hi}; bf16x2_t b = __builtin_convertvector(v, bf16x2_t); return __builtin_bit_cast(unsigned, b); }
__device__ __forceinline__ float silu_f(float x) { return x * __builtin_amdgcn_rcpf(1.f + __expf(-x)); }
__device__ __forceinline__ float sigm_f(float x) { return __builtin_amdgcn_rcpf(1.f + __expf(-x)); }
__device__ __forceinline__ float wave_sum(float v) {
#pragma unroll
    for (int o = 1; o < 64; o <<= 1) v += __shfl_xor(v, o);
    return v;
}
__device__ __forceinline__ int crow(int reg, int h) { return (reg & 3) + 8 * (reg >> 2) + 4 * h; }
#define MFMA32(a, b, c) __builtin_amdgcn_mfma_f32_32x32x16_bf16((a), (b), (c), 0, 0, 0)
#define MFMA16(a, b, c) __builtin_amdgcn_mfma_f32_16x16x32_bf16((a), (b), (c), 0, 0, 0)
__device__ __forceinline__ s16x4 tr_read(const LAS unsigned char* p) {
    typedef short v4i16_t __attribute__((ext_vector_type(4)));
    return __builtin_bit_cast(s16x4, __builtin_amdgcn_ds_read_tr16_b64_v4i16((LAS v4i16_t*)p));
}
__device__ __forceinline__ bf16x8 tr_pair(const LAS unsigned char* plo, const LAS unsigned char* phi) {
    const s16x4 lo = tr_read(plo), hi = tr_read(phi);
    return __builtin_shufflevector(lo, hi, 0, 1, 2, 3, 4, 5, 6, 7);
}
__device__ __forceinline__ bf16x8 pack8(float a0, float a1, float a2, float a3, float a4, float a5, float a6, float a7) {
    u32x4 p; p.x = pk2(a0, a1); p.y = pk2(a2, a3); p.z = pk2(a4, a5); p.w = pk2(a6, a7);
    return __builtin_bit_cast(bf16x8, p);
}

__device__ __forceinline__ void p0_load_tile(const float* W, int ldw, int k0, int n0, LAS float* scr, int lane) {
    float t[32];
#pragma unroll
    for (int i = 0; i < 32; ++i) t[i] = W[(size_t)(k0 + 2 * i + (lane >> 5)) * ldw + n0 + (lane & 31)];
#pragma unroll
    for (int i = 0; i < 32; ++i) scr[(2 * i + (lane >> 5)) * 33 + (lane & 31)] = t[i];
}
__device__ __forceinline__ void p0_phase(const Args& a, LAS unsigned char* lds, int tid_unused, int lane_unused, int wave, int G) {
    const int lane = fresh_lane(), tid = wave * 64 + lane;
    const float* cvec = a.in[1]; const float* w_ada = a.in[2]; const float* b_ada = a.in[3];
    float* MOD = (float*)(a.ws + WS_MOD);
    LAS float* cT = (LAS float*)lds;
    LAS float* red = (LAS float*)(lds + 32768);
    if ((int)blockIdx.x < 192) {
        { float t[16];
#pragma unroll
          for (int i = 0; i < 16; ++i) t[i] = cvec[tid + 512 * i];
#pragma unroll
          for (int i = 0; i < 16; ++i) { const int idx = tid + 512 * i; cT[(idx & 1023) * 8 + (idx >> 10)] = t[i]; } }
        __syncthreads();
        for (int item = blockIdx.x; item < 192; item += G) {
            const int j0 = item * 16, col = lane & 15, rsub = lane >> 4, kq = wave;
            float w[32];
#pragma unroll
            for (int i = 0; i < 32; ++i) w[i] = w_ada[(size_t)(kq * 128 + 4 * i + rsub) * 3072 + j0 + col];
            float acc[8];
#pragma unroll
            for (int bb = 0; bb < 8; ++bb) acc[bb] = 0.f;
#pragma unroll
            for (int i = 0; i < 32; ++i) { const int k = kq * 128 + 4 * i + rsub;
                const f32x4 c0 = *(const LAS f32x4*)(cT + k * 8), c1 = *(const LAS f32x4*)(cT + k * 8 + 4);
                acc[0] += c0.x * w[i]; acc[1] += c0.y * w[i]; acc[2] += c0.z * w[i]; acc[3] += c0.w * w[i];
                acc[4] += c1.x * w[i]; acc[5] += c1.y * w[i]; acc[6] += c1.z * w[i]; acc[7] += c1.w * w[i]; }
#pragma unroll
            for (int bb = 0; bb < 8; ++bb) { acc[bb] += __shfl_xor(acc[bb], 16); acc[bb] += __shfl_xor(acc[bb], 32); }
            if (lane < 16) {
#pragma unroll
                for (int bb = 0; bb < 8; ++bb) red[(kq * 8 + bb) * 16 + col] = acc[bb]; }
            __syncthreads();
            if (tid < 128) { const int bb = tid >> 4, cc = tid & 15; float sum = 0.f;
#pragma unroll
                for (int q = 0; q < 8; ++q) sum += red[(q * 8 + bb) * 16 + cc];
                MOD[bb * 3072 + j0 + cc] = sum + b_ada[j0 + cc]; }
            __syncthreads();
        }
    }
    LAS float* scr = (LAS float*)(lds + 40960 + wave * 8448);
    const int gw = blockIdx.x * 8 + wave, NGW = G * 8;
    constexpr int I_IN = 16 * (NP / 32), I_W = 16 * 32;
    bf16* WINT = (bf16*)((unsigned char*)a.out + OUT_WINT);
    for (int it = gw; it < I_IN + 3 * I_W + 128; it += NGW) {
        if (it >= I_IN + 3 * I_W) {
            const int r_ = it - (I_IN + 3 * I_W), nt = r_ & 7, kb = r_ >> 3;
            p0_load_tile(a.in[5], NIN, 64 * kb, NP_MAIN + 16 + 32 * nt, scr, lane);
            bf16* WF = (bf16*)(a.ws + WS_WTF);
            const int r = lane & 31, h = lane >> 5;
#pragma unroll
            for (int s4 = 0; s4 < 4; ++s4) { const LAS float* s = scr + (16 * s4 + 8 * h) * 33 + r;
                u32x4 o; o.x = pk2(s[0 * 33], s[1 * 33]); o.y = pk2(s[2 * 33], s[3 * 33]); o.z = pk2(s[4 * 33], s[5 * 33]); o.w = pk2(s[6 * 33], s[7 * 33]);
                *(u32x4*)(WF + ((size_t)(nt * 64 + 4 * kb + s4) * 64 + lane) * 8) = o; }
        } else if (it < I_IN) {
            const int nblk = NP / 32, kb = it / nblk, nb = it % nblk, k0 = 64 * kb, n0p = 32 * nb, n0 = n0p + (n0p >= 2304 ? 16 : 0);
            p0_load_tile(a.in[5], NIN, k0, n0, scr, lane);
            const int c = lane & 7;
#pragma unroll
            for (int j = 0; j < 4; ++j) { const int n = (lane >> 3) + 8 * j; const LAS float* s = scr + (8 * c) * 33 + n;
                u32x4 o; o.x = pk2(s[0 * 33], s[1 * 33]); o.y = pk2(s[2 * 33], s[3 * 33]); o.z = pk2(s[4 * 33], s[5 * 33]); o.w = pk2(s[6 * 33], s[7 * 33]);
                *(u32x4*)(WINT + (size_t)(n0p + n) * 1024 + k0 + 8 * c) = o; }
        } else {
            int r_ = it - I_IN; const int which = r_ / I_W; r_ -= which * I_W;
            const float* W = a.in[12 + which];
            bf16* WF = (bf16*)(a.ws + WS_WMF + (size_t)which * 2 * MiB);
            const int nt = r_ & 31, kb = r_ >> 5;
            p0_load_tile(W, 1024, 64 * kb, 32 * nt, scr, lane);
            const int r = lane & 31, h = lane >> 5;
#pragma unroll
            for (int s4 = 0; s4 < 4; ++s4) { const LAS float* s = scr + (16 * s4 + 8 * h) * 33 + r;
                f32x4 m0 = (f32x4){1.f, 1.f, 1.f, 1.f}, m1 = m0;
                if (which == 0) { m0 = *(const f32x4*)(a.in[11] + 64 * kb + 16 * s4 + 8 * h); m1 = *(const f32x4*)(a.in[11] + 64 * kb + 16 * s4 + 8 * h + 4); }
                u32x4 o; o.x = pk2(s[0 * 33] * m0.x, s[1 * 33] * m0.y); o.y = pk2(s[2 * 33] * m0.z, s[3 * 33] * m0.w); o.z = pk2(s[4 * 33] * m1.x, s[5 * 33] * m1.y); o.w = pk2(s[6 * 33] * m1.z, s[7 * 33] * m1.w);
                *(u32x4*)(WF + ((size_t)(nt * 64 + 4 * kb + s4) * 64 + lane) * 8) = o; }
        }
    }
}

__device__ __forceinline__ void p1_phase(const Args& a, LAS unsigned char* lds, int tid_unused, int lane_unused, int wave, int G) {
    const int lane_in = fresh_lane(), tid = wave * 64 + lane_in;
    const float* x = a.in[0]; const float* norm_w = a.in[4]; const float* w_in = a.in[5]; const float* dt_bias = a.in[8];
    const float* MOD = (const float*)(a.ws + WS_MOD);
    float* DT = (float*)(a.ws + WS_DT);
    bf16* H = (bf16*)((unsigned char*)a.out + OUT_H);
    LAS float* wdt = (LAS float*)lds;
    { float t[32];
#pragma unroll
      for (int i = 0; i < 32; ++i) { const int idx = tid + NTHR * i; t[i] = w_in[(size_t)(idx >> 4) * NIN + 2304 + (idx & 15)]; }
#pragma unroll
      for (int i = 0; i < 32; ++i) { const int idx = tid + NTHR * i; wdt[(idx & 15) * 1028 + (idx >> 4)] = t[i]; } }
    __syncthreads();
    for (int blk = blockIdx.x; blk < 256; blk += G) {
        const int b = blk >> 5;
        float gk[16], sh[16];
#pragma unroll
        for (int jj = 0; jj < 4; ++jj) { const int k = 4 * lane_in + 256 * jj;
            const f32x4 nw = *(const f32x4*)(norm_w + k), sc = *(const f32x4*)(MOD + b * 3072 + 1024 + k), sf = *(const f32x4*)(MOD + b * 3072 + k);
#pragma unroll
            for (int e = 0; e < 4; ++e) { gk[4 * jj + e] = nw[e] * (1.f + sc[e]); sh[4 * jj + e] = sf[e]; } }
        f32x4 vn[2][4];
        { const int lane = fresh_lane();
#pragma unroll
          for (int rr = 0; rr < 2; ++rr)
#pragma unroll
              for (int jj = 0; jj < 4; ++jj) vn[rr][jj] = *((const f32x4*)(x + (size_t)(blk * 64 + wave * 8 + rr) * D) + lane + 64 * jj); }
        for (int g = 0; g < 4; ++g) {
            asm volatile("" ::: "memory");
            const int lane = fresh_lane();
            const int m0 = blk * 64 + wave * 8 + g * 2;
            f32x4 v[2][4];
#pragma unroll
            for (int rr = 0; rr < 2; ++rr)
#pragma unroll
                for (int jj = 0; jj < 4; ++jj) v[rr][jj] = vn[rr][jj];
            if (g + 1 < 4) {
#pragma unroll
                for (int rr = 0; rr < 2; ++rr)
#pragma unroll
                    for (int jj = 0; jj < 4; ++jj) vn[rr][jj] = *((const f32x4*)(x + (size_t)(m0 + 2 + rr) * D) + lane + 64 * jj);
            }
            __builtin_amdgcn_sched_barrier(0);
            float hv[2][16];
#pragma unroll
            for (int rr = 0; rr < 2; ++rr) {
                float ss = 0.f;
#pragma unroll
                for (int jj = 0; jj < 4; ++jj) ss += (v[rr][jj].x * v[rr][jj].x + v[rr][jj].y * v[rr][jj].y) + (v[rr][jj].z * v[rr][jj].z + v[rr][jj].w * v[rr][jj].w);
                const float rs = 1.0f / sqrtf(wave_sum(ss) * (1.f / D) + EPS);
                unsigned long long* o8 = (unsigned long long*)(H + (size_t)(m0 + rr) * D) + lane;
#pragma unroll
                for (int jj = 0; jj < 4; ++jj) {
#pragma unroll
                    for (int e = 0; e < 4; ++e) hv[rr][4 * jj + e] = v[rr][jj][e] * rs * gk[4 * jj + e] + sh[4 * jj + e];
                    o8[64 * jj] = (unsigned long long)pk2(hv[rr][4 * jj], hv[rr][4 * jj + 1]) | ((unsigned long long)pk2(hv[rr][4 * jj + 2], hv[rr][4 * jj + 3]) << 32);
                }
            }
            float acc[32];
#pragma unroll
            for (int i = 0; i < 32; ++i) acc[i] = 0.f;
#pragma unroll
            for (int j = 0; j < 16; ++j) {
#pragma unroll
                for (int jj = 0; jj < 4; ++jj) { const f32x4 w = *(const LAS f32x4*)(wdt + j * 1028 + 4 * lane + 256 * jj);
#pragma unroll
                    for (int rr = 0; rr < 2; ++rr) acc[rr * 16 + j] += (hv[rr][4 * jj] * w.x + hv[rr][4 * jj + 1] * w.y) + (hv[rr][4 * jj + 2] * w.z + hv[rr][4 * jj + 3] * w.w); }
                if ((j & 3) == 3) asm volatile("" ::: "memory");
            }
#pragma unroll
            for (int half = 16; half >= 1; half >>= 1) {
                const bool up = (lane & half) != 0;
#pragma unroll
                for (int i = 0; i < half; ++i) { float lo_ = acc[i], hi_ = acc[i + half]; asm volatile("" : "+v"(lo_), "+v"(hi_));
                    const float keep = up ? hi_ : lo_, send = up ? lo_ : hi_; acc[i] = keep + __shfl_xor(send, half); }
            }
            const float tot = acc[0] + __shfl_xor(acc[0], 32);
            const float xr_ = tot + dt_bias[lane & 15];
            const float dtv = xr_ > 20.f ? xr_ : log1pf(__expf(xr_));
            if (lane < 32) DT[(size_t)m0 * 16 + lane] = dtv;
        }
    }
}

constexpr size_t OUT_XBCC = 0;
__device__ __forceinline__ void p3a_phase(const Args& a, int wave, int G) {
    const bf16* PROJ = (const bf16*)(a.ws + WS_PROJ);
    bf16* XBCC = (bf16*)((unsigned char*)a.out + OUT_XBCC);
    const float* conv_w = a.in[6]; const float* conv_b = a.in[7];
    const int lane = fresh_lane(), tid = wave * 64 + lane;
    if (tid >= 480) return;
    const int oct = tid % 160, tgl = tid / 160;
    float cw[4][8], cb[8];
#pragma unroll
    for (int e = 0; e < 8; ++e) { cb[e] = conv_b[8 * oct + e];
#pragma unroll
        for (int k = 0; k < 4; ++k) cw[k][e] = conv_w[k * 1280 + 8 * oct + e]; }
    for (int blk = blockIdx.x; blk < 256; blk += G) {
        for (int tg = tgl; tg < 8; tg += 3) {
            const int m0 = blk * 64 + 8 * tg, ts0 = m0 & (SEQ - 1);
            const char* src = (const char*)(PROJ + (size_t)m0 * NP + C_X + 8 * oct);
            u32x4 raw[11];
#pragma unroll
            for (int i = 0; i < 11; ++i) { const bool ok = (ts0 - 3 + i) >= 0; raw[i] = ok ? *(const u32x4*)(src + ((long)i - 3) * (NP * 2)) : (u32x4){0u, 0u, 0u, 0u}; }
#pragma unroll
            for (int jj = 0; jj < 8; ++jj) {
                float o[8];
#pragma unroll
                for (int e = 0; e < 8; ++e) {
                    float s_ = cb[e];
#pragma unroll
                    for (int k = 0; k < 4; ++k) { const unsigned w = raw[jj + k][e >> 1]; s_ += cw[k][e] * ((e & 1) ? bf_hi(w) : bf_lo(w)); }
                    o[e] = silu_f(s_);
                }
                u32x4 ov; ov.x = pk2(o[0], o[1]); ov.y = pk2(o[2], o[3]); ov.z = pk2(o[4], o[5]); ov.w = pk2(o[6], o[7]);
                *(u32x4*)(XBCC + (size_t)(m0 + jj) * 1280 + 8 * oct) = ov;
            }
        }
    }
}

constexpr int TP = 72;
constexpr int L_CQ = 0, L_BK = 18432, L_BKW = 36864, L_XV = 55296, L_ST0 = 73728, L_ST1 = 82944, L_ACS = 92160, L_DTJ = 93184, L_WJ = 94208, L_CW = 95232;

__device__ __forceinline__ void p3_phase(const Args& a, LAS unsigned char* lds, int tid_in, int lane_in, int wave, int G, const bool dry = false) {
    bf16* PROJ = (bf16*)(a.ws + WS_PROJ);
    const float* DT = (const float*)(a.ws + WS_DT);
    float* SSQM = (float*)(a.ws + WS_SSQM); float* SSQR = (float*)(a.ws + WS_SSQR);
    const float* conv_w = a.in[6]; const float* conv_b = a.in[7]; const float* a_log = a.in[9]; const float* d_skip = a.in[10]; const float* m_norm_w = a.in[11];
    const int pt = wave & 1, it = wave >> 1;
#ifdef PROBE_SEL
    unsigned long long t0_ = 0ull; unsigned tacc_ = 0u;
    const bool probing = ((int)blockIdx.x == PROBE_BLK && wave == PROBE_WAVE);
#define TB(k) do { if (PROBE_SEL == (k) && probing) t0_ = __builtin_amdgcn_s_memrealtime(); } while (0)
#define TE(k) do { if (PROBE_SEL == (k) && probing) tacc_ += (unsigned)(__builtin_amdgcn_s_memrealtime() - t0_); } while (0)
#else
#define TB(k) do {} while (0)
#define TE(k) do {} while (0)
#endif
    for (int item = blockIdx.x; item < 256; item += G) {
        const int lane = fresh_lane(), tid = wave * 64 + lane;
        const int r = lane & 31, h = lane >> 5, i16 = lane & 15, q4 = i16 >> 2, p4 = i16 & 3, blk16 = (lane >> 4) & 1;
        const int xcd_ = item & 7, kk_ = item >> 3;
        const bool ssd = kk_ < 16;
        int b, hd, half;
        if (ssd) { const int pair = 2 * xcd_ + (kk_ >> 3); b = pair >> 1; hd = 8 * (pair & 1) + (kk_ & 7); half = 0; }
        else { const int t = xcd_ * 16 + (kk_ - 16); b = t >> 4; hd = (t >> 1) & 7; half = t & 1; }
        const size_t mb = (size_t)b * SEQ;
        __syncthreads();
        for (int idx = tid; idx < 9216 / 4; idx += NTHR) ((LAS unsigned*)(lds + L_ST0))[idx] = 0u;
        const float lg = ssd ? 0.f : log1pf(-exp2f(-5.0f - (float)hd));
        if (!ssd && tid < 256) { const int par = tid >> 7, j = tid & 127;
            ((LAS float*)(lds + L_ACS))[par * 128 + j] = (float)(j + 1) * lg * 1.4426950408889634f; ((LAS float*)(lds + L_DTJ))[par * 128 + j] = (float)(j + 1) * lg * 1.4426950408889634f; ((LAS float*)(lds + L_WJ))[par * 128 + j] = __expf((float)(127 - j) * lg); }
        const float Ah = ssd ? -__expf(a_log[hd]) : 0.f;
        const float Dsk = ssd ? d_skip[hd] : 0.f;
        const int ltile = 3 - (tid >> 7), loct = tid & 7, ltg = (tid >> 3) & 15;
        int lcol = 0;
        float invf[8];
        if (ssd) {
            lcol = (ltile == 0) ? (64 * hd + 8 * loct) : (ltile == 1 ? (1024 + 64 * (hd >> 3) + 8 * loct) : (1152 + 64 * (hd >> 3) + 8 * loct));
            if (ltile == 3) lcol = 1024 + 64 * (hd >> 3) + 8 * loct;
#pragma unroll
            for (int e = 0; e < 8; ++e) invf[e] = 0.f;
        } else {
#pragma unroll
            for (int e = 0; e < 8; ++e) invf[e] = exp2f(-(float)(8 * (tid & 3) + e) * (13.287712379549449f / 32.f));
        }
        f32x16 sacc;
#pragma unroll
        for (int i = 0; i < 16; ++i) sacc[i] = 0.f;
        u32x4 raw[8];
        const int rj = tid >> 2, ro4 = tid & 3;
        const int j0 = 8 * ltg;
        const char* pbase = (const char*)(PROJ + mb * NP);
        const char* xbase = (const char*)((const bf16*)((const unsigned char*)a.out + OUT_XBCC) + mb * 1280);
        const unsigned soff = (unsigned)((j0 * 1280 + lcol) * 2);
        const unsigned roff = (unsigned)((rj * NP) * 2);
#define P3_ISSUE(cc) do { const char* cbp = pbase + (size_t)(cc) * (128 * NP * 2); \
        if (ssd) { const char* xp = xbase + (size_t)(cc) * (128 * 1280 * 2) + soff; _Pragma("unroll") for (int i = 0; i < 8; ++i) raw[i] = *(const u32x4*)(xp + i * (1280 * 2)); } \
        else { const char* rp = cbp + roff; \
            raw[0] = *(const u32x4*)(rp + (C_Q + 64 * hd + 8 * ro4) * 2); raw[1] = *(const u32x4*)(rp + (C_Q + 64 * hd + 32 + 8 * ro4) * 2); \
            raw[2] = *(const u32x4*)(rp + (C_K + 64 * hd + 8 * ro4) * 2); raw[3] = *(const u32x4*)(rp + (C_K + 64 * hd + 32 + 8 * ro4) * 2); \
            raw[4] = *(const u32x4*)(rp + (C_V + 128 * hd + 64 * half + 16 * ro4) * 2); raw[5] = *(const u32x4*)(rp + (C_V + 128 * hd + 64 * half + 16 * ro4 + 8) * 2); } } while (0)
        float dq0 = 0.f, dq1 = 0.f;
#define P3_SCAN(cc) do { LAS float* ACSw = (LAS float*)(lds + L_ACS) + ((cc) & 1) * 128; LAS float* DTJw = (LAS float*)(lds + L_DTJ) + ((cc) & 1) * 128; LAS float* WJw = (LAS float*)(lds + L_WJ) + ((cc) & 1) * 128; \
        const float v0 = dq0 * Ah, v1 = dq1 * Ah, s_ = v0 + v1; float incl = s_; \
        _Pragma("unroll") for (int o = 1; o < 64; o <<= 1) { const float t = __shfl_up(incl, o); if (lane >= o) incl += t; } \
        const float c0 = (incl - s_) + v0, tot = __shfl(incl, 63), c1 = (lane == 63) ? tot : c0 + v1; \
        ACSw[2 * lane] = c0 * 1.4426950408889634f; ACSw[2 * lane + 1] = c1 * 1.4426950408889634f; \
        DTJw[2 * lane] = c0 * 1.4426950408889634f - __log2f(dq0); DTJw[2 * lane + 1] = c1 * 1.4426950408889634f - __log2f(dq1); \
        WJw[2 * lane] = dq0 * __expf(tot - c0); WJw[2 * lane + 1] = dq1 * __expf(tot - c1); } while (0)
#define P3_DTLOAD(cc) do { dq0 = DT[(mb + (size_t)(cc) * 128 + 2 * lane) * 16 + hd]; dq1 = DT[(mb + (size_t)(cc) * 128 + 2 * lane + 1) * 16 + hd]; } while (0)
        if (ssd && wave == 0) { P3_DTLOAD(0); P3_SCAN(0); P3_DTLOAD(1); }
        u32x2 zzn[4];
        { const bf16* orow0 = PROJ + (mb + 16 * wave + i16) * NP + (ssd ? (C_Z + 64 * hd) : (C_GR + 128 * hd + 64 * half));
#pragma unroll
          for (int g4 = 0; g4 < 4; ++g4) zzn[g4] = *(const u32x2*)(orow0 + 16 * g4 + 4 * (lane >> 4)); }
        P3_ISSUE(0);

        TB(1);
        for (int c = 0; c < 16; ++c) {
            const int par = c & 1;
            const size_t m0 = mb + (size_t)c * 128;
            LAS float* ACS = (LAS float*)(lds + L_ACS) + par * 128; LAS float* DTJ = (LAS float*)(lds + L_DTJ) + par * 128; LAS float* WJ = (LAS float*)(lds + L_WJ) + par * 128;
            TB(5);
            __syncthreads();
            TE(5); TB(2);
#ifndef P3_REPL
#define P3_REPL 1
#endif
            _Pragma("nounroll") for (int repl_ = 0; repl_ < P3_REPL; ++repl_) {
            if (repl_) __syncthreads();
            if (ssd) {
                {
                    LAS unsigned char* dst = lds + (ltile == 0 ? L_XV : (ltile == 1 ? L_BK : (ltile == 2 ? L_CQ : L_BKW)));
#pragma unroll
                    for (int jj = 0; jj < 8; ++jj) {
                        u32x4 v = raw[jj];
                        if (ltile == 3) { const float wj = WJ[j0 + jj];
                            v.x = pk2(bf_lo(v.x) * wj, bf_hi(v.x) * wj); v.y = pk2(bf_lo(v.y) * wj, bf_hi(v.y) * wj); v.z = pk2(bf_lo(v.z) * wj, bf_hi(v.z) * wj); v.w = pk2(bf_lo(v.w) * wj, bf_hi(v.w) * wj); }
                        *(LAS u32x4*)(dst + ((j0 + jj) * TP + 8 * loct) * 2) = v;
                    }
                }
            } else {
                const int j = rj, o4 = ro4;
                const u32x4 q1 = raw[0], q2 = raw[1], k1 = raw[2], k2 = raw[3];
                const float pos = (float)(c * 128 + j), wj = WJ[j];
                float ql[8], qh[8], kl[8], kh[8];
#pragma unroll
                for (int e = 0; e < 8; ++e) {
                    const float rev = pos * invf[e] * 0.15915494309189535f, fr = rev - floorf(rev);
                    const float cs = __builtin_amdgcn_cosf(fr), sn = __builtin_amdgcn_sinf(fr);
                    const unsigned wq1 = q1[e >> 1], wq2 = q2[e >> 1], wk1 = k1[e >> 1], wk2 = k2[e >> 1];
                    const float a1 = (e & 1) ? bf_hi(wq1) : bf_lo(wq1), a2 = (e & 1) ? bf_hi(wq2) : bf_lo(wq2);
                    const float b1 = ((e & 1) ? bf_hi(wk1) : bf_lo(wk1)) * 0.125f, b2 = ((e & 1) ? bf_hi(wk2) : bf_lo(wk2)) * 0.125f;
                    ql[e] = a1 * cs - a2 * sn; qh[e] = a1 * sn + a2 * cs;
                    kl[e] = b1 * cs - b2 * sn; kh[e] = b1 * sn + b2 * cs;
                }
                u32x4 t;
                t.x = pk2(ql[0], ql[1]); t.y = pk2(ql[2], ql[3]); t.z = pk2(ql[4], ql[5]); t.w = pk2(ql[6], ql[7]); *(LAS u32x4*)(lds + L_CQ + (j * TP + 8 * o4) * 2) = t;
                t.x = pk2(qh[0], qh[1]); t.y = pk2(qh[2], qh[3]); t.z = pk2(qh[4], qh[5]); t.w = pk2(qh[6], qh[7]); *(LAS u32x4*)(lds + L_CQ + (j * TP + 32 + 8 * o4) * 2) = t;
                t.x = pk2(kl[0], kl[1]); t.y = pk2(kl[2], kl[3]); t.z = pk2(kl[4], kl[5]); t.w = pk2(kl[6], kl[7]); *(LAS u32x4*)(lds + L_BK + (j * TP + 8 * o4) * 2) = t;
                t.x = pk2(kh[0], kh[1]); t.y = pk2(kh[2], kh[3]); t.z = pk2(kh[4], kh[5]); t.w = pk2(kh[6], kh[7]); *(LAS u32x4*)(lds + L_BK + (j * TP + 32 + 8 * o4) * 2) = t;
                t.x = pk2(kl[0] * wj, kl[1] * wj); t.y = pk2(kl[2] * wj, kl[3] * wj); t.z = pk2(kl[4] * wj, kl[5] * wj); t.w = pk2(kl[6] * wj, kl[7] * wj); *(LAS u32x4*)(lds + L_BKW + (j * TP + 8 * o4) * 2) = t;
                t.x = pk2(kh[0] * wj, kh[1] * wj); t.y = pk2(kh[2] * wj, kh[3] * wj); t.z = pk2(kh[4] * wj, kh[5] * wj); t.w = pk2(kh[6] * wj, kh[7] * wj); *(LAS u32x4*)(lds + L_BKW + (j * TP + 32 + 8 * o4) * 2) = t;
                *(LAS u32x4*)(lds + L_XV + (j * TP + 16 * o4) * 2) = raw[4]; *(LAS u32x4*)(lds + L_XV + (j * TP + 16 * o4 + 8) * 2) = raw[5];
            }
            }
            TE(2); TB(6);
            __syncthreads();
            TE(6); TB(3);
            const int q16 = lane >> 4, iTok = 16 * wave + i16;
            bf16* orow = PROJ + (m0 + iTok) * NP + (ssd ? (C_Z + 64 * hd) : (C_GR + 128 * hd + 64 * half));
            u32x2 zz[4];
#pragma unroll
            for (int g4 = 0; g4 < 4; ++g4) zz[g4] = zzn[g4];
            if (c + 1 < 16) {
#pragma unroll
                for (int g4 = 0; g4 < 4; ++g4) zzn[g4] = *(const u32x2*)(orow + 128 * NP + 16 * g4 + 4 * q16);
                P3_ISSUE(c + 1);
            }
            __builtin_amdgcn_sched_barrier(0);
            if (ssd && wave == 0 && c + 1 < 16) { P3_SCAN(c + 1); if (c + 2 < 16) P3_DTLOAD(c + 2); }
#ifndef P3_REPC
#define P3_REPC 1
#endif
            f32x16 acc;
            float acs_i = 0.f;
            LAS unsigned char* STw = lds + (par ? L_ST0 : L_ST1);
            _Pragma("nounroll") for (int repc_ = 0; repc_ < P3_REPC; ++repc_) {
            bf16x8 cqb[2];
#pragma unroll
            for (int s = 0; s < 2; ++s) cqb[s] = *(const LAS bf16x8*)(lds + L_CQ + (iTok * TP + 32 * s + 8 * q16) * 2);
            const LAS unsigned char* STr = lds + (par ? L_ST1 : L_ST0);
#pragma unroll
            for (int i = 0; i < 16; ++i) acc[i] = 0.f;
            f32x4 ya[4];
#pragma unroll
            for (int p4t = 0; p4t < 4; ++p4t) { ya[p4t] = (f32x4){0.f, 0.f, 0.f, 0.f};
#pragma unroll
                for (int s = 0; s < 2; ++s) { const bf16x8 sa = *(const LAS bf16x8*)(STr + ((16 * p4t + i16) * TP + 32 * s + 8 * q16) * 2); ya[p4t] = MFMA16(sa, cqb[s], ya[p4t]); } }
            acs_i = ACS[iTok];
            { const float ei = __builtin_amdgcn_exp2f(acs_i);
#pragma unroll
              for (int p4t = 0; p4t < 4; ++p4t) ya[p4t] = ya[p4t] * ei; }
            const int nblk = (wave >> 1) + 1;
            bf16x8 kq0[2], kq1[2];
#pragma unroll
            for (int s = 0; s < 2; ++s) { kq0[s] = *(const LAS bf16x8*)(lds + L_BK + (i16 * TP + 32 * s + 8 * q16) * 2); kq1[s] = *(const LAS bf16x8*)(lds + L_BK + ((16 + i16) * TP + 32 * s + 8 * q16) * 2); }
            for (int jb = 0; jb < nblk; ++jb) {
                const int j0 = 32 * jb;
                f32x4 t0 = (f32x4){0.f, 0.f, 0.f, 0.f}, t1 = t0;
#pragma unroll
                for (int s = 0; s < 2; ++s) { t0 = MFMA16(kq0[s], cqb[s], t0); t1 = MFMA16(kq1[s], cqb[s], t1); }
#pragma unroll
                for (int s = 0; s < 2; ++s) { kq0[s] = *(const LAS bf16x8*)(lds + L_BK + ((j0 + 32 + i16) * TP + 32 * s + 8 * q16) * 2); kq1[s] = *(const LAS bf16x8*)(lds + L_BK + ((j0 + 48 + i16) * TP + 32 * s + 8 * q16) * 2); }
                const f32x4 b0 = *(const LAS f32x4*)(DTJ + j0 + 4 * q16), b1 = *(const LAS f32x4*)(DTJ + j0 + 16 + 4 * q16);
                bf16x8 xa[4];
#pragma unroll
                for (int p4t = 0; p4t < 4; ++p4t) { const LAS unsigned char* xb = lds + L_XV + ((j0 + 4 * q16 + q4) * TP + 16 * p4t + 4 * p4) * 2; xa[p4t] = tr_pair(xb, xb + 16 * TP * 2); }
                __builtin_amdgcn_sched_barrier(0);
                const bool lastb = (jb == nblk - 1);
                float pv[8];
#pragma unroll
                for (int e = 0; e < 4; ++e) {
                    float v0 = t0[e] * __builtin_amdgcn_exp2f(acs_i - b0[e]), v1 = t1[e] * __builtin_amdgcn_exp2f(acs_i - b1[e]);
                    if (lastb && (j0 + 4 * q16 + e) > iTok) v0 = 0.f;
                    if (lastb && (j0 + 16 + 4 * q16 + e) > iTok) v1 = 0.f;
                    pv[e] = v0; pv[4 + e] = v1;
                }
                const bf16x8 pf = pack8(pv[0], pv[1], pv[2], pv[3], pv[4], pv[5], pv[6], pv[7]);
#pragma unroll
                for (int p4t = 0; p4t < 4; ++p4t) ya[p4t] = MFMA16(xa[p4t], pf, ya[p4t]);
            }
#pragma unroll
            for (int p4t = 0; p4t < 4; ++p4t)
#pragma unroll
                for (int e = 0; e < 4; ++e) acc[4 * p4t + e] = ya[p4t][e];
            }
            TE(3); TB(4);
            if (it < 2 && c < 15) {
                const int nt = it;
                const float dec = __builtin_amdgcn_exp2f(ACS[127]);
#pragma unroll
                for (int i = 0; i < 16; ++i) sacc[i] *= dec;
                f32x16 sacc2;
#pragma unroll
                for (int i = 0; i < 16; ++i) sacc2[i] = 0.f;
#pragma unroll
                for (int ks = 0; ks < 8; ++ks) {
                    const LAS unsigned char* xb = lds + L_XV + ((16 * ks + 8 * h + q4) * TP + 32 * pt + 16 * blk16 + 4 * p4) * 2;
                    const LAS unsigned char* kb = lds + L_BKW + ((16 * ks + 8 * h + q4) * TP + 32 * nt + 16 * blk16 + 4 * p4) * 2;
                    const bf16x8 xa = tr_pair(xb, xb + 4 * TP * 2), kbf = tr_pair(kb, kb + 4 * TP * 2);
                    if (ks & 1) sacc2 = MFMA32(xa, kbf, sacc2); else sacc = MFMA32(xa, kbf, sacc);
                }
#pragma unroll
                for (int i = 0; i < 16; ++i) sacc[i] += sacc2[i];
#pragma unroll
                for (int i = 0; i < 16; ++i) { const int p = 32 * pt + crow(i, h);
                    *(LAS unsigned short*)(STw + (p * TP + 32 * nt + r) * 2) = (unsigned short)(pk2(sacc[i], 0.f) & 0xffffu); }
            }
            {
                float ss = 0.f;
#pragma unroll
                for (int g4 = 0; g4 < 4; ++g4) {
                    const int p = 16 * g4 + 4 * q16;
                    const float z0 = bf_lo(zz[g4].x), z1 = bf_hi(zz[g4].x), z2 = bf_lo(zz[g4].y), z3 = bf_hi(zz[g4].y);
                    float y0 = acc[4 * g4], y1 = acc[4 * g4 + 1], y2 = acc[4 * g4 + 2], y3 = acc[4 * g4 + 3];
                    float o0, o1, o2, o3;
                    if (ssd) {
                        const u32x2 xv = *(const LAS u32x2*)(lds + L_XV + (iTok * TP + p) * 2);
                        y0 = (y0 + Dsk * bf_lo(xv.x)) * silu_f(z0); y1 = (y1 + Dsk * bf_hi(xv.x)) * silu_f(z1); y2 = (y2 + Dsk * bf_lo(xv.y)) * silu_f(z2); y3 = (y3 + Dsk * bf_hi(xv.y)) * silu_f(z3);
                        ss += (y0 * y0 + y1 * y1) + (y2 * y2 + y3 * y3);
                        o0 = y0; o1 = y1; o2 = y2; o3 = y3;
                    } else {
                        ss += (y0 * y0 + y1 * y1) + (y2 * y2 + y3 * y3);
                        o0 = y0 * silu_f(z0); o1 = y1 * silu_f(z1); o2 = y2 * silu_f(z2); o3 = y3 * silu_f(z3);
                    }
                    u32x2 ov; ov.x = pk2(o0, o1); ov.y = pk2(o2, o3);
                    if (dry) *(u32x2*)((bf16*)((unsigned char*)a.out + 40 * MiB) + (m0 + iTok) * 512 + ((64 * hd + 64 * half + p) & 511)) = ov; else *(u32x2*)(orow + p) = ov;
                }
                ss += __shfl_xor(ss, 16); ss += __shfl_xor(ss, 32);
                if (q16 < 2) { const float sv = (q16 == 0) ? ss : 0.f;
                    if (ssd) SSQM[(m0 + iTok) * 32 + hd * 2 + q16] = sv; else SSQR[(m0 + iTok) * 32 + hd * 4 + half * 2 + q16] = sv; }
            }
            TE(4);
        }
        TE(1);
#undef P3_ISSUE
#undef P3_SCAN
#undef P3_DTLOAD
    }
#ifdef PROBE_SEL
    if (probing && fresh_lane() == 0) ((unsigned*)(a.ws + WS_CTL))[4000] = tacc_;
#endif
#undef TB
#undef TE
}

constexpr int MP = 1032;
constexpr int L4_MERGED = 0, L4_ASTG = 132096, L4_RM = 150528, L4_RR = 151040, L4_RED = 153088, L4_RS = 155136;
static_assert(L4_RS + 256 <= LDS_BYTES, "P4 LDS map");

__device__ __forceinline__ void p4_panel_load(u32x4 (&ar)[16], const bf16* Abase, int tid) {
    const int srow = tid >> 3, soct = tid & 7; const int rot = ((int)blockIdx.x >> 3) & 15;
    const char* ab = (const char*)Abase; const unsigned aoff = (unsigned)((srow * NP + 8 * soct) * 2);
#pragma unroll
    for (int i = 0; i < 16; ++i) ar[i] = *(const u32x4*)(ab + ((rot + i) & 15) * 128 + aoff);
}
template <int SEGSHIFT>
__device__ __forceinline__ void p4_gemmT(f32x16 (&accT)[2][2], u32x4 (&ar)[16], const bf16* Anext  , const LAS float* rsc  , int nseg,
                                         const bf16* WF  , int nt0  , LAS unsigned char* lds, int tid, int lane) {
    const int srow = tid >> 3, soct = tid & 7, r = lane & 31, h = lane >> 5;
    const char* wb = (const char*)WF + (size_t)nt0 * 65536; const unsigned woff = (unsigned)(lane * 16);
    const int rot = ((int)blockIdx.x >> 3) & 15;
    bf16x8 wc[4][2];
    { const char* wk0 = wb + rot * 4096;
#pragma unroll
      for (int s = 0; s < 4; ++s) { wc[s][0] = *(const bf16x8*)(wk0 + s * 1024 + woff); wc[s][1] = *(const bf16x8*)(wk0 + 65536 + s * 1024 + woff); } }
#define P4_STAGE_WRITE(ki_) do { const int kc_ = ((ki_) + rot) & 15; const float sc = rsc[srow * nseg + ((kc_ * 64) >> SEGSHIFT)]; \
        u32x4 o; \
        o.x = pk2(bf_lo(ar[ki_].x) * sc, bf_hi(ar[ki_].x) * sc); o.y = pk2(bf_lo(ar[ki_].y) * sc, bf_hi(ar[ki_].y) * sc); \
        o.z = pk2(bf_lo(ar[ki_].z) * sc, bf_hi(ar[ki_].z) * sc); o.w = pk2(bf_lo(ar[ki_].w) * sc, bf_hi(ar[ki_].w) * sc); \
        *(LAS u32x4*)(lds + L4_ASTG + ((ki_) & 1) * 9216 + (srow * TP + 8 * soct) * 2) = o; } while (0)
    P4_STAGE_WRITE(0);
#pragma unroll
    for (int ki = 0; ki < 16; ++ki) {
        const int kc = (ki + rot) & 15;
        LAS unsigned char* stg = lds + L4_ASTG + (ki & 1) * 9216;
        __syncthreads();
        if (ki + 1 < 16) P4_STAGE_WRITE(ki + 1);
        const int kn = (kc + 1) & 15;
        const char* wk = wb + kn * 4096;
        bf16x8 a0 = *(const LAS bf16x8*)(stg + (r * TP + 8 * h) * 2), a1 = *(const LAS bf16x8*)(stg + ((32 + r) * TP + 8 * h) * 2);
#pragma unroll
        for (int s = 0; s < 4; ++s) {
            bf16x8 n0 = a0, n1 = a1;
            if (s < 3) { n0 = *(const LAS bf16x8*)(stg + (r * TP + 16 * (s + 1) + 8 * h) * 2); n1 = *(const LAS bf16x8*)(stg + ((32 + r) * TP + 16 * (s + 1) + 8 * h) * 2); }
            accT[0][0] = MFMA32(wc[s][0], a0, accT[0][0]); accT[0][1] = MFMA32(wc[s][1], a0, accT[0][1]);
            accT[1][0] = MFMA32(wc[s][0], a1, accT[1][0]); accT[1][1] = MFMA32(wc[s][1], a1, accT[1][1]);
            wc[s][0] = *(const bf16x8*)(wk + s * 1024 + woff); wc[s][1] = *(const bf16x8*)(wk + 65536 + s * 1024 + woff);
            __builtin_amdgcn_sched_barrier(0);
            a0 = n0; a1 = n1;
        }
    }
#undef P4_STAGE_WRITE
    p4_panel_load(ar, Anext, tid);
    __builtin_amdgcn_sched_barrier(0);
    __syncthreads();
}


__device__ __forceinline__ void tail_gemmT(f32x16 (&accT)[2], const bf16* Abase  , const bf16* WF  , int nt  , LAS unsigned char* lds, int tid, int lane) {
    const int srow = tid >> 3, soct = tid & 7, r = lane & 31, h = lane >> 5;
    const char* ab = (const char*)Abase; const unsigned aoff = (unsigned)((srow * 1024 + 8 * soct) * 2);
    const char* wb = (const char*)WF + (size_t)nt * 65536; const unsigned woff = (unsigned)(lane * 16);
    const int rot = ((int)blockIdx.x >> 3) & 15;
    u32x4 ar[16];
#pragma unroll
    for (int i = 0; i < 16; ++i) ar[i] = *(const u32x4*)(ab + ((rot + i) & 15) * 128 + aoff);
    bf16x8 wc[4];
    { const char* wk0 = wb + rot * 4096;
#pragma unroll
      for (int s = 0; s < 4; ++s) wc[s] = *(const bf16x8*)(wk0 + s * 1024 + woff); }
#pragma unroll
    for (int ki = 0; ki < 16; ++ki) {
        const int kc = (ki + rot) & 15;
        LAS unsigned char* stg = lds + L4_ASTG + (ki & 1) * 9216;
        *(LAS u32x4*)(stg + (srow * TP + 8 * soct) * 2) = ar[ki];
        __syncthreads();
        const char* wk = wb + ((kc + 1) & 15) * 4096;
#pragma unroll
        for (int s = 0; s < 4; ++s) {
            const bf16x8 a0 = *(const LAS bf16x8*)(stg + (r * TP + 16 * s + 8 * h) * 2), a1 = *(const LAS bf16x8*)(stg + ((32 + r) * TP + 16 * s + 8 * h) * 2);
            accT[0] = MFMA32(wc[s], a0, accT[0]); accT[1] = MFMA32(wc[s], a1, accT[1]);
            wc[s] = *(const bf16x8*)(wk + s * 1024 + woff);
            __builtin_amdgcn_sched_barrier(0);
        }
    }
    __syncthreads();
}

__device__ __forceinline__ void p4_phase(const Args& a, LAS unsigned char* lds, int tid_in, int lane_in, int wave, int G) {
    const bf16* PROJ = (const bf16*)(a.ws + WS_PROJ);
    const float* SSQM = (const float*)(a.ws + WS_SSQM); const float* SSQR = (const float*)(a.ws + WS_SSQR);
    const float* MOD = (const float*)(a.ws + WS_MOD);
    const bf16* WMF = (const bf16*)(a.ws + WS_WMF); const bf16* WRF = (const bf16*)(a.ws + WS_WRF); const bf16* WOF = (const bf16*)(a.ws + WS_WOF);
    const float* x = a.in[0]; const float* fw = a.in[15]; float* out = a.out;
    LAS float* RM = (LAS float*)(lds + L4_RM); LAS float* RR = (LAS float*)(lds + L4_RR); LAS float* RED = (LAS float*)(lds + L4_RED); LAS float* RS = (LAS float*)(lds + L4_RS);
    for (int blk = blockIdx.x; blk < 256; blk += G) {
        const size_t m0 = (size_t)blk * 64; const int b = blk >> 5;
        int lane = fresh_lane(), tid = wave * 64 + lane, r = lane & 31, h = lane >> 5;
        u32x4 ar[16];
        p4_panel_load(ar, PROJ + m0 * NP + C_Z, tid);
        __syncthreads();
        { const int row = tid >> 3, sub = tid & 7;
          const f32x4 qv = *(const f32x4*)(SSQR + (m0 + row) * 32 + 4 * sub);
          RR[row * 8 + sub] = 1.0f / sqrtf(((qv.x + qv.y) + (qv.z + qv.w)) * (1.f / 128.f) + EPS);
          if (sub < 2) { float s = 0.f;
#pragma unroll
              for (int i = 0; i < 4; ++i) { const f32x4 v = *(const f32x4*)(SSQM + (m0 + row) * 32 + 16 * sub + 4 * i); s += (v.x + v.y) + (v.z + v.w); }
              RM[row * 2 + sub] = 1.0f / sqrtf(s * (1.f / 512.f) + EPS); } }
        __syncthreads();
#ifndef P4_SKIP1
#ifndef P4_REP1
#define P4_REP1 1
#endif
        for (int nh_ = 0; nh_ < 2 * P4_REP1; ++nh_) {
            const int nh = nh_ & 1;
            lane = fresh_lane(); tid = wave * 64 + lane; r = lane & 31; h = lane >> 5;
            const int nt0 = 16 * nh + 2 * wave;
            const bf16* pblk = PROJ + m0 * NP;
            f32x16 accT[2][2];
#pragma unroll
            for (int i = 0; i < 2; ++i)
#pragma unroll
                for (int j = 0; j < 2; ++j)
#pragma unroll
                    for (int e = 0; e < 16; ++e) accT[i][j][e] = 0.f;
            u32x2 gpre[2][2][4];
            { const unsigned lo0 = (unsigned)((r * NP + 4 * h) * 2); const char* gb0 = (const char*)(pblk + C_GAM + 32 * nt0);
#pragma unroll
              for (int rt = 0; rt < 2; ++rt)
#pragma unroll
                  for (int ct = 0; ct < 2; ++ct)
#pragma unroll
                      for (int g4 = 0; g4 < 4; ++g4) gpre[rt][ct][g4] = *(const u32x2*)(gb0 + (lo0 + (unsigned)((32 * rt * NP + 32 * ct + 8 * g4) * 2)));
              __builtin_amdgcn_sched_barrier(0); }
            p4_gemmT<9>(accT, ar, pblk + C_GR, RM, 2, WMF, nt0, lds, tid, lane);
            {
                lane = fresh_lane(); r = lane & 31; h = lane >> 5;
                const unsigned lm = launder((unsigned)(L4_MERGED + (r * MP + 4 * h) * 2));
#pragma unroll
                for (int rt = 0; rt < 2; ++rt)
#pragma unroll
                    for (int ct = 0; ct < 2; ++ct)
#pragma unroll
                        for (int g4 = 0; g4 < 4; ++g4) {
                            const u32x2 gg = gpre[rt][ct][g4];
                            u32x2 ov; ov.x = pk2(accT[rt][ct][4 * g4] * sigm_f(bf_lo(gg.x)), accT[rt][ct][4 * g4 + 1] * sigm_f(bf_hi(gg.x)));
                            ov.y = pk2(accT[rt][ct][4 * g4 + 2] * sigm_f(bf_lo(gg.y)), accT[rt][ct][4 * g4 + 3] * sigm_f(bf_hi(gg.y)));
                            *(LAS u32x2*)(lds + lm + (unsigned)((32 * rt * MP + 32 * (nt0 + ct) + 8 * g4) * 2)) = ov; }
            }
#pragma unroll
            for (int i = 0; i < 2; ++i)
#pragma unroll
                for (int j = 0; j < 2; ++j)
#pragma unroll
                    for (int e = 0; e < 16; ++e) accT[i][j][e] = 0.f;
            lane = fresh_lane(); tid = wave * 64 + lane; r = lane & 31; h = lane >> 5;
            { const unsigned lo0 = (unsigned)((r * NP + 4 * h) * 2); const char* gb0 = (const char*)(pblk + C_GAR + 32 * nt0);
#pragma unroll
              for (int rt = 0; rt < 2; ++rt)
#pragma unroll
                  for (int ct = 0; ct < 2; ++ct)
#pragma unroll
                      for (int g4 = 0; g4 < 4; ++g4) gpre[rt][ct][g4] = *(const u32x2*)(gb0 + (lo0 + (unsigned)((32 * rt * NP + 32 * ct + 8 * g4) * 2)));
              __builtin_amdgcn_sched_barrier(0); }
            p4_gemmT<7>(accT, ar, pblk + C_Z, RR, 8, WRF, nt0, lds, tid, lane);
            {
                lane = fresh_lane(); r = lane & 31; h = lane >> 5;
                const unsigned lm = launder((unsigned)(L4_MERGED + (r * MP + 4 * h) * 2));
#pragma unroll
                for (int rt = 0; rt < 2; ++rt)
#pragma unroll
                    for (int ct = 0; ct < 2; ++ct)
#pragma unroll
                        for (int g4 = 0; g4 < 4; ++g4) {
                            const u32x2 gg = gpre[rt][ct][g4];
                            LAS u32x2* mp = (LAS u32x2*)(lds + lm + (unsigned)((32 * rt * MP + 32 * (nt0 + ct) + 8 * g4) * 2));
                            const u32x2 pm = *mp;
                            const float v0 = bf_lo(pm.x) + accT[rt][ct][4 * g4] * sigm_f(bf_lo(gg.x)), v1 = bf_hi(pm.x) + accT[rt][ct][4 * g4 + 1] * sigm_f(bf_hi(gg.x));
                            const float v2 = bf_lo(pm.y) + accT[rt][ct][4 * g4 + 2] * sigm_f(bf_lo(gg.y)), v3 = bf_hi(pm.y) + accT[rt][ct][4 * g4 + 3] * sigm_f(bf_hi(gg.y));
                            u32x2 ov; ov.x = pk2(v0, v1); ov.y = pk2(v2, v3);
                            *mp = ov; }
            }
        }
#endif
        __syncthreads();
        lane = fresh_lane(); tid = wave * 64 + lane; r = lane & 31; h = lane >> 5;
#ifndef P4_SKIP2
#ifndef P4_REP2
#define P4_REP2 1
#endif
        _Pragma("nounroll") for (int rep2_ = 0; rep2_ < P4_REP2; ++rep2_) {
            if (rep2_) { __syncthreads(); lane = fresh_lane(); tid = wave * 64 + lane; r = lane & 31; h = lane >> 5; }
            f32x16 acc[2][4];
#pragma unroll
            for (int i = 0; i < 2; ++i)
#pragma unroll
                for (int j = 0; j < 4; ++j)
#pragma unroll
                    for (int e = 0; e < 16; ++e) acc[i][j][e] = 0.f;
            const char* wb = (const char*)WOF + (size_t)(4 * wave) * 65536; const unsigned woff = (unsigned)(lane * 16);
            const int rot2 = ((int)blockIdx.x >> 3) & 31;
            bf16x8 wc[2][4];
#pragma unroll
            for (int s = 0; s < 2; ++s)
#pragma unroll
                for (int ct = 0; ct < 4; ++ct) wc[s][ct] = *(const bf16x8*)(wb + ct * 65536 + (2 * rot2 + s) * 1024 + woff);
            const LAS unsigned char* ma = lds + L4_MERGED + (r * MP + 8 * h) * 2;
            bf16x8 a0 = *(const LAS bf16x8*)(ma + (2 * rot2) * 32), a1 = *(const LAS bf16x8*)(ma + 32 * MP * 2 + (2 * rot2) * 32);
            for (int ki = 0; ki < 32; ++ki) {
                const int kp = (ki + rot2) & 31, kpn = (kp + 1) & 31;
#pragma unroll
                for (int s = 0; s < 2; ++s) {
                    const int ksn = (s == 0) ? 2 * kp + 1 : 2 * kpn;
                    const bf16x8 n0 = *(const LAS bf16x8*)(ma + ksn * 32), n1 = *(const LAS bf16x8*)(ma + 32 * MP * 2 + ksn * 32);
#pragma unroll
                    for (int ct = 0; ct < 4; ++ct) { acc[0][ct] = MFMA32(a0, wc[s][ct], acc[0][ct]); acc[1][ct] = MFMA32(a1, wc[s][ct], acc[1][ct]); }
#pragma unroll
                    for (int ct = 0; ct < 4; ++ct) wc[s][ct] = *(const bf16x8*)(wb + ct * 65536 + (2 * kpn + s) * 1024 + woff);
                    __builtin_amdgcn_sched_barrier(0);
                    a0 = n0; a1 = n1;
                }
            }
            lane = fresh_lane(); r = lane & 31; h = lane >> 5;
            const char* xblk = (const char*)(x + m0 * D); char* oblk = (char*)(out + m0 * D);
            const unsigned eo = launder((unsigned)(4 * (4 * h * D + 128 * wave + r)));
            const unsigned rb = launder((unsigned)(L4_RED + (4 * h * 8 + wave) * 4));
            float gate[4], fwv[4];
#pragma unroll
            for (int ct = 0; ct < 4; ++ct) { const int n = 32 * (4 * wave + ct) + r; gate[ct] = MOD[b * 3072 + 2048 + n]; fwv[ct] = fw[n]; }
            float xv[2][8][4];
#define P4_XLOAD(buf, bidx) do { _Pragma("unroll") for (int e = 0; e < 8; ++e) _Pragma("unroll") for (int ct = 0; ct < 4; ++ct) \
                xv[buf][e][ct] = *(const float*)(xblk + (eo + (unsigned)(((32 * ((bidx) >> 1) + (e & 3) + 8 * (2 * ((bidx) & 1) + (e >> 2))) * D + 32 * ct) * 4))); } while (0)
            P4_XLOAD(0, 0);
#pragma unroll
            for (int bi = 0; bi < 4; ++bi) {
                const int rt = bi >> 1, g8 = bi & 1;
                if (bi + 1 < 4) P4_XLOAD((bi + 1) & 1, bi + 1);
                __builtin_amdgcn_sched_barrier(0);
#pragma unroll
                for (int e = 0; e < 8; ++e) {
                    const int reg = 8 * g8 + e, rowc = 32 * rt + (reg & 3) + 8 * (reg >> 2);
                    float s = 0.f;
#pragma unroll
                    for (int ct = 0; ct < 4; ++ct) { const float v = xv[bi & 1][e][ct] + gate[ct] * acc[rt][ct][reg]; acc[rt][ct][reg] = v; s += v * v; }
                    s += __shfl_xor(s, 16); s += __shfl_xor(s, 8); s += __shfl_xor(s, 4); s += __shfl_xor(s, 2); s += __shfl_xor(s, 1);
                    *(LAS float*)(lds + rb + (unsigned)(rowc * 32)) = s;
                }
                asm volatile("" ::: "memory"); __builtin_amdgcn_sched_barrier(0);
            }
#undef P4_XLOAD
            __syncthreads();
            if (tid < 64) { float s = 0.f;
#pragma unroll
                for (int w = 0; w < 8; ++w) s += RED[tid * 8 + w];
                RS[tid] = 1.0f / sqrtf(s * (1.f / D) + EPS); }
            __syncthreads();
            const unsigned eo2 = launder(eo);
            const unsigned sb = launder((unsigned)(L4_RS + 4 * h * 4));
#pragma unroll
            for (int rt = 0; rt < 2; ++rt)
#pragma unroll
                for (int reg = 0; reg < 16; ++reg) {
                    const int rowc = 32 * rt + (reg & 3) + 8 * (reg >> 2); const float rs = *(const LAS float*)(lds + sb + (unsigned)(rowc * 4));
#pragma unroll
                    for (int ct = 0; ct < 4; ++ct) *(float*)(oblk + (eo2 + (unsigned)((rowc * D + 32 * ct) * 4))) = acc[rt][ct][reg] * rs * fwv[ct];
                }
        }
#endif
    }
}

#define XB_TMO      128
#define XB_XCNT(j)  (256  + 64 * (j))
#define XB_XSUB(j)  (1280 + 64 * (j))
#define XB_XGEN(j)  (2304 + 64 * (j))
#define XB_TOP      3328
#define XB_TOPGEN   3392
#define XCD_BAR_WORDS 3456
#define XB_SPIN_CAP (1u << 18)

__device__ __forceinline__ unsigned xb_ld(unsigned* p)              { return __hip_atomic_load(p, __ATOMIC_RELAXED, __HIP_MEMORY_SCOPE_AGENT); }
__device__ __forceinline__ unsigned xb_add(unsigned* p, unsigned v) { return __hip_atomic_fetch_add(p, v, __ATOMIC_RELAXED, __HIP_MEMORY_SCOPE_AGENT); }
__device__ __forceinline__ unsigned xb_xcc_id() { return (unsigned)__builtin_amdgcn_s_getreg((3 << 11) | 20) & 0xFu; }
#define XB_SPIN(cond, bar) do { unsigned _sp = 0; while (cond) { __builtin_amdgcn_s_sleep(1); \
    if ((++_sp & 255u) == 0u) { if (xb_ld(&(bar)[XB_TMO])) break; if (_sp > XB_SPIN_CAP) { atomicAdd(&(bar)[XB_TMO], 1u); break; } } } } while (0)

struct XcdBarrier {
    unsigned* bar; unsigned x;
    volatile LAS unsigned* st;
};

__device__ __forceinline__ XcdBarrier xcd_barrier_post(unsigned* bar, volatile LAS unsigned* st, const int wave_) {
    XcdBarrier b; b.bar = bar; b.x = xb_xcc_id(); b.st = st;
    if (wave_ == 0 && fresh_lane() == 0) (void)xb_add(&bar[XB_XCNT(b.x)], 1u);
    return b;
}
__device__ __forceinline__ void xcd_barrier_complete(unsigned* bar, unsigned x, unsigned& nloc, unsigned& nx) {
    const unsigned G = gridDim.x * gridDim.y * gridDim.z;
    unsigned sum, cnt, mine, sp = 0u;
    for (;;) {
        sum = 0u; cnt = 0u; mine = 0u;
#pragma unroll
        for (unsigned j = 0; j < 16; ++j) { const unsigned c = xb_ld(&bar[XB_XCNT(j)]); sum += c; cnt += (c > 0u) ? 1u : 0u; mine = (j == x) ? c : mine; }
        if (sum == G) break;
        __builtin_amdgcn_s_sleep(1);
        if ((++sp & 255u) == 0u) { if (xb_ld(&bar[XB_TMO])) break; if (sp > XB_SPIN_CAP) { atomicAdd(&bar[XB_TMO], 1u); break; } }
    }
    nloc = mine > 0u ? mine : 1u; nx = cnt > 0u ? cnt : 1u;
}

__device__ __forceinline__ void xcd_barrier(const XcdBarrier& b, const int wave_) {
    asm volatile("s_waitcnt vmcnt(0)" ::: "memory");
    __syncthreads();
    if (wave_ == 0 && fresh_lane() == 0) {
        unsigned* bar = b.bar;
        __builtin_amdgcn_s_waitcnt(0);
        unsigned nloc = b.st[0], nx = b.st[1];
        if (nloc == 0u) { xcd_barrier_complete(bar, b.x, nloc, nx); b.st[0] = nloc; b.st[1] = nx; }
        const unsigned old = xb_add(&bar[XB_XSUB(b.x)], 1u);
        const unsigned gen = old / nloc;
        if (old + 1u == (gen + 1u) * nloc) {
            __builtin_amdgcn_fence(__ATOMIC_RELEASE, "agent");
            asm volatile("s_waitcnt vmcnt(0)" ::: "memory");
            const unsigned og = xb_add(&bar[XB_TOP], 1u);
            const unsigned tg = og / nx;
            if (og + 1u == (tg + 1u) * nx) xb_add(&bar[XB_TOPGEN], 1u);
            else XB_SPIN(xb_ld(&bar[XB_TOPGEN]) == tg, bar);
            __builtin_amdgcn_fence(__ATOMIC_ACQUIRE, "agent");
            xb_add(&bar[XB_XGEN(b.x)], 1u);
            asm volatile("s_waitcnt vmcnt(0)" ::: "memory");
        } else {
            XB_SPIN(xb_ld(&bar[XB_XGEN(b.x)]) == gen, bar);
            __builtin_amdgcn_fence(__ATOMIC_ACQUIRE, "agent");
            asm volatile("s_waitcnt vmcnt(0)" ::: "memory");
        }
    }
    __syncthreads();
}

#ifdef SELF_CLEAN_BARRIER
__device__ unsigned g_bar[4096];
#endif
__global__ void __launch_bounds__(NTHR, 2) hybrid_fwd(Args args) {
    extern __shared__ __attribute__((aligned(16))) unsigned char lds_raw[];
    LAS unsigned char* lds = (LAS unsigned char*)lds_raw;
    const int wave = __builtin_amdgcn_readfirstlane((int)threadIdx.x >> 6), G = gridDim.x; const int tid = 0, lane = 0;
    cg::grid_group grid = cg::this_grid();
    volatile LAS unsigned* misc = (volatile LAS unsigned*)(lds + LDS_MISC);
    if (threadIdx.x < 2) misc[threadIdx.x] = 0u;
    __syncthreads();
    if (args.ph_lo < 0) grid.sync();
    #ifdef SELF_CLEAN_BARRIER
    XcdBarrier xbar = xcd_barrier_post(g_bar, misc, wave);
#else
    XcdBarrier xbar = xcd_barrier_post((unsigned*)(args.ws + WS_CTL), misc, wave);
#endif
    const int lo = args.ph_lo, hi = args.ph_hi;
#ifndef PHMASK
#define PHMASK 31
#endif
#define IN(k) (((PHMASK >> (k)) & 1) && lo <= (k) && (k) < hi)
#define SEAM(k) do { if (IN(k) && IN((k) + 1)) xcd_barrier(xbar, wave); } while (0)
#ifndef REPEAT_MASK
#define REPEAT_MASK 0
#endif
#ifdef PROBE_PH
    unsigned long long pt0_ = 0ull; unsigned pacc_ = 0u;
#define PB(k) do { if (PROBE_PH == (k)) pt0_ = __builtin_amdgcn_s_memrealtime(); } while (0)
#define PE(k) do { if (PROBE_PH == (k)) pacc_ += (unsigned)(__builtin_amdgcn_s_memrealtime() - pt0_); } while (0)
#else
#define PB(k) do {} while (0)
#define PE(k) do {} while (0)
#endif
    PB(20);
#define REP(k) _Pragma("nounroll") for (int rep_ = 0; rep_ < 1 + ((REPEAT_MASK >> (k)) & 1); ++rep_)
#ifdef EXTRA_SYNCS
    for (int es_ = 0; es_ < EXTRA_SYNCS; ++es_) xcd_barrier(xbar, wave);
#endif
    PB(0);
    if (IN(0)) REP(0) { if (rep_) xcd_barrier(xbar, wave); p0_phase(args, lds, tid, lane, wave, G); }
    PE(0); PB(10); SEAM(0); PE(10); PB(1);
    if (IN(1)) REP(1) { if (rep_) xcd_barrier(xbar, wave); p1_phase(args, lds, tid, lane, wave, G); }
    PE(1); PB(11); SEAM(1); PE(11); PB(2);
    if (IN(2)) REP(2) {
        if (rep_) xcd_barrier(xbar, wave);
        __syncthreads();
        pg8::Gemm g{(const pg8::bf16_t*)((const unsigned char*)args.out + OUT_H), (const pg8::bf16_t*)((const unsigned char*)args.out + OUT_WINT), MTOK, NP_MAIN, D};
        pg8::StaticOrder S; S.init(MTOK, NP_MAIN, G, (int)blockIdx.x);
        pg8::EpiProj E{(pg8::bf16_t*)(args.ws + WS_PROJ), NP};
        pg8::gemm_phase<pg8::EpiProj, pg8::StaticOrder, true, true>(lds, g, S, E, wave);
        for (int blk = blockIdx.x; blk < 256; blk += G) {
            const int lane_ = fresh_lane(), tid_ = wave * 64 + lane_;
            f32x16 accT[2];
#pragma unroll
            for (int i = 0; i < 2; ++i)
#pragma unroll
                for (int e = 0; e < 16; ++e) accT[i][e] = 0.f;
            tail_gemmT(accT, (const bf16*)((const unsigned char*)args.out + OUT_H) + (size_t)blk * 64 * 1024, (const bf16*)(args.ws + WS_WTF), wave, lds, tid_, lane_);
            const int l2 = fresh_lane(), r2 = l2 & 31, h2 = l2 >> 5;
            bf16* prow = (bf16*)(args.ws + WS_PROJ) + ((size_t)blk * 64 + r2) * NP + NP_MAIN + 32 * wave + 4 * h2;
#pragma unroll
            for (int rt = 0; rt < 2; ++rt)
#pragma unroll
                for (int g4 = 0; g4 < 4; ++g4) { u32x2 ov; ov.x = pk2(accT[rt][4 * g4], accT[rt][4 * g4 + 1]); ov.y = pk2(accT[rt][4 * g4 + 2], accT[rt][4 * g4 + 3]);
                    *(u32x2*)(prow + (size_t)rt * 32 * NP + 8 * g4) = ov; }
        }
    }
    PE(2); PB(12); SEAM(2); PE(12); PB(3);
    if (IN(3)) { p3a_phase(args, wave, G); PE(3); PB(13); xcd_barrier(xbar, wave); PE(13); PB(4); if ((REPEAT_MASK >> 3) & 1) { p3_phase(args, lds, tid, lane, wave, G, true); xcd_barrier(xbar, wave); } p3_phase(args, lds, tid, lane, wave, G); }
    PE(4); PB(14); SEAM(3); PE(14); PB(5);
    if (IN(4)) REP(4) { if (rep_) xcd_barrier(xbar, wave); p4_phase(args, lds, tid, lane, wave, G); }
#undef REP
    PE(5); PE(20);
#if defined(SELF_CLEAN_BARRIER) && !defined(PROBE_PH)
    {
        __syncthreads();
        if (wave == 0) {
            const int l_ = fresh_lane();
            unsigned last_ = 0u;
            if (l_ == 0) last_ = (__hip_atomic_fetch_add(&g_bar[4032], 1u, __ATOMIC_RELAXED, __HIP_MEMORY_SCOPE_AGENT) == (unsigned)G - 1u) ? 1u : 0u;
            last_ = (unsigned)__builtin_amdgcn_readfirstlane((int)last_);
            if (last_) {
                if (l_ < 16) { __hip_atomic_store(&g_bar[XB_XCNT(l_)], 0u, __ATOMIC_RELAXED, __HIP_MEMORY_SCOPE_AGENT); __hip_atomic_store(&g_bar[XB_XSUB(l_)], 0u, __ATOMIC_RELAXED, __HIP_MEMORY_SCOPE_AGENT); __hip_atomic_store(&g_bar[XB_XGEN(l_)], 0u, __ATOMIC_RELAXED, __HIP_MEMORY_SCOPE_AGENT); }
                if (l_ == 16) { __hip_atomic_store(&g_bar[XB_TOP], 0u, __ATOMIC_RELAXED, __HIP_MEMORY_SCOPE_AGENT); __hip_atomic_store(&g_bar[XB_TOPGEN], 0u, __ATOMIC_RELAXED, __HIP_MEMORY_SCOPE_AGENT);
                                __hip_atomic_store(&g_bar[XB_TMO], 0u, __ATOMIC_RELAXED, __HIP_MEMORY_SCOPE_AGENT); __hip_atomic_store(&g_bar[4032], 0u, __ATOMIC_RELAXED, __HIP_MEMORY_SCOPE_AGENT); }
            }
        }
    }
#endif
#ifdef PROBE_PH
    if (blockIdx.x == PROBE_PBLK && wave == 0 && fresh_lane() == 0) ((unsigned*)(args.ws + WS_CTL))[4001] = pacc_;
    if (blockIdx.x == 0) { xcd_barrier(xbar, wave); } else { xcd_barrier(xbar, wave); }
    if (blockIdx.x == 0 && wave == 0 && fresh_lane() == 0) { asm volatile("s_waitcnt vmcnt(0)" ::: "memory"); args.out[0] = 50.0f * floorf(0.01f * (float)__hip_atomic_load((unsigned*)(args.ws + WS_CTL) + 4001, __ATOMIC_RELAXED, __HIP_MEMORY_SCOPE_AGENT) / 50.0f + 0.5f); }
#endif
#ifdef PROBE_SEL
    if (blockIdx.x == 0 && wave == 0 && fresh_lane() == 0) { asm volatile("s_waitcnt vmcnt(0)" ::: "memory"); args.out[0] = 0.01f * (float)((volatile unsigned*)(args.ws + WS_CTL))[4000]; }
#endif
#undef IN
#undef SEAM
}

extern "C" void kernel_launch(void* const* d_in, const int* in_sizes, int n_in, void* d_out, int out_size, void* d_ws, size_t ws_size, hipStream_t stream) {
    static int grid = 0;
    if (grid == 0) {
        if (n_in != 16 || out_size != MTOK * D || ws_size < WS_END) { fprintf(stderr, "kernel_launch: unexpected shapes (n_in %d out %d ws %zu)\n", n_in, out_size, ws_size); grid = -1; return; }
        int dev = 0, cus = 0, per_cu = 0;
        (void)hipGetDevice(&dev);
        (void)hipDeviceGetAttribute(&cus, hipDeviceAttributeMultiprocessorCount, dev);
        if (hipFuncSetAttribute((const void*)hybrid_fwd, hipFuncAttributeMaxDynamicSharedMemorySize, LDS_BYTES) != hipSuccess) { fprintf(stderr, "kernel_launch: hipFuncSetAttribute failed\n"); grid = -1; return; }
        if (hipOccupancyMaxActiveBlocksPerMultiprocessor(&per_cu, (const void*)hybrid_fwd, NTHR, LDS_BYTES) != hipSuccess || per_cu < 1) { fprintf(stderr, "kernel_launch: occupancy query says %d\n", per_cu); per_cu = 1; }
        (void)hipGetLastError();
        grid = cus * per_cu;
        if (grid > 256) grid = 256;
        if (grid < 1) grid = 1;
    }
    if (grid < 0) return;
#ifndef SELF_CLEAN_BARRIER
    if (hipMemsetAsync((char*)d_ws + WS_CTL, 0, CTL_BYTES, stream) != hipSuccess) { fprintf(stderr, "kernel_launch: memset of the barrier words failed\n"); return; }
#endif
    Args a{};
    for (int i = 0; i < 16; ++i) a.in[i] = (const float*)d_in[i];
    a.out = (float*)d_out; a.ws = (unsigned char*)d_ws;
#if N_LAUNCHES == 1
    a.ph_lo = 0; a.ph_hi = NPH;
    void* kargs[] = {&a};
    hipError_t e = hipLaunchCooperativeKernel((const void*)hybrid_fwd, dim3(grid), dim3(NTHR), kargs, LDS_BYTES, stream);
    if (e != hipSuccess) fprintf(stderr, "kernel_launch: cooperative launch failed: %s (grid %d)\n", hipGetErrorString(e), grid);
#else
    for (int p = 0; p < NPH; ++p) {
        a.ph_lo = p; a.ph_hi = p + 1;
        hipLaunchKernelGGL(hybrid_fwd, dim3(grid), dim3(NTHR), LDS_BYTES, stream, a);
    }
#endif
}
```

```cpp
#include <hip/hip_runtime.h>
#include <hip/hip_cooperative_groups.h>
#include <cstdio>
#include <cstdint>
namespace cg = cooperative_groups;
#define N_LAUNCHES 1
#define REPEAT_MASK 0
#define P4_REP2 1
__device__ __forceinline__ unsigned launder(unsigned v) { asm volatile("" : "+v"(v)); return v; }
__device__ __forceinline__ int fresh_lane() { unsigned z; asm volatile("v_mov_b32 %0, 0" : "=v"(z)); return (int)__builtin_amdgcn_mbcnt_hi(~0u, __builtin_amdgcn_mbcnt_lo(~0u, z)); }
namespace pg8 {
#define PG8_LAS __attribute__((address_space(3)))
typedef unsigned short bf16_t;
typedef short bf16x8 __attribute__((ext_vector_type(8)));
typedef float f32x4 __attribute__((ext_vector_type(4)));
typedef unsigned u32x4 __attribute__((ext_vector_type(4)));
constexpr int BM = 256, BK = 64, HALF = 128, HTB = HALF * BK * 2  , STAGE_BYTES = 8 * HTB, NXCD = 8, WGM = 8;

__host__ __device__ __forceinline__ int lds_byte(int r, int c) { const int st = (r >> 4) * 2 + (c >> 5), rr = r & 15, cc = c & 31, ob = rr * 64 + cc * 2; return st * 1024 + (ob ^ (((ob >> 9) & 1) << 5)); }
__host__ __device__ __forceinline__ void stage_rc(int b, int& R, int& C) { const int st = b / 1024, sb = b % 1024, swz = sb ^ (((sb >> 9) & 1) << 5); R = (st >> 1) * 16 + swz / 64; C = (st & 1) * 32 + (swz % 64) / 2; }
__host__ __device__ __forceinline__ int perm32(int rho) { const int n = rho >> 4, i = rho & 15; return 8 * (i >> 2) + 4 * n + (i & 3); }

struct Unit { int pm, pn; };
struct Gemm { const bf16_t* A; const bf16_t* Bt; int M, N, K; };

struct StaticOrder {
    int nM, nN, nwg, G, c;
    __host__ __device__ void init(int M, int N, int G_, int c_) { nM = M / BM; nN = N / BM; nwg = nM * nN; G = G_; c = c_; }
    __host__ __device__ bool next(int i, Unit& u) const {
        const long L = (long)i * G + c; if (L >= nwg) return false;
        int wgid = (int)L; { const int q = nwg / NXCD, r = nwg % NXCD, xcd = wgid % NXCD, off = wgid / NXCD; wgid = (xcd < r ? xcd * (q + 1) : r * (q + 1) + (xcd - r) * q) + off; }
        const int nig = WGM * nN, gid = wgid / nig, fm = gid * WGM, gsz = (nM - fm) < WGM ? (nM - fm) : WGM;
        u.pm = fm + ((wgid % nig) % gsz); u.pn = (wgid % nig) / gsz; return true;
    }
    __device__ __forceinline__ void a_ready(const Unit&) const {}
    __device__ __forceinline__ void done(const Unit&) const {}
};
__device__ __forceinline__ unsigned cvt_pk_bf16(float lo, float hi) { unsigned r; asm volatile("v_cvt_pk_bf16_f32 %0, %1, %2" : "=v"(r) : "v"(lo), "v"(hi)); return r; }
struct EpiProj {
    static constexpr bool PERM = true, AFTER_DRAIN = false;
    bf16_t* O; int ldc;
    __device__ __forceinline__ void operator()(const f32x4 (&acc)[2][2][4][2], const Unit& u, int wr, int wc, int fr, int fq) const {
        const int row0 = u.pm * BM + wr * 64 + fr; const int col0 = u.pn * BM + wc * 32 + 8 * fq;
#pragma unroll
        for (int ai = 0; ai < 2; ++ai)
#pragma unroll
            for (int m = 0; m < 4; ++m) { bf16_t* rowp = O + (size_t)(row0 + ai * HALF + m * 16) * ldc + col0;
#pragma unroll
                for (int bj = 0; bj < 2; ++bj) { const f32x4 v0 = acc[ai][bj][m][0], v1 = acc[ai][bj][m][1];
                    u32x4 w; w.x = cvt_pk_bf16(v0[0], v0[1]); w.y = cvt_pk_bf16(v0[2], v0[3]); w.z = cvt_pk_bf16(v1[0], v1[1]); w.w = cvt_pk_bf16(v1[2], v1[3]);
                    *(u32x4*)(rowp + bj * HALF) = w; } }
    }
    __device__ __forceinline__ void fused(f32x4 (&)[2][2][4][2], const Unit&, int, int, int, int, PG8_LAS unsigned char*, int, int) const {}
};
template <class Epi, class Sched, bool ALIGN_EPI = false, bool SP2 = false>
__device__ __forceinline__ void gemm_phase(PG8_LAS unsigned char* lds, const Gemm g, const Sched& S, const Epi& E, const int wid) {
    const int lane = ::fresh_lane(), tid = wid * 64 + lane, wr = wid >> 2, wc = wid & 3, fr = lane & 15, fq = lane >> 4;
    const int K = g.K, nt = K / BK;
    unsigned voffA[2], voffB[2];
#pragma unroll
    for (int i = 0; i < 2; ++i) { int R, C; stage_rc(tid * 16 + i * 8192, R, C); const int Rb = Epi::PERM ? ((R & ~31) + perm32(R & 31)) : R;
        voffA[i] = (unsigned)(R * K + C) * 2u; voffB[i] = (unsigned)(Rb * K + C) * 2u; }
    const size_t kstep = (size_t)(BK * 2);
    const size_t hstep = (size_t)HALF * K * 2;
    const size_t tstep = 2 * hstep;
    const unsigned ldsw = (unsigned)wid * 1024u;
    const int aoff = lds_byte(wr * 64 + fr, fq * 8), boff = lds_byte(wc * 32 + fr, fq * 8);
#define PG8_SA(b, h) (((b) * 2 + (h)) * HTB)
#define PG8_SB(b, h) ((4 + (b) * 2 + (h)) * HTB)
#define PG8_STAGE(bufoff, gbase, voff) do { _Pragma("unroll") for (int _i = 0; _i < 2; ++_i) \
        __builtin_amdgcn_global_load_lds((const unsigned*)((const char*)(gbase) + (voff)[_i]), (PG8_LAS unsigned*)(lds + (bufoff) + ldsw + _i * 8192), 16, 0, 0); } while (0)
#define PG8_LDA(dst, b, h) do { _Pragma("unroll") for (int m = 0; m < 4; ++m) _Pragma("unroll") for (int k = 0; k < 2; ++k) dst[m][k] = *(const PG8_LAS bf16x8*)(lds + PG8_SA(b, h) + aoff + m * 2048 + k * 1024); } while (0)
#define PG8_LDB(dst, b, h) do { _Pragma("unroll") for (int n = 0; n < 2; ++n) _Pragma("unroll") for (int k = 0; k < 2; ++k) dst[n][k] = *(const PG8_LAS bf16x8*)(lds + PG8_SB(b, h) + boff + n * 2048 + k * 1024); } while (0)
#define PG8_MMA(ai, bj, At, Bt) do { __builtin_amdgcn_s_setprio(1); _Pragma("unroll") for (int m = 0; m < 4; ++m) _Pragma("unroll") for (int n = 0; n < 2; ++n) _Pragma("unroll") for (int k = 0; k < 2; ++k) \
        acc[ai][bj][m][n] = __builtin_amdgcn_mfma_f32_16x16x32_bf16(Bt[n][k], At[m][k], acc[ai][bj][m][n], 0, 0, 0); __builtin_amdgcn_s_setprio(0); } while (0)
#define PG8_WAIT_V(n) asm volatile("s_waitcnt vmcnt(" #n ")" ::: "memory")
#define PG8_WAIT_L(n) asm volatile("s_waitcnt lgkmcnt(" #n ")" ::: "memory")
#define PG8_BAR __builtin_amdgcn_s_barrier()
#define PG8_SCHED __builtin_amdgcn_sched_barrier(0)
    Unit cur, nxt; int ui = 0;
    if (!S.next(0, cur)) return;
    f32x4 acc[2][2][4][2];
#pragma unroll
    for (int a = 0; a < 2; ++a)
#pragma unroll
        for (int b = 0; b < 2; ++b)
#pragma unroll
            for (int m = 0; m < 4; ++m)
#pragma unroll
                for (int n = 0; n < 2; ++n) acc[a][b][m][n] = (f32x4){0.f, 0.f, 0.f, 0.f};
    bf16x8 At[4][2], B0[2][2], B1[2][2];
    const char* cA = (const char*)g.A + (size_t)cur.pm * tstep; const char* cB = (const char*)g.Bt + (size_t)cur.pn * tstep;
    S.a_ready(cur);
    if constexpr (SP2) {
        PG8_STAGE(PG8_SB(0, 0), cB, voffB); PG8_STAGE(PG8_SB(0, 1), cB + hstep, voffB); PG8_STAGE(PG8_SA(0, 0), cA, voffA); PG8_STAGE(PG8_SA(0, 1), cA + hstep, voffA);
        if (wr == 1) PG8_BAR;
        PG8_WAIT_V(2); PG8_BAR;
        PG8_STAGE(PG8_SB(1, 0), cB + kstep, voffB); PG8_STAGE(PG8_SA(1, 0), cA + kstep, voffA); PG8_STAGE(PG8_SB(1, 1), cB + hstep + kstep, voffB);
        PG8_WAIT_V(6); PG8_BAR;
    } else {
        PG8_STAGE(PG8_SB(0, 0), cB, voffB); PG8_STAGE(PG8_SA(0, 0), cA, voffA); PG8_STAGE(PG8_SB(0, 1), cB + hstep, voffB); PG8_STAGE(PG8_SA(0, 1), cA + hstep, voffA);
        if (wr == 1) PG8_BAR;
        PG8_WAIT_V(4); PG8_BAR;
        PG8_STAGE(PG8_SB(1, 0), cB + kstep, voffB); PG8_STAGE(PG8_SA(1, 0), cA + kstep, voffA); PG8_STAGE(PG8_SB(1, 1), cB + hstep + kstep, voffB);
        PG8_WAIT_V(6); PG8_BAR;
    }
    for (;;) {
        const bool has_next = S.next(ui + 1, nxt);
        const char* nA = has_next ? (const char*)g.A + (size_t)nxt.pm * tstep : cA; const char* nB = has_next ? (const char*)g.Bt + (size_t)nxt.pn * tstep : cB;
        for (int t = 0; t < nt; t += 2) {
            const bool last = (t == nt - 2);
            const char* a1 = cA + (size_t)(t + 1) * kstep;
            const char* a2 = last ? nA : cA + (size_t)(t + 2) * kstep; const char* b2 = last ? nB : cB + (size_t)(t + 2) * kstep;
            const char* a3 = a2 + kstep; const char* b3 = b2 + kstep;
            if (last && has_next) S.a_ready(nxt);
            if constexpr (SP2) {
            PG8_LDB(B0, 0, 0); PG8_LDB(B1, 0, 1); PG8_SCHED; PG8_LDA(At, 0, 0); PG8_STAGE(PG8_SA(1, 1), a1 + hstep, voffA);
            PG8_WAIT_V(8); PG8_WAIT_L(0); PG8_BAR; PG8_MMA(0, 0, At, B0); PG8_MMA(0, 1, At, B1); PG8_BAR; PG8_SCHED;
            PG8_LDA(At, 0, 1); PG8_STAGE(PG8_SB(0, 0), b2, voffB); PG8_STAGE(PG8_SB(0, 1), b2 + hstep, voffB); PG8_STAGE(PG8_SA(0, 0), a2, voffA);
            PG8_WAIT_V(8); PG8_WAIT_L(0); PG8_BAR; PG8_MMA(1, 0, At, B0); PG8_MMA(1, 1, At, B1); PG8_BAR; PG8_SCHED;
            PG8_LDB(B0, 1, 0); PG8_LDB(B1, 1, 1); PG8_SCHED; PG8_LDA(At, 1, 0); PG8_STAGE(PG8_SA(0, 1), a2 + hstep, voffA);
            PG8_WAIT_V(8); PG8_WAIT_L(0); PG8_BAR; PG8_MMA(0, 0, At, B0); PG8_MMA(0, 1, At, B1); PG8_BAR; PG8_SCHED;
            PG8_LDA(At, 1, 1); PG8_STAGE(PG8_SB(1, 0), b3, voffB); PG8_STAGE(PG8_SB(1, 1), b3 + hstep, voffB); PG8_STAGE(PG8_SA(1, 0), a3, voffA);
            PG8_WAIT_V(8); PG8_WAIT_L(0); PG8_BAR; PG8_MMA(1, 0, At, B0); PG8_MMA(1, 1, At, B1); PG8_BAR; PG8_SCHED;
            } else {
            PG8_LDB(B0, 0, 0); PG8_SCHED; PG8_LDA(At, 0, 0); PG8_STAGE(PG8_SA(1, 1), a1 + hstep, voffA);
            PG8_WAIT_L(8); PG8_BAR; PG8_WAIT_L(0); PG8_MMA(0, 0, At, B0); PG8_BAR; PG8_SCHED;
            PG8_LDB(B1, 0, 1); PG8_STAGE(PG8_SB(0, 0), b2, voffB);
            PG8_BAR; PG8_WAIT_L(0); PG8_MMA(0, 1, At, B1); PG8_BAR;
            PG8_LDA(At, 0, 1); PG8_STAGE(PG8_SA(0, 0), a2, voffA);
            PG8_BAR; PG8_WAIT_L(0); PG8_MMA(1, 0, At, B0); PG8_BAR; PG8_SCHED;
            PG8_STAGE(PG8_SB(0, 1), b2 + hstep, voffB);
            PG8_WAIT_V(6); PG8_BAR; PG8_MMA(1, 1, At, B1); PG8_BAR;
            PG8_LDB(B0, 1, 0); PG8_SCHED; PG8_LDA(At, 1, 0); PG8_STAGE(PG8_SA(0, 1), a2 + hstep, voffA);
            PG8_WAIT_L(8); PG8_BAR; PG8_WAIT_L(0); PG8_MMA(0, 0, At, B0); PG8_BAR; PG8_SCHED;
            PG8_LDB(B1, 1, 1); PG8_STAGE(PG8_SB(1, 0), b3, voffB);
            PG8_BAR; PG8_WAIT_L(0); PG8_MMA(0, 1, At, B1); PG8_BAR;
            PG8_LDA(At, 1, 1); PG8_STAGE(PG8_SA(1, 0), a3, voffA);
            PG8_BAR; PG8_WAIT_L(0); PG8_MMA(1, 0, At, B0); PG8_BAR; PG8_SCHED;
            PG8_STAGE(PG8_SB(1, 1), b3 + hstep, voffB);
            PG8_WAIT_V(6); PG8_BAR; PG8_MMA(1, 1, At, B1); PG8_BAR;
            }
        }
        if constexpr (ALIGN_EPI) { if (wr == 0) PG8_BAR; }
        if constexpr (!Epi::AFTER_DRAIN) { E(acc, cur, wr, wc, fr, fq); S.done(cur); }
        if (!has_next) break;
#pragma unroll
        for (int a = 0; a < 2; ++a)
#pragma unroll
            for (int b = 0; b < 2; ++b)
#pragma unroll
                for (int m = 0; m < 4; ++m)
#pragma unroll
                    for (int n = 0; n < 2; ++n) acc[a][b][m][n] = (f32x4){0.f, 0.f, 0.f, 0.f};
        cur = nxt; cA = nA; cB = nB; ++ui;
        if constexpr (ALIGN_EPI) { if (wr == 1) PG8_BAR; }
    }
    PG8_WAIT_V(0);
    if constexpr (!ALIGN_EPI) { if (wr == 0) PG8_BAR; }
    PG8_BAR;
    if constexpr (Epi::AFTER_DRAIN) { E.fused(acc, cur, wr, wc, fr, fq, lds, wid, lane); S.done(cur); }
#undef PG8_SA
#undef PG8_SB
#undef PG8_STAGE
#undef PG8_LDA
#undef PG8_LDB
#undef PG8_MMA
#undef PG8_WAIT_V
#undef PG8_WAIT_L
#undef PG8_BAR
#undef PG8_SCHED
}
}

#define LAS __attribute__((address_space(3)))
typedef unsigned short bf16;
typedef short bf16x8 __attribute__((ext_vector_type(8)));
typedef short s16x4 __attribute__((ext_vector_type(4)));
typedef float f32x4 __attribute__((ext_vector_type(4)));
typedef float f32x16 __attribute__((ext_vector_type(16)));
typedef unsigned u32x4 __attribute__((ext_vector_type(4)));
typedef unsigned u32x2 __attribute__((ext_vector_type(2)));
typedef float f32x2_t __attribute__((ext_vector_type(2)));
typedef __bf16 bf16x2_t __attribute__((ext_vector_type(2)));

#ifndef N_LAUNCHES
#define N_LAUNCHES 1
#endif
constexpr int NPH = 5;
constexpr int D = 1024, NB = 8, SEQ = 2048, MTOK = NB * SEQ, NIN = 7440, NP = 7424, NP_MAIN = 7168;
constexpr int C_Z = 0, C_X = 1024, C_B = 2048, C_C = 2176, C_Q = 2304, C_K = 2816, C_V = 3328, C_GR = 4352, C_GAM = 5376, C_GAR = 6400;
constexpr float EPS = 1e-6f;
constexpr size_t MiB = 1u << 20;
constexpr size_t WS_PROJ = 0;
constexpr size_t WS_WMF = 232 * MiB, WS_WRF = 234 * MiB, WS_WOF = 236 * MiB;
constexpr size_t WS_MOD = 238 * MiB;
constexpr size_t WS_DT = 239 * MiB;
constexpr size_t WS_SSQM = 240 * MiB;
constexpr size_t WS_SSQR = 242 * MiB;
constexpr int CW_MODCNT = 3900;
constexpr size_t WS_CTL = 244 * MiB, CTL_BYTES = 16384;
constexpr size_t WS_WTF = 245 * MiB;
constexpr size_t WS_END = 246 * MiB;
constexpr size_t OUT_H = 0, OUT_WINT = 32 * MiB;
constexpr int LDS_BYTES = 155648, LDS_MISC = 155520;
constexpr int NTHR = 512;

struct Args { const float* in[16]; float* out; unsigned char* ws; int ph_lo, ph_hi; };

__device__ __forceinline__ float bf_lo(unsigned u) { return __uint_as_float(u << 16); }
__device__ __forceinline__ float bf_hi(unsigned u) { return __uint_as_float(u & 0xffff0000u); }
__device__ __forceinline__ unsigned pk2(float lo, float hi) { f32x2_t v = {lo, hi}; bf16x2_t b = __builtin_convertvector(v, bf16x2_t); return __builtin_bit_cast(unsigned, b); }
__device__ __forceinline__ float silu_f(float x) { return x * __builtin_amdgcn_rcpf(1.f + __expf(-x)); }
__device__ __forceinline__ float sigm_f(float x) { return __builtin_amdgcn_rcpf(1.f + __expf(-x)); }
__device__ __forceinline__ float wave_sum(float v) {
#pragma unroll
    for (int o = 1; o < 64; o <<= 1) v += __shfl_xor(v, o);
    return v;
}
__device__ __forceinline__ int crow(int reg, int h) { return (reg & 3) + 8 * (reg >> 2) + 4 * h; }
#define MFMA32(a, b, c) __builtin_amdgcn_mfma_f32_32x32x16_bf16((a), (b), (c), 0, 0, 0)
#define MFMA16(a, b, c) __builtin_amdgcn_mfma_f32_16x16x32_bf16((a), (b), (c), 0, 0, 0)
__device__ __forceinline__ s16x4 tr_read(const LAS unsigned char* p) {
    typedef short v4i16_t __attribute__((ext_vector_type(4)));
    return __builtin_bit_cast(s16x4, __builtin_amdgcn_ds_read_tr16_b64_v4i16((LAS v4i16_t*)p));
}
__device__ __forceinline__ bf16x8 tr_pair(const LAS unsigned char* plo, const LAS unsigned char* phi) {
    const s16x4 lo = tr_read(plo), hi = tr_read(phi);
    return __builtin_shufflevector(lo, hi, 0, 1, 2, 3, 4, 5, 6, 7);
}
__device__ __forceinline__ bf16x8 pack8(float a0, float a1, float a2, float a3, float a4, float a5, float a6, float a7) {
    u32x4 p; p.x = pk2(a0, a1); p.y = pk2(a2, a3); p.z = pk2(a4, a5); p.w = pk2(a6, a7);
    return __builtin_bit_cast(bf16x8, p);
}

__device__ __forceinline__ void p0_load_tile(const float* W, int ldw, int k0, int n0, LAS float* scr, int lane) {
    float t[32];
#pragma unroll
    for (int i = 0; i < 32; ++i) t[i] = W[(size_t)(k0 + 2 * i + (lane >> 5)) * ldw + n0 + (lane & 31)];
#pragma unroll
    for (int i = 0; i < 32; ++i) scr[(2 * i + (lane >> 5)) * 33 + (lane & 31)] = t[i];
}
__device__ __forceinline__ void p0_phase(const Args& a, LAS unsigned char* lds, int tid_unused, int lane_unused, int wave, int G) {
    const int lane = fresh_lane(), tid = wave * 64 + lane;
    const float* cvec = a.in[1]; const float* w_ada = a.in[2]; const float* b_ada = a.in[3];
    float* MOD = (float*)(a.ws + WS_MOD);
    LAS float* cT = (LAS float*)lds;
    LAS float* red = (LAS float*)(lds + 32768);
    if ((int)blockIdx.x < 192) {
        { float t[16];
#pragma unroll
          for (int i = 0; i < 16; ++i) t[i] = cvec[tid + 512 * i];
#pragma unroll
          for (int i = 0; i < 16; ++i) { const int idx = tid + 512 * i; cT[(idx & 1023) * 8 + (idx >> 10)] = t[i]; } }
        __syncthreads();
        for (int item = blockIdx.x; item < 192; item += G) {
            const int j0 = item * 16, col = lane & 15, rsub = lane >> 4, kq = wave;
            float w[32];
#pragma unroll
            for (int i = 0; i < 32; ++i) w[i] = w_ada[(size_t)(kq * 128 + 4 * i + rsub) * 3072 + j0 + col];
            float acc[8];
#pragma unroll
            for (int bb = 0; bb < 8; ++bb) acc[bb] = 0.f;
#pragma unroll
            for (int i = 0; i < 32; ++i) { const int k = kq * 128 + 4 * i + rsub;
                const f32x4 c0 = *(const LAS f32x4*)(cT + k * 8), c1 = *(const LAS f32x4*)(cT + k * 8 + 4);
                acc[0] += c0.x * w[i]; acc[1] += c0.y * w[i]; acc[2] += c0.z * w[i]; acc[3] += c0.w * w[i];
                acc[4] += c1.x * w[i]; acc[5] += c1.y * w[i]; acc[6] += c1.z * w[i]; acc[7] += c1.w * w[i]; }
#pragma unroll
            for (int bb = 0; bb < 8; ++bb) { acc[bb] += __shfl_xor(acc[bb], 16); acc[bb] += __shfl_xor(acc[bb], 32); }
            if (lane < 16) {
#pragma unroll
                for (int bb = 0; bb < 8; ++bb) red[(kq * 8 + bb) * 16 + col] = acc[bb]; }
            __syncthreads();
            if (tid < 128) { const int bb = tid >> 4, cc = tid & 15; float sum = 0.f;
#pragma unroll
                for (int q = 0; q < 8; ++q) sum += red[(q * 8 + bb) * 16 + cc];
                __hip_atomic_store(&MOD[bb * 3072 + j0 + cc], sum + b_ada[j0 + cc], __ATOMIC_RELAXED, __HIP_MEMORY_SCOPE_AGENT); }
            asm volatile("s_waitcnt vmcnt(0)" ::: "memory");
            __syncthreads();
            if (tid == 0) __hip_atomic_fetch_add((unsigned*)(a.ws + WS_CTL) + CW_MODCNT, 1u, __ATOMIC_RELAXED, __HIP_MEMORY_SCOPE_AGENT);
        }
    }
    LAS float* scr = (LAS float*)(lds + 40960 + wave * 8448);
    const int gw = blockIdx.x * 8 + wave, NGW = G * 8;
    constexpr int I_IN = 16 * (NP / 32), I_W = 16 * 32;
    bf16* WINT = (bf16*)((unsigned char*)a.out + OUT_WINT);
    for (int it = gw; it < I_IN + 3 * I_W + 128; it += NGW) {
        if (it >= I_IN + 3 * I_W) {
            const int r_ = it - (I_IN + 3 * I_W), nt = r_ & 7, kb = r_ >> 3;
            p0_load_tile(a.in[5], NIN, 64 * kb, NP_MAIN + 16 + 32 * nt, scr, lane);
            bf16* WF = (bf16*)(a.ws + WS_WTF);
            const int r = lane & 31, h = lane >> 5;
#pragma unroll
            for (int s4 = 0; s4 < 4; ++s4) { const LAS float* s = scr + (16 * s4 + 8 * h) * 33 + r;
                u32x4 o; o.x = pk2(s[0 * 33], s[1 * 33]); o.y = pk2(s[2 * 33], s[3 * 33]); o.z = pk2(s[4 * 33], s[5 * 33]); o.w = pk2(s[6 * 33], s[7 * 33]);
                *(u32x4*)(WF + ((size_t)(nt * 64 + 4 * kb + s4) * 64 + lane) * 8) = o; }
        } else if (it < I_IN) {
            const int nblk = NP / 32, kb = it / nblk, nb = it % nblk, k0 = 64 * kb, n0p = 32 * nb, n0 = n0p + (n0p >= 2304 ? 16 : 0);
            p0_load_tile(a.in[5], NIN, k0, n0, scr, lane);
            const int c = lane & 7;
#pragma unroll
            for (int j = 0; j < 4; ++j) { const int n = (lane >> 3) + 8 * j; const LAS float* s = scr + (8 * c) * 33 + n;
                u32x4 o; o.x = pk2(s[0 * 33], s[1 * 33]); o.y = pk2(s[2 * 33], s[3 * 33]); o.z = pk2(s[4 * 33], s[5 * 33]); o.w = pk2(s[6 * 33], s[7 * 33]);
                *(u32x4*)(WINT + (size_t)(n0p + n) * 1024 + k0 + 8 * c) = o; }
        } else {
            int r_ = it - I_IN; const int which = r_ / I_W; r_ -= which * I_W;
            const float* W = a.in[12 + which];
            bf16* WF = (bf16*)(a.ws + WS_WMF + (size_t)which * 2 * MiB);
            const int nt = r_ & 31, kb = r_ >> 5;
            p0_load_tile(W, 1024, 64 * kb, 32 * nt, scr, lane);
            const int r = lane & 31, h = lane >> 5;
#pragma unroll
            for (int s4 = 0; s4 < 4; ++s4) { const LAS float* s = scr + (16 * s4 + 8 * h) * 33 + r;
                f32x4 m0 = (f32x4){1.f, 1.f, 1.f, 1.f}, m1 = m0;
                if (which == 0) { m0 = *(const f32x4*)(a.in[11] + 64 * kb + 16 * s4 + 8 * h); m1 = *(const f32x4*)(a.in[11] + 64 * kb + 16 * s4 + 8 * h + 4); }
                u32x4 o; o.x = pk2(s[0 * 33] * m0.x, s[1 * 33] * m0.y); o.y = pk2(s[2 * 33] * m0.z, s[3 * 33] * m0.w); o.z = pk2(s[4 * 33] * m1.x, s[5 * 33] * m1.y); o.w = pk2(s[6 * 33] * m1.z, s[7 * 33] * m1.w);
                *(u32x4*)(WF + ((size_t)(nt * 64 + 4 * kb + s4) * 64 + lane) * 8) = o; }
        }
    }
}

__device__ __forceinline__ void p1_phase(const Args& a, LAS unsigned char* lds, int tid_unused, int lane_unused, int wave, int G) {
    const int lane_in = fresh_lane(), tid = wave * 64 + lane_in;
    const float* x = a.in[0]; const float* norm_w = a.in[4]; const float* w_in = a.in[5]; const float* dt_bias = a.in[8];
    const float* MOD = (const float*)(a.ws + WS_MOD);
    float* DT = (float*)(a.ws + WS_DT);
    bf16* H = (bf16*)((unsigned char*)a.out + OUT_H);
    LAS float* wdt = (LAS float*)lds;
    { float t[32];
#pragma unroll
      for (int i = 0; i < 32; ++i) { const int idx = tid + NTHR * i; t[i] = w_in[(size_t)(idx >> 4) * NIN + 2304 + (idx & 15)]; }
#pragma unroll
      for (int i = 0; i < 32; ++i) { const int idx = tid + NTHR * i; wdt[(idx & 15) * 1028 + (idx >> 4)] = t[i]; } }
    if (wave == 0) {
        unsigned* cnt = (unsigned*)(a.ws + WS_CTL) + CW_MODCNT; unsigned spins = 0u;
        while ((unsigned)__builtin_amdgcn_readfirstlane((int)__hip_atomic_load(cnt, __ATOMIC_RELAXED, __HIP_MEMORY_SCOPE_AGENT)) < 192u) { __builtin_amdgcn_s_sleep(1); if (++spins > (1u << 20)) break; }
        __builtin_amdgcn_fence(__ATOMIC_ACQUIRE, "agent");
        asm volatile("s_waitcnt vmcnt(0)" ::: "memory");
    }
    __syncthreads();
    for (int blk = blockIdx.x; blk < 256; blk += G) {
        const int b = blk >> 5;
        float gk[16], sh[16];
#pragma unroll
        for (int jj = 0; jj < 4; ++jj) { const int k = 4 * lane_in + 256 * jj;
            const f32x4 nw = *(const f32x4*)(norm_w + k), sc = *(const f32x4*)(MOD + b * 3072 + 1024 + k), sf = *(const f32x4*)(MOD + b * 3072 + k);
#pragma unroll
            for (int e = 0; e < 4; ++e) { gk[4 * jj + e] = nw[e] * (1.f + sc[e]); sh[4 * jj + e] = sf[e]; } }
        f32x4 vn[2][4];
        { const int lane = fresh_lane();
#pragma unroll
          for (int rr = 0; rr < 2; ++rr)
#pragma unroll
              for (int jj = 0; jj < 4; ++jj) vn[rr][jj] = *((const f32x4*)(x + (size_t)(blk * 64 + wave * 8 + rr) * D) + lane + 64 * jj); }
        for (int g = 0; g < 4; ++g) {
            asm volatile("" ::: "memory");
            const int lane = fresh_lane();
            const int m0 = blk * 64 + wave * 8 + g * 2;
            f32x4 v[2][4];
#pragma unroll
            for (int rr = 0; rr < 2; ++rr)
#pragma unroll
                for (int jj = 0; jj < 4; ++jj) v[rr][jj] = vn[rr][jj];
            if (g + 1 < 4) {
#pragma unroll
                for (int rr = 0; rr < 2; ++rr)
#pragma unroll
                    for (int jj = 0; jj < 4; ++jj) vn[rr][jj] = *((const f32x4*)(x + (size_t)(m0 + 2 + rr) * D) + lane + 64 * jj);
            }
            __builtin_amdgcn_sched_barrier(0);
            float hv[2][16];
#pragma unroll
            for (int rr = 0; rr < 2; ++rr) {
                float ss = 0.f;
#pragma unroll
                for (int jj = 0; jj < 4; ++jj) ss += (v[rr][jj].x * v[rr][jj].x + v[rr][jj].y * v[rr][jj].y) + (v[rr][jj].z * v[rr][jj].z + v[rr][jj].w * v[rr][jj].w);
                const float rs = 1.0f / sqrtf(wave_sum(ss) * (1.f / D) + EPS);
                unsigned long long* o8 = (unsigned long long*)(H + (size_t)(m0 + rr) * D) + lane;
#pragma unroll
                for (int jj = 0; jj < 4; ++jj) {
#pragma unroll
                    for (int e = 0; e < 4; ++e) hv[rr][4 * jj + e] = v[rr][jj][e] * rs * gk[4 * jj + e] + sh[4 * jj + e];
                    o8[64 * jj] = (unsigned long long)pk2(hv[rr][4 * jj], hv[rr][4 * jj + 1]) | ((unsigned long long)pk2(hv[rr][4 * jj + 2], hv[rr][4 * jj + 3]) << 32);
                }
            }
            float acc[32];
#pragma unroll
            for (int i = 0; i < 32; ++i) acc[i] = 0.f;
#pragma unroll
            for (int j = 0; j < 16; ++j) {
#pragma unroll
                for (int jj = 0; jj < 4; ++jj) { const f32x4 w = *(const LAS f32x4*)(wdt + j * 1028 + 4 * lane + 256 * jj);
#pragma unroll
                    for (int rr = 0; rr < 2; ++rr) acc[rr * 16 + j] += (hv[rr][4 * jj] * w.x + hv[rr][4 * jj + 1] * w.y) + (hv[rr][4 * jj + 2] * w.z + hv[rr][4 * jj + 3] * w.w); }
                if ((j & 3) == 3) asm volatile("" ::: "memory");
            }
#pragma unroll
            for (int half = 16; half >= 1; half >>= 1) {
                const bool up = (lane & half) != 0;
#pragma unroll
                for (int i = 0; i < half; ++i) { float lo_ = acc[i], hi_ = acc[i + half]; asm volatile("" : "+v"(lo_), "+v"(hi_));
                    const float keep = up ? hi_ : lo_, send = up ? lo_ : hi_; acc[i] = keep + __shfl_xor(send, half); }
            }
            const float tot = acc[0] + __shfl_xor(acc[0], 32);
            const float xr_ = tot + dt_bias[lane & 15];
            const float dtv = xr_ > 20.f ? xr_ : log1pf(__expf(xr_));
            if (lane < 32) DT[(size_t)m0 * 16 + lane] = dtv;
        }
    }
}

constexpr size_t OUT_XBCC = 0;
__device__ __forceinline__ void p3a_phase(const Args& a, int wave, int G) {
    const bf16* PROJ = (const bf16*)(a.ws + WS_PROJ);
    bf16* XBCC = (bf16*)((unsigned char*)a.out + OUT_XBCC);
    const float* conv_w = a.in[6]; const float* conv_b = a.in[7];
    const int lane = fresh_lane(), tid = wave * 64 + lane;
    if (tid >= 480) return;
    const int oct = tid % 160, tgl = tid / 160;
    float cw[4][8], cb[8];
#pragma unroll
    for (int e = 0; e < 8; ++e) { cb[e] = conv_b[8 * oct + e];
#pragma unroll
        for (int k = 0; k < 4; ++k) cw[k][e] = conv_w[k * 1280 + 8 * oct + e]; }
    for (int blk = blockIdx.x; blk < 256; blk += G) {
        for (int tg = tgl; tg < 8; tg += 3) {
            const int m0 = blk * 64 + 8 * tg, ts0 = m0 & (SEQ - 1);
            const char* src = (const char*)(PROJ + (size_t)m0 * NP + C_X + 8 * oct);
            u32x4 raw[11];
#pragma unroll
            for (int i = 0; i < 11; ++i) { const bool ok = (ts0 - 3 + i) >= 0; raw[i] = ok ? *(const u32x4*)(src + ((long)i - 3) * (NP * 2)) : (u32x4){0u, 0u, 0u, 0u}; }
#pragma unroll
            for (int jj = 0; jj < 8; ++jj) {
                float o[8];
#pragma unroll
                for (int e = 0; e < 8; ++e) {
                    float s_ = cb[e];
#pragma unroll
                    for (int k = 0; k < 4; ++k) { const unsigned w = raw[jj + k][e >> 1]; s_ += cw[k][e] * ((e & 1) ? bf_hi(w) : bf_lo(w)); }
                    o[e] = silu_f(s_);
                }
                u32x4 ov; ov.x = pk2(o[0], o[1]); ov.y = pk2(o[2], o[3]); ov.z = pk2(o[4], o[5]); ov.w = pk2(o[6], o[7]);
                *(u32x4*)(XBCC + (size_t)(m0 + jj) * 1280 + 8 * oct) = ov;
            }
        }
    }
}

constexpr int TP = 72;
constexpr int L_CQ = 0, L_BK = 18432, L_BKW = 36864, L_XV = 55296, L_ST0 = 73728, L_ST1 = 82944, L_ACS = 92160, L_DTJ = 93184, L_WJ = 94208, L_CW = 95232;

__device__ __forceinline__ void p3_phase(const Args& a, LAS unsigned char* lds, int tid_in, int lane_in, int wave, int G, const bool dry = false) {
    bf16* PROJ = (bf16*)(a.ws + WS_PROJ);
    const float* DT = (const float*)(a.ws + WS_DT);
    float* SSQM = (float*)(a.ws + WS_SSQM); float* SSQR = (float*)(a.ws + WS_SSQR);
    const float* conv_w = a.in[6]; const float* conv_b = a.in[7]; const float* a_log = a.in[9]; const float* d_skip = a.in[10]; const float* m_norm_w = a.in[11];
    const int pt = wave & 1, it = wave >> 1;
#ifdef PROBE_SEL
    unsigned long long t0_ = 0ull; unsigned tacc_ = 0u;
    const bool probing = ((int)blockIdx.x == PROBE_BLK && wave == PROBE_WAVE);
#define TB(k) do { if (PROBE_SEL == (k) && probing) t0_ = __builtin_amdgcn_s_memrealtime(); } while (0)
#define TE(k) do { if (PROBE_SEL == (k) && probing) tacc_ += (unsigned)(__builtin_amdgcn_s_memrealtime() - t0_); } while (0)
#else
#define TB(k) do {} while (0)
#define TE(k) do {} while (0)
#endif
    for (int item = blockIdx.x; item < 256; item += G) {
        const int lane = fresh_lane(), tid = wave * 64 + lane;
        const int r = lane & 31, h = lane >> 5, i16 = lane & 15, q4 = i16 >> 2, p4 = i16 & 3, blk16 = (lane >> 4) & 1;
        const int xcd_ = item & 7, kk_ = item >> 3;
        const bool ssd = kk_ < 16;
        int b, hd, half;
        if (ssd) { const int pair = 2 * xcd_ + (kk_ >> 3); b = pair >> 1; hd = 8 * (pair & 1) + (kk_ & 7); half = 0; }
        else { const int t = xcd_ * 16 + (kk_ - 16); b = t >> 4; hd = (t >> 1) & 7; half = t & 1; }
        const size_t mb = (size_t)b * SEQ;
        __syncthreads();
        for (int idx = tid; idx < 9216 / 4; idx += NTHR) ((LAS unsigned*)(lds + L_ST0))[idx] = 0u;
        const float lg = ssd ? 0.f : log1pf(-exp2f(-5.0f - (float)hd));
        if (!ssd && tid < 256) { const int par = tid >> 7, j = tid & 127;
            ((LAS float*)(lds + L_ACS))[par * 128 + j] = (float)(j + 1) * lg * 1.4426950408889634f; ((LAS float*)(lds + L_DTJ))[par * 128 + j] = (float)(j + 1) * lg * 1.4426950408889634f; ((LAS float*)(lds + L_WJ))[par * 128 + j] = __expf((float)(127 - j) * lg); }
        const float Ah = ssd ? -__expf(a_log[hd]) : 0.f;
        const float Dsk = ssd ? d_skip[hd] : 0.f;
        const int ltile = 3 - (tid >> 7), loct = tid & 7, ltg = (tid >> 3) & 15;
        int lcol = 0;
        float invf[8];
        if (ssd) {
            lcol = (ltile == 0) ? (64 * hd + 8 * loct) : (ltile == 1 ? (1024 + 64 * (hd >> 3) + 8 * loct) : (1152 + 64 * (hd >> 3) + 8 * loct));
            if (ltile == 3) lcol = 1024 + 64 * (hd >> 3) + 8 * loct;
#pragma unroll
            for (int e = 0; e < 8; ++e) invf[e] = 0.f;
        } else {
#pragma unroll
            for (int e = 0; e < 8; ++e) invf[e] = exp2f(-(float)(8 * (tid & 3) + e) * (13.287712379549449f / 32.f));
        }
        f32x16 sacc;
#pragma unroll
        for (int i = 0; i < 16; ++i) sacc[i] = 0.f;
        u32x4 raw[8];
        const int rj = tid >> 2, ro4 = tid & 3;
        const int j0 = 8 * ltg;
        const char* pbase = (const char*)(PROJ + mb * NP);
        const char* xbase = (const char*)((const bf16*)((const unsigned char*)a.out + OUT_XBCC) + mb * 1280);
        const unsigned soff = (unsigned)((j0 * 1280 + lcol) * 2);
        const unsigned roff = (unsigned)((rj * NP) * 2);
#define P3_ISSUE(cc) do { const char* cbp = pbase + (size_t)(cc) * (128 * NP * 2); \
        if (ssd) { const char* xp = xbase + (size_t)(cc) * (128 * 1280 * 2) + soff; _Pragma("unroll") for (int i = 0; i < 8; ++i) raw[i] = *(const u32x4*)(xp + i * (1280 * 2)); } \
        else { const char* rp = cbp + roff; \
            raw[0] = *(const u32x4*)(rp + (C_Q + 64 * hd + 8 * ro4) * 2); raw[1] = *(const u32x4*)(rp + (C_Q + 64 * hd + 32 + 8 * ro4) * 2); \
            raw[2] = *(const u32x4*)(rp + (C_K + 64 * hd + 8 * ro4) * 2); raw[3] = *(const u32x4*)(rp + (C_K + 64 * hd + 32 + 8 * ro4) * 2); \
            raw[4] = *(const u32x4*)(rp + (C_V + 128 * hd + 64 * half + 16 * ro4) * 2); raw[5] = *(const u32x4*)(rp + (C_V + 128 * hd + 64 * half + 16 * ro4 + 8) * 2); } } while (0)
        float dq0 = 0.f, dq1 = 0.f;
#define P3_SCAN(cc) do { LAS float* ACSw = (LAS float*)(lds + L_ACS) + ((cc) & 1) * 128; LAS float* DTJw = (LAS float*)(lds + L_DTJ) + ((cc) & 1) * 128; LAS float* WJw = (LAS float*)(lds + L_WJ) + ((cc) & 1) * 128; \
        const float v0 = dq0 * Ah, v1 = dq1 * Ah, s_ = v0 + v1; float incl = s_; \
        _Pragma("unroll") for (int o = 1; o < 64; o <<= 1) { const float t = __shfl_up(incl, o); if (lane >= o) incl += t; } \
        const float c0 = (incl - s_) + v0, tot = __shfl(incl, 63), c1 = (lane == 63) ? tot : c0 + v1; \
        ACSw[2 * lane] = c0 * 1.4426950408889634f; ACSw[2 * lane + 1] = c1 * 1.4426950408889634f; \
        DTJw[2 * lane] = c0 * 1.4426950408889634f - __log2f(dq0); DTJw[2 * lane + 1] = c1 * 1.4426950408889634f - __log2f(dq1); \
        WJw[2 * lane] = dq0 * __expf(tot - c0); WJw[2 * lane + 1] = dq1 * __expf(tot - c1); } while (0)
#define P3_DTLOAD(cc) do { dq0 = DT[(mb + (size_t)(cc) * 128 + 2 * lane) * 16 + hd]; dq1 = DT[(mb + (size_t)(cc) * 128 + 2 * lane + 1) * 16 + hd]; } while (0)
        if (ssd && wave == 0) { P3_DTLOAD(0); P3_SCAN(0); P3_DTLOAD(1); }
        u32x2 zzn[4];
        { const bf16* orow0 = PROJ + (mb + 16 * wave + i16) * NP + (ssd ? (C_Z + 64 * hd) : (C_GR + 128 * hd + 64 * half));
#pragma unroll
          for (int g4 = 0; g4 < 4; ++g4) zzn[g4] = *(const u32x2*)(orow0 + 16 * g4 + 4 * (lane >> 4)); }
        P3_ISSUE(0);

        TB(1);
        for (int c = 0; c < 16; ++c) {
            const int par = c & 1;
            const size_t m0 = mb + (size_t)c * 128;
            LAS float* ACS = (LAS float*)(lds + L_ACS) + par * 128; LAS float* DTJ = (LAS float*)(lds + L_DTJ) + par * 128; LAS float* WJ = (LAS float*)(lds + L_WJ) + par * 128;
            TB(5);
            __syncthreads();
            TE(5); TB(2);
#ifndef P3_REPL
#define P3_REPL 1
#endif
            _Pragma("nounroll") for (int repl_ = 0; repl_ < P3_REPL; ++repl_) {
            if (repl_) __syncthreads();
            if (ssd) {
                {
                    LAS unsigned char* dst = lds + (ltile == 0 ? L_XV : (ltile == 1 ? L_BK : (ltile == 2 ? L_CQ : L_BKW)));
#pragma unroll
                    for (int jj = 0; jj < 8; ++jj) {
                        u32x4 v = raw[jj];
                        if (ltile == 3) { const float wj = WJ[j0 + jj];
                            v.x = pk2(bf_lo(v.x) * wj, bf_hi(v.x) * wj); v.y = pk2(bf_lo(v.y) * wj, bf_hi(v.y) * wj); v.z = pk2(bf_lo(v.z) * wj, bf_hi(v.z) * wj); v.w = pk2(bf_lo(v.w) * wj, bf_hi(v.w) * wj); }
                        *(LAS u32x4*)(dst + ((j0 + jj) * TP + 8 * loct) * 2) = v;
                    }
                }
            } else {
                const int j = rj, o4 = ro4;
                const u32x4 q1 = raw[0], q2 = raw[1], k1 = raw[2], k2 = raw[3];
                const float pos = (float)(c * 128 + j), wj = WJ[j];
                float ql[8], qh[8], kl[8], kh[8];
#pragma unroll
                for (int e = 0; e < 8; ++e) {
                    const float rev = pos * invf[e] * 0.15915494309189535f, fr = rev - floorf(rev);
                    const float cs = __builtin_amdgcn_cosf(fr), sn = __builtin_amdgcn_sinf(fr);
                    const unsigned wq1 = q1[e >> 1], wq2 = q2[e >> 1], wk1 = k1[e >> 1], wk2 = k2[e >> 1];
                    const float a1 = (e & 1) ? bf_hi(wq1) : bf_lo(wq1), a2 = (e & 1) ? bf_hi(wq2) : bf_lo(wq2);
                    const float b1 = ((e & 1) ? bf_hi(wk1) : bf_lo(wk1)) * 0.125f, b2 = ((e & 1) ? bf_hi(wk2) : bf_lo(wk2)) * 0.125f;
                    ql[e] = a1 * cs - a2 * sn; qh[e] = a1 * sn + a2 * cs;
                    kl[e] = b1 * cs - b2 * sn; kh[e] = b1 * sn + b2 * cs;
                }
                u32x4 t;
                t.x = pk2(ql[0], ql[1]); t.y = pk2(ql[2], ql[3]); t.z = pk2(ql[4], ql[5]); t.w = pk2(ql[6], ql[7]); *(LAS u32x4*)(lds + L_CQ + (j * TP + 8 * o4) * 2) = t;
                t.x = pk2(qh[0], qh[1]); t.y = pk2(qh[2], qh[3]); t.z = pk2(qh[4], qh[5]); t.w = pk2(qh[6], qh[7]); *(LAS u32x4*)(lds + L_CQ + (j * TP + 32 + 8 * o4) * 2) = t;
                t.x = pk2(kl[0], kl[1]); t.y = pk2(kl[2], kl[3]); t.z = pk2(kl[4], kl[5]); t.w = pk2(kl[6], kl[7]); *(LAS u32x4*)(lds + L_BK + (j * TP + 8 * o4) * 2) = t;
                t.x = pk2(kh[0], kh[1]); t.y = pk2(kh[2], kh[3]); t.z = pk2(kh[4], kh[5]); t.w = pk2(kh[6], kh[7]); *(LAS u32x4*)(lds + L_BK + (j * TP + 32 + 8 * o4) * 2) = t;
                t.x = pk2(kl[0] * wj, kl[1] * wj); t.y = pk2(kl[2] * wj, kl[3] * wj); t.z = pk2(kl[4] * wj, kl[5] * wj); t.w = pk2(kl[6] * wj, kl[7] * wj); *(LAS u32x4*)(lds + L_BKW + (j * TP + 8 * o4) * 2) = t;
                t.x = pk2(kh[0] * wj, kh[1] * wj); t.y = pk2(kh[2] * wj, kh[3] * wj); t.z = pk2(kh[4] * wj, kh[5] * wj); t.w = pk2(kh[6] * wj, kh[7] * wj); *(LAS u32x4*)(lds + L_BKW + (j * TP + 32 + 8 * o4) * 2) = t;
                *(LAS u32x4*)(lds + L_XV + (j * TP + 16 * o4) * 2) = raw[4]; *(LAS u32x4*)(lds + L_XV + (j * TP + 16 * o4 + 8) * 2) = raw[5];
            }
            }
            TE(2); TB(6);
            __syncthreads();
            TE(6); TB(3);
            const int q16 = lane >> 4, iTok = 16 * wave + i16;
            bf16* orow = PROJ + (m0 + iTok) * NP + (ssd ? (C_Z + 64 * hd) : (C_GR + 128 * hd + 64 * half));
            u32x2 zz[4];
#pragma unroll
            for (int g4 = 0; g4 < 4; ++g4) zz[g4] = zzn[g4];
            if (c + 1 < 16) {
#pragma unroll
                for (int g4 = 0; g4 < 4; ++g4) zzn[g4] = *(const u32x2*)(orow + 128 * NP + 16 * g4 + 4 * q16);
                P3_ISSUE(c + 1);
            }
            __builtin_amdgcn_sched_barrier(0);
            if (ssd && wave == 0 && c + 1 < 16) { P3_SCAN(c + 1); if (c + 2 < 16) P3_DTLOAD(c + 2); }
#ifndef P3_REPC
#define P3_REPC 1
#endif
            f32x16 acc;
            float acs_i = 0.f;
            LAS unsigned char* STw = lds + (par ? L_ST0 : L_ST1);
            _Pragma("nounroll") for (int repc_ = 0; repc_ < P3_REPC; ++repc_) {
            bf16x8 cqb[2];
#pragma unroll
            for (int s = 0; s < 2; ++s) cqb[s] = *(const LAS bf16x8*)(lds + L_CQ + (iTok * TP + 32 * s + 8 * q16) * 2);
            const LAS unsigned char* STr = lds + (par ? L_ST1 : L_ST0);
#pragma unroll
            for (int i = 0; i < 16; ++i) acc[i] = 0.f;
            f32x4 ya[4];
#pragma unroll
            for (int p4t = 0; p4t < 4; ++p4t) { ya[p4t] = (f32x4){0.f, 0.f, 0.f, 0.f};
#pragma unroll
                for (int s = 0; s < 2; ++s) { const bf16x8 sa = *(const LAS bf16x8*)(STr + ((16 * p4t + i16) * TP + 32 * s + 8 * q16) * 2); ya[p4t] = MFMA16(sa, cqb[s], ya[p4t]); } }
            acs_i = ACS[iTok];
            { const float ei = __builtin_amdgcn_exp2f(acs_i);
#pragma unroll
              for (int p4t = 0; p4t < 4; ++p4t) ya[p4t] = ya[p4t] * ei; }
            const int nblk = (wave >> 1) + 1;
            bf16x8 kq0[2], kq1[2];
#pragma unroll
            for (int s = 0; s < 2; ++s) { kq0[s] = *(const LAS bf16x8*)(lds + L_BK + (i16 * TP + 32 * s + 8 * q16) * 2); kq1[s] = *(const LAS bf16x8*)(lds + L_BK + ((16 + i16) * TP + 32 * s + 8 * q16) * 2); }
            for (int jb = 0; jb < nblk; ++jb) {
                const int j0 = 32 * jb;
                f32x4 t0 = (f32x4){0.f, 0.f, 0.f, 0.f}, t1 = t0;
#pragma unroll
                for (int s = 0; s < 2; ++s) { t0 = MFMA16(kq0[s], cqb[s], t0); t1 = MFMA16(kq1[s], cqb[s], t1); }
#pragma unroll
                for (int s = 0; s < 2; ++s) { kq0[s] = *(const LAS bf16x8*)(lds + L_BK + ((j0 + 32 + i16) * TP + 32 * s + 8 * q16) * 2); kq1[s] = *(const LAS bf16x8*)(lds + L_BK + ((j0 + 48 + i16) * TP + 32 * s + 8 * q16) * 2); }
                const f32x4 b0 = *(const LAS f32x4*)(DTJ + j0 + 4 * q16), b1 = *(const LAS f32x4*)(DTJ + j0 + 16 + 4 * q16);
                bf16x8 xa[4];
#pragma unroll
                for (int p4t = 0; p4t < 4; ++p4t) { const LAS unsigned char* xb = lds + L_XV + ((j0 + 4 * q16 + q4) * TP + 16 * p4t + 4 * p4) * 2; xa[p4t] = tr_pair(xb, xb + 16 * TP * 2); }
                __builtin_amdgcn_sched_barrier(0);
                const bool lastb = (jb == nblk - 1);
                float pv[8];
#pragma unroll
                for (int e = 0; e < 4; ++e) {
                    float v0 = t0[e] * __builtin_amdgcn_exp2f(acs_i - b0[e]), v1 = t1[e] * __builtin_amdgcn_exp2f(acs_i - b1[e]);
                    if (lastb && (j0 + 4 * q16 + e) > iTok) v0 = 0.f;
                    if (lastb && (j0 + 16 + 4 * q16 + e) > iTok) v1 = 0.f;
                    pv[e] = v0; pv[4 + e] = v1;
                }
                const bf16x8 pf = pack8(pv[0], pv[1], pv[2], pv[3], pv[4], pv[5], pv[6], pv[7]);
#pragma unroll
                for (int p4t = 0; p4t < 4; ++p4t) ya[p4t] = MFMA16(xa[p4t], pf, ya[p4t]);
            }
#pragma unroll
            for (int p4t = 0; p4t < 4; ++p4t)
#pragma unroll
                for (int e = 0; e < 4; ++e) acc[4 * p4t + e] = ya[p4t][e];
            }
            TE(3); TB(4);
            if (it < 2 && c < 15) {
                const int nt = it;
                const float dec = __builtin_amdgcn_exp2f(ACS[127]);
#pragma unroll
                for (int i = 0; i < 16; ++i) sacc[i] *= dec;
                f32x16 sacc2;
#pragma unroll
                for (int i = 0; i < 16; ++i) sacc2[i] = 0.f;
#pragma unroll
                for (int ks = 0; ks < 8; ++ks) {
                    const LAS unsigned char* xb = lds + L_XV + ((16 * ks + 8 * h + q4) * TP + 32 * pt + 16 * blk16 + 4 * p4) * 2;
                    const LAS unsigned char* kb = lds + L_BKW + ((16 * ks + 8 * h + q4) * TP + 32 * nt + 16 * blk16 + 4 * p4) * 2;
                    const bf16x8 xa = tr_pair(xb, xb + 4 * TP * 2), kbf = tr_pair(kb, kb + 4 * TP * 2);
                    if (ks & 1) sacc2 = MFMA32(xa, kbf, sacc2); else sacc = MFMA32(xa, kbf, sacc);
                }
#pragma unroll
                for (int i = 0; i < 16; ++i) sacc[i] += sacc2[i];
#pragma unroll
                for (int i = 0; i < 16; ++i) { const int p = 32 * pt + crow(i, h);
                    *(LAS unsigned short*)(STw + (p * TP + 32 * nt + r) * 2) = (unsigned short)(pk2(sacc[i], 0.f) & 0xffffu); }
            }
            {
                float ss = 0.f;
#pragma unroll
                for (int g4 = 0; g4 < 4; ++g4) {
                    const int p = 16 * g4 + 4 * q16;
                    const float z0 = bf_lo(zz[g4].x), z1 = bf_hi(zz[g4].x), z2 = bf_lo(zz[g4].y), z3 = bf_hi(zz[g4].y);
                    float y0 = acc[4 * g4], y1 = acc[4 * g4 + 1], y2 = acc[4 * g4 + 2], y3 = acc[4 * g4 + 3];
                    float o0, o1, o2, o3;
                    if (ssd) {
                        const u32x2 xv = *(const LAS u32x2*)(lds + L_XV + (iTok * TP + p) * 2);
                        y0 = (y0 + Dsk * bf_lo(xv.x)) * silu_f(z0); y1 = (y1 + Dsk * bf_hi(xv.x)) * silu_f(z1); y2 = (y2 + Dsk * bf_lo(xv.y)) * silu_f(z2); y3 = (y3 + Dsk * bf_hi(xv.y)) * silu_f(z3);
                        ss += (y0 * y0 + y1 * y1) + (y2 * y2 + y3 * y3);
                        o0 = y0; o1 = y1; o2 = y2; o3 = y3;
                    } else {
                        ss += (y0 * y0 + y1 * y1) + (y2 * y2 + y3 * y3);
                        o0 = y0 * silu_f(z0); o1 = y1 * silu_f(z1); o2 = y2 * silu_f(z2); o3 = y3 * silu_f(z3);
                    }
                    u32x2 ov; ov.x = pk2(o0, o1); ov.y = pk2(o2, o3);
                    if (dry) *(u32x2*)((bf16*)((unsigned char*)a.out + 40 * MiB) + (m0 + iTok) * 512 + ((64 * hd + 64 * half + p) & 511)) = ov; else *(u32x2*)(orow + p) = ov;
                }
                ss += __shfl_xor(ss, 16); ss += __shfl_xor(ss, 32);
                if (q16 < 2) { const float sv = (q16 == 0) ? ss : 0.f;
                    if (ssd) SSQM[(m0 + iTok) * 32 + hd * 2 + q16] = sv; else SSQR[(m0 + iTok) * 32 + hd * 4 + half * 2 + q16] = sv; }
            }
            TE(4);
        }
        TE(1);
#undef P3_ISSUE
#undef P3_SCAN
#undef P3_DTLOAD
    }
#ifdef PROBE_SEL
    if (probing && fresh_lane() == 0) ((unsigned*)(a.ws + WS_CTL))[4000] = tacc_;
#endif
#undef TB
#undef TE
}

constexpr int MP = 1032;
constexpr int L4_MERGED = 0, L4_ASTG = 132096, L4_RM = 150528, L4_RR = 151040, L4_RED = 153088, L4_RS = 155136;
static_assert(L4_RS + 256 <= LDS_BYTES, "P4 LDS map");

__device__ __forceinline__ void p4_panel_load(u32x4 (&ar)[16], const bf16* Abase, int tid) {
    const int srow = tid >> 3, soct = tid & 7; const int rot = ((int)blockIdx.x >> 3) & 15;
    const char* ab = (const char*)Abase; const unsigned aoff = (unsigned)((srow * NP + 8 * soct) * 2);
#pragma unroll
    for (int i = 0; i < 16; ++i) ar[i] = *(const u32x4*)(ab + ((rot + i) & 15) * 128 + aoff);
}
template <int SEGSHIFT>
__device__ __forceinline__ void p4_gemmT(f32x16 (&accT)[2][2], u32x4 (&ar)[16], const bf16* Anext  , const LAS float* rsc  , int nseg,
                                         const bf16* WF  , int nt0  , LAS unsigned char* lds, int tid, int lane) {
    const int srow = tid >> 3, soct = tid & 7, r = lane & 31, h = lane >> 5;
    const char* wb = (const char*)WF + (size_t)nt0 * 65536; const unsigned woff = (unsigned)(lane * 16);
    const int rot = ((int)blockIdx.x >> 3) & 15;
    bf16x8 wc[4][2];
    { const char* wk0 = wb + rot * 4096;
#pragma unroll
      for (int s = 0; s < 4; ++s) { wc[s][0] = *(const bf16x8*)(wk0 + s * 1024 + woff); wc[s][1] = *(const bf16x8*)(wk0 + 65536 + s * 1024 + woff); } }
#define P4_STAGE_WRITE(ki_) do { const int kc_ = ((ki_) + rot) & 15; const float sc = rsc[srow * nseg + ((kc_ * 64) >> SEGSHIFT)]; \
        u32x4 o; \
        o.x = pk2(bf_lo(ar[ki_].x) * sc, bf_hi(ar[ki_].x) * sc); o.y = pk2(bf_lo(ar[ki_].y) * sc, bf_hi(ar[ki_].y) * sc); \
        o.z = pk2(bf_lo(ar[ki_].z) * sc, bf_hi(ar[ki_].z) * sc); o.w = pk2(bf_lo(ar[ki_].w) * sc, bf_hi(ar[ki_].w) * sc); \
        *(LAS u32x4*)(lds + L4_ASTG + ((ki_) & 1) * 9216 + (srow * TP + 8 * soct) * 2) = o; } while (0)
    P4_STAGE_WRITE(0);
#pragma unroll
    for (int ki = 0; ki < 16; ++ki) {
        const int kc = (ki + rot) & 15;
        LAS unsigned char* stg = lds + L4_ASTG + (ki & 1) * 9216;
        __syncthreads();
        if (ki + 1 < 16) P4_STAGE_WRITE(ki + 1);
        const int kn = (kc + 1) & 15;
        const char* wk = wb + kn * 4096;
        bf16x8 a0 = *(const LAS bf16x8*)(stg + (r * TP + 8 * h) * 2), a1 = *(const LAS bf16x8*)(stg + ((32 + r) * TP + 8 * h) * 2);
#pragma unroll
        for (int s = 0; s < 4; ++s) {
            bf16x8 n0 = a0, n1 = a1;
            if (s < 3) { n0 = *(const LAS bf16x8*)(stg + (r * TP + 16 * (s + 1) + 8 * h) * 2); n1 = *(const LAS bf16x8*)(stg + ((32 + r) * TP + 16 * (s + 1) + 8 * h) * 2); }
            accT[0][0] = MFMA32(wc[s][0], a0, accT[0][0]); accT[0][1] = MFMA32(wc[s][1], a0, accT[0][1]);
            accT[1][0] = MFMA32(wc[s][0], a1, accT[1][0]); accT[1][1] = MFMA32(wc[s][1], a1, accT[1][1]);
            wc[s][0] = *(const bf16x8*)(wk + s * 1024 + woff); wc[s][1] = *(const bf16x8*)(wk + 65536 + s * 1024 + woff);
            __builtin_amdgcn_sched_barrier(0);
            a0 = n0; a1 = n1;
        }
    }
#undef P4_STAGE_WRITE
    p4_panel_load(ar, Anext, tid);
    __builtin_amdgcn_sched_barrier(0);
    __syncthreads();
}


__device__ __forceinline__ void tail_gemmT(f32x16 (&accT)[2], const bf16* Abase  , const bf16* WF  , int nt  , LAS unsigned char* lds, int tid, int lane) {
    const int srow = tid >> 3, soct = tid & 7, r = lane & 31, h = lane >> 5;
    const char* ab = (const char*)Abase; const unsigned aoff = (unsigned)((srow * 1024 + 8 * soct) * 2);
    const char* wb = (const char*)WF + (size_t)nt * 65536; const unsigned woff = (unsigned)(lane * 16);
    const int rot = ((int)blockIdx.x >> 3) & 15;
    u32x4 ar[16];
#pragma unroll
    for (int i = 0; i < 16; ++i) ar[i] = *(const u32x4*)(ab + ((rot + i) & 15) * 128 + aoff);
    bf16x8 wc[4];
    { const char* wk0 = wb + rot * 4096;
#pragma unroll
      for (int s = 0; s < 4; ++s) wc[s] = *(const bf16x8*)(wk0 + s * 1024 + woff); }
#pragma unroll
    for (int ki = 0; ki < 16; ++ki) {
        const int kc = (ki + rot) & 15;
        LAS unsigned char* stg = lds + L4_ASTG + (ki & 1) * 9216;
        *(LAS u32x4*)(stg + (srow * TP + 8 * soct) * 2) = ar[ki];
        __syncthreads();
        const char* wk = wb + ((kc + 1) & 15) * 4096;
#pragma unroll
        for (int s = 0; s < 4; ++s) {
            const bf16x8 a0 = *(const LAS bf16x8*)(stg + (r * TP + 16 * s + 8 * h) * 2), a1 = *(const LAS bf16x8*)(stg + ((32 + r) * TP + 16 * s + 8 * h) * 2);
            accT[0] = MFMA32(wc[s], a0, accT[0]); accT[1] = MFMA32(wc[s], a1, accT[1]);
            wc[s] = *(const bf16x8*)(wk + s * 1024 + woff);
            __builtin_amdgcn_sched_barrier(0);
        }
    }
    __syncthreads();
}

__device__ __forceinline__ void p4_phase(const Args& a, LAS unsigned char* lds, int tid_in, int lane_in, int wave, int G) {
    const bf16* PROJ = (const bf16*)(a.ws + WS_PROJ);
    const float* SSQM = (const float*)(a.ws + WS_SSQM); const float* SSQR = (const float*)(a.ws + WS_SSQR);
    const float* MOD = (const float*)(a.ws + WS_MOD);
    const bf16* WMF = (const bf16*)(a.ws + WS_WMF); const bf16* WRF = (const bf16*)(a.ws + WS_WRF); const bf16* WOF = (const bf16*)(a.ws + WS_WOF);
    const float* x = a.in[0]; const float* fw = a.in[15]; float* out = a.out;
    LAS float* RM = (LAS float*)(lds + L4_RM); LAS float* RR = (LAS float*)(lds + L4_RR); LAS float* RED = (LAS float*)(lds + L4_RED); LAS float* RS = (LAS float*)(lds + L4_RS);
    for (int blk = blockIdx.x; blk < 256; blk += G) {
        const size_t m0 = (size_t)blk * 64; const int b = blk >> 5;
        int lane = fresh_lane(), tid = wave * 64 + lane, r = lane & 31, h = lane >> 5;
        u32x4 ar[16];
        p4_panel_load(ar, PROJ + m0 * NP + C_Z, tid);
        __syncthreads();
        { const int row = tid >> 3, sub = tid & 7;
          const f32x4 qv = *(const f32x4*)(SSQR + (m0 + row) * 32 + 4 * sub);
          RR[row * 8 + sub] = 1.0f / sqrtf(((qv.x + qv.y) + (qv.z + qv.w)) * (1.f / 128.f) + EPS);
          if (sub < 2) { float s = 0.f;
#pragma unroll
              for (int i = 0; i < 4; ++i) { const f32x4 v = *(const f32x4*)(SSQM + (m0 + row) * 32 + 16 * sub + 4 * i); s += (v.x + v.y) + (v.z + v.w); }
              RM[row * 2 + sub] = 1.0f / sqrtf(s * (1.f / 512.f) + EPS); } }
        __syncthreads();
#ifndef P4_SKIP1
#ifndef P4_REP1
#define P4_REP1 1
#endif
        for (int nh_ = 0; nh_ < 2 * P4_REP1; ++nh_) {
            const int nh = nh_ & 1;
            lane = fresh_lane(); tid = wave * 64 + lane; r = lane & 31; h = lane >> 5;
            const int nt0 = 16 * nh + 2 * wave;
            const bf16* pblk = PROJ + m0 * NP;
            f32x16 accT[2][2];
#pragma unroll
            for (int i = 0; i < 2; ++i)
#pragma unroll
                for (int j = 0; j < 2; ++j)
#pragma unroll
                    for (int e = 0; e < 16; ++e) accT[i][j][e] = 0.f;
            u32x2 gpre[2][2][4];
            { const unsigned lo0 = (unsigned)((r * NP + 4 * h) * 2); const char* gb0 = (const char*)(pblk + C_GAM + 32 * nt0);
#pragma unroll
              for (int rt = 0; rt < 2; ++rt)
#pragma unroll
                  for (int ct = 0; ct < 2; ++ct)
#pragma unroll
                      for (int g4 = 0; g4 < 4; ++g4) gpre[rt][ct][g4] = *(const u32x2*)(gb0 + (lo0 + (unsigned)((32 * rt * NP + 32 * ct + 8 * g4) * 2)));
              __builtin_amdgcn_sched_barrier(0); }
            p4_gemmT<9>(accT, ar, pblk + C_GR, RM, 2, WMF, nt0, lds, tid, lane);
            {
                lane = fresh_lane(); r = lane & 31; h = lane >> 5;
                const unsigned lm = launder((unsigned)(L4_MERGED + (r * MP + 4 * h) * 2));
#pragma unroll
                for (int rt = 0; rt < 2; ++rt)
#pragma unroll
                    for (int ct = 0; ct < 2; ++ct)
#pragma unroll
                        for (int g4 = 0; g4 < 4; ++g4) {
                            const u32x2 gg = gpre[rt][ct][g4];
                            u32x2 ov; ov.x = pk2(accT[rt][ct][4 * g4] * sigm_f(bf_lo(gg.x)), accT[rt][ct][4 * g4 + 1] * sigm_f(bf_hi(gg.x)));
                            ov.y = pk2(accT[rt][ct][4 * g4 + 2] * sigm_f(bf_lo(gg.y)), accT[rt][ct][4 * g4 + 3] * sigm_f(bf_hi(gg.y)));
                            *(LAS u32x2*)(lds + lm + (unsigned)((32 * rt * MP + 32 * (nt0 + ct) + 8 * g4) * 2)) = ov; }
            }
#pragma unroll
            for (int i = 0; i < 2; ++i)
#pragma unroll
                for (int j = 0; j < 2; ++j)
#pragma unroll
                    for (int e = 0; e < 16; ++e) accT[i][j][e] = 0.f;
            lane = fresh_lane(); tid = wave * 64 + lane; r = lane & 31; h = lane >> 5;
            { const unsigned lo0 = (unsigned)((r * NP + 4 * h) * 2); const char* gb0 = (const char*)(pblk + C_GAR + 32 * nt0);
#pragma unroll
              for (int rt = 0; rt < 2; ++rt)
#pragma unroll
                  for (int ct = 0; ct < 2; ++ct)
#pragma unroll
                      for (int g4 = 0; g4 < 4; ++g4) gpre[rt][ct][g4] = *(const u32x2*)(gb0 + (lo0 + (unsigned)((32 * rt * NP + 32 * ct + 8 * g4) * 2)));
              __builtin_amdgcn_sched_barrier(0); }
            p4_gemmT<7>(accT, ar, pblk + C_Z, RR, 8, WRF, nt0, lds, tid, lane);
            {
                lane = fresh_lane(); r = lane & 31; h = lane >> 5;
                const unsigned lm = launder((unsigned)(L4_MERGED + (r * MP + 4 * h) * 2));
#pragma unroll
                for (int rt = 0; rt < 2; ++rt)
#pragma unroll
                    for (int ct = 0; ct < 2; ++ct)
#pragma unroll
                        for (int g4 = 0; g4 < 4; ++g4) {
                            const u32x2 gg = gpre[rt][ct][g4];
                            LAS u32x2* mp = (LAS u32x2*)(lds + lm + (unsigned)((32 * rt * MP + 32 * (nt0 + ct) + 8 * g4) * 2));
                            const u32x2 pm = *mp;
                            const float v0 = bf_lo(pm.x) + accT[rt][ct][4 * g4] * sigm_f(bf_lo(gg.x)), v1 = bf_hi(pm.x) + accT[rt][ct][4 * g4 + 1] * sigm_f(bf_hi(gg.x));
                            const float v2 = bf_lo(pm.y) + accT[rt][ct][4 * g4 + 2] * sigm_f(bf_lo(gg.y)), v3 = bf_hi(pm.y) + accT[rt][ct][4 * g4 + 3] * sigm_f(bf_hi(gg.y));
                            u32x2 ov; ov.x = pk2(v0, v1); ov.y = pk2(v2, v3);
                            *mp = ov; }
            }
        }
#endif
        __syncthreads();
        lane = fresh_lane(); tid = wave * 64 + lane; r = lane & 31; h = lane >> 5;
#ifndef P4_SKIP2
#ifndef P4_REP2
#define P4_REP2 1
#endif
        _Pragma("nounroll") for (int rep2_ = 0; rep2_ < P4_REP2; ++rep2_) {
            if (rep2_) { __syncthreads(); lane = fresh_lane(); tid = wave * 64 + lane; r = lane & 31; h = lane >> 5; }
            f32x16 acc[2][4];
#pragma unroll
            for (int i = 0; i < 2; ++i)
#pragma unroll
                for (int j = 0; j < 4; ++j)
#pragma unroll
                    for (int e = 0; e < 16; ++e) acc[i][j][e] = 0.f;
            const char* wb = (const char*)WOF + (size_t)(4 * wave) * 65536; const unsigned woff = (unsigned)(lane * 16);
            const int rot2 = ((int)blockIdx.x >> 3) & 31;
            bf16x8 wc[2][4];
#pragma unroll
            for (int s = 0; s < 2; ++s)
#pragma unroll
                for (int ct = 0; ct < 4; ++ct) wc[s][ct] = *(const bf16x8*)(wb + ct * 65536 + (2 * rot2 + s) * 1024 + woff);
            const LAS unsigned char* ma = lds + L4_MERGED + (r * MP + 8 * h) * 2;
            bf16x8 a0 = *(const LAS bf16x8*)(ma + (2 * rot2) * 32), a1 = *(const LAS bf16x8*)(ma + 32 * MP * 2 + (2 * rot2) * 32);
            for (int ki = 0; ki < 32; ++ki) {
                const int kp = (ki + rot2) & 31, kpn = (kp + 1) & 31;
#pragma unroll
                for (int s = 0; s < 2; ++s) {
                    const int ksn = (s == 0) ? 2 * kp + 1 : 2 * kpn;
                    const bf16x8 n0 = *(const LAS bf16x8*)(ma + ksn * 32), n1 = *(const LAS bf16x8*)(ma + 32 * MP * 2 + ksn * 32);
#pragma unroll
                    for (int ct = 0; ct < 4; ++ct) { acc[0][ct] = MFMA32(a0, wc[s][ct], acc[0][ct]); acc[1][ct] = MFMA32(a1, wc[s][ct], acc[1][ct]); }
#pragma unroll
                    for (int ct = 0; ct < 4; ++ct) wc[s][ct] = *(const bf16x8*)(wb + ct * 65536 + (2 * kpn + s) * 1024 + woff);
                    __builtin_amdgcn_sched_barrier(0);
                    a0 = n0; a1 = n1;
                }
            }
            lane = fresh_lane(); r = lane & 31; h = lane >> 5;
            const char* xblk = (const char*)(x + m0 * D); char* oblk = (char*)(out + m0 * D);
            const unsigned eo = launder((unsigned)(4 * (4 * h * D + 128 * wave + r)));
            const unsigned rb = launder((unsigned)(L4_RED + (4 * h * 8 + wave) * 4));
            float gate[4], fwv[4];
#pragma unroll
            for (int ct = 0; ct < 4; ++ct) { const int n = 32 * (4 * wave + ct) + r; gate[ct] = MOD[b * 3072 + 2048 + n]; fwv[ct] = fw[n]; }
            float xv[2][8][4];
#define P4_XLOAD(buf, bidx) do { _Pragma("unroll") for (int e = 0; e < 8; ++e) _Pragma("unroll") for (int ct = 0; ct < 4; ++ct) \
                xv[buf][e][ct] = *(const float*)(xblk + (eo + (unsigned)(((32 * ((bidx) >> 1) + (e & 3) + 8 * (2 * ((bidx) & 1) + (e >> 2))) * D + 32 * ct) * 4))); } while (0)
            P4_XLOAD(0, 0);
#pragma unroll
            for (int bi = 0; bi < 4; ++bi) {
                const int rt = bi >> 1, g8 = bi & 1;
                if (bi + 1 < 4) P4_XLOAD((bi + 1) & 1, bi + 1);
                __builtin_amdgcn_sched_barrier(0);
#pragma unroll
                for (int e = 0; e < 8; ++e) {
                    const int reg = 8 * g8 + e, rowc = 32 * rt + (reg & 3) + 8 * (reg >> 2);
                    float s = 0.f;
#pragma unroll
                    for (int ct = 0; ct < 4; ++ct) { const float v = xv[bi & 1][e][ct] + gate[ct] * acc[rt][ct][reg]; acc[rt][ct][reg] = v; s += v * v; }
                    s += __shfl_xor(s, 16); s += __shfl_xor(s, 8); s += __shfl_xor(s, 4); s += __shfl_xor(s, 2); s += __shfl_xor(s, 1);
                    *(LAS float*)(lds + rb + (unsigned)(rowc * 32)) = s;
                }
                asm volatile("" ::: "memory"); __builtin_amdgcn_sched_barrier(0);
            }
#undef P4_XLOAD
            __syncthreads();
            if (tid < 64) { float s = 0.f;
#pragma unroll
                for (int w = 0; w < 8; ++w) s += RED[tid * 8 + w];
                RS[tid] = 1.0f / sqrtf(s * (1.f / D) + EPS); }
            __syncthreads();
            const unsigned eo2 = launder(eo);
            const unsigned sb = launder((unsigned)(L4_RS + 4 * h * 4));
#pragma unroll
            for (int rt = 0; rt < 2; ++rt)
#pragma unroll
                for (int reg = 0; reg < 16; ++reg) {
                    const int rowc = 32 * rt + (reg & 3) + 8 * (reg >> 2); const float rs = *(const LAS float*)(lds + sb + (unsigned)(rowc * 4));
#pragma unroll
                    for (int ct = 0; ct < 4; ++ct) *(float*)(oblk + (eo2 + (unsigned)((rowc * D + 32 * ct) * 4))) = acc[rt][ct][reg] * rs * fwv[ct];
                }
        }
#endif
    }
}

#define XB_TMO      128
#define XB_XCNT(j)  (256  + 64 * (j))
#define XB_XSUB(j)  (1280 + 64 * (j))
#define XB_XGEN(j)  (2304 + 64 * (j))
#define XB_TOP      3328
#define XB_TOPGEN   3392
#define XCD_BAR_WORDS 3456
#define XB_SPIN_CAP (1u << 18)

__device__ __forceinline__ unsigned xb_ld(unsigned* p)              { return __hip_atomic_load(p, __ATOMIC_RELAXED, __HIP_MEMORY_SCOPE_AGENT); }
__device__ __forceinline__ unsigned xb_add(unsigned* p, unsigned v) { return __hip_atomic_fetch_add(p, v, __ATOMIC_RELAXED, __HIP_MEMORY_SCOPE_AGENT); }
__device__ __forceinline__ unsigned xb_xcc_id() { return (unsigned)__builtin_amdgcn_s_getreg((3 << 11) | 20) & 0xFu; }
#define XB_SPIN(cond, bar) do { unsigned _sp = 0; while (cond) { __builtin_amdgcn_s_sleep(1); \
    if ((++_sp & 255u) == 0u) { if (xb_ld(&(bar)[XB_TMO])) break; if (_sp > XB_SPIN_CAP) { atomicAdd(&(bar)[XB_TMO], 1u); break; } } } } while (0)

struct XcdBarrier {
    unsigned* bar; unsigned x;
    volatile LAS unsigned* st;
};

__device__ __forceinline__ XcdBarrier xcd_barrier_post(unsigned* bar, volatile LAS unsigned* st, const int wave_) {
    XcdBarrier b; b.bar = bar; b.x = xb_xcc_id(); b.st = st;
    if (wave_ == 0 && fresh_lane() == 0) (void)xb_add(&bar[XB_XCNT(b.x)], 1u);
    return b;
}
__device__ __forceinline__ void xcd_barrier_complete(unsigned* bar, unsigned x, unsigned& nloc, unsigned& nx) {
    const unsigned G = gridDim.x * gridDim.y * gridDim.z;
    unsigned sum, cnt, mine, sp = 0u;
    for (;;) {
        sum = 0u; cnt = 0u; mine = 0u;
#pragma unroll
        for (unsigned j = 0; j < 16; ++j) { const unsigned c = xb_ld(&bar[XB_XCNT(j)]); sum += c; cnt += (c > 0u) ? 1u : 0u; mine = (j == x) ? c : mine; }
        if (sum == G) break;
        __builtin_amdgcn_s_sleep(1);
        if ((++sp & 255u) == 0u) { if (xb_ld(&bar[XB_TMO])) break; if (sp > XB_SPIN_CAP) { atomicAdd(&bar[XB_TMO], 1u); break; } }
    }
    nloc = mine > 0u ? mine : 1u; nx = cnt > 0u ? cnt : 1u;
}

__device__ __forceinline__ void xcd_barrier(const XcdBarrier& b, const int wave_) {
    asm volatile("s_waitcnt vmcnt(0)" ::: "memory");
    __syncthreads();
    if (wave_ == 0 && fresh_lane() == 0) {
        unsigned* bar = b.bar;
        __builtin_amdgcn_s_waitcnt(0);
        unsigned nloc = b.st[0], nx = b.st[1];
        if (nloc == 0u) { xcd_barrier_complete(bar, b.x, nloc, nx); b.st[0] = nloc; b.st[1] = nx; }
        const unsigned old = xb_add(&bar[XB_XSUB(b.x)], 1u);
        const unsigned gen = old / nloc;
        if (old + 1u == (gen + 1u) * nloc) {
            __builtin_amdgcn_fence(__ATOMIC_RELEASE, "agent");
            asm volatile("s_waitcnt vmcnt(0)" ::: "memory");
            const unsigned og = xb_add(&bar[XB_TOP], 1u);
            const unsigned tg = og / nx;
            if (og + 1u == (tg + 1u) * nx) xb_add(&bar[XB_TOPGEN], 1u);
            else XB_SPIN(xb_ld(&bar[XB_TOPGEN]) == tg, bar);
            __builtin_amdgcn_fence(__ATOMIC_ACQUIRE, "agent");
            xb_add(&bar[XB_XGEN(b.x)], 1u);
            asm volatile("s_waitcnt vmcnt(0)" ::: "memory");
        } else {
            XB_SPIN(xb_ld(&bar[XB_XGEN(b.x)]) == gen, bar);
            __builtin_amdgcn_fence(__ATOMIC_ACQUIRE, "agent");
            asm volatile("s_waitcnt vmcnt(0)" ::: "memory");
        }
    }
    __syncthreads();
}

#ifdef SELF_CLEAN_BARRIER
__device__ unsigned g_bar[4096];
#endif
__global__ void __launch_bounds__(NTHR, 2) hybrid_fwd(Args args) {
    extern __shared__ __attribute__((aligned(16))) unsigned char lds_raw[];
    LAS unsigned char* lds = (LAS unsigned char*)lds_raw;
    const int wave = __builtin_amdgcn_readfirstlane((int)threadIdx.x >> 6), G = gridDim.x; const int tid = 0, lane = 0;
    cg::grid_group grid = cg::this_grid();
    volatile LAS unsigned* misc = (volatile LAS unsigned*)(lds + LDS_MISC);
    if (threadIdx.x < 2) misc[threadIdx.x] = 0u;
    __syncthreads();
    if (args.ph_lo < 0) grid.sync();
    #ifdef SELF_CLEAN_BARRIER
    XcdBarrier xbar = xcd_barrier_post(g_bar, misc, wave);
#else
    XcdBarrier xbar = xcd_barrier_post((unsigned*)(args.ws + WS_CTL), misc, wave);
#endif
    const int lo = args.ph_lo, hi = args.ph_hi;
#ifndef PHMASK
#define PHMASK 31
#endif
#define IN(k) (((PHMASK >> (k)) & 1) && lo <= (k) && (k) < hi)
#define SEAM(k) do { if (IN(k) && IN((k) + 1)) xcd_barrier(xbar, wave); } while (0)
#ifndef REPEAT_MASK
#define REPEAT_MASK 0
#endif
#ifdef PROBE_PH
    unsigned long long pt0_ = 0ull; unsigned pacc_ = 0u;
#define PB(k) do { if (PROBE_PH == (k)) pt0_ = __builtin_amdgcn_s_memrealtime(); } while (0)
#define PE(k) do { if (PROBE_PH == (k)) pacc_ += (unsigned)(__builtin_amdgcn_s_memrealtime() - pt0_); } while (0)
#else
#define PB(k) do {} while (0)
#define PE(k) do {} while (0)
#endif
    PB(20);
#define REP(k) _Pragma("nounroll") for (int rep_ = 0; rep_ < 1 + ((REPEAT_MASK >> (k)) & 1); ++rep_)
#ifdef EXTRA_SYNCS
    for (int es_ = 0; es_ < EXTRA_SYNCS; ++es_) xcd_barrier(xbar, wave);
#endif
    PB(0);
    if (IN(0)) REP(0) { if (rep_) xcd_barrier(xbar, wave); p0_phase(args, lds, tid, lane, wave, G); }
    PE(0); PB(10); __syncthreads();   PE(10); PB(1);
    if (IN(1)) REP(1) { if (rep_) xcd_barrier(xbar, wave); p1_phase(args, lds, tid, lane, wave, G); }
    PE(1); PB(11); SEAM(1); PE(11); PB(2);
    if (IN(2)) REP(2) {
        if (rep_) xcd_barrier(xbar, wave);
        __syncthreads();
        pg8::Gemm g{(const pg8::bf16_t*)((const unsigned char*)args.out + OUT_H), (const pg8::bf16_t*)((const unsigned char*)args.out + OUT_WINT), MTOK, NP_MAIN, D};
        pg8::StaticOrder S; S.init(MTOK, NP_MAIN, G, (int)blockIdx.x);
        pg8::EpiProj E{(pg8::bf16_t*)(args.ws + WS_PROJ), NP};
        pg8::gemm_phase<pg8::EpiProj, pg8::StaticOrder, true, true>(lds, g, S, E, wave);
        for (int blk = blockIdx.x; blk < 256; blk += G) {
            const int lane_ = fresh_lane(), tid_ = wave * 64 + lane_;
            f32x16 accT[2];
#pragma unroll
            for (int i = 0; i < 2; ++i)
#pragma unroll
                for (int e = 0; e < 16; ++e) accT[i][e] = 0.f;
            tail_gemmT(accT, (const bf16*)((const unsigned char*)args.out + OUT_H) + (size_t)blk * 64 * 1024, (const bf16*)(args.ws + WS_WTF), wave, lds, tid_, lane_);
            const int l2 = fresh_lane(), r2 = l2 & 31, h2 = l2 >> 5;
            bf16* prow = (bf16*)(args.ws + WS_PROJ) + ((size_t)blk * 64 + r2) * NP + NP_MAIN + 32 * wave + 4 * h2;
#pragma unroll
            for (int rt = 0; rt < 2; ++rt)
#pragma unroll
                for (int g4 = 0; g4 < 4; ++g4) { u32x2 ov; ov.x = pk2(accT[rt][4 * g4], accT[rt][4 * g4 + 1]); ov.y = pk2(accT[rt][4 * g4 + 2], accT[rt][4 * g4 + 3]);
                    *(u32x2*)(prow + (size_t)rt * 32 * NP + 8 * g4) = ov; }
        }
    }
    PE(2); PB(12); SEAM(2); PE(12); PB(3);
    if (IN(3)) { p3a_phase(args, wave, G); PE(3); PB(13); xcd_barrier(xbar, wave); PE(13); PB(4); if ((REPEAT_MASK >> 3) & 1) { p3_phase(args, lds, tid, lane, wave, G, true); xcd_barrier(xbar, wave); } p3_phase(args, lds, tid, lane, wave, G); }
    PE(4); PB(14); SEAM(3); PE(14); PB(5);
    if (IN(4)) REP(4) { if (rep_) xcd_barrier(xbar, wave); p4_phase(args, lds, tid, lane, wave, G); }
#undef REP
    PE(5); PE(20);
#if defined(SELF_CLEAN_BARRIER) && !defined(PROBE_PH)
    {
        __syncthreads();
        if (wave == 0) {
            const int l_ = fresh_lane();
            unsigned last_ = 0u;
            if (l_ == 0) last_ = (__hip_atomic_fetch_add(&g_bar[4032], 1u, __ATOMIC_RELAXED, __HIP_MEMORY_SCOPE_AGENT) == (unsigned)G - 1u) ? 1u : 0u;
            last_ = (unsigned)__builtin_amdgcn_readfirstlane((int)last_);
            if (last_) {
                if (l_ < 16) { __hip_atomic_store(&g_bar[XB_XCNT(l_)], 0u, __ATOMIC_RELAXED, __HIP_MEMORY_SCOPE_AGENT); __hip_atomic_store(&g_bar[XB_XSUB(l_)], 0u, __ATOMIC_RELAXED, __HIP_MEMORY_SCOPE_AGENT); __hip_atomic_store(&g_bar[XB_XGEN(l_)], 0u, __ATOMIC_RELAXED, __HIP_MEMORY_SCOPE_AGENT); }
                if (l_ == 16) { __hip_atomic_store(&g_bar[XB_TOP], 0u, __ATOMIC_RELAXED, __HIP_MEMORY_SCOPE_AGENT); __hip_atomic_store(&g_bar[XB_TOPGEN], 0u, __ATOMIC_RELAXED, __HIP_MEMORY_SCOPE_AGENT);
                                __hip_atomic_store(&g_bar[XB_TMO], 0u, __ATOMIC_RELAXED, __HIP_MEMORY_SCOPE_AGENT); __hip_atomic_store(&g_bar[4032], 0u, __ATOMIC_RELAXED, __HIP_MEMORY_SCOPE_AGENT); }
            }
        }
    }
#endif
#ifdef PROBE_PH
    if (blockIdx.x == PROBE_PBLK && wave == 0 && fresh_lane() == 0) ((unsigned*)(args.ws + WS_CTL))[4001] = pacc_;
    if (blockIdx.x == 0) { xcd_barrier(xbar, wave); } else { xcd_barrier(xbar, wave); }
    if (blockIdx.x == 0 && wave == 0 && fresh_lane() == 0) { asm volatile("s_waitcnt vmcnt(0)" ::: "memory"); args.out[0] = 50.0f * floorf(0.01f * (float)__hip_atomic_load((unsigned*)(args.ws + WS_CTL) + 4001, __ATOMIC_RELAXED, __HIP_MEMORY_SCOPE_AGENT) / 50.0f + 0.5f); }
#endif
#ifdef PROBE_SEL
    if (blockIdx.x == 0 && wave == 0 && fresh_lane() == 0) { asm volatile("s_waitcnt vmcnt(0)" ::: "memory"); args.out[0] = 0.01f * (float)((volatile unsigned*)(args.ws + WS_CTL))[4000]; }
#endif
#undef IN
#undef SEAM
}

extern "C" void kernel_launch(void* const* d_in, const int* in_sizes, int n_in, void* d_out, int out_size, void* d_ws, size_t ws_size, hipStream_t stream) {
    static int grid = 0;
    if (grid == 0) {
        if (n_in != 16 || out_size != MTOK * D || ws_size < WS_END) { fprintf(stderr, "kernel_launch: unexpected shapes (n_in %d out %d ws %zu)\n", n_in, out_size, ws_size); grid = -1; return; }
        int dev = 0, cus = 0, per_cu = 0;
        (void)hipGetDevice(&dev);
        (void)hipDeviceGetAttribute(&cus, hipDeviceAttributeMultiprocessorCount, dev);
        if (hipFuncSetAttribute((const void*)hybrid_fwd, hipFuncAttributeMaxDynamicSharedMemorySize, LDS_BYTES) != hipSuccess) { fprintf(stderr, "kernel_launch: hipFuncSetAttribute failed\n"); grid = -1; return; }
        if (hipOccupancyMaxActiveBlocksPerMultiprocessor(&per_cu, (const void*)hybrid_fwd, NTHR, LDS_BYTES) != hipSuccess || per_cu < 1) { fprintf(stderr, "kernel_launch: occupancy query says %d\n", per_cu); per_cu = 1; }
        (void)hipGetLastError();
        grid = cus * per_cu;
        if (grid > 256) grid = 256;
        if (grid < 1) grid = 1;
    }
    if (grid < 0) return;
#ifndef SELF_CLEAN_BARRIER
    if (hipMemsetAsync((char*)d_ws + WS_CTL, 0, CTL_BYTES, stream) != hipSuccess) { fprintf(stderr, "kernel_launch: memset of the barrier words failed\n"); return; }
#endif
    Args a{};
    for (int i = 0; i < 16; ++i) a.in[i] = (const float*)d_in[i];
    a.out = (float*)d_out; a.ws = (unsigned char*)d_ws;
#if N_LAUNCHES == 1
    a.ph_lo = 0; a.ph_hi = NPH;
    void* kargs[] = {&a};
    hipError_t e = hipLaunchCooperativeKernel((const void*)hybrid_fwd, dim3(grid), dim3(NTHR), kargs, LDS_BYTES, stream);
    if (e != hipSuccess) fprintf(stderr, "kernel_launch: cooperative launch failed: %s (grid %d)\n", hipGetErrorString(e), grid);
#else
    for (int p = 0; p < NPH; ++p) {
        a.ph_lo = p; a.ph_hi = p + 1;
        hipLaunchKernelGGL(hybrid_fwd, dim3(grid), dim3(NTHR), LDS_BYTES, stream, a);
    }
#endif
}
```

```cpp
#include <hip/hip_runtime.h>
#include <hip/hip_cooperative_groups.h>
#include <cstdio>
#include <cstdint>
namespace cg = cooperative_groups;
#define N_LAUNCHES 1
#define REPEAT_MASK 0
#define P4_REP2 1
__device__ __forceinline__ unsigned launder(unsigned v) { asm volatile("" : "+v"(v)); return v; }
__device__ __forceinline__ int fresh_lane() { unsigned z; asm volatile("v_mov_b32 %0, 0" : "=v"(z)); return (int)__builtin_amdgcn_mbcnt_hi(~0u, __builtin_amdgcn_mbcnt_lo(~0u, z)); }
namespace pg8 {
#define PG8_LAS __attribute__((address_space(3)))
typedef unsigned short bf16_t;
typedef short bf16x8 __attribute__((ext_vector_type(8)));
typedef float f32x4 __attribute__((ext_vector_type(4)));
typedef unsigned u32x4 __attribute__((ext_vector_type(4)));
constexpr int BM = 256, BK = 64, HALF = 128, HTB = HALF * BK * 2  , STAGE_BYTES = 8 * HTB, NXCD = 8, WGM = 8;

__host__ __device__ __forceinline__ int lds_byte(int r, int c) { const int st = (r >> 4) * 2 + (c >> 5), rr = r & 15, cc = c & 31, ob = rr * 64 + cc * 2; return st * 1024 + (ob ^ (((ob >> 9) & 1) << 5)); }
__host__ __device__ __forceinline__ void stage_rc(int b, int& R, int& C) { const int st = b / 1024, sb = b % 1024, swz = sb ^ (((sb >> 9) & 1) << 5); R = (st >> 1) * 16 + swz / 64; C = (st & 1) * 32 + (swz % 64) / 2; }
__host__ __device__ __forceinline__ int perm32(int rho) { const int n = rho >> 4, i = rho & 15; return 8 * (i >> 2) + 4 * n + (i & 3); }

struct Unit { int pm, pn; };
struct Gemm { const bf16_t* A; const bf16_t* Bt; int M, N, K; };

struct StaticOrder {
    int nM, nN, nwg, G, c;
    __host__ __device__ void init(int M, int N, int G_, int c_) { nM = M / BM; nN = N / BM; nwg = nM * nN; G = G_; c = c_; }
    __host__ __device__ bool next(int i, Unit& u) const {
        const long L = (long)i * G + c; if (L >= nwg) return false;
        int wgid = (int)L; { const int q = nwg / NXCD, r = nwg % NXCD, xcd = wgid % NXCD, off = wgid / NXCD; wgid = (xcd < r ? xcd * (q + 1) : r * (q + 1) + (xcd - r) * q) + off; }
        const int nig = WGM * nN, gid = wgid / nig, fm = gid * WGM, gsz = (nM - fm) < WGM ? (nM - fm) : WGM;
        u.pm = fm + ((wgid % nig) % gsz); u.pn = (wgid % nig) / gsz; return true;
    }
    __device__ __forceinline__ void a_ready(const Unit&) const {}
    __device__ __forceinline__ void done(const Unit&) const {}
};
__device__ __forceinline__ unsigned cvt_pk_bf16(float lo, float hi) { unsigned r; asm volatile("v_cvt_pk_bf16_f32 %0, %1, %2" : "=v"(r) : "v"(lo), "v"(hi)); return r; }
struct EpiProj {
    static constexpr bool PERM = true, AFTER_DRAIN = false;
    bf16_t* O; int ldc;
    __device__ __forceinline__ void operator()(const f32x4 (&acc)[2][2][4][2], const Unit& u, int wr, int wc, int fr, int fq) const {
        const int row0 = u.pm * BM + wr * 64 + fr; const int col0 = u.pn * BM + wc * 32 + 8 * fq;
#pragma unroll
        for (int ai = 0; ai < 2; ++ai)
#pragma unroll
            for (int m = 0; m < 4; ++m) { bf16_t* rowp = O + (size_t)(row0 + ai * HALF + m * 16) * ldc + col0;
#pragma unroll
                for (int bj = 0; bj < 2; ++bj) { const f32x4 v0 = acc[ai][bj][m][0], v1 = acc[ai][bj][m][1];
                    u32x4 w; w.x = cvt_pk_bf16(v0[0], v0[1]); w.y = cvt_pk_bf16(v0[2], v0[3]); w.z = cvt_pk_bf16(v1[0], v1[1]); w.w = cvt_pk_bf16(v1[2], v1[3]);
                    *(u32x4*)(rowp + bj * HALF) = w; } }
    }
    __device__ __forceinline__ void fused(f32x4 (&)[2][2][4][2], const Unit&, int, int, int, int, PG8_LAS unsigned char*, int, int) const {}
};
template <class Epi, class Sched, bool ALIGN_EPI = false, bool SP2 = false>
__device__ __forceinline__ void gemm_phase(PG8_LAS unsigned char* lds, const Gemm g, const Sched& S, const Epi& E, const int wid) {
    const int lane = ::fresh_lane(), tid = wid * 64 + lane, wr = wid >> 2, wc = wid & 3, fr = lane & 15, fq = lane >> 4;
    const int K = g.K, nt = K / BK;
    unsigned voffA[2], voffB[2];
#pragma unroll
    for (int i = 0; i < 2; ++i) { int R, C; stage_rc(tid * 16 + i * 8192, R, C); const int Rb = Epi::PERM ? ((R & ~31) + perm32(R & 31)) : R;
        voffA[i] = (unsigned)(R * K + C) * 2u; voffB[i] = (unsigned)(Rb * K + C) * 2u; }
    const size_t kstep = (size_t)(BK * 2);
    const size_t hstep = (size_t)HALF * K * 2;
    const size_t tstep = 2 * hstep;
    const unsigned ldsw = (unsigned)wid * 1024u;
    const int aoff = lds_byte(wr * 64 + fr, fq * 8), boff = lds_byte(wc * 32 + fr, fq * 8);
#define PG8_SA(b, h) (((b) * 2 + (h)) * HTB)
#define PG8_SB(b, h) ((4 + (b) * 2 + (h)) * HTB)
#define PG8_STAGE(bufoff, gbase, voff) do { _Pragma("unroll") for (int _i = 0; _i < 2; ++_i) \
        __builtin_amdgcn_global_load_lds((const unsigned*)((const char*)(gbase) + (voff)[_i]), (PG8_LAS unsigned*)(lds + (bufoff) + ldsw + _i * 8192), 16, 0, 0); } while (0)
#define PG8_LDA(dst, b, h) do { _Pragma("unroll") for (int m = 0; m < 4; ++m) _Pragma("unroll") for (int k = 0; k < 2; ++k) dst[m][k] = *(const PG8_LAS bf16x8*)(lds + PG8_SA(b, h) + aoff + m * 2048 + k * 1024); } while (0)
#define PG8_LDB(dst, b, h) do { _Pragma("unroll") for (int n = 0; n < 2; ++n) _Pragma("unroll") for (int k = 0; k < 2; ++k) dst[n][k] = *(const PG8_LAS bf16x8*)(lds + PG8_SB(b, h) + boff + n * 2048 + k * 1024); } while (0)
#define PG8_MMA(ai, bj, At, Bt) do { __builtin_amdgcn_s_setprio(1); _Pragma("unroll") for (int m = 0; m < 4; ++m) _Pragma("unroll") for (int n = 0; n < 2; ++n) _Pragma("unroll") for (int k = 0; k < 2; ++k) \
        acc[ai][bj][m][n] = __builtin_amdgcn_mfma_f32_16x16x32_bf16(Bt[n][k], At[m][k], acc[ai][bj][m][n], 0, 0, 0); __builtin_amdgcn_s_setprio(0); } while (0)
#define PG8_WAIT_V(n) asm volatile("s_waitcnt vmcnt(" #n ")" ::: "memory")
#define PG8_WAIT_L(n) asm volatile("s_waitcnt lgkmcnt(" #n ")" ::: "memory")
#define PG8_BAR __builtin_amdgcn_s_barrier()
#define PG8_SCHED __builtin_amdgcn_sched_barrier(0)
    Unit cur, nxt; int ui = 0;
    if (!S.next(0, cur)) return;
    f32x4 acc[2][2][4][2];
#pragma unroll
    for (int a = 0; a < 2; ++a)
#pragma unroll
        for (int b = 0; b < 2; ++b)
#pragma unroll
            for (int m = 0; m < 4; ++m)
#pragma unroll
                for (int n = 0; n < 2; ++n) acc[a][b][m][n] = (f32x4){0.f, 0.f, 0.f, 0.f};
    bf16x8 At[4][2], B0[2][2], B1[2][2];
    const char* cA = (const char*)g.A + (size_t)cur.pm * tstep; const char* cB = (const char*)g.Bt + (size_t)cur.pn * tstep;
    S.a_ready(cur);
    if constexpr (SP2) {
        PG8_STAGE(PG8_SB(0, 0), cB, voffB); PG8_STAGE(PG8_SB(0, 1), cB + hstep, voffB); PG8_STAGE(PG8_SA(0, 0), cA, voffA); PG8_STAGE(PG8_SA(0, 1), cA + hstep, voffA);
        if (wr == 1) PG8_BAR;
        PG8_WAIT_V(2); PG8_BAR;
        PG8_STAGE(PG8_SB(1, 0), cB + kstep, voffB); PG8_STAGE(PG8_SA(1, 0), cA + kstep, voffA); PG8_STAGE(PG8_SB(1, 1), cB + hstep + kstep, voffB);
        PG8_WAIT_V(6); PG8_BAR;
    } else {
        PG8_STAGE(PG8_SB(0, 0), cB, voffB); PG8_STAGE(PG8_SA(0, 0), cA, voffA); PG8_STAGE(PG8_SB(0, 1), cB + hstep, voffB); PG8_STAGE(PG8_SA(0, 1), cA + hstep, voffA);
        if (wr == 1) PG8_BAR;
        PG8_WAIT_V(4); PG8_BAR;
        PG8_STAGE(PG8_SB(1, 0), cB + kstep, voffB); PG8_STAGE(PG8_SA(1, 0), cA + kstep, voffA); PG8_STAGE(PG8_SB(1, 1), cB + hstep + kstep, voffB);
        PG8_WAIT_V(6); PG8_BAR;
    }
    for (;;) {
        const bool has_next = S.next(ui + 1, nxt);
        const char* nA = has_next ? (const char*)g.A + (size_t)nxt.pm * tstep : cA; const char* nB = has_next ? (const char*)g.Bt + (size_t)nxt.pn * tstep : cB;
        for (int t = 0; t < nt; t += 2) {
            const bool last = (t == nt - 2);
            const char* a1 = cA + (size_t)(t + 1) * kstep;
            const char* a2 = last ? nA : cA + (size_t)(t + 2) * kstep; const char* b2 = last ? nB : cB + (size_t)(t + 2) * kstep;
            const char* a3 = a2 + kstep; const char* b3 = b2 + kstep;
            if (last && has_next) S.a_ready(nxt);
            if constexpr (SP2) {
            PG8_LDB(B0, 0, 0); PG8_LDB(B1, 0, 1); PG8_SCHED; PG8_LDA(At, 0, 0); PG8_STAGE(PG8_SA(1, 1), a1 + hstep, voffA);
            PG8_WAIT_V(8); PG8_WAIT_L(0); PG8_BAR; PG8_MMA(0, 0, At, B0); PG8_MMA(0, 1, At, B1); PG8_BAR; PG8_SCHED;
            PG8_LDA(At, 0, 1); PG8_STAGE(PG8_SB(0, 0), b2, voffB); PG8_STAGE(PG8_SB(0, 1), b2 + hstep, voffB); PG8_STAGE(PG8_SA(0, 0), a2, voffA);
            PG8_WAIT_V(8); PG8_WAIT_L(0); PG8_BAR; PG8_MMA(1, 0, At, B0); PG8_MMA(1, 1, At, B1); PG8_BAR; PG8_SCHED;
            PG8_LDB(B0, 1, 0); PG8_LDB(B1, 1, 1); PG8_SCHED; PG8_LDA(At, 1, 0); PG8_STAGE(PG8_SA(0, 1), a2 + hstep, voffA);
            PG8_WAIT_V(8); PG8_WAIT_L(0); PG8_BAR; PG8_MMA(0, 0, At, B0); PG8_MMA(0, 1, At, B1); PG8_BAR; PG8_SCHED;
            PG8_LDA(At, 1, 1); PG8_STAGE(PG8_SB(1, 0), b3, voffB); PG8_STAGE(PG8_SB(1, 1), b3 + hstep, voffB); PG8_STAGE(PG8_SA(1, 0), a3, voffA);
            PG8_WAIT_V(8); PG8_WAIT_L(0); PG8_BAR; PG8_MMA(1, 0, At, B0); PG8_MMA(1, 1, At, B1); PG8_BAR; PG8_SCHED;
            } else {
            PG8_LDB(B0, 0, 0); PG8_SCHED; PG8_LDA(At, 0, 0); PG8_STAGE(PG8_SA(1, 1), a1 + hstep, voffA);
            PG8_WAIT_L(8); PG8_BAR; PG8_WAIT_L(0); PG8_MMA(0, 0, At, B0); PG8_BAR; PG8_SCHED;
            PG8_LDB(B1, 0, 1); PG8_STAGE(PG8_SB(0, 0), b2, voffB);
            PG8_BAR; PG8_WAIT_L(0); PG8_MMA(0, 1, At, B1); PG8_BAR;
            PG8_LDA(At, 0, 1); PG8_STAGE(PG8_SA(0, 0), a2, voffA);
            PG8_BAR; PG8_WAIT_L(0); PG8_MMA(1, 0, At, B0); PG8_BAR; PG8_SCHED;
            PG8_STAGE(PG8_SB(0, 1), b2 + hstep, voffB);
            PG8_WAIT_V(6); PG8_BAR; PG8_MMA(1, 1, At, B1); PG8_BAR;
            PG8_LDB(B0, 1, 0); PG8_SCHED; PG8_LDA(At, 1, 0); PG8_STAGE(PG8_SA(0, 1), a2 + hstep, voffA);
            PG8_WAIT_L(8); PG8_BAR; PG8_WAIT_L(0); PG8_MMA(0, 0, At, B0); PG8_BAR; PG8_SCHED;
            PG8_LDB(B1, 1, 1); PG8_STAGE(PG8_SB(1, 0), b3, voffB);
            PG8_BAR; PG8_WAIT_L(0); PG8_MMA(0, 1, At, B1); PG8_BAR;
            PG8_LDA(At, 1, 1); PG8_STAGE(PG8_SA(1, 0), a3, voffA);
            PG8_BAR; PG8_WAIT_L(0); PG8_MMA(1, 0, At, B0); PG8_BAR; PG8_SCHED;
            PG8_STAGE(PG8_SB(1, 1), b3 + hstep, voffB);
            PG8_WAIT_V(6); PG8_BAR; PG8_MMA(1, 1, At, B1); PG8_BAR;
            }
        }
        if constexpr (ALIGN_EPI) { if (wr == 0) PG8_BAR; }
        if constexpr (!Epi::AFTER_DRAIN) { E(acc, cur, wr, wc, fr, fq); S.done(cur); }
        if (!has_next) break;
#pragma unroll
        for (int a = 0; a < 2; ++a)
#pragma unroll
            for (int b = 0; b < 2; ++b)
#pragma unroll
                for (int m = 0; m < 4; ++m)
#pragma unroll
                    for (int n = 0; n < 2; ++n) acc[a][b][m][n] = (f32x4){0.f, 0.f, 0.f, 0.f};
        cur = nxt; cA = nA; cB = nB; ++ui;
        if constexpr (ALIGN_EPI) { if (wr == 1) PG8_BAR; }
    }
    PG8_WAIT_V(0);
    if constexpr (!ALIGN_EPI) { if (wr == 0) PG8_BAR; }
    PG8_BAR;
    if constexpr (Epi::AFTER_DRAIN) { E.fused(acc, cur, wr, wc, fr, fq, lds, wid, lane); S.done(cur); }
#undef PG8_SA
#undef PG8_SB
#undef PG8_STAGE
#undef PG8_LDA
#undef PG8_LDB
#undef PG8_MMA
#undef PG8_WAIT_V
#undef PG8_WAIT_L
#undef PG8_BAR
#undef PG8_SCHED
}
}

#define LAS __attribute__((address_space(3)))
typedef unsigned short bf16;
typedef short bf16x8 __attribute__((ext_vector_type(8)));
typedef short s16x4 __attribute__((ext_vector_type(4)));
typedef float f32x4 __attribute__((ext_vector_type(4)));
typedef float f32x16 __attribute__((ext_vector_type(16)));
typedef unsigned u32x4 __attribute__((ext_vector_type(4)));
typedef unsigned u32x2 __attribute__((ext_vector_type(2)));
typedef float f32x2_t __attribute__((ext_vector_type(2)));
typedef __bf16 bf16x2_t __attribute__((ext_vector_type(2)));

#ifndef N_LAUNCHES
#define N_LAUNCHES 1
#endif
constexpr int NPH = 5;
constexpr int D = 1024, NB = 8, SEQ = 2048, MTOK = NB * SEQ, NIN = 7440, NP = 7424, NP_MAIN = 7168;
constexpr int C_Z = 0, C_X = 1024, C_B = 2048, C_C = 2176, C_Q = 2304, C_K = 2816, C_V = 3328, C_GR = 4352, C_GAM = 5376, C_GAR = 6400;
constexpr float EPS = 1e-6f;
constexpr size_t MiB = 1u << 20;
constexpr size_t WS_PROJ = 0;
constexpr size_t WS_WMF = 232 * MiB, WS_WRF = 234 * MiB, WS_WOF = 236 * MiB;
constexpr size_t WS_MOD = 238 * MiB;
constexpr size_t WS_DT = 239 * MiB;
constexpr size_t WS_SSQM = 240 * MiB;
constexpr size_t WS_SSQR = 242 * MiB;
constexpr int CW_MODCNT = 3900;
constexpr size_t WS_CTL = 244 * MiB, CTL_BYTES = 16384;
constexpr size_t WS_WTF = 245 * MiB;
constexpr size_t WS_END = 246 * MiB;
constexpr size_t OUT_H = 0, OUT_WINT = 32 * MiB;
constexpr int LDS_BYTES = 155648, LDS_MISC = 155520;
constexpr int NTHR = 512;

struct Args { const float* in[16]; float* out; unsigned char* ws; int ph_lo, ph_hi; };

__device__ __forceinline__ float bf_lo(unsigned u) { return __uint_as_float(u << 16); }
__device__ __forceinline__ float bf_hi(unsigned u) { return __uint_as_float(u & 0xffff0000u); }
__device__ __forceinline__ unsigned pk2(float lo, float hi) { f32x2_t v = {lo, hi}; bf16x2_t b = __builtin_convertvector(v, bf16x2_t); return __builtin_bit_cast(unsigned, b); }
__device__ __forceinline__ float silu_f(float x) { return x * __builtin_amdgcn_rcpf(1.f + __expf(-x)); }
__device__ __forceinline__ float sigm_f(float x) { return __builtin_amdgcn_rcpf(1.f + __expf(-x)); }
__device__ __forceinline__ float wave_sum(float v) {
#pragma unroll
    for (int o = 1; o < 64; o <<= 1) v += __shfl_xor(v, o);
    return v;
}
__device__ __forceinline__ int crow(int reg, int h) { return (reg & 3) + 8 * (reg >> 2) + 4 * h; }
#define MFMA32(a, b, c) __builtin_amdgcn_mfma_f32_32x32x16_bf16((a), (b), (c), 0, 0, 0)
#define MFMA16(a, b, c) __builtin_amdgcn_mfma_f32_16x16x32_bf16((a), (b), (c), 0, 0, 0)
__device__ __forceinline__ s16x4 tr_read(const LAS unsigned char* p) {
    typedef short v4i16_t __attribute__((ext_vector_type(4)));
    return __builtin_bit_cast(s16x4, __builtin_amdgcn_ds_read_tr16_b64_v4i16((LAS v4i16_t*)p));
}
__device__ __forceinline__ bf16x8 tr_pair(const LAS unsigned char* plo, const LAS unsigned char* phi) {
    const s16x4 lo = tr_read(plo), hi = tr_read(phi);
    return __builtin_shufflevector(lo, hi, 0, 1, 2, 3, 4, 5, 6, 7);
}
__device__ __forceinline__ bf16x8 pack8(float a0, float a1, float a2, float a3, float a4, float a5, float a6, float a7) {
    u32x4 p; p.x = pk2(a0, a1); p.y = pk2(a2, a3); p.z = pk2(a4, a5); p.w = pk2(a6, a7);
    return __builtin_bit_cast(bf16x8, p);
}

__device__ __forceinline__ void p0_load_tile(const float* W, int ldw, int k0, int n0, LAS float* scr, int lane) {
    float t[32];
#pragma unroll
    for (int i = 0; i < 32; ++i) t[i] = W[(size_t)(k0 + 2 * i + (lane >> 5)) * ldw + n0 + (lane & 31)];
#pragma unroll
    for (int i = 0; i < 32; ++i) scr[(2 * i + (lane >> 5)) * 33 + (lane & 31)] = t[i];
}
__device__ __forceinline__ void p0_phase(const Args& a, LAS unsigned char* lds, int tid_unused, int lane_unused, int wave, int G) {
    const int lane = fresh_lane(), tid = wave * 64 + lane;
    const float* cvec = a.in[1]; const float* w_ada = a.in[2]; const float* b_ada = a.in[3];
    float* MOD = (float*)(a.ws + WS_MOD);
    LAS float* cT = (LAS float*)lds;
    LAS float* red = (LAS float*)(lds + 32768);
    if ((int)blockIdx.x < 192) {
        { float t[16];
#pragma unroll
          for (int i = 0; i < 16; ++i) t[i] = cvec[tid + 512 * i];
#pragma unroll
          for (int i = 0; i < 16; ++i) { const int idx = tid + 512 * i; cT[(idx & 1023) * 8 + (idx >> 10)] = t[i]; } }
        __syncthreads();
        for (int item = blockIdx.x; item < 192; item += G) {
            const int j0 = item * 16, col = lane & 15, rsub = lane >> 4, kq = wave;
            float w[32];
#pragma unroll
            for (int i = 0; i < 32; ++i) w[i] = w_ada[(size_t)(kq * 128 + 4 * i + rsub) * 3072 + j0 + col];
            float acc[8];
#pragma unroll
            for (int bb = 0; bb < 8; ++bb) acc[bb] = 0.f;
#pragma unroll
            for (int i = 0; i < 32; ++i) { const int k = kq * 128 + 4 * i + rsub;
                const f32x4 c0 = *(const LAS f32x4*)(cT + k * 8), c1 = *(const LAS f32x4*)(cT + k * 8 + 4);
                acc[0] += c0.x * w[i]; acc[1] += c0.y * w[i]; acc[2] += c0.z * w[i]; acc[3] += c0.w * w[i];
                acc[4] += c1.x * w[i]; acc[5] += c1.y * w[i]; acc[6] += c1.z * w[i]; acc[7] += c1.w * w[i]; }
#pragma unroll
            for (int bb = 0; bb < 8; ++bb) { acc[bb] += __shfl_xor(acc[bb], 16); acc[bb] += __shfl_xor(acc[bb], 32); }
            if (lane < 16) {
#pragma unroll
                for (int bb = 0; bb < 8; ++bb) red[(kq * 8 + bb) * 16 + col] = acc[bb]; }
            __syncthreads();
            if (tid < 128) { const int bb = tid >> 4, cc = tid & 15; float sum = 0.f;
#pragma unroll
                for (int q = 0; q < 8; ++q) sum += red[(q * 8 + bb) * 16 + cc];
                __hip_atomic_store(&MOD[bb * 3072 + j0 + cc], sum + b_ada[j0 + cc], __ATOMIC_RELAXED, __HIP_MEMORY_SCOPE_AGENT); }
            asm volatile("s_waitcnt vmcnt(0)" ::: "memory");
            __syncthreads();
            if (tid == 0) __hip_atomic_fetch_add((unsigned*)(a.ws + WS_CTL) + CW_MODCNT, 1u, __ATOMIC_RELAXED, __HIP_MEMORY_SCOPE_AGENT);
        }
    }
    LAS float* scr = (LAS float*)(lds + 40960 + wave * 8448);
    const int gw = blockIdx.x * 8 + wave, NGW = G * 8;
    constexpr int I_IN = 16 * (NP / 32), I_W = 16 * 32;
    bf16* WINT = (bf16*)((unsigned char*)a.out + OUT_WINT);
    for (int it = gw; it < I_IN + 3 * I_W + 128; it += NGW) {
        if (it >= I_IN + 3 * I_W) {
            const int r_ = it - (I_IN + 3 * I_W), nt = r_ & 7, kb = r_ >> 3;
            p0_load_tile(a.in[5], NIN, 64 * kb, NP_MAIN + 16 + 32 * nt, scr, lane);
            bf16* WF = (bf16*)(a.ws + WS_WTF);
            const int r = lane & 31, h = lane >> 5;
#pragma unroll
            for (int s4 = 0; s4 < 4; ++s4) { const LAS float* s = scr + (16 * s4 + 8 * h) * 33 + r;
                u32x4 o; o.x = pk2(s[0 * 33], s[1 * 33]); o.y = pk2(s[2 * 33], s[3 * 33]); o.z = pk2(s[4 * 33], s[5 * 33]); o.w = pk2(s[6 * 33], s[7 * 33]);
                *(u32x4*)(WF + ((size_t)(nt * 64 + 4 * kb + s4) * 64 + lane) * 8) = o; }
        } else if (it < I_IN) {
            const int nblk = NP / 32, kb = it / nblk, nb = it % nblk, k0 = 64 * kb, n0p = 32 * nb, n0 = n0p + (n0p >= 2304 ? 16 : 0);
            p0_load_tile(a.in[5], NIN, k0, n0, scr, lane);
            const int c = lane & 7;
#pragma unroll
            for (int j = 0; j < 4; ++j) { const int n = (lane >> 3) + 8 * j; const LAS float* s = scr + (8 * c) * 33 + n;
                u32x4 o; o.x = pk2(s[0 * 33], s[1 * 33]); o.y = pk2(s[2 * 33], s[3 * 33]); o.z = pk2(s[4 * 33], s[5 * 33]); o.w = pk2(s[6 * 33], s[7 * 33]);
                *(u32x4*)(WINT + (size_t)(n0p + n) * 1024 + k0 + 8 * c) = o; }
        } else {
            int r_ = it - I_IN; const int which = r_ / I_W; r_ -= which * I_W;
            const float* W = a.in[12 + which];
            bf16* WF = (bf16*)(a.ws + WS_WMF + (size_t)which * 2 * MiB);
            const int nt = r_ & 31, kb = r_ >> 5;
            p0_load_tile(W, 1024, 64 * kb, 32 * nt, scr, lane);
            const int r = lane & 31, h = lane >> 5;
#pragma unroll
            for (int s4 = 0; s4 < 4; ++s4) { const LAS float* s = scr + (16 * s4 + 8 * h) * 33 + r;
                f32x4 m0 = (f32x4){1.f, 1.f, 1.f, 1.f}, m1 = m0;
                if (which == 0) { m0 = *(const f32x4*)(a.in[11] + 64 * kb + 16 * s4 + 8 * h); m1 = *(const f32x4*)(a.in[11] + 64 * kb + 16 * s4 + 8 * h + 4); }
                u32x4 o; o.x = pk2(s[0 * 33] * m0.x, s[1 * 33] * m0.y); o.y = pk2(s[2 * 33] * m0.z, s[3 * 33] * m0.w); o.z = pk2(s[4 * 33] * m1.x, s[5 * 33] * m1.y); o.w = pk2(s[6 * 33] * m1.z, s[7 * 33] * m1.w);
                *(u32x4*)(WF + ((size_t)(nt * 64 + 4 * kb + s4) * 64 + lane) * 8) = o; }
        }
    }
}

__device__ __forceinline__ void p1_phase(const Args& a, LAS unsigned char* lds, int tid_unused, int lane_unused, int wave, int G) {
    const int lane_in = fresh_lane(), tid = wave * 64 + lane_in;
    const float* x = a.in[0]; const float* norm_w = a.in[4]; const float* w_in = a.in[5]; const float* dt_bias = a.in[8];
    const float* MOD = (const float*)(a.ws + WS_MOD);
    float* DT = (float*)(a.ws + WS_DT);
    bf16* H = (bf16*)((unsigned char*)a.out + OUT_H);
    LAS float* wdt = (LAS float*)lds;
    { float t[32];
#pragma unroll
      for (int i = 0; i < 32; ++i) { const int idx = tid + NTHR * i; t[i] = w_in[(size_t)(idx >> 4) * NIN + 2304 + (idx & 15)]; }
#pragma unroll
      for (int i = 0; i < 32; ++i) { const int idx = tid + NTHR * i; wdt[(idx & 15) * 1028 + (idx >> 4)] = t[i]; } }
    if (wave == 0) {
        unsigned* cnt = (unsigned*)(a.ws + WS_CTL) + CW_MODCNT; unsigned spins = 0u;
        while ((unsigned)__builtin_amdgcn_readfirstlane((int)__hip_atomic_load(cnt, __ATOMIC_RELAXED, __HIP_MEMORY_SCOPE_AGENT)) < 192u) { __builtin_amdgcn_s_sleep(1); if (++spins > (1u << 20)) break; }
        __builtin_amdgcn_fence(__ATOMIC_ACQUIRE, "agent");
        asm volatile("s_waitcnt vmcnt(0)" ::: "memory");
    }
    __syncthreads();
    for (int blk = blockIdx.x; blk < 256; blk += G) {
        const int b = blk >> 5;
        float gk[16], sh[16];
#pragma unroll
        for (int jj = 0; jj < 4; ++jj) { const int k = 4 * lane_in + 256 * jj;
            const f32x4 nw = *(const f32x4*)(norm_w + k), sc = *(const f32x4*)(MOD + b * 3072 + 1024 + k), sf = *(const f32x4*)(MOD + b * 3072 + k);
#pragma unroll
            for (int e = 0; e < 4; ++e) { gk[4 * jj + e] = nw[e] * (1.f + sc[e]); sh[4 * jj + e] = sf[e]; } }
        f32x4 vn[2][4];
        { const int lane = fresh_lane();
#pragma unroll
          for (int rr = 0; rr < 2; ++rr)
#pragma unroll
              for (int jj = 0; jj < 4; ++jj) vn[rr][jj] = __builtin_nontemporal_load((const f32x4*)(x + (size_t)(blk * 64 + wave * 8 + rr) * D) + lane + 64 * jj); }
        for (int g = 0; g < 4; ++g) {
            asm volatile("" ::: "memory");
            const int lane = fresh_lane();
            const int m0 = blk * 64 + wave * 8 + g * 2;
            f32x4 v[2][4];
#pragma unroll
            for (int rr = 0; rr < 2; ++rr)
#pragma unroll
                for (int jj = 0; jj < 4; ++jj) v[rr][jj] = vn[rr][jj];
            if (g + 1 < 4) {
#pragma unroll
                for (int rr = 0; rr < 2; ++rr)
#pragma unroll
                    for (int jj = 0; jj < 4; ++jj) vn[rr][jj] = __builtin_nontemporal_load((const f32x4*)(x + (size_t)(m0 + 2 + rr) * D) + lane + 64 * jj);
            }
            __builtin_amdgcn_sched_barrier(0);
            float hv[2][16];
#pragma unroll
            for (int rr = 0; rr < 2; ++rr) {
                float ss = 0.f;
#pragma unroll
                for (int jj = 0; jj < 4; ++jj) ss += (v[rr][jj].x * v[rr][jj].x + v[rr][jj].y * v[rr][jj].y) + (v[rr][jj].z * v[rr][jj].z + v[rr][jj].w * v[rr][jj].w);
                const float rs = 1.0f / sqrtf(wave_sum(ss) * (1.f / D) + EPS);
                unsigned long long* o8 = (unsigned long long*)(H + (size_t)(m0 + rr) * D) + lane;
#pragma unroll
                for (int jj = 0; jj < 4; ++jj) {
#pragma unroll
                    for (int e = 0; e < 4; ++e) hv[rr][4 * jj + e] = v[rr][jj][e] * rs * gk[4 * jj + e] + sh[4 * jj + e];
                    o8[64 * jj] = (unsigned long long)pk2(hv[rr][4 * jj], hv[rr][4 * jj + 1]) | ((unsigned long long)pk2(hv[rr][4 * jj + 2], hv[rr][4 * jj + 3]) << 32);
                }
            }
            float acc[32];
#pragma unroll
            for (int i = 0; i < 32; ++i) acc[i] = 0.f;
#pragma unroll
            for (int j = 0; j < 16; ++j) {
#pragma unroll
                for (int jj = 0; jj < 4; ++jj) { const f32x4 w = *(const LAS f32x4*)(wdt + j * 1028 + 4 * lane + 256 * jj);
#pragma unroll
                    for (int rr = 0; rr < 2; ++rr) acc[rr * 16 + j] += (hv[rr][4 * jj] * w.x + hv[rr][4 * jj + 1] * w.y) + (hv[rr][4 * jj + 2] * w.z + hv[rr][4 * jj + 3] * w.w); }
                if ((j & 3) == 3) asm volatile("" ::: "memory");
            }
#pragma unroll
            for (int half = 16; half >= 1; half >>= 1) {
                const bool up = (lane & half) != 0;
#pragma unroll
                for (int i = 0; i < half; ++i) { float lo_ = acc[i], hi_ = acc[i + half]; asm volatile("" : "+v"(lo_), "+v"(hi_));
                    const float keep = up ? hi_ : lo_, send = up ? lo_ : hi_; acc[i] = keep + __shfl_xor(send, half); }
            }
            const float tot = acc[0] + __shfl_xor(acc[0], 32);
            const float xr_ = tot + dt_bias[lane & 15];
            const float dtv = xr_ > 20.f ? xr_ : log1pf(__expf(xr_));
            if (lane < 32) DT[(size_t)m0 * 16 + lane] = dtv;
        }
    }
}

constexpr size_t OUT_XBCC = 0;
__device__ __forceinline__ void p3a_phase(const Args& a, int wave, int G) {
    const bf16* PROJ = (const bf16*)(a.ws + WS_PROJ);
    bf16* XBCC = (bf16*)((unsigned char*)a.out + OUT_XBCC);
    const float* conv_w = a.in[6]; const float* conv_b = a.in[7];
    const int lane = fresh_lane(), tid = wave * 64 + lane;
    if (tid >= 480) return;
    const int oct = tid % 160, tgl = tid / 160;
    float cw[4][8], cb[8];
#pragma unroll
    for (int e = 0; e < 8; ++e) { cb[e] = conv_b[8 * oct + e];
#pragma unroll
        for (int k = 0; k < 4; ++k) cw[k][e] = conv_w[k * 1280 + 8 * oct + e]; }
    for (int blk = blockIdx.x; blk < 256; blk += G) {
        for (int tg = tgl; tg < 8; tg += 3) {
            const int m0 = blk * 64 + 8 * tg, ts0 = m0 & (SEQ - 1);
            const char* src = (const char*)(PROJ + (size_t)m0 * NP + C_X + 8 * oct);
            u32x4 raw[11];
#pragma unroll
            for (int i = 0; i < 11; ++i) { const bool ok = (ts0 - 3 + i) >= 0; raw[i] = ok ? *(const u32x4*)(src + ((long)i - 3) * (NP * 2)) : (u32x4){0u, 0u, 0u, 0u}; }
#pragma unroll
            for (int jj = 0; jj < 8; ++jj) {
                float o[8];
#pragma unroll
                for (int e = 0; e < 8; ++e) {
                    float s_ = cb[e];
#pragma unroll
                    for (int k = 0; k < 4; ++k) { const unsigned w = raw[jj + k][e >> 1]; s_ += cw[k][e] * ((e & 1) ? bf_hi(w) : bf_lo(w)); }
                    o[e] = silu_f(s_);
                }
                u32x4 ov; ov.x = pk2(o[0], o[1]); ov.y = pk2(o[2], o[3]); ov.z = pk2(o[4], o[5]); ov.w = pk2(o[6], o[7]);
                *(u32x4*)(XBCC + (size_t)(m0 + jj) * 1280 + 8 * oct) = ov;
            }
        }
    }
}

constexpr int TP = 72;
constexpr int L_CQ = 0, L_BK = 18432, L_BKW = 36864, L_XV = 55296, L_ST0 = 73728, L_ST1 = 82944, L_ACS = 92160, L_DTJ = 93184, L_WJ = 94208, L_CW = 95232;

__device__ __forceinline__ void p3_phase(const Args& a, LAS unsigned char* lds, int tid_in, int lane_in, int wave, int G, const bool dry = false) {
    bf16* PROJ = (bf16*)(a.ws + WS_PROJ);
    const float* DT = (const float*)(a.ws + WS_DT);
    float* SSQM = (float*)(a.ws + WS_SSQM); float* SSQR = (float*)(a.ws + WS_SSQR);
    const float* conv_w = a.in[6]; const float* conv_b = a.in[7]; const float* a_log = a.in[9]; const float* d_skip = a.in[10]; const float* m_norm_w = a.in[11];
    const int pt = wave & 1, it = wave >> 1;
#ifdef PROBE_SEL
    unsigned long long t0_ = 0ull; unsigned tacc_ = 0u;
    const bool probing = ((int)blockIdx.x == PROBE_BLK && wave == PROBE_WAVE);
#define TB(k) do { if (PROBE_SEL == (k) && probing) t0_ = __builtin_amdgcn_s_memrealtime(); } while (0)
#define TE(k) do { if (PROBE_SEL == (k) && probing) tacc_ += (unsigned)(__builtin_amdgcn_s_memrealtime() - t0_); } while (0)
#else
#define TB(k) do {} while (0)
#define TE(k) do {} while (0)
#endif
    for (int item = blockIdx.x; item < 256; item += G) {
        const int lane = fresh_lane(), tid = wave * 64 + lane;
        const int r = lane & 31, h = lane >> 5, i16 = lane & 15, q4 = i16 >> 2, p4 = i16 & 3, blk16 = (lane >> 4) & 1;
        const int xcd_ = item & 7, kk_ = item >> 3;
        const bool ssd = kk_ < 16;
        int b, hd, half;
        if (ssd) { const int pair = 2 * xcd_ + (kk_ >> 3); b = pair >> 1; hd = 8 * (pair & 1) + (kk_ & 7); half = 0; }
        else { const int t = xcd_ * 16 + (kk_ - 16); b = t >> 4; hd = (t >> 1) & 7; half = t & 1; }
        const size_t mb = (size_t)b * SEQ;
        __syncthreads();
        for (int idx = tid; idx < 9216 / 4; idx += NTHR) ((LAS unsigned*)(lds + L_ST0))[idx] = 0u;
        const float lg = ssd ? 0.f : log1pf(-exp2f(-5.0f - (float)hd));
        if (!ssd && tid < 256) { const int par = tid >> 7, j = tid & 127;
            ((LAS float*)(lds + L_ACS))[par * 128 + j] = (float)(j + 1) * lg * 1.4426950408889634f; ((LAS float*)(lds + L_DTJ))[par * 128 + j] = (float)(j + 1) * lg * 1.4426950408889634f; ((LAS float*)(lds + L_WJ))[par * 128 + j] = __expf((float)(127 - j) * lg); }
        const float Ah = ssd ? -__expf(a_log[hd]) : 0.f;
        const float Dsk = ssd ? d_skip[hd] : 0.f;
        const int ltile = 3 - (tid >> 7), loct = tid & 7, ltg = (tid >> 3) & 15;
        int lcol = 0;
        float invf[8];
        if (ssd) {
            lcol = (ltile == 0) ? (64 * hd + 8 * loct) : (ltile == 1 ? (1024 + 64 * (hd >> 3) + 8 * loct) : (1152 + 64 * (hd >> 3) + 8 * loct));
            if (ltile == 3) lcol = 1024 + 64 * (hd >> 3) + 8 * loct;
#pragma unroll
            for (int e = 0; e < 8; ++e) invf[e] = 0.f;
        } else {
#pragma unroll
            for (int e = 0; e < 8; ++e) invf[e] = exp2f(-(float)(8 * (tid & 3) + e) * (13.287712379549449f / 32.f));
        }
        f32x16 sacc;
#pragma unroll
        for (int i = 0; i < 16; ++i) sacc[i] = 0.f;
        u32x4 raw[8];
        const int rj = tid >> 2, ro4 = tid & 3;
        const int j0 = 8 * ltg;
        const char* pbase = (const char*)(PROJ + mb * NP);
        const char* xbase = (const char*)((const bf16*)((const unsigned char*)a.out + OUT_XBCC) + mb * 1280);
        const unsigned soff = (unsigned)((j0 * 1280 + lcol) * 2);
        const unsigned roff = (unsigned)((rj * NP) * 2);
#define P3_ISSUE(cc) do { const char* cbp = pbase + (size_t)(cc) * (128 * NP * 2); \
        if (ssd) { const char* xp = xbase + (size_t)(cc) * (128 * 1280 * 2) + soff; _Pragma("unroll") for (int i = 0; i < 8; ++i) raw[i] = *(const u32x4*)(xp + i * (1280 * 2)); } \
        else { const char* rp = cbp + roff; \
            raw[0] = *(const u32x4*)(rp + (C_Q + 64 * hd + 8 * ro4) * 2); raw[1] = *(const u32x4*)(rp + (C_Q + 64 * hd + 32 + 8 * ro4) * 2); \
            raw[2] = *(const u32x4*)(rp + (C_K + 64 * hd + 8 * ro4) * 2); raw[3] = *(const u32x4*)(rp + (C_K + 64 * hd + 32 + 8 * ro4) * 2); \
            raw[4] = *(const u32x4*)(rp + (C_V + 128 * hd + 64 * half + 16 * ro4) * 2); raw[5] = *(const u32x4*)(rp + (C_V + 128 * hd + 64 * half + 16 * ro4 + 8) * 2); } } while (0)
        float dq0 = 0.f, dq1 = 0.f;
#define P3_SCAN(cc) do { LAS float* ACSw = (LAS float*)(lds + L_ACS) + ((cc) & 1) * 128; LAS float* DTJw = (LAS float*)(lds + L_DTJ) + ((cc) & 1) * 128; LAS float* WJw = (LAS float*)(lds + L_WJ) + ((cc) & 1) * 128; \
        const float v0 = dq0 * Ah, v1 = dq1 * Ah, s_ = v0 + v1; float incl = s_; \
        _Pragma("unroll") for (int o = 1; o < 64; o <<= 1) { const float t = __shfl_up(incl, o); if (lane >= o) incl += t; } \
        const float c0 = (incl - s_) + v0, tot = __shfl(incl, 63), c1 = (lane == 63) ? tot : c0 + v1; \
        ACSw[2 * lane] = c0 * 1.4426950408889634f; ACSw[2 * lane + 1] = c1 * 1.4426950408889634f; \
        DTJw[2 * lane] = c0 * 1.4426950408889634f - __log2f(dq0); DTJw[2 * lane + 1] = c1 * 1.4426950408889634f - __log2f(dq1); \
        WJw[2 * lane] = dq0 * __expf(tot - c0); WJw[2 * lane + 1] = dq1 * __expf(tot - c1); } while (0)
#define P3_DTLOAD(cc) do { dq0 = DT[(mb + (size_t)(cc) * 128 + 2 * lane) * 16 + hd]; dq1 = DT[(mb + (size_t)(cc) * 128 + 2 * lane + 1) * 16 + hd]; } while (0)
        if (ssd && wave == 0) { P3_DTLOAD(0); P3_SCAN(0); P3_DTLOAD(1); }
        u32x2 zzn[4];
        { const bf16* orow0 = PROJ + (mb + 16 * wave + i16) * NP + (ssd ? (C_Z + 64 * hd) : (C_GR + 128 * hd + 64 * half));
#pragma unroll
          for (int g4 = 0; g4 < 4; ++g4) zzn[g4] = *(const u32x2*)(orow0 + 16 * g4 + 4 * (lane >> 4)); }
        P3_ISSUE(0);

        TB(1);
        for (int c = 0; c < 16; ++c) {
            const int par = c & 1;
            const size_t m0 = mb + (size_t)c * 128;
            LAS float* ACS = (LAS float*)(lds + L_ACS) + par * 128; LAS float* DTJ = (LAS float*)(lds + L_DTJ) + par * 128; LAS float* WJ = (LAS float*)(lds + L_WJ) + par * 128;
            TB(5);
            __syncthreads();
            TE(5); TB(2);
#ifndef P3_REPL
#define P3_REPL 1
#endif
            _Pragma("nounroll") for (int repl_ = 0; repl_ < P3_REPL; ++repl_) {
            if (repl_) __syncthreads();
            if (ssd) {
                {
                    LAS unsigned char* dst = lds + (ltile == 0 ? L_XV : (ltile == 1 ? L_BK : (ltile == 2 ? L_CQ : L_BKW)));
#pragma unroll
                    for (int jj = 0; jj < 8; ++jj) {
                        u32x4 v = raw[jj];
                        if (ltile == 3) { const float wj = WJ[j0 + jj];
                            v.x = pk2(bf_lo(v.x) * wj, bf_hi(v.x) * wj); v.y = pk2(bf_lo(v.y) * wj, bf_hi(v.y) * wj); v.z = pk2(bf_lo(v.z) * wj, bf_hi(v.z) * wj); v.w = pk2(bf_lo(v.w) * wj, bf_hi(v.w) * wj); }
                        *(LAS u32x4*)(dst + ((j0 + jj) * TP + 8 * loct) * 2) = v;
                    }
                }
            } else {
                const int j = rj, o4 = ro4;
                const u32x4 q1 = raw[0], q2 = raw[1], k1 = raw[2], k2 = raw[3];
                const float pos = (float)(c * 128 + j), wj = WJ[j];
                float ql[8], qh[8], kl[8], kh[8];
#pragma unroll
                for (int e = 0; e < 8; ++e) {
                    const float rev = pos * invf[e] * 0.15915494309189535f, fr = rev - floorf(rev);
                    const float cs = __builtin_amdgcn_cosf(fr), sn = __builtin_amdgcn_sinf(fr);
                    const unsigned wq1 = q1[e >> 1], wq2 = q2[e >> 1], wk1 = k1[e >> 1], wk2 = k2[e >> 1];
                    const float a1 = (e & 1) ? bf_hi(wq1) : bf_lo(wq1), a2 = (e & 1) ? bf_hi(wq2) : bf_lo(wq2);
                    const float b1 = ((e & 1) ? bf_hi(wk1) : bf_lo(wk1)) * 0.125f, b2 = ((e & 1) ? bf_hi(wk2) : bf_lo(wk2)) * 0.125f;
                    ql[e] = a1 * cs - a2 * sn; qh[e] = a1 * sn + a2 * cs;
                    kl[e] = b1 * cs - b2 * sn; kh[e] = b1 * sn + b2 * cs;
                }
                u32x4 t;
                t.x = pk2(ql[0], ql[1]); t.y = pk2(ql[2], ql[3]); t.z = pk2(ql[4], ql[5]); t.w = pk2(ql[6], ql[7]); *(LAS u32x4*)(lds + L_CQ + (j * TP + 8 * o4) * 2) = t;
                t.x = pk2(qh[0], qh[1]); t.y = pk2(qh[2], qh[3]); t.z = pk2(qh[4], qh[5]); t.w = pk2(qh[6], qh[7]); *(LAS u32x4*)(lds + L_CQ + (j * TP + 32 + 8 * o4) * 2) = t;
                t.x = pk2(kl[0], kl[1]); t.y = pk2(kl[2], kl[3]); t.z = pk2(kl[4], kl[5]); t.w = pk2(kl[6], kl[7]); *(LAS u32x4*)(lds + L_BK + (j * TP + 8 * o4) * 2) = t;
                t.x = pk2(kh[0], kh[1]); t.y = pk2(kh[2], kh[3]); t.z = pk2(kh[4], kh[5]); t.w = pk2(kh[6], kh[7]); *(LAS u32x4*)(lds + L_BK + (j * TP + 32 + 8 * o4) * 2) = t;
                t.x = pk2(kl[0] * wj, kl[1] * wj); t.y = pk2(kl[2] * wj, kl[3] * wj); t.z = pk2(kl[4] * wj, kl[5] * wj); t.w = pk2(kl[6] * wj, kl[7] * wj); *(LAS u32x4*)(lds + L_BKW + (j * TP + 8 * o4) * 2) = t;
                t.x = pk2(kh[0] * wj, kh[1] * wj); t.y = pk2(kh[2] * wj, kh[3] * wj); t.z = pk2(kh[4] * wj, kh[5] * wj); t.w = pk2(kh[6] * wj, kh[7] * wj); *(LAS u32x4*)(lds + L_BKW + (j * TP + 32 + 8 * o4) * 2) = t;
                *(LAS u32x4*)(lds + L_XV + (j * TP + 16 * o4) * 2) = raw[4]; *(LAS u32x4*)(lds + L_XV + (j * TP + 16 * o4 + 8) * 2) = raw[5];
            }
            }
            TE(2); TB(6);
            __syncthreads();
            TE(6); TB(3);
            const int q16 = lane >> 4, iTok = 16 * wave + i16;
            bf16* orow = PROJ + (m0 + iTok) * NP + (ssd ? (C_Z + 64 * hd) : (C_GR + 128 * hd + 64 * half));
            u32x2 zz[4];
#pragma unroll
            for (int g4 = 0; g4 < 4; ++g4) zz[g4] = zzn[g4];
            if (c + 1 < 16) {
#pragma unroll
                for (int g4 = 0; g4 < 4; ++g4) zzn[g4] = *(const u32x2*)(orow + 128 * NP + 16 * g4 + 4 * q16);
                P3_ISSUE(c + 1);
            }
            __builtin_amdgcn_sched_barrier(0);
            if (ssd && wave == 0 && c + 1 < 16) { P3_SCAN(c + 1); if (c + 2 < 16) P3_DTLOAD(c + 2); }
#ifndef P3_REPC
#define P3_REPC 1
#endif
            f32x16 acc;
            float acs_i = 0.f;
            LAS unsigned char* STw = lds + (par ? L_ST0 : L_ST1);
            _Pragma("nounroll") for (int repc_ = 0; repc_ < P3_REPC; ++repc_) {
            bf16x8 cqb[2];
#pragma unroll
            for (int s = 0; s < 2; ++s) cqb[s] = *(const LAS bf16x8*)(lds + L_CQ + (iTok * TP + 32 * s + 8 * q16) * 2);
            const LAS unsigned char* STr = lds + (par ? L_ST1 : L_ST0);
#pragma unroll
            for (int i = 0; i < 16; ++i) acc[i] = 0.f;
            f32x4 ya[4];
#pragma unroll
            for (int p4t = 0; p4t < 4; ++p4t) { ya[p4t] = (f32x4){0.f, 0.f, 0.f, 0.f};
#pragma unroll
                for (int s = 0; s < 2; ++s) { const bf16x8 sa = *(const LAS bf16x8*)(STr + ((16 * p4t + i16) * TP + 32 * s + 8 * q16) * 2); ya[p4t] = MFMA16(sa, cqb[s], ya[p4t]); } }
            acs_i = ACS[iTok];
            { const float ei = __builtin_amdgcn_exp2f(acs_i);
#pragma unroll
              for (int p4t = 0; p4t < 4; ++p4t) ya[p4t] = ya[p4t] * ei; }
            const int nblk = (wave >> 1) + 1;
            bf16x8 kq0[2], kq1[2];
#pragma unroll
            for (int s = 0; s < 2; ++s) { kq0[s] = *(const LAS bf16x8*)(lds + L_BK + (i16 * TP + 32 * s + 8 * q16) * 2); kq1[s] = *(const LAS bf16x8*)(lds + L_BK + ((16 + i16) * TP + 32 * s + 8 * q16) * 2); }
            for (int jb = 0; jb < nblk; ++jb) {
                const int j0 = 32 * jb;
                f32x4 t0 = (f32x4){0.f, 0.f, 0.f, 0.f}, t1 = t0;
#pragma unroll
                for (int s = 0; s < 2; ++s) { t0 = MFMA16(kq0[s], cqb[s], t0); t1 = MFMA16(kq1[s], cqb[s], t1); }
#pragma unroll
                for (int s = 0; s < 2; ++s) { kq0[s] = *(const LAS bf16x8*)(lds + L_BK + ((j0 + 32 + i16) * TP + 32 * s + 8 * q16) * 2); kq1[s] = *(const LAS bf16x8*)(lds + L_BK + ((j0 + 48 + i16) * TP + 32 * s + 8 * q16) * 2); }
                const f32x4 b0 = *(const LAS f32x4*)(DTJ + j0 + 4 * q16), b1 = *(const LAS f32x4*)(DTJ + j0 + 16 + 4 * q16);
                bf16x8 xa[4];
#pragma unroll
                for (int p4t = 0; p4t < 4; ++p4t) { const LAS unsigned char* xb = lds + L_XV + ((j0 + 4 * q16 + q4) * TP + 16 * p4t + 4 * p4) * 2; xa[p4t] = tr_pair(xb, xb + 16 * TP * 2); }
                __builtin_amdgcn_sched_barrier(0);
                const bool lastb = (jb == nblk - 1);
                float pv[8];
#pragma unroll
                for (int e = 0; e < 4; ++e) {
                    float v0 = t0[e] * __builtin_amdgcn_exp2f(acs_i - b0[e]), v1 = t1[e] * __builtin_amdgcn_exp2f(acs_i - b1[e]);
                    if (lastb && (j0 + 4 * q16 + e) > iTok) v0 = 0.f;
                    if (lastb && (j0 + 16 + 4 * q16 + e) > iTok) v1 = 0.f;
                    pv[e] = v0; pv[4 + e] = v1;
                }
                const bf16x8 pf = pack8(pv[0], pv[1], pv[2], pv[3], pv[4], pv[5], pv[6], pv[7]);
#pragma unroll
                for (int p4t = 0; p4t < 4; ++p4t) ya[p4t] = MFMA16(xa[p4t], pf, ya[p4t]);
            }
#pragma unroll
            for (int p4t = 0; p4t < 4; ++p4t)
#pragma unroll
                for (int e = 0; e < 4; ++e) acc[4 * p4t + e] = ya[p4t][e];
            }
            TE(3); TB(4);
            if (it < 2 && c < 15) {
                const int nt = it;
                const float dec = __builtin_amdgcn_exp2f(ACS[127]);
#pragma unroll
                for (int i = 0; i < 16; ++i) sacc[i] *= dec;
                f32x16 sacc2;
#pragma unroll
                for (int i = 0; i < 16; ++i) sacc2[i] = 0.f;
#pragma unroll
                for (int ks = 0; ks < 8; ++ks) {
                    const LAS unsigned char* xb = lds + L_XV + ((16 * ks + 8 * h + q4) * TP + 32 * pt + 16 * blk16 + 4 * p4) * 2;
                    const LAS unsigned char* kb = lds + L_BKW + ((16 * ks + 8 * h + q4) * TP + 32 * nt + 16 * blk16 + 4 * p4) * 2;
                    const bf16x8 xa = tr_pair(xb, xb + 4 * TP * 2), kbf = tr_pair(kb, kb + 4 * TP * 2);
                    if (ks & 1) sacc2 = MFMA32(xa, kbf, sacc2); else sacc = MFMA32(xa, kbf, sacc);
                }
#pragma unroll
                for (int i = 0; i < 16; ++i) sacc[i] += sacc2[i];
#pragma unroll
                for (int i = 0; i < 16; ++i) { const int p = 32 * pt + crow(i, h);
                    *(LAS unsigned short*)(STw + (p * TP + 32 * nt + r) * 2) = (unsigned short)(pk2(sacc[i], 0.f) & 0xffffu); }
            }
            {
                float ss = 0.f;
#pragma unroll
                for (int g4 = 0; g4 < 4; ++g4) {
                    const int p = 16 * g4 + 4 * q16;
                    const float z0 = bf_lo(zz[g4].x), z1 = bf_hi(zz[g4].x), z2 = bf_lo(zz[g4].y), z3 = bf_hi(zz[g4].y);
                    float y0 = acc[4 * g4], y1 = acc[4 * g4 + 1], y2 = acc[4 * g4 + 2], y3 = acc[4 * g4 + 3];
                    float o0, o1, o2, o3;
                    if (ssd) {
                        const u32x2 xv = *(const LAS u32x2*)(lds + L_XV + (iTok * TP + p) * 2);
                        y0 = (y0 + Dsk * bf_lo(xv.x)) * silu_f(z0); y1 = (y1 + Dsk * bf_hi(xv.x)) * silu_f(z1); y2 = (y2 + Dsk * bf_lo(xv.y)) * silu_f(z2); y3 = (y3 + Dsk * bf_hi(xv.y)) * silu_f(z3);
                        ss += (y0 * y0 + y1 * y1) + (y2 * y2 + y3 * y3);
                        o0 = y0; o1 = y1; o2 = y2; o3 = y3;
                    } else {
                        ss += (y0 * y0 + y1 * y1) + (y2 * y2 + y3 * y3);
                        o0 = y0 * silu_f(z0); o1 = y1 * silu_f(z1); o2 = y2 * silu_f(z2); o3 = y3 * silu_f(z3);
                    }
                    u32x2 ov; ov.x = pk2(o0, o1); ov.y = pk2(o2, o3);
                    if (dry) *(u32x2*)((bf16*)((unsigned char*)a.out + 40 * MiB) + (m0 + iTok) * 512 + ((64 * hd + 64 * half + p) & 511)) = ov; else *(u32x2*)(orow + p) = ov;
                }
                ss += __shfl_xor(ss, 16); ss += __shfl_xor(ss, 32);
                if (q16 < 2) { const float sv = (q16 == 0) ? ss : 0.f;
                    if (ssd) SSQM[(m0 + iTok) * 32 + hd * 2 + q16] = sv; else SSQR[(m0 + iTok) * 32 + hd * 4 + half * 2 + q16] = sv; }
            }
            TE(4);
        }
        TE(1);
#undef P3_ISSUE
#undef P3_SCAN
#undef P3_DTLOAD
    }
#ifdef PROBE_SEL
    if (probing && fresh_lane() == 0) ((unsigned*)(a.ws + WS_CTL))[4000] = tacc_;
#endif
#undef TB
#undef TE
}

constexpr int MP = 1032;
constexpr int L4_MERGED = 0, L4_ASTG = 132096, L4_RM = 150528, L4_RR = 151040, L4_RED = 153088, L4_RS = 155136;
static_assert(L4_RS + 256 <= LDS_BYTES, "P4 LDS map");

__device__ __forceinline__ void p4_panel_load(u32x4 (&ar)[16], const bf16* Abase, int tid) {
    const int srow = tid >> 3, soct = tid & 7; const int rot = ((int)blockIdx.x >> 3) & 15;
    const char* ab = (const char*)Abase; const unsigned aoff = (unsigned)((srow * NP + 8 * soct) * 2);
#pragma unroll
    for (int i = 0; i < 16; ++i) ar[i] = *(const u32x4*)(ab + ((rot + i) & 15) * 128 + aoff);
}
template <int SEGSHIFT>
__device__ __forceinline__ void p4_gemmT(f32x16 (&accT)[2][2], u32x4 (&ar)[16], const bf16* Anext  , const LAS float* rsc  , int nseg,
                                         const bf16* WF  , int nt0  , LAS unsigned char* lds, int tid, int lane) {
    const int srow = tid >> 3, soct = tid & 7, r = lane & 31, h = lane >> 5;
    const char* wb = (const char*)WF + (size_t)nt0 * 65536; const unsigned woff = (unsigned)(lane * 16);
    const int rot = ((int)blockIdx.x >> 3) & 15;
    bf16x8 wc[4][2];
    { const char* wk0 = wb + rot * 4096;
#pragma unroll
      for (int s = 0; s < 4; ++s) { wc[s][0] = *(const bf16x8*)(wk0 + s * 1024 + woff); wc[s][1] = *(const bf16x8*)(wk0 + 65536 + s * 1024 + woff); } }
#define P4_STAGE_WRITE(ki_) do { const int kc_ = ((ki_) + rot) & 15; const float sc = rsc[srow * nseg + ((kc_ * 64) >> SEGSHIFT)]; \
        u32x4 o; \
        o.x = pk2(bf_lo(ar[ki_].x) * sc, bf_hi(ar[ki_].x) * sc); o.y = pk2(bf_lo(ar[ki_].y) * sc, bf_hi(ar[ki_].y) * sc); \
        o.z = pk2(bf_lo(ar[ki_].z) * sc, bf_hi(ar[ki_].z) * sc); o.w = pk2(bf_lo(ar[ki_].w) * sc, bf_hi(ar[ki_].w) * sc); \
        *(LAS u32x4*)(lds + L4_ASTG + ((ki_) & 1) * 9216 + (srow * TP + 8 * soct) * 2) = o; } while (0)
    P4_STAGE_WRITE(0);
#pragma unroll
    for (int ki = 0; ki < 16; ++ki) {
        const int kc = (ki + rot) & 15;
        LAS unsigned char* stg = lds + L4_ASTG + (ki & 1) * 9216;
        __syncthreads();
        if (ki + 1 < 16) P4_STAGE_WRITE(ki + 1);
        const int kn = (kc + 1) & 15;
        const char* wk = wb + kn * 4096;
        bf16x8 a0 = *(const LAS bf16x8*)(stg + (r * TP + 8 * h) * 2), a1 = *(const LAS bf16x8*)(stg + ((32 + r) * TP + 8 * h) * 2);
#pragma unroll
        for (int s = 0; s < 4; ++s) {
            bf16x8 n0 = a0, n1 = a1;
            if (s < 3) { n0 = *(const LAS bf16x8*)(stg + (r * TP + 16 * (s + 1) + 8 * h) * 2); n1 = *(const LAS bf16x8*)(stg + ((32 + r) * TP + 16 * (s + 1) + 8 * h) * 2); }
            accT[0][0] = MFMA32(wc[s][0], a0, accT[0][0]); accT[0][1] = MFMA32(wc[s][1], a0, accT[0][1]);
            accT[1][0] = MFMA32(wc[s][0], a1, accT[1][0]); accT[1][1] = MFMA32(wc[s][1], a1, accT[1][1]);
            wc[s][0] = *(const bf16x8*)(wk + s * 1024 + woff); wc[s][1] = *(const bf16x8*)(wk + 65536 + s * 1024 + woff);
            __builtin_amdgcn_sched_barrier(0);
            a0 = n0; a1 = n1;
        }
    }
#undef P4_STAGE_WRITE
    p4_panel_load(ar, Anext, tid);
    __builtin_amdgcn_sched_barrier(0);
    __syncthreads();
}


__device__ __forceinline__ void tail_gemmT(f32x16 (&accT)[2], const bf16* Abase  , const bf16* WF  , int nt  , LAS unsigned char* lds, int tid, int lane) {
    const int srow = tid >> 3, soct = tid & 7, r = lane & 31, h = lane >> 5;
    const char* ab = (const char*)Abase; const unsigned aoff = (unsigned)((srow * 1024 + 8 * soct) * 2);
    const char* wb = (const char*)WF + (size_t)nt * 65536; const unsigned woff = (unsigned)(lane * 16);
    const int rot = ((int)blockIdx.x >> 3) & 15;
    u32x4 ar[16];
#pragma unroll
    for (int i = 0; i < 16; ++i) ar[i] = *(const u32x4*)(ab + ((rot + i) & 15) * 128 + aoff);
    bf16x8 wc[4];
    { const char* wk0 = wb + rot * 4096;
#pragma unroll
      for (int s = 0; s < 4; ++s) wc[s] = *(const bf16x8*)(wk0 + s * 1024 + woff); }
#pragma unroll
    for (int ki = 0; ki < 16; ++ki) {
        const int kc = (ki + rot) & 15;
        LAS unsigned char* stg = lds + L4_ASTG + (ki & 1) * 9216;
        *(LAS u32x4*)(stg + (srow * TP + 8 * soct) * 2) = ar[ki];
        __syncthreads();
        const char* wk = wb + ((kc + 1) & 15) * 4096;
#pragma unroll
        for (int s = 0; s < 4; ++s) {
            const bf16x8 a0 = *(const LAS bf16x8*)(stg + (r * TP + 16 * s + 8 * h) * 2), a1 = *(const LAS bf16x8*)(stg + ((32 + r) * TP + 16 * s + 8 * h) * 2);
            accT[0] = MFMA32(wc[s], a0, accT[0]); accT[1] = MFMA32(wc[s], a1, accT[1]);
            wc[s] = *(const bf16x8*)(wk + s * 1024 + woff);
            __builtin_amdgcn_sched_barrier(0);
        }
    }
    __syncthreads();
}

__device__ __forceinline__ void p4_phase(const Args& a, LAS unsigned char* lds, int tid_in, int lane_in, int wave, int G) {
    const bf16* PROJ = (const bf16*)(a.ws + WS_PROJ);
    const float* SSQM = (const float*)(a.ws + WS_SSQM); const float* SSQR = (const float*)(a.ws + WS_SSQR);
    const float* MOD = (const float*)(a.ws + WS_MOD);
    const bf16* WMF = (const bf16*)(a.ws + WS_WMF); const bf16* WRF = (const bf16*)(a.ws + WS_WRF); const bf16* WOF = (const bf16*)(a.ws + WS_WOF);
    const float* x = a.in[0]; const float* fw = a.in[15]; float* out = a.out;
    LAS float* RM = (LAS float*)(lds + L4_RM); LAS float* RR = (LAS float*)(lds + L4_RR); LAS float* RED = (LAS float*)(lds + L4_RED); LAS float* RS = (LAS float*)(lds + L4_RS);
    for (int blk = blockIdx.x; blk < 256; blk += G) {
        const size_t m0 = (size_t)blk * 64; const int b = blk >> 5;
        int lane = fresh_lane(), tid = wave * 64 + lane, r = lane & 31, h = lane >> 5;
        u32x4 ar[16];
        p4_panel_load(ar, PROJ + m0 * NP + C_Z, tid);
        __syncthreads();
        { const int row = tid >> 3, sub = tid & 7;
          const f32x4 qv = *(const f32x4*)(SSQR + (m0 + row) * 32 + 4 * sub);
          RR[row * 8 + sub] = 1.0f / sqrtf(((qv.x + qv.y) + (qv.z + qv.w)) * (1.f / 128.f) + EPS);
          if (sub < 2) { float s = 0.f;
#pragma unroll
              for (int i = 0; i < 4; ++i) { const f32x4 v = *(const f32x4*)(SSQM + (m0 + row) * 32 + 16 * sub + 4 * i); s += (v.x + v.y) + (v.z + v.w); }
              RM[row * 2 + sub] = 1.0f / sqrtf(s * (1.f / 512.f) + EPS); } }
        __syncthreads();
#ifndef P4_SKIP1
#ifndef P4_REP1
#define P4_REP1 1
#endif
        for (int nh_ = 0; nh_ < 2 * P4_REP1; ++nh_) {
            const int nh = nh_ & 1;
            lane = fresh_lane(); tid = wave * 64 + lane; r = lane & 31; h = lane >> 5;
            const int nt0 = 16 * nh + 2 * wave;
            const bf16* pblk = PROJ + m0 * NP;
            f32x16 accT[2][2];
#pragma unroll
            for (int i = 0; i < 2; ++i)
#pragma unroll
                for (int j = 0; j < 2; ++j)
#pragma unroll
                    for (int e = 0; e < 16; ++e) accT[i][j][e] = 0.f;
            u32x2 gpre[2][2][4];
            { const unsigned lo0 = (unsigned)((r * NP + 4 * h) * 2); const char* gb0 = (const char*)(pblk + C_GAM + 32 * nt0);
#pragma unroll
              for (int rt = 0; rt < 2; ++rt)
#pragma unroll
                  for (int ct = 0; ct < 2; ++ct)
#pragma unroll
                      for (int g4 = 0; g4 < 4; ++g4) gpre[rt][ct][g4] = *(const u32x2*)(gb0 + (lo0 + (unsigned)((32 * rt * NP + 32 * ct + 8 * g4) * 2)));
              __builtin_amdgcn_sched_barrier(0); }
            p4_gemmT<9>(accT, ar, pblk + C_GR, RM, 2, WMF, nt0, lds, tid, lane);
            {
                lane = fresh_lane(); r = lane & 31; h = lane >> 5;
                const unsigned lm = launder((unsigned)(L4_MERGED + (r * MP + 4 * h) * 2));
#pragma unroll
                for (int rt = 0; rt < 2; ++rt)
#pragma unroll
                    for (int ct = 0; ct < 2; ++ct)
#pragma unroll
                        for (int g4 = 0; g4 < 4; ++g4) {
                            const u32x2 gg = gpre[rt][ct][g4];
                            u32x2 ov; ov.x = pk2(accT[rt][ct][4 * g4] * sigm_f(bf_lo(gg.x)), accT[rt][ct][4 * g4 + 1] * sigm_f(bf_hi(gg.x)));
                            ov.y = pk2(accT[rt][ct][4 * g4 + 2] * sigm_f(bf_lo(gg.y)), accT[rt][ct][4 * g4 + 3] * sigm_f(bf_hi(gg.y)));
                            *(LAS u32x2*)(lds + lm + (unsigned)((32 * rt * MP + 32 * (nt0 + ct) + 8 * g4) * 2)) = ov; }
            }
#pragma unroll
            for (int i = 0; i < 2; ++i)
#pragma unroll
                for (int j = 0; j < 2; ++j)
#pragma unroll
                    for (int e = 0; e < 16; ++e) accT[i][j][e] = 0.f;
            lane = fresh_lane(); tid = wave * 64 + lane; r = lane & 31; h = lane >> 5;
            { const unsigned lo0 = (unsigned)((r * NP + 4 * h) * 2); const char* gb0 = (const char*)(pblk + C_GAR + 32 * nt0);
#pragma unroll
              for (int rt = 0; rt < 2; ++rt)
#pragma unroll
                  for (int ct = 0; ct < 2; ++ct)
#pragma unroll
                      for (int g4 = 0; g4 < 4; ++g4) gpre[rt][ct][g4] = *(const u32x2*)(gb0 + (lo0 + (unsigned)((32 * rt * NP + 32 * ct + 8 * g4) * 2)));
              __builtin_amdgcn_sched_barrier(0); }
            p4_gemmT<7>(accT, ar, pblk + C_Z, RR, 8, WRF, nt0, lds, tid, lane);
            {
                lane = fresh_lane(); r = lane & 31; h = lane >> 5;
                const unsigned lm = launder((unsigned)(L4_MERGED + (r * MP + 4 * h) * 2));
#pragma unroll
                for (int rt = 0; rt < 2; ++rt)
#pragma unroll
                    for (int ct = 0; ct < 2; ++ct)
#pragma unroll
                        for (int g4 = 0; g4 < 4; ++g4) {
                            const u32x2 gg = gpre[rt][ct][g4];
                            LAS u32x2* mp = (LAS u32x2*)(lds + lm + (unsigned)((32 * rt * MP + 32 * (nt0 + ct) + 8 * g4) * 2));
                            const u32x2 pm = *mp;
                            const float v0 = bf_lo(pm.x) + accT[rt][ct][4 * g4] * sigm_f(bf_lo(gg.x)), v1 = bf_hi(pm.x) + accT[rt][ct][4 * g4 + 1] * sigm_f(bf_hi(gg.x));
                            const float v2 = bf_lo(pm.y) + accT[rt][ct][4 * g4 + 2] * sigm_f(bf_lo(gg.y)), v3 = bf_hi(pm.y) + accT[rt][ct][4 * g4 + 3] * sigm_f(bf_hi(gg.y));
                            u32x2 ov; ov.x = pk2(v0, v1); ov.y = pk2(v2, v3);
                            *mp = ov; }
            }
        }
#endif
        __syncthreads();
        lane = fresh_lane(); tid = wave * 64 + lane; r = lane & 31; h = lane >> 5;
#ifndef P4_SKIP2
#ifndef P4_REP2
#define P4_REP2 1
#endif
        _Pragma("nounroll") for (int rep2_ = 0; rep2_ < P4_REP2; ++rep2_) {
            if (rep2_) { __syncthreads(); lane = fresh_lane(); tid = wave * 64 + lane; r = lane & 31; h = lane >> 5; }
            f32x16 acc[2][4];
#pragma unroll
            for (int i = 0; i < 2; ++i)
#pragma unroll
                for (int j = 0; j < 4; ++j)
#pragma unroll
                    for (int e = 0; e < 16; ++e) acc[i][j][e] = 0.f;
            const char* wb = (const char*)WOF + (size_t)(4 * wave) * 65536; const unsigned woff = (unsigned)(lane * 16);
            const int rot2 = ((int)blockIdx.x >> 3) & 31;
            bf16x8 wc[2][4];
#pragma unroll
            for (int s = 0; s < 2; ++s)
#pragma unroll
                for (int ct = 0; ct < 4; ++ct) wc[s][ct] = *(const bf16x8*)(wb + ct * 65536 + (2 * rot2 + s) * 1024 + woff);
            const LAS unsigned char* ma = lds + L4_MERGED + (r * MP + 8 * h) * 2;
            bf16x8 a0 = *(const LAS bf16x8*)(ma + (2 * rot2) * 32), a1 = *(const LAS bf16x8*)(ma + 32 * MP * 2 + (2 * rot2) * 32);
            for (int ki = 0; ki < 32; ++ki) {
                const int kp = (ki + rot2) & 31, kpn = (kp + 1) & 31;
#pragma unroll
                for (int s = 0; s < 2; ++s) {
                    const int ksn = (s == 0) ? 2 * kp + 1 : 2 * kpn;
                    const bf16x8 n0 = *(const LAS bf16x8*)(ma + ksn * 32), n1 = *(const LAS bf16x8*)(ma + 32 * MP * 2 + ksn * 32);
#pragma unroll
                    for (int ct = 0; ct < 4; ++ct) { acc[0][ct] = MFMA32(a0, wc[s][ct], acc[0][ct]); acc[1][ct] = MFMA32(a1, wc[s][ct], acc[1][ct]); }
#pragma unroll
                    for (int ct = 0; ct < 4; ++ct) wc[s][ct] = *(const bf16x8*)(wb + ct * 65536 + (2 * kpn + s) * 1024 + woff);
                    __builtin_amdgcn_sched_barrier(0);
                    a0 = n0; a1 = n1;
                }
            }
            lane = fresh_lane(); r = lane & 31; h = lane >> 5;
            const char* xblk = (const char*)(x + m0 * D); char* oblk = (char*)(out + m0 * D);
            const unsigned eo = launder((unsigned)(4 * (4 * h * D + 128 * wave + r)));
            const unsigned rb = launder((unsigned)(L4_RED + (4 * h * 8 + wave) * 4));
            float gate[4], fwv[4];
#pragma unroll
            for (int ct = 0; ct < 4; ++ct) { const int n = 32 * (4 * wave + ct) + r; gate[ct] = MOD[b * 3072 + 2048 + n]; fwv[ct] = fw[n]; }
            float xv[2][8][4];
#define P4_XLOAD(buf, bidx) do { _Pragma("unroll") for (int e = 0; e < 8; ++e) _Pragma("unroll") for (int ct = 0; ct < 4; ++ct) \
                xv[buf][e][ct] = __builtin_nontemporal_load((const float*)(xblk + (eo + (unsigned)(((32 * ((bidx) >> 1) + (e & 3) + 8 * (2 * ((bidx) & 1) + (e >> 2))) * D + 32 * ct) * 4)))); } while (0)
            P4_XLOAD(0, 0);
#pragma unroll
            for (int bi = 0; bi < 4; ++bi) {
                const int rt = bi >> 1, g8 = bi & 1;
                if (bi + 1 < 4) P4_XLOAD((bi + 1) & 1, bi + 1);
                __builtin_amdgcn_sched_barrier(0);
#pragma unroll
                for (int e = 0; e < 8; ++e) {
                    const int reg = 8 * g8 + e, rowc = 32 * rt + (reg & 3) + 8 * (reg >> 2);
                    float s = 0.f;
#pragma unroll
                    for (int ct = 0; ct < 4; ++ct) { const float v = xv[bi & 1][e][ct] + gate[ct] * acc[rt][ct][reg]; acc[rt][ct][reg] = v; s += v * v; }
                    s += __shfl_xor(s, 16); s += __shfl_xor(s, 8); s += __shfl_xor(s, 4); s += __shfl_xor(s, 2); s += __shfl_xor(s, 1);
                    *(LAS float*)(lds + rb + (unsigned)(rowc * 32)) = s;
                }
                asm volatile("" ::: "memory"); __builtin_amdgcn_sched_barrier(0);
            }
#undef P4_XLOAD
            __syncthreads();
            if (tid < 64) { float s = 0.f;
#pragma unroll
                for (int w = 0; w < 8; ++w) s += RED[tid * 8 + w];
                RS[tid] = 1.0f / sqrtf(s * (1.f / D) + EPS); }
            __syncthreads();
            const unsigned eo2 = launder(eo);
            const unsigned sb = launder((unsigned)(L4_RS + 4 * h * 4));
#pragma unroll
            for (int rt = 0; rt < 2; ++rt)
#pragma unroll
                for (int reg = 0; reg < 16; ++reg) {
                    const int rowc = 32 * rt + (reg & 3) + 8 * (reg >> 2); const float rs = *(const LAS float*)(lds + sb + (unsigned)(rowc * 4));
#pragma unroll
                    for (int ct = 0; ct < 4; ++ct) __builtin_nontemporal_store(acc[rt][ct][reg] * rs * fwv[ct], (float*)(oblk + (eo2 + (unsigned)((rowc * D + 32 * ct) * 4))));
                }
        }
#endif
    }
}

#define XB_TMO      128
#define XB_XCNT(j)  (256  + 64 * (j))
#define XB_XSUB(j)  (1280 + 64 * (j))
#define XB_XGEN(j)  (2304 + 64 * (j))
#define XB_TOP      3328
#define XB_TOPGEN   3392
#define XCD_BAR_WORDS 3456
#define XB_SPIN_CAP (1u << 18)

__device__ __forceinline__ unsigned xb_ld(unsigned* p)              { return __hip_atomic_load(p, __ATOMIC_RELAXED, __HIP_MEMORY_SCOPE_AGENT); }
__device__ __forceinline__ unsigned xb_add(unsigned* p, unsigned v) { return __hip_atomic_fetch_add(p, v, __ATOMIC_RELAXED, __HIP_MEMORY_SCOPE_AGENT); }
__device__ __forceinline__ unsigned xb_xcc_id() { return (unsigned)__builtin_amdgcn_s_getreg((3 << 11) | 20) & 0xFu; }
#define XB_SPIN(cond, bar) do { unsigned _sp = 0; while (cond) { __builtin_amdgcn_s_sleep(1); \
    if ((++_sp & 255u) == 0u) { if (xb_ld(&(bar)[XB_TMO])) break; if (_sp > XB_SPIN_CAP) { atomicAdd(&(bar)[XB_TMO], 1u); break; } } } } while (0)

struct XcdBarrier {
    unsigned* bar; unsigned x;
    volatile LAS unsigned* st;
};

__device__ __forceinline__ XcdBarrier xcd_barrier_post(unsigned* bar, volatile LAS unsigned* st, const int wave_) {
    XcdBarrier b; b.bar = bar; b.x = xb_xcc_id(); b.st = st;
    if (wave_ == 0 && fresh_lane() == 0) (void)xb_add(&bar[XB_XCNT(b.x)], 1u);
    return b;
}
__device__ __forceinline__ void xcd_barrier_complete(unsigned* bar, unsigned x, unsigned& nloc, unsigned& nx) {
    const unsigned G = gridDim.x * gridDim.y * gridDim.z;
    unsigned sum, cnt, mine, sp = 0u;
    for (;;) {
        sum = 0u; cnt = 0u; mine = 0u;
#pragma unroll
        for (unsigned j = 0; j < 16; ++j) { const unsigned c = xb_ld(&bar[XB_XCNT(j)]); sum += c; cnt += (c > 0u) ? 1u : 0u; mine = (j == x) ? c : mine; }
        if (sum == G) break;
        __builtin_amdgcn_s_sleep(1);
        if ((++sp & 255u) == 0u) { if (xb_ld(&bar[XB_TMO])) break; if (sp > XB_SPIN_CAP) { atomicAdd(&bar[XB_TMO], 1u); break; } }
    }
    nloc = mine > 0u ? mine : 1u; nx = cnt > 0u ? cnt : 1u;
}

__device__ __forceinline__ void xcd_barrier(const XcdBarrier& b, const int wave_) {
    asm volatile("s_waitcnt vmcnt(0)" ::: "memory");
    __syncthreads();
    if (wave_ == 0 && fresh_lane() == 0) {
        unsigned* bar = b.bar;
        __builtin_amdgcn_s_waitcnt(0);
        unsigned nloc = b.st[0], nx = b.st[1];
        if (nloc == 0u) { xcd_barrier_complete(bar, b.x, nloc, nx); b.st[0] = nloc; b.st[1] = nx; }
        const unsigned old = xb_add(&bar[XB_XSUB(b.x)], 1u);
        const unsigned gen = old / nloc;
        if (old + 1u == (gen + 1u) * nloc) {
            __builtin_amdgcn_fence(__ATOMIC_RELEASE, "agent");
            asm volatile("s_waitcnt vmcnt(0)" ::: "memory");
            const unsigned og = xb_add(&bar[XB_TOP], 1u);
            const unsigned tg = og / nx;
            if (og + 1u == (tg + 1u) * nx) xb_add(&bar[XB_TOPGEN], 1u);
            else XB_SPIN(xb_ld(&bar[XB_TOPGEN]) == tg, bar);
            __builtin_amdgcn_fence(__ATOMIC_ACQUIRE, "agent");
            xb_add(&bar[XB_XGEN(b.x)], 1u);
            asm volatile("s_waitcnt vmcnt(0)" ::: "memory");
        } else {
            XB_SPIN(xb_ld(&bar[XB_XGEN(b.x)]) == gen, bar);
            __builtin_amdgcn_fence(__ATOMIC_ACQUIRE, "agent");
            asm volatile("s_waitcnt vmcnt(0)" ::: "memory");
        }
    }
    __syncthreads();
}

#ifdef SELF_CLEAN_BARRIER
__device__ unsigned g_bar[4096];
#endif
__global__ void __launch_bounds__(NTHR, 2) hybrid_fwd(Args args) {
    extern __shared__ __attribute__((aligned(16))) unsigned char lds_raw[];
    LAS unsigned char* lds = (LAS unsigned char*)lds_raw;
    const int wave = __builtin_amdgcn_readfirstlane((int)threadIdx.x >> 6), G = gridDim.x; const int tid = 0, lane = 0;
    cg::grid_group grid = cg::this_grid();
    volatile LAS unsigned* misc = (volatile LAS unsigned*)(lds + LDS_MISC);
    if (threadIdx.x < 2) misc[threadIdx.x] = 0u;
    __syncthreads();
    if (args.ph_lo < 0) grid.sync();
    #ifdef SELF_CLEAN_BARRIER
    XcdBarrier xbar = xcd_barrier_post(g_bar, misc, wave);
#else
    XcdBarrier xbar = xcd_barrier_post((unsigned*)(args.ws + WS_CTL), misc, wave);
#endif
    const int lo = args.ph_lo, hi = args.ph_hi;
#ifndef PHMASK
#define PHMASK 31
#endif
#define IN(k) (((PHMASK >> (k)) & 1) && lo <= (k) && (k) < hi)
#define SEAM(k) do { if (IN(k) && IN((k) + 1)) xcd_barrier(xbar, wave); } while (0)
#ifndef REPEAT_MASK
#define REPEAT_MASK 0
#endif
#ifdef PROBE_PH
    unsigned long long pt0_ = 0ull; unsigned pacc_ = 0u;
#define PB(k) do { if (PROBE_PH == (k)) pt0_ = __builtin_amdgcn_s_memrealtime(); } while (0)
#define PE(k) do { if (PROBE_PH == (k)) pacc_ += (unsigned)(__builtin_amdgcn_s_memrealtime() - pt0_); } while (0)
#else
#define PB(k) do {} while (0)
#define PE(k) do {} while (0)
#endif
    PB(20);
#define REP(k) _Pragma("nounroll") for (int rep_ = 0; rep_ < 1 + ((REPEAT_MASK >> (k)) & 1); ++rep_)
#ifdef EXTRA_SYNCS
    for (int es_ = 0; es_ < EXTRA_SYNCS; ++es_) xcd_barrier(xbar, wave);
#endif
    PB(0);
    if (IN(0)) REP(0) { if (rep_) xcd_barrier(xbar, wave); p0_phase(args, lds, tid, lane, wave, G); }
    PE(0); PB(10); __syncthreads();   PE(10); PB(1);
    if (IN(1)) REP(1) { if (rep_) xcd_barrier(xbar, wave); p1_phase(args, lds, tid, lane, wave, G); }
    PE(1); PB(11); SEAM(1); PE(11); PB(2);
    if (IN(2)) REP(2) {
        if (rep_) xcd_barrier(xbar, wave);
        __syncthreads();
        pg8::Gemm g{(const pg8::bf16_t*)((const unsigned char*)args.out + OUT_H), (const pg8::bf16_t*)((const unsigned char*)args.out + OUT_WINT), MTOK, NP_MAIN, D};
        pg8::StaticOrder S; S.init(MTOK, NP_MAIN, G, (int)blockIdx.x);
        pg8::EpiProj E{(pg8::bf16_t*)(args.ws + WS_PROJ), NP};
        pg8::gemm_phase<pg8::EpiProj, pg8::StaticOrder, true, true>(lds, g, S, E, wave);
        for (int blk = blockIdx.x; blk < 256; blk += G) {
            const int lane_ = fresh_lane(), tid_ = wave * 64 + lane_;
            f32x16 accT[2];
#pragma unroll
            for (int i = 0; i < 2; ++i)
#pragma unroll
                for (int e = 0; e < 16; ++e) accT[i][e] = 0.f;
            tail_gemmT(accT, (const bf16*)((const unsigned char*)args.out + OUT_H) + (size_t)blk * 64 * 1024, (const bf16*)(args.ws + WS_WTF), wave, lds, tid_, lane_);
            const int l2 = fresh_lane(), r2 = l2 & 31, h2 = l2 >> 5;
            bf16* prow = (bf16*)(args.ws + WS_PROJ) + ((size_t)blk * 64 + r2) * NP + NP_MAIN + 32 * wave + 4 * h2;
#pragma unroll
            for (int rt = 0; rt < 2; ++rt)
#pragma unroll
                for (int g4 = 0; g4 < 4; ++g4) { u32x2 ov; ov.x = pk2(accT[rt][4 * g4], accT[rt][4 * g4 + 1]); ov.y = pk2(accT[rt][4 * g4 + 2], accT[rt][4 * g4 + 3]);
                    *(u32x2*)(prow + (size_t)rt * 32 * NP + 8 * g4) = ov; }
        }
    }
    PE(2); PB(12); SEAM(2); PE(12); PB(3);
    if (IN(3)) { p3a_phase(args, wave, G); PE(3); PB(13); xcd_barrier(xbar, wave); PE(13); PB(4); if ((REPEAT_MASK >> 3) & 1) { p3_phase(args, lds, tid, lane, wave, G, true); xcd_barrier(xbar, wave); } p3_phase(args, lds, tid, lane, wave, G); }
    PE(4); PB(14); SEAM(3); PE(14); PB(5);
    if (IN(4)) REP(4) { if (rep_) xcd_barrier(xbar, wave); p4_phase(args, lds, tid, lane, wave, G); }
#undef REP
    PE(5); PE(20);
#if defined(SELF_CLEAN_BARRIER) && !defined(PROBE_PH)
    {
        __syncthreads();
        if (wave == 0) {
            const int l_ = fresh_lane();
            unsigned last_ = 0u;
            if (l_ == 0) last_ = (__hip_atomic_fetch_add(&g_bar[4032], 1u, __ATOMIC_RELAXED, __HIP_MEMORY_SCOPE_AGENT) == (unsigned)G - 1u) ? 1u : 0u;
            last_ = (unsigned)__builtin_amdgcn_readfirstlane((int)last_);
            if (last_) {
                if (l_ < 16) { __hip_atomic_store(&g_bar[XB_XCNT(l_)], 0u, __ATOMIC_RELAXED, __HIP_MEMORY_SCOPE_AGENT); __hip_atomic_store(&g_bar[XB_XSUB(l_)], 0u, __ATOMIC_RELAXED, __HIP_MEMORY_SCOPE_AGENT); __hip_atomic_store(&g_bar[XB_XGEN(l_)], 0u, __ATOMIC_RELAXED, __HIP_MEMORY_SCOPE_AGENT); }
                if (l_ == 16) { __hip_atomic_store(&g_bar[XB_TOP], 0u, __ATOMIC_RELAXED, __HIP_MEMORY_SCOPE_AGENT); __hip_atomic_store(&g_bar[XB_TOPGEN], 0u, __ATOMIC_RELAXED, __HIP_MEMORY_SCOPE_AGENT);
                                __hip_atomic_store(&g_bar[XB_TMO], 0u, __ATOMIC_RELAXED, __HIP_MEMORY_SCOPE_AGENT); __hip_atomic_store(&g_bar[4032], 0u, __ATOMIC_RELAXED, __HIP_MEMORY_SCOPE_AGENT); }
            }
        }
    }
#endif
#ifdef PROBE_PH
    if (blockIdx.x == PROBE_PBLK && wave == 0 && fresh_lane() == 0) ((unsigned*)(args.ws + WS_CTL))[4001] = pacc_;
    if (blockIdx.x == 0) { xcd_barrier(xbar, wave); } else { xcd_barrier(xbar, wave); }
    if (blockIdx.x == 0 && wave == 0 && fresh_lane() == 0) { asm volatile("s_waitcnt vmcnt(0)" ::: "memory"); args.out[0] = 50.0f * floorf(0.01f * (float)__hip_atomic_load((unsigned*)(args.ws + WS_CTL) + 4001, __ATOMIC_RELAXED, __HIP_MEMORY_SCOPE_AGENT) / 50.0f + 0.5f); }
#endif
#ifdef PROBE_SEL
    if (blockIdx.x == 0 && wave == 0 && fresh_lane() == 0) { asm volatile("s_waitcnt vmcnt(0)" ::: "memory"); args.out[0] = 0.01f * (float)((volatile unsigned*)(args.ws + WS_CTL))[4000]; }
#endif
#undef IN
#undef SEAM
}

extern "C" void kernel_launch(void* const* d_in, const int* in_sizes, int n_in, void* d_out, int out_size, void* d_ws, size_t ws_size, hipStream_t stream) {
    static int grid = 0;
    if (grid == 0) {
        if (n_in != 16 || out_size != MTOK * D || ws_size < WS_END) { fprintf(stderr, "kernel_launch: unexpected shapes (n_in %d out %d ws %zu)\n", n_in, out_size, ws_size); grid = -1; return; }
        int dev = 0, cus = 0, per_cu = 0;
        (void)hipGetDevice(&dev);
        (void)hipDeviceGetAttribute(&cus, hipDeviceAttributeMultiprocessorCount, dev);
        if (hipFuncSetAttribute((const void*)hybrid_fwd, hipFuncAttributeMaxDynamicSharedMemorySize, LDS_BYTES) != hipSuccess) { fprintf(stderr, "kernel_launch: hipFuncSetAttribute failed\n"); grid = -1; return; }
        if (hipOccupancyMaxActiveBlocksPerMultiprocessor(&per_cu, (const void*)hybrid_fwd, NTHR, LDS_BYTES) != hipSuccess || per_cu < 1) { fprintf(stderr, "kernel_launch: occupancy query says %d\n", per_cu); per_cu = 1; }
        (void)hipGetLastError();
        grid = cus * per_cu;
        if (grid > 256) grid = 256;
        if (grid < 1) grid = 1;
    }
    if (grid < 0) return;
#ifndef SELF_CLEAN_BARRIER
    if (hipMemsetAsync((char*)d_ws + WS_CTL, 0, CTL_BYTES, stream) != hipSuccess) { fprintf(stderr, "kernel_launch: memset of the barrier words failed\n"); return; }
#endif
    Args a{};
    for (int i = 0; i < 16; ++i) a.in[i] = (const float*)d_in[i];
    a.out = (float*)d_out; a.ws = (unsigned char*)d_ws;
#if N_LAUNCHES == 1
    a.ph_lo = 0; a.ph_hi = NPH;
    void* kargs[] = {&a};
    hipError_t e = hipLaunchCooperativeKernel((const void*)hybrid_fwd, dim3(grid), dim3(NTHR), kargs, LDS_BYTES, stream);
    if (e != hipSuccess) fprintf(stderr, "kernel_launch: cooperative launch failed: %s (grid %d)\n", hipGetErrorString(e), grid);
#else
    for (int p = 0; p < NPH; ++p) {
        a.ph_lo = p; a.ph_hi = p + 1;
        hipLaunchKernelGGL(hybrid_fwd, dim3(grid), dim3(NTHR), LDS_BYTES, stream, a);
    }
#endif
}
```

```cpp
#include <hip/hip_runtime.h>
#include <hip/hip_cooperative_groups.h>
#include <cstdio>
#include <cstdint>
namespace cg = cooperative_groups;
#define N_LAUNCHES 1
#define REPEAT_MASK 0
#define P4_REP2 1
__device__ __forceinline__ unsigned launder(unsigned v) { asm volatile("" : "+v"(v)); return v; }
__device__ __forceinline__ int fresh_lane() { unsigned z; asm volatile("v_mov_b32 %0, 0" : "=v"(z)); return (int)__builtin_amdgcn_mbcnt_hi(~0u, __builtin_amdgcn_mbcnt_lo(~0u, z)); }
namespace pg8 {
#define PG8_LAS __attribute__((address_space(3)))
typedef unsigned short bf16_t;
typedef short bf16x8 __attribute__((ext_vector_type(8)));
typedef float f32x4 __attribute__((ext_vector_type(4)));
typedef unsigned u32x4 __attribute__((ext_vector_type(4)));
constexpr int BM = 256, BK = 64, HALF = 128, HTB = HALF * BK * 2  , STAGE_BYTES = 8 * HTB, NXCD = 8, WGM = 8;

__host__ __device__ __forceinline__ int lds_byte(int r, int c) { const int st = (r >> 4) * 2 + (c >> 5), rr = r & 15, cc = c & 31, ob = rr * 64 + cc * 2; return st * 1024 + (ob ^ (((ob >> 9) & 1) << 5)); }
__host__ __device__ __forceinline__ void stage_rc(int b, int& R, int& C) { const int st = b / 1024, sb = b % 1024, swz = sb ^ (((sb >> 9) & 1) << 5); R = (st >> 1) * 16 + swz / 64; C = (st & 1) * 32 + (swz % 64) / 2; }
__host__ __device__ __forceinline__ int perm32(int rho) { const int n = rho >> 4, i = rho & 15; return 8 * (i >> 2) + 4 * n + (i & 3); }

struct Unit { int pm, pn; };
struct Gemm { const bf16_t* A; const bf16_t* Bt; int M, N, K; };

struct StaticOrder {
    int nM, nN, nwg, G, c;
    __host__ __device__ void init(int M, int N, int G_, int c_) { nM = M / BM; nN = N / BM; nwg = nM * nN; G = G_; c = c_; }
    __host__ __device__ bool next(int i, Unit& u) const {
        const long L = (long)i * G + c; if (L >= nwg) return false;
        int wgid = (int)L; { const int q = nwg / NXCD, r = nwg % NXCD, xcd = wgid % NXCD, off = wgid / NXCD; wgid = (xcd < r ? xcd * (q + 1) : r * (q + 1) + (xcd - r) * q) + off; }
        const int nig = WGM * nN, gid = wgid / nig, fm = gid * WGM, gsz = (nM - fm) < WGM ? (nM - fm) : WGM;
        u.pm = fm + ((wgid % nig) % gsz); u.pn = (wgid % nig) / gsz; return true;
    }
    __device__ __forceinline__ void a_ready(const Unit&) const {}
    __device__ __forceinline__ void done(const Unit&) const {}
};
__device__ __forceinline__ unsigned cvt_pk_bf16(float lo, float hi) { unsigned r; asm volatile("v_cvt_pk_bf16_f32 %0, %1, %2" : "=v"(r) : "v"(lo), "v"(hi)); return r; }
struct EpiProj {
    static constexpr bool PERM = true, AFTER_DRAIN = false;
    bf16_t* O; int ldc;
    __device__ __forceinline__ void operator()(const f32x4 (&acc)[2][2][4][2], const Unit& u, int wr, int wc, int fr, int fq) const {
        const int row0 = u.pm * BM + wr * 64 + fr; const int col0 = u.pn * BM + wc * 32 + 8 * fq;
#pragma unroll
        for (int ai = 0; ai < 2; ++ai)
#pragma unroll
            for (int m = 0; m < 4; ++m) { bf16_t* rowp = O + (size_t)(row0 + ai * HALF + m * 16) * ldc + col0;
#pragma unroll
                for (int bj = 0; bj < 2; ++bj) { const f32x4 v0 = acc[ai][bj][m][0], v1 = acc[ai][bj][m][1];
                    u32x4 w; w.x = cvt_pk_bf16(v0[0], v0[1]); w.y = cvt_pk_bf16(v0[2], v0[3]); w.z = cvt_pk_bf16(v1[0], v1[1]); w.w = cvt_pk_bf16(v1[2], v1[3]);
                    *(u32x4*)(rowp + bj * HALF) = w; } }
    }
    __device__ __forceinline__ void fused(f32x4 (&)[2][2][4][2], const Unit&, int, int, int, int, PG8_LAS unsigned char*, int, int) const {}
};
template <class Epi, class Sched, bool ALIGN_EPI = false, bool SP2 = false>
__device__ __forceinline__ void gemm_phase(PG8_LAS unsigned char* lds, const Gemm g, const Sched& S, const Epi& E, const int wid) {
    const int lane = ::fresh_lane(), tid = wid * 64 + lane, wr = wid >> 2, wc = wid & 3, fr = lane & 15, fq = lane >> 4;
    const int K = g.K, nt = K / BK;
    unsigned voffA[2], voffB[2];
#pragma unroll
    for (int i = 0; i < 2; ++i) { int R, C; stage_rc(tid * 16 + i * 8192, R, C); const int Rb = Epi::PERM ? ((R & ~31) + perm32(R & 31)) : R;
        voffA[i] = (unsigned)(R * K + C) * 2u; voffB[i] = (unsigned)(Rb * K + C) * 2u; }
    const size_t kstep = (size_t)(BK * 2);
    const size_t hstep = (size_t)HALF * K * 2;
    const size_t tstep = 2 * hstep;
    const unsigned ldsw = (unsigned)wid * 1024u;
    const int aoff = lds_byte(wr * 64 + fr, fq * 8), boff = lds_byte(wc * 32 + fr, fq * 8);
#define PG8_SA(b, h) (((b) * 2 + (h)) * HTB)
#define PG8_SB(b, h) ((4 + (b) * 2 + (h)) * HTB)
#define PG8_STAGE(bufoff, gbase, voff) do { _Pragma("unroll") for (int _i = 0; _i < 2; ++_i) \
        __builtin_amdgcn_global_load_lds((const unsigned*)((const char*)(gbase) + (voff)[_i]), (PG8_LAS unsigned*)(lds + (bufoff) + ldsw + _i * 8192), 16, 0, 0); } while (0)
#define PG8_LDA(dst, b, h) do { _Pragma("unroll") for (int m = 0; m < 4; ++m) _Pragma("unroll") for (int k = 0; k < 2; ++k) dst[m][k] = *(const PG8_LAS bf16x8*)(lds + PG8_SA(b, h) + aoff + m * 2048 + k * 1024); } while (0)
#define PG8_LDB(dst, b, h) do { _Pragma("unroll") for (int n = 0; n < 2; ++n) _Pragma("unroll") for (int k = 0; k < 2; ++k) dst[n][k] = *(const PG8_LAS bf16x8*)(lds + PG8_SB(b, h) + boff + n * 2048 + k * 1024); } while (0)
#define PG8_MMA(ai, bj, At, Bt) do { __builtin_amdgcn_s_setprio(1); _Pragma("unroll") for (int m = 0; m < 4; ++m) _Pragma("unroll") for (int n = 0; n < 2; ++n) _Pragma("unroll") for (int k = 0; k < 2; ++k) \
        acc[ai][bj][m][n] = __builtin_amdgcn_mfma_f32_16x16x32_bf16(Bt[n][k], At[m][k], acc[ai][bj][m][n], 0, 0, 0); __builtin_amdgcn_s_setprio(0); } while (0)
#define PG8_WAIT_V(n) asm volatile("s_waitcnt vmcnt(" #n ")" ::: "memory")
#define PG8_WAIT_L(n) asm volatile("s_waitcnt lgkmcnt(" #n ")" ::: "memory")
#define PG8_BAR __builtin_amdgcn_s_barrier()
#define PG8_SCHED __builtin_amdgcn_sched_barrier(0)
    Unit cur, nxt; int ui = 0;
    if (!S.next(0, cur)) return;
    f32x4 acc[2][2][4][2];
#pragma unroll
    for (int a = 0; a < 2; ++a)
#pragma unroll
        for (int b = 0; b < 2; ++b)
#pragma unroll
            for (int m = 0; m < 4; ++m)
#pragma unroll
                for (int n = 0; n < 2; ++n) acc[a][b][m][n] = (f32x4){0.f, 0.f, 0.f, 0.f};
    bf16x8 At[4][2], B0[2][2], B1[2][2];
    const char* cA = (const char*)g.A + (size_t)cur.pm * tstep; const char* cB = (const char*)g.Bt + (size_t)cur.pn * tstep;
    S.a_ready(cur);
    if constexpr (SP2) {
        PG8_STAGE(PG8_SB(0, 0), cB, voffB); PG8_STAGE(PG8_SB(0, 1), cB + hstep, voffB); PG8_STAGE(PG8_SA(0, 0), cA, voffA); PG8_STAGE(PG8_SA(0, 1), cA + hstep, voffA);
        if (wr == 1) PG8_BAR;
        PG8_WAIT_V(2); PG8_BAR;
        PG8_STAGE(PG8_SB(1, 0), cB + kstep, voffB); PG8_STAGE(PG8_SA(1, 0), cA + kstep, voffA); PG8_STAGE(PG8_SB(1, 1), cB + hstep + kstep, voffB);
        PG8_WAIT_V(6); PG8_BAR;
    } else {
        PG8_STAGE(PG8_SB(0, 0), cB, voffB); PG8_STAGE(PG8_SA(0, 0), cA, voffA); PG8_STAGE(PG8_SB(0, 1), cB + hstep, voffB); PG8_STAGE(PG8_SA(0, 1), cA + hstep, voffA);
        if (wr == 1) PG8_BAR;
        PG8_WAIT_V(4); PG8_BAR;
        PG8_STAGE(PG8_SB(1, 0), cB + kstep, voffB); PG8_STAGE(PG8_SA(1, 0), cA + kstep, voffA); PG8_STAGE(PG8_SB(1, 1), cB + hstep + kstep, voffB);
        PG8_WAIT_V(6); PG8_BAR;
    }
    for (;;) {
        const bool has_next = S.next(ui + 1, nxt);
        const char* nA = has_next ? (const char*)g.A + (size_t)nxt.pm * tstep : cA; const char* nB = has_next ? (const char*)g.Bt + (size_t)nxt.pn * tstep : cB;
        for (int t = 0; t < nt; t += 2) {
            const bool last = (t == nt - 2);
            const char* a1 = cA + (size_t)(t + 1) * kstep;
            const char* a2 = last ? nA : cA + (size_t)(t + 2) * kstep; const char* b2 = last ? nB : cB + (size_t)(t + 2) * kstep;
            const char* a3 = a2 + kstep; const char* b3 = b2 + kstep;
            if (last && has_next) S.a_ready(nxt);
            if constexpr (SP2) {
            PG8_LDB(B0, 0, 0); PG8_LDB(B1, 0, 1); PG8_SCHED; PG8_LDA(At, 0, 0); PG8_STAGE(PG8_SA(1, 1), a1 + hstep, voffA);
            PG8_WAIT_V(8); PG8_WAIT_L(0); PG8_BAR; PG8_MMA(0, 0, At, B0); PG8_MMA(0, 1, At, B1); PG8_BAR; PG8_SCHED;
            PG8_LDA(At, 0, 1); PG8_STAGE(PG8_SB(0, 0), b2, voffB); PG8_STAGE(PG8_SB(0, 1), b2 + hstep, voffB); PG8_STAGE(PG8_SA(0, 0), a2, voffA);
            PG8_WAIT_V(8); PG8_WAIT_L(0); PG8_BAR; PG8_MMA(1, 0, At, B0); PG8_MMA(1, 1, At, B1); PG8_BAR; PG8_SCHED;
            PG8_LDB(B0, 1, 0); PG8_LDB(B1, 1, 1); PG8_SCHED; PG8_LDA(At, 1, 0); PG8_STAGE(PG8_SA(0, 1), a2 + hstep, voffA);
            PG8_WAIT_V(8); PG8_WAIT_L(0); PG8_BAR; PG8_MMA(0, 0, At, B0); PG8_MMA(0, 1, At, B1); PG8_BAR; PG8_SCHED;
            PG8_LDA(At, 1, 1); PG8_STAGE(PG8_SB(1, 0), b3, voffB); PG8_STAGE(PG8_SB(1, 1), b3 + hstep, voffB); PG8_STAGE(PG8_SA(1, 0), a3, voffA);
            PG8_WAIT_V(8); PG8_WAIT_L(0); PG8_BAR; PG8_MMA(1, 0, At, B0); PG8_MMA(1, 1, At, B1); PG8_BAR; PG8_SCHED;
            } else {
            PG8_LDB(B0, 0, 0); PG8_SCHED; PG8_LDA(At, 0, 0); PG8_STAGE(PG8_SA(1, 1), a1 + hstep, voffA);
            PG8_WAIT_L(8); PG8_BAR; PG8_WAIT_L(0); PG8_MMA(0, 0, At, B0); PG8_BAR; PG8_SCHED;
            PG8_LDB(B1, 0, 1); PG8_STAGE(PG8_SB(0, 0), b2, voffB);
            PG8_BAR; PG8_WAIT_L(0); PG8_MMA(0, 1, At, B1); PG8_BAR;
            PG8_LDA(At, 0, 1); PG8_STAGE(PG8_SA(0, 0), a2, voffA);
            PG8_BAR; PG8_WAIT_L(0); PG8_MMA(1, 0, At, B0); PG8_BAR; PG8_SCHED;
            PG8_STAGE(PG8_SB(0, 1), b2 + hstep, voffB);
            PG8_WAIT_V(6); PG8_BAR; PG8_MMA(1, 1, At, B1); PG8_BAR;
            PG8_LDB(B0, 1, 0); PG8_SCHED; PG8_LDA(At, 1, 0); PG8_STAGE(PG8_SA(0, 1), a2 + hstep, voffA);
            PG8_WAIT_L(8); PG8_BAR; PG8_WAIT_L(0); PG8_MMA(0, 0, At, B0); PG8_BAR; PG8_SCHED;
            PG8_LDB(B1, 1, 1); PG8_STAGE(PG8_SB(1, 0), b3, voffB);
            PG8_BAR; PG8_WAIT_L(0); PG8_MMA(0, 1, At, B1); PG8_BAR;
            PG8_LDA(At, 1, 1); PG8_STAGE(PG8_SA(1, 0), a3, voffA);
            PG8_BAR; PG8_WAIT_L(0); PG8_MMA(1, 0, At, B0); PG8_BAR; PG8_SCHED;
            PG8_STAGE(PG8_SB(1, 1), b3 + hstep, voffB);
            PG8_WAIT_V(6); PG8_BAR; PG8_MMA(1, 1, At, B1); PG8_BAR;
            }
        }
        if constexpr (ALIGN_EPI) { if (wr == 0) PG8_BAR; }
        if constexpr (!Epi::AFTER_DRAIN) { E(acc, cur, wr, wc, fr, fq); S.done(cur); }
        if (!has_next) break;
#pragma unroll
        for (int a = 0; a < 2; ++a)
#pragma unroll
            for (int b = 0; b < 2; ++b)
#pragma unroll
                for (int m = 0; m < 4; ++m)
#pragma unroll
                    for (int n = 0; n < 2; ++n) acc[a][b][m][n] = (f32x4){0.f, 0.f, 0.f, 0.f};
        cur = nxt; cA = nA; cB = nB; ++ui;
        if constexpr (ALIGN_EPI) { if (wr == 1) PG8_BAR; }
    }
    PG8_WAIT_V(0);
    if constexpr (!ALIGN_EPI) { if (wr == 0) PG8_BAR; }
    PG8_BAR;
    if constexpr (Epi::AFTER_DRAIN) { E.fused(acc, cur, wr, wc, fr, fq, lds, wid, lane); S.done(cur); }
#undef PG8_SA
#undef PG8_SB
#undef PG8_STAGE
#undef PG8_LDA
#undef PG8_LDB
#undef PG8_MMA
#undef PG8_WAIT_V
#undef PG8_WAIT_L
#undef PG8_BAR
#undef PG8_SCHED
}
}

#define LAS __attribute__((address_space(3)))
typedef unsigned short bf16;
typedef short bf16x8 __attribute__((ext_vector_type(8)));
typedef short s16x4 __attribute__((ext_vector_type(4)));
typedef float f32x4 __attribute__((ext_vector_type(4)));
typedef float f32x16 __attribute__((ext_vector_type(16)));
typedef unsigned u32x4 __attribute__((ext_vector_type(4)));
typedef unsigned u32x2 __attribute__((ext_vector_type(2)));
typedef float f32x2_t __attribute__((ext_vector_type(2)));
typedef __bf16 bf16x2_t __attribute__((ext_vector_type(2)));

#ifndef N_LAUNCHES
#define N_LAUNCHES 1
#endif
constexpr int NPH = 5;
constexpr int D = 1024, NB = 8, SEQ = 2048, MTOK = NB * SEQ, NIN = 7440, NP = 7424, NP_MAIN = 7168;
constexpr int C_Z = 0, C_X = 1024, C_B = 2048, C_C = 2176, C_Q = 2304, C_K = 2816, C_V = 3328, C_GR = 4352, C_GAM = 5376, C_GAR = 6400;
constexpr float EPS = 1e-6f;
constexpr size_t MiB = 1u << 20;
constexpr size_t WS_PROJ = 0;
constexpr size_t WS_WMF = 232 * MiB, WS_WRF = 234 * MiB, WS_WOF = 236 * MiB;
constexpr size_t WS_MOD = 238 * MiB;
constexpr size_t WS_DT = 239 * MiB;
constexpr size_t WS_SSQM = 240 * MiB;
constexpr size_t WS_SSQR = 242 * MiB;
constexpr int CW_MODCNT = 3900;
constexpr size_t WS_CTL = 244 * MiB, CTL_BYTES = 16384;
constexpr size_t WS_WTF = 245 * MiB;
constexpr size_t WS_END = 246 * MiB;
constexpr size_t OUT_H = 0, OUT_WINT = 32 * MiB;
constexpr int LDS_BYTES = 155648, LDS_MISC = 155520;
constexpr int NTHR = 512;

struct Args { const float* in[16]; float* out; unsigned char* ws; int ph_lo, ph_hi; };

__device__ __forceinline__ float bf_lo(unsigned u) { return __uint_as_float(u << 16); }
__device__ __forceinline__ float bf_hi(unsigned u) { return __uint_as_float(u & 0xffff0000u); }
__device__ __forceinline__ unsigned pk2(float lo, float hi) { f32x2_t v = {lo, hi}; bf16x2_t b = __builtin_convertvector(v, bf16x2_t); return __builtin_bit_cast(unsigned, b); }
__device__ __forceinline__ float silu_f(float x) { return x * __builtin_amdgcn_rcpf(1.f + __expf(-x)); }
__device__ __forceinline__ float sigm_f(float x) { return __builtin_amdgcn_rcpf(1.f + __expf(-x)); }
__device__ __forceinline__ float wave_sum(float v) {
#pragma unroll
    for (int o = 1; o < 64; o <<= 1) v += __shfl_xor(v, o);
    return v;
}
__device__ __forceinline__ int crow(int reg, int h) { return (reg & 3) + 8 * (reg >> 2) + 4 * h; }
#define MFMA32(a, b, c) __builtin_amdgcn_mfma_f32_32x32x16_bf16((a), (b), (c), 0, 0, 0)
#define MFMA16(a, b, c) __builtin_amdgcn_mfma_f32_16x16x32_bf16((a), (b), (c), 0, 0, 0)
__device__ __forceinline__ s16x4 tr_read(const LAS unsigned char* p) {
    typedef short v4i16_t __attribute__((ext_vector_type(4)));
    return __builtin_bit_cast(s16x4, __builtin_amdgcn_ds_read_tr16_b64_v4i16((LAS v4i16_t*)p));
}
__device__ __forceinline__ bf16x8 tr_pair(const LAS unsigned char* plo, const LAS unsigned char* phi) {
    const s16x4 lo = tr_read(plo), hi = tr_read(phi);
    return __builtin_shufflevector(lo, hi, 0, 1, 2, 3, 4, 5, 6, 7);
}
__device__ __forceinline__ bf16x8 pack8(float a0, float a1, float a2, float a3, float a4, float a5, float a6, float a7) {
    u32x4 p; p.x = pk2(a0, a1); p.y = pk2(a2, a3); p.z = pk2(a4, a5); p.w = pk2(a6, a7);
    return __builtin_bit_cast(bf16x8, p);
}

__device__ __forceinline__ void p0_load_tile(const float* W, int ldw, int k0, int n0, LAS float* scr, int lane) {
    float t[32];
#pragma unroll
    for (int i = 0; i < 32; ++i) t[i] = __builtin_nontemporal_load(W + (size_t)(k0 + 2 * i + (lane >> 5)) * ldw + n0 + (lane & 31));
#pragma unroll
    for (int i = 0; i < 32; ++i) scr[(2 * i + (lane >> 5)) * 33 + (lane & 31)] = t[i];
}
__device__ __forceinline__ void p0_phase(const Args& a, LAS unsigned char* lds, int tid_unused, int lane_unused, int wave, int G) {
    const int lane = fresh_lane(), tid = wave * 64 + lane;
    const float* cvec = a.in[1]; const float* w_ada = a.in[2]; const float* b_ada = a.in[3];
    float* MOD = (float*)(a.ws + WS_MOD);
    LAS float* cT = (LAS float*)lds;
    LAS float* red = (LAS float*)(lds + 32768);
    if ((int)blockIdx.x < 192) {
        { float t[16];
#pragma unroll
          for (int i = 0; i < 16; ++i) t[i] = cvec[tid + 512 * i];
#pragma unroll
          for (int i = 0; i < 16; ++i) { const int idx = tid + 512 * i; cT[(idx & 1023) * 8 + (idx >> 10)] = t[i]; } }
        __syncthreads();
        for (int item = blockIdx.x; item < 192; item += G) {
            const int j0 = item * 16, col = lane & 15, rsub = lane >> 4, kq = wave;
            float w[32];
#pragma unroll
            for (int i = 0; i < 32; ++i) w[i] = __builtin_nontemporal_load(w_ada + (size_t)(kq * 128 + 4 * i + rsub) * 3072 + j0 + col);
            float acc[8];
#pragma unroll
            for (int bb = 0; bb < 8; ++bb) acc[bb] = 0.f;
#pragma unroll
            for (int i = 0; i < 32; ++i) { const int k = kq * 128 + 4 * i + rsub;
                const f32x4 c0 = *(const LAS f32x4*)(cT + k * 8), c1 = *(const LAS f32x4*)(cT + k * 8 + 4);
                acc[0] += c0.x * w[i]; acc[1] += c0.y * w[i]; acc[2] += c0.z * w[i]; acc[3] += c0.w * w[i];
                acc[4] += c1.x * w[i]; acc[5] += c1.y * w[i]; acc[6] += c1.z * w[i]; acc[7] += c1.w * w[i]; }
#pragma unroll
            for (int bb = 0; bb < 8; ++bb) { acc[bb] += __shfl_xor(acc[bb], 16); acc[bb] += __shfl_xor(acc[bb], 32); }
            if (lane < 16) {
#pragma unroll
                for (int bb = 0; bb < 8; ++bb) red[(kq * 8 + bb) * 16 + col] = acc[bb]; }
            __syncthreads();
            if (tid < 128) { const int bb = tid >> 4, cc = tid & 15; float sum = 0.f;
#pragma unroll
                for (int q = 0; q < 8; ++q) sum += red[(q * 8 + bb) * 16 + cc];
                __hip_atomic_store(&MOD[bb * 3072 + j0 + cc], sum + b_ada[j0 + cc], __ATOMIC_RELAXED, __HIP_MEMORY_SCOPE_AGENT); }
            asm volatile("s_waitcnt vmcnt(0)" ::: "memory");
            __syncthreads();
            if (tid == 0) __hip_atomic_fetch_add((unsigned*)(a.ws + WS_CTL) + CW_MODCNT, 1u, __ATOMIC_RELAXED, __HIP_MEMORY_SCOPE_AGENT);
        }
    }
    LAS float* scr = (LAS float*)(lds + 40960 + wave * 8448);
    const int gw = blockIdx.x * 8 + wave, NGW = G * 8;
    constexpr int I_IN = 16 * (NP / 32), I_W = 16 * 32;
    bf16* WINT = (bf16*)((unsigned char*)a.out + OUT_WINT);
    for (int it = gw; it < I_IN + 3 * I_W + 128; it += NGW) {
        if (it >= I_IN + 3 * I_W) {
            const int r_ = it - (I_IN + 3 * I_W), nt = r_ & 7, kb = r_ >> 3;
            p0_load_tile(a.in[5], NIN, 64 * kb, NP_MAIN + 16 + 32 * nt, scr, lane);
            bf16* WF = (bf16*)(a.ws + WS_WTF);
            const int r = lane & 31, h = lane >> 5;
#pragma unroll
            for (int s4 = 0; s4 < 4; ++s4) { const LAS float* s = scr + (16 * s4 + 8 * h) * 33 + r;
                u32x4 o; o.x = pk2(s[0 * 33], s[1 * 33]); o.y = pk2(s[2 * 33], s[3 * 33]); o.z = pk2(s[4 * 33], s[5 * 33]); o.w = pk2(s[6 * 33], s[7 * 33]);
                *(u32x4*)(WF + ((size_t)(nt * 64 + 4 * kb + s4) * 64 + lane) * 8) = o; }
        } else if (it < I_IN) {
            const int nblk = NP / 32, kb = it / nblk, nb = it % nblk, k0 = 64 * kb, n0p = 32 * nb, n0 = n0p + (n0p >= 2304 ? 16 : 0);
            p0_load_tile(a.in[5], NIN, k0, n0, scr, lane);
            const int c = lane & 7;
#pragma unroll
            for (int j = 0; j < 4; ++j) { const int n = (lane >> 3) + 8 * j; const LAS float* s = scr + (8 * c) * 33 + n;
                u32x4 o; o.x = pk2(s[0 * 33], s[1 * 33]); o.y = pk2(s[2 * 33], s[3 * 33]); o.z = pk2(s[4 * 33], s[5 * 33]); o.w = pk2(s[6 * 33], s[7 * 33]);
                *(u32x4*)(WINT + (size_t)(n0p + n) * 1024 + k0 + 8 * c) = o; }
        } else {
            int r_ = it - I_IN; const int which = r_ / I_W; r_ -= which * I_W;
            const float* W = a.in[12 + which];
            bf16* WF = (bf16*)(a.ws + WS_WMF + (size_t)which * 2 * MiB);
            const int nt = r_ & 31, kb = r_ >> 5;
            p0_load_tile(W, 1024, 64 * kb, 32 * nt, scr, lane);
            const int r = lane & 31, h = lane >> 5;
#pragma unroll
            for (int s4 = 0; s4 < 4; ++s4) { const LAS float* s = scr + (16 * s4 + 8 * h) * 33 + r;
                f32x4 m0 = (f32x4){1.f, 1.f, 1.f, 1.f}, m1 = m0;
                if (which == 0) { m0 = *(const f32x4*)(a.in[11] + 64 * kb + 16 * s4 + 8 * h); m1 = *(const f32x4*)(a.in[11] + 64 * kb + 16 * s4 + 8 * h + 4); }
                u32x4 o; o.x = pk2(s[0 * 33] * m0.x, s[1 * 33] * m0.y); o.y = pk2(s[2 * 33] * m0.z, s[3 * 33] * m0.w); o.z = pk2(s[4 * 33] * m1.x, s[5 * 33] * m1.y); o.w = pk2(s[6 * 33] * m1.z, s[7 * 33] * m1.w);
                *(u32x4*)(WF + ((size_t)(nt * 64 + 4 * kb + s4) * 64 + lane) * 8) = o; }
        }
    }
}

__device__ __forceinline__ void p1_phase(const Args& a, LAS unsigned char* lds, int tid_unused, int lane_unused, int wave, int G) {
    const int lane_in = fresh_lane(), tid = wave * 64 + lane_in;
    const float* x = a.in[0]; const float* norm_w = a.in[4]; const float* w_in = a.in[5]; const float* dt_bias = a.in[8];
    const float* MOD = (const float*)(a.ws + WS_MOD);
    float* DT = (float*)(a.ws + WS_DT);
    bf16* H = (bf16*)((unsigned char*)a.out + OUT_H);
    LAS float* wdt = (LAS float*)lds;
    { float t[32];
#pragma unroll
      for (int i = 0; i < 32; ++i) { const int idx = tid + NTHR * i; t[i] = w_in[(size_t)(idx >> 4) * NIN + 2304 + (idx & 15)]; }
#pragma unroll
      for (int i = 0; i < 32; ++i) { const int idx = tid + NTHR * i; wdt[(idx & 15) * 1028 + (idx >> 4)] = t[i]; } }
    if (wave == 0) {
        unsigned* cnt = (unsigned*)(a.ws + WS_CTL) + CW_MODCNT; unsigned spins = 0u;
        while ((unsigned)__builtin_amdgcn_readfirstlane((int)__hip_atomic_load(cnt, __ATOMIC_RELAXED, __HIP_MEMORY_SCOPE_AGENT)) < 192u) { __builtin_amdgcn_s_sleep(1); if (++spins > (1u << 20)) break; }
        __builtin_amdgcn_fence(__ATOMIC_ACQUIRE, "agent");
        asm volatile("s_waitcnt vmcnt(0)" ::: "memory");
    }
    __syncthreads();
    for (int blk = blockIdx.x; blk < 256; blk += G) {
        const int b = blk >> 5;
        float gk[16], sh[16];
#pragma unroll
        for (int jj = 0; jj < 4; ++jj) { const int k = 4 * lane_in + 256 * jj;
            const f32x4 nw = *(const f32x4*)(norm_w + k), sc = *(const f32x4*)(MOD + b * 3072 + 1024 + k), sf = *(const f32x4*)(MOD + b * 3072 + k);
#pragma unroll
            for (int e = 0; e < 4; ++e) { gk[4 * jj + e] = nw[e] * (1.f + sc[e]); sh[4 * jj + e] = sf[e]; } }
        f32x4 vn[2][4];
        { const int lane = fresh_lane();
#pragma unroll
          for (int rr = 0; rr < 2; ++rr)
#pragma unroll
              for (int jj = 0; jj < 4; ++jj) vn[rr][jj] = __builtin_nontemporal_load((const f32x4*)(x + (size_t)(blk * 64 + wave * 8 + rr) * D) + lane + 64 * jj); }
        for (int g = 0; g < 4; ++g) {
            asm volatile("" ::: "memory");
            const int lane = fresh_lane();
            const int m0 = blk * 64 + wave * 8 + g * 2;
            f32x4 v[2][4];
#pragma unroll
            for (int rr = 0; rr < 2; ++rr)
#pragma unroll
                for (int jj = 0; jj < 4; ++jj) v[rr][jj] = vn[rr][jj];
            if (g + 1 < 4) {
#pragma unroll
                for (int rr = 0; rr < 2; ++rr)
#pragma unroll
                    for (int jj = 0; jj < 4; ++jj) vn[rr][jj] = __builtin_nontemporal_load((const f32x4*)(x + (size_t)(m0 + 2 + rr) * D) + lane + 64 * jj);
            }
            __builtin_amdgcn_sched_barrier(0);
            float hv[2][16];
#pragma unroll
            for (int rr = 0; rr < 2; ++rr) {
                float ss = 0.f;
#pragma unroll
                for (int jj = 0; jj < 4; ++jj) ss += (v[rr][jj].x * v[rr][jj].x + v[rr][jj].y * v[rr][jj].y) + (v[rr][jj].z * v[rr][jj].z + v[rr][jj].w * v[rr][jj].w);
                const float rs = 1.0f / sqrtf(wave_sum(ss) * (1.f / D) + EPS);
                unsigned long long* o8 = (unsigned long long*)(H + (size_t)(m0 + rr) * D) + lane;
#pragma unroll
                for (int jj = 0; jj < 4; ++jj) {
#pragma unroll
                    for (int e = 0; e < 4; ++e) hv[rr][4 * jj + e] = v[rr][jj][e] * rs * gk[4 * jj + e] + sh[4 * jj + e];
                    o8[64 * jj] = (unsigned long long)pk2(hv[rr][4 * jj], hv[rr][4 * jj + 1]) | ((unsigned long long)pk2(hv[rr][4 * jj + 2], hv[rr][4 * jj + 3]) << 32);
                }
            }
            float acc[32];
#pragma unroll
            for (int i = 0; i < 32; ++i) acc[i] = 0.f;
#pragma unroll
            for (int j = 0; j < 16; ++j) {
#pragma unroll
                for (int jj = 0; jj < 4; ++jj) { const f32x4 w = *(const LAS f32x4*)(wdt + j * 1028 + 4 * lane + 256 * jj);
#pragma unroll
                    for (int rr = 0; rr < 2; ++rr) acc[rr * 16 + j] += (hv[rr][4 * jj] * w.x + hv[rr][4 * jj + 1] * w.y) + (hv[rr][4 * jj + 2] * w.z + hv[rr][4 * jj + 3] * w.w); }
                if ((j & 3) == 3) asm volatile("" ::: "memory");
            }
#pragma unroll
            for (int half = 16; half >= 1; half >>= 1) {
                const bool up = (lane & half) != 0;
#pragma unroll
                for (int i = 0; i < half; ++i) { float lo_ = acc[i], hi_ = acc[i + half]; asm volatile("" : "+v"(lo_), "+v"(hi_));
                    const float keep = up ? hi_ : lo_, send = up ? lo_ : hi_; acc[i] = keep + __shfl_xor(send, half); }
            }
            const float tot = acc[0] + __shfl_xor(acc[0], 32);
            const float xr_ = tot + dt_bias[lane & 15];
            const float dtv = xr_ > 20.f ? xr_ : log1pf(__expf(xr_));
            if (lane < 32) DT[(size_t)m0 * 16 + lane] = dtv;
        }
    }
}

constexpr size_t OUT_XBCC = 0;
__device__ __forceinline__ void p3a_phase(const Args& a, int wave, int G) {
    const bf16* PROJ = (const bf16*)(a.ws + WS_PROJ);
    bf16* XBCC = (bf16*)((unsigned char*)a.out + OUT_XBCC);
    const float* conv_w = a.in[6]; const float* conv_b = a.in[7];
    const int lane = fresh_lane(), tid = wave * 64 + lane;
    if (tid >= 480) return;
    const int oct = tid % 160, tgl = tid / 160;
    float cw[4][8], cb[8];
#pragma unroll
    for (int e = 0; e < 8; ++e) { cb[e] = conv_b[8 * oct + e];
#pragma unroll
        for (int k = 0; k < 4; ++k) cw[k][e] = conv_w[k * 1280 + 8 * oct + e]; }
    for (int blk = blockIdx.x; blk < 256; blk += G) {
        for (int tg = tgl; tg < 8; tg += 3) {
            const int m0 = blk * 64 + 8 * tg, ts0 = m0 & (SEQ - 1);
            const char* src = (const char*)(PROJ + (size_t)m0 * NP + C_X + 8 * oct);
            u32x4 raw[11];
#pragma unroll
            for (int i = 0; i < 11; ++i) { const bool ok = (ts0 - 3 + i) >= 0; raw[i] = ok ? *(const u32x4*)(src + ((long)i - 3) * (NP * 2)) : (u32x4){0u, 0u, 0u, 0u}; }
#pragma unroll
            for (int jj = 0; jj < 8; ++jj) {
                float o[8];
#pragma unroll
                for (int e = 0; e < 8; ++e) {
                    float s_ = cb[e];
#pragma unroll
                    for (int k = 0; k < 4; ++k) { const unsigned w = raw[jj + k][e >> 1]; s_ += cw[k][e] * ((e & 1) ? bf_hi(w) : bf_lo(w)); }
                    o[e] = silu_f(s_);
                }
                u32x4 ov; ov.x = pk2(o[0], o[1]); ov.y = pk2(o[2], o[3]); ov.z = pk2(o[4], o[5]); ov.w = pk2(o[6], o[7]);
                *(u32x4*)(XBCC + (size_t)(m0 + jj) * 1280 + 8 * oct) = ov;
            }
        }
    }
}

constexpr int TP = 72;
constexpr int L_CQ = 0, L_BK = 18432, L_BKW = 36864, L_XV = 55296, L_ST0 = 73728, L_ST1 = 82944, L_ACS = 92160, L_DTJ = 93184, L_WJ = 94208, L_CW = 95232;

__device__ __forceinline__ void p3_phase(const Args& a, LAS unsigned char* lds, int tid_in, int lane_in, int wave, int G, const bool dry = false) {
    bf16* PROJ = (bf16*)(a.ws + WS_PROJ);
    const float* DT = (const float*)(a.ws + WS_DT);
    float* SSQM = (float*)(a.ws + WS_SSQM); float* SSQR = (float*)(a.ws + WS_SSQR);
    const float* conv_w = a.in[6]; const float* conv_b = a.in[7]; const float* a_log = a.in[9]; const float* d_skip = a.in[10]; const float* m_norm_w = a.in[11];
    const int pt = wave & 1, it = wave >> 1;
#ifdef PROBE_SEL
    unsigned long long t0_ = 0ull; unsigned tacc_ = 0u;
    const bool probing = ((int)blockIdx.x == PROBE_BLK && wave == PROBE_WAVE);
#define TB(k) do { if (PROBE_SEL == (k) && probing) t0_ = __builtin_amdgcn_s_memrealtime(); } while (0)
#define TE(k) do { if (PROBE_SEL == (k) && probing) tacc_ += (unsigned)(__builtin_amdgcn_s_memrealtime() - t0_); } while (0)
#else
#define TB(k) do {} while (0)
#define TE(k) do {} while (0)
#endif
    for (int item = blockIdx.x; item < 256; item += G) {
        const int lane = fresh_lane(), tid = wave * 64 + lane;
        const int r = lane & 31, h = lane >> 5, i16 = lane & 15, q4 = i16 >> 2, p4 = i16 & 3, blk16 = (lane >> 4) & 1;
        const int xcd_ = item & 7, kk_ = item >> 3;
        const bool ssd = kk_ < 16;
        int b, hd, half;
        if (ssd) { const int pair = 2 * xcd_ + (kk_ >> 3); b = pair >> 1; hd = 8 * (pair & 1) + (kk_ & 7); half = 0; }
        else { const int t = xcd_ * 16 + (kk_ - 16); b = t >> 4; hd = (t >> 1) & 7; half = t & 1; }
        const size_t mb = (size_t)b * SEQ;
        __syncthreads();
        for (int idx = tid; idx < 9216 / 4; idx += NTHR) ((LAS unsigned*)(lds + L_ST0))[idx] = 0u;
        const float lg = ssd ? 0.f : log1pf(-exp2f(-5.0f - (float)hd));
        if (!ssd && tid < 256) { const int par = tid >> 7, j = tid & 127;
            ((LAS float*)(lds + L_ACS))[par * 128 + j] = (float)(j + 1) * lg * 1.4426950408889634f; ((LAS float*)(lds + L_DTJ))[par * 128 + j] = (float)(j + 1) * lg * 1.4426950408889634f; ((LAS float*)(lds + L_WJ))[par * 128 + j] = __expf((float)(127 - j) * lg); }
        const float Ah = ssd ? -__expf(a_log[hd]) : 0.f;
        const float Dsk = ssd ? d_skip[hd] : 0.f;
        const int ltile = 3 - (tid >> 7), loct = tid & 7, ltg = (tid >> 3) & 15;
        int lcol = 0;
        float invf[8];
        if (ssd) {
            lcol = (ltile == 0) ? (64 * hd + 8 * loct) : (ltile == 1 ? (1024 + 64 * (hd >> 3) + 8 * loct) : (1152 + 64 * (hd >> 3) + 8 * loct));
            if (ltile == 3) lcol = 1024 + 64 * (hd >> 3) + 8 * loct;
#pragma unroll
            for (int e = 0; e < 8; ++e) invf[e] = 0.f;
        } else {
#pragma unroll
            for (int e = 0; e < 8; ++e) invf[e] = exp2f(-(float)(8 * (tid & 3) + e) * (13.287712379549449f / 32.f));
        }
        f32x16 sacc;
#pragma unroll
        for (int i = 0; i < 16; ++i) sacc[i] = 0.f;
        u32x4 raw[8];
        const int rj = tid >> 2, ro4 = tid & 3;
        const int j0 = 8 * ltg;
        const char* pbase = (const char*)(PROJ + mb * NP);
        const char* xbase = (const char*)((const bf16*)((const unsigned char*)a.out + OUT_XBCC) + mb * 1280);
        const unsigned soff = (unsigned)((j0 * 1280 + lcol) * 2);
        const unsigned roff = (unsigned)((rj * NP) * 2);
#define P3_ISSUE(cc) do { const char* cbp = pbase + (size_t)(cc) * (128 * NP * 2); \
        if (ssd) { const char* xp = xbase + (size_t)(cc) * (128 * 1280 * 2) + soff; _Pragma("unroll") for (int i = 0; i < 8; ++i) raw[i] = *(const u32x4*)(xp + i * (1280 * 2)); } \
        else { const char* rp = cbp + roff; \
            raw[0] = *(const u32x4*)(rp + (C_Q + 64 * hd + 8 * ro4) * 2); raw[1] = *(const u32x4*)(rp + (C_Q + 64 * hd + 32 + 8 * ro4) * 2); \
            raw[2] = *(const u32x4*)(rp + (C_K + 64 * hd + 8 * ro4) * 2); raw[3] = *(const u32x4*)(rp + (C_K + 64 * hd + 32 + 8 * ro4) * 2); \
            raw[4] = *(const u32x4*)(rp + (C_V + 128 * hd + 64 * half + 16 * ro4) * 2); raw[5] = *(const u32x4*)(rp + (C_V + 128 * hd + 64 * half + 16 * ro4 + 8) * 2); } } while (0)
        float dq0 = 0.f, dq1 = 0.f;
#define P3_SCAN(cc) do { LAS float* ACSw = (LAS float*)(lds + L_ACS) + ((cc) & 1) * 128; LAS float* DTJw = (LAS float*)(lds + L_DTJ) + ((cc) & 1) * 128; LAS float* WJw = (LAS float*)(lds + L_WJ) + ((cc) & 1) * 128; \
        const float v0 = dq0 * Ah, v1 = dq1 * Ah, s_ = v0 + v1; float incl = s_; \
        _Pragma("unroll") for (int o = 1; o < 64; o <<= 1) { const float t = __shfl_up(incl, o); if (lane >= o) incl += t; } \
        const float c0 = (incl - s_) + v0, tot = __shfl(incl, 63), c1 = (lane == 63) ? tot : c0 + v1; \
        ACSw[2 * lane] = c0 * 1.4426950408889634f; ACSw[2 * lane + 1] = c1 * 1.4426950408889634f; \
        DTJw[2 * lane] = c0 * 1.4426950408889634f - __log2f(dq0); DTJw[2 * lane + 1] = c1 * 1.4426950408889634f - __log2f(dq1); \
        WJw[2 * lane] = dq0 * __expf(tot - c0); WJw[2 * lane + 1] = dq1 * __expf(tot - c1); } while (0)
#define P3_DTLOAD(cc) do { dq0 = DT[(mb + (size_t)(cc) * 128 + 2 * lane) * 16 + hd]; dq1 = DT[(mb + (size_t)(cc) * 128 + 2 * lane + 1) * 16 + hd]; } while (0)
        if (ssd && wave == 0) { P3_DTLOAD(0); P3_SCAN(0); P3_DTLOAD(1); }
        u32x2 zzn[4];
        { const bf16* orow0 = PROJ + (mb + 16 * wave + i16) * NP + (ssd ? (C_Z + 64 * hd) : (C_GR + 128 * hd + 64 * half));
#pragma unroll
          for (int g4 = 0; g4 < 4; ++g4) zzn[g4] = *(const u32x2*)(orow0 + 16 * g4 + 4 * (lane >> 4)); }
        P3_ISSUE(0);

        TB(1);
        for (int c = 0; c < 16; ++c) {
            const int par = c & 1;
            const size_t m0 = mb + (size_t)c * 128;
            LAS float* ACS = (LAS float*)(lds + L_ACS) + par * 128; LAS float* DTJ = (LAS float*)(lds + L_DTJ) + par * 128; LAS float* WJ = (LAS float*)(lds + L_WJ) + par * 128;
            TB(5);
            __syncthreads();
            TE(5); TB(2);
#ifndef P3_REPL
#define P3_REPL 1
#endif
            _Pragma("nounroll") for (int repl_ = 0; repl_ < P3_REPL; ++repl_) {
            if (repl_) __syncthreads();
            if (ssd) {
                {
                    LAS unsigned char* dst = lds + (ltile == 0 ? L_XV : (ltile == 1 ? L_BK : (ltile == 2 ? L_CQ : L_BKW)));
#pragma unroll
                    for (int jj = 0; jj < 8; ++jj) {
                        u32x4 v = raw[jj];
                        if (ltile == 3) { const float wj = WJ[j0 + jj];
                            v.x = pk2(bf_lo(v.x) * wj, bf_hi(v.x) * wj); v.y = pk2(bf_lo(v.y) * wj, bf_hi(v.y) * wj); v.z = pk2(bf_lo(v.z) * wj, bf_hi(v.z) * wj); v.w = pk2(bf_lo(v.w) * wj, bf_hi(v.w) * wj); }
                        *(LAS u32x4*)(dst + ((j0 + jj) * TP + 8 * loct) * 2) = v;
                    }
                }
            } else {
                const int j = rj, o4 = ro4;
                const u32x4 q1 = raw[0], q2 = raw[1], k1 = raw[2], k2 = raw[3];
                const float pos = (float)(c * 128 + j), wj = WJ[j];
                float ql[8], qh[8], kl[8], kh[8];
#pragma unroll
                for (int e = 0; e < 8; ++e) {
                    const float rev = pos * invf[e] * 0.15915494309189535f, fr = rev - floorf(rev);
                    const float cs = __builtin_amdgcn_cosf(fr), sn = __builtin_amdgcn_sinf(fr);
                    const unsigned wq1 = q1[e >> 1], wq2 = q2[e >> 1], wk1 = k1[e >> 1], wk2 = k2[e >> 1];
                    const float a1 = (e & 1) ? bf_hi(wq1) : bf_lo(wq1), a2 = (e & 1) ? bf_hi(wq2) : bf_lo(wq2);
                    const float b1 = ((e & 1) ? bf_hi(wk1) : bf_lo(wk1)) * 0.125f, b2 = ((e & 1) ? bf_hi(wk2) : bf_lo(wk2)) * 0.125f;
                    ql[e] = a1 * cs - a2 * sn; qh[e] = a1 * sn + a2 * cs;
                    kl[e] = b1 * cs - b2 * sn; kh[e] = b1 * sn + b2 * cs;
                }
                u32x4 t;
                t.x = pk2(ql[0], ql[1]); t.y = pk2(ql[2], ql[3]); t.z = pk2(ql[4], ql[5]); t.w = pk2(ql[6], ql[7]); *(LAS u32x4*)(lds + L_CQ + (j * TP + 8 * o4) * 2) = t;
                t.x = pk2(qh[0], qh[1]); t.y = pk2(qh[2], qh[3]); t.z = pk2(qh[4], qh[5]); t.w = pk2(qh[6], qh[7]); *(LAS u32x4*)(lds + L_CQ + (j * TP + 32 + 8 * o4) * 2) = t;
                t.x = pk2(kl[0], kl[1]); t.y = pk2(kl[2], kl[3]); t.z = pk2(kl[4], kl[5]); t.w = pk2(kl[6], kl[7]); *(LAS u32x4*)(lds + L_BK + (j * TP + 8 * o4) * 2) = t;
                t.x = pk2(kh[0], kh[1]); t.y = pk2(kh[2], kh[3]); t.z = pk2(kh[4], kh[5]); t.w = pk2(kh[6], kh[7]); *(LAS u32x4*)(lds + L_BK + (j * TP + 32 + 8 * o4) * 2) = t;
                t.x = pk2(kl[0] * wj, kl[1] * wj); t.y = pk2(kl[2] * wj, kl[3] * wj); t.z = pk2(kl[4] * wj, kl[5] * wj); t.w = pk2(kl[6] * wj, kl[7] * wj); *(LAS u32x4*)(lds + L_BKW + (j * TP + 8 * o4) * 2) = t;
                t.x = pk2(kh[0] * wj, kh[1] * wj); t.y = pk2(kh[2] * wj, kh[3] * wj); t.z = pk2(kh[4] * wj, kh[5] * wj); t.w = pk2(kh[6] * wj, kh[7] * wj); *(LAS u32x4*)(lds + L_BKW + (j * TP + 32 + 8 * o4) * 2) = t;
                *(LAS u32x4*)(lds + L_XV + (j * TP + 16 * o4) * 2) = raw[4]; *(LAS u32x4*)(lds + L_XV + (j * TP + 16 * o4 + 8) * 2) = raw[5];
            }
            }
            TE(2); TB(6);
            __syncthreads();
            TE(6); TB(3);
            const int q16 = lane >> 4, iTok = 16 * wave + i16;
            bf16* orow = PROJ + (m0 + iTok) * NP + (ssd ? (C_Z + 64 * hd) : (C_GR + 128 * hd + 64 * half));
            u32x2 zz[4];
#pragma unroll
            for (int g4 = 0; g4 < 4; ++g4) zz[g4] = zzn[g4];
            if (c + 1 < 16) {
#pragma unroll
                for (int g4 = 0; g4 < 4; ++g4) zzn[g4] = *(const u32x2*)(orow + 128 * NP + 16 * g4 + 4 * q16);
                P3_ISSUE(c + 1);
            }
            __builtin_amdgcn_sched_barrier(0);
            if (ssd && wave == 0 && c + 1 < 16) { P3_SCAN(c + 1); if (c + 2 < 16) P3_DTLOAD(c + 2); }
#ifndef P3_REPC
#define P3_REPC 1
#endif
            f32x16 acc;
            float acs_i = 0.f;
            LAS unsigned char* STw = lds + (par ? L_ST0 : L_ST1);
            _Pragma("nounroll") for (int repc_ = 0; repc_ < P3_REPC; ++repc_) {
            bf16x8 cqb[2];
#pragma unroll
            for (int s = 0; s < 2; ++s) cqb[s] = *(const LAS bf16x8*)(lds + L_CQ + (iTok * TP + 32 * s + 8 * q16) * 2);
            const LAS unsigned char* STr = lds + (par ? L_ST1 : L_ST0);
#pragma unroll
            for (int i = 0; i < 16; ++i) acc[i] = 0.f;
            f32x4 ya[4];
#pragma unroll
            for (int p4t = 0; p4t < 4; ++p4t) { ya[p4t] = (f32x4){0.f, 0.f, 0.f, 0.f};
#pragma unroll
                for (int s = 0; s < 2; ++s) { const bf16x8 sa = *(const LAS bf16x8*)(STr + ((16 * p4t + i16) * TP + 32 * s + 8 * q16) * 2); ya[p4t] = MFMA16(sa, cqb[s], ya[p4t]); } }
            acs_i = ACS[iTok];
            { const float ei = __builtin_amdgcn_exp2f(acs_i);
#pragma unroll
              for (int p4t = 0; p4t < 4; ++p4t) ya[p4t] = ya[p4t] * ei; }
            const int nblk = (wave >> 1) + 1;
            bf16x8 kq0[2], kq1[2];
#pragma unroll
            for (int s = 0; s < 2; ++s) { kq0[s] = *(const LAS bf16x8*)(lds + L_BK + (i16 * TP + 32 * s + 8 * q16) * 2); kq1[s] = *(const LAS bf16x8*)(lds + L_BK + ((16 + i16) * TP + 32 * s + 8 * q16) * 2); }
            for (int jb = 0; jb < nblk; ++jb) {
                const int j0 = 32 * jb;
                f32x4 t0 = (f32x4){0.f, 0.f, 0.f, 0.f}, t1 = t0;
#pragma unroll
                for (int s = 0; s < 2; ++s) { t0 = MFMA16(kq0[s], cqb[s], t0); t1 = MFMA16(kq1[s], cqb[s], t1); }
#pragma unroll
                for (int s = 0; s < 2; ++s) { kq0[s] = *(const LAS bf16x8*)(lds + L_BK + ((j0 + 32 + i16) * TP + 32 * s + 8 * q16) * 2); kq1[s] = *(const LAS bf16x8*)(lds + L_BK + ((j0 + 48 + i16) * TP + 32 * s + 8 * q16) * 2); }
                const f32x4 b0 = *(const LAS f32x4*)(DTJ + j0 + 4 * q16), b1 = *(const LAS f32x4*)(DTJ + j0 + 16 + 4 * q16);
                bf16x8 xa[4];
#pragma unroll
                for (int p4t = 0; p4t < 4; ++p4t) { const LAS unsigned char* xb = lds + L_XV + ((j0 + 4 * q16 + q4) * TP + 16 * p4t + 4 * p4) * 2; xa[p4t] = tr_pair(xb, xb + 16 * TP * 2); }
                __builtin_amdgcn_sched_barrier(0);
                const bool lastb = (jb == nblk - 1);
                float pv[8];
#pragma unroll
                for (int e = 0; e < 4; ++e) {
                    float v0 = t0[e] * __builtin_amdgcn_exp2f(acs_i - b0[e]), v1 = t1[e] * __builtin_amdgcn_exp2f(acs_i - b1[e]);
                    if (lastb && (j0 + 4 * q16 + e) > iTok) v0 = 0.f;
                    if (lastb && (j0 + 16 + 4 * q16 + e) > iTok) v1 = 0.f;
                    pv[e] = v0; pv[4 + e] = v1;
                }
                const bf16x8 pf = pack8(pv[0], pv[1], pv[2], pv[3], pv[4], pv[5], pv[6], pv[7]);
#pragma unroll
                for (int p4t = 0; p4t < 4; ++p4t) ya[p4t] = MFMA16(xa[p4t], pf, ya[p4t]);
            }
#pragma unroll
            for (int p4t = 0; p4t < 4; ++p4t)
#pragma unroll
                for (int e = 0; e < 4; ++e) acc[4 * p4t + e] = ya[p4t][e];
            }
            TE(3); TB(4);
            if (it < 2 && c < 15) {
                const int nt = it;
                const float dec = __builtin_amdgcn_exp2f(ACS[127]);
#pragma unroll
                for (int i = 0; i < 16; ++i) sacc[i] *= dec;
                f32x16 sacc2;
#pragma unroll
                for (int i = 0; i < 16; ++i) sacc2[i] = 0.f;
#pragma unroll
                for (int ks = 0; ks < 8; ++ks) {
                    const LAS unsigned char* xb = lds + L_XV + ((16 * ks + 8 * h + q4) * TP + 32 * pt + 16 * blk16 + 4 * p4) * 2;
                    const LAS unsigned char* kb = lds + L_BKW + ((16 * ks + 8 * h + q4) * TP + 32 * nt + 16 * blk16 + 4 * p4) * 2;
                    const bf16x8 xa = tr_pair(xb, xb + 4 * TP * 2), kbf = tr_pair(kb, kb + 4 * TP * 2);
                    if (ks & 1) sacc2 = MFMA32(xa, kbf, sacc2); else sacc = MFMA32(xa, kbf, sacc);
                }
#pragma unroll
                for (int i = 0; i < 16; ++i) sacc[i] += sacc2[i];
#pragma unroll
                for (int i = 0; i < 16; ++i) { const int p = 32 * pt + crow(i, h);
                    *(LAS unsigned short*)(STw + (p * TP + 32 * nt + r) * 2) = (unsigned short)(pk2(sacc[i], 0.f) & 0xffffu); }
            }
            {
                float ss = 0.f;
#pragma unroll
                for (int g4 = 0; g4 < 4; ++g4) {
                    const int p = 16 * g4 + 4 * q16;
                    const float z0 = bf_lo(zz[g4].x), z1 = bf_hi(zz[g4].x), z2 = bf_lo(zz[g4].y), z3 = bf_hi(zz[g4].y);
                    float y0 = acc[4 * g4], y1 = acc[4 * g4 + 1], y2 = acc[4 * g4 + 2], y3 = acc[4 * g4 + 3];
                    float o0, o1, o2, o3;
                    if (ssd) {
                        const u32x2 xv = *(const LAS u32x2*)(lds + L_XV + (iTok * TP + p) * 2);
                        y0 = (y0 + Dsk * bf_lo(xv.x)) * silu_f(z0); y1 = (y1 + Dsk * bf_hi(xv.x)) * silu_f(z1); y2 = (y2 + Dsk * bf_lo(xv.y)) * silu_f(z2); y3 = (y3 + Dsk * bf_hi(xv.y)) * silu_f(z3);
                        ss += (y0 * y0 + y1 * y1) + (y2 * y2 + y3 * y3);
                        o0 = y0; o1 = y1; o2 = y2; o3 = y3;
                    } else {
                        ss += (y0 * y0 + y1 * y1) + (y2 * y2 + y3 * y3);
                        o0 = y0 * silu_f(z0); o1 = y1 * silu_f(z1); o2 = y2 * silu_f(z2); o3 = y3 * silu_f(z3);
                    }
                    u32x2 ov; ov.x = pk2(o0, o1); ov.y = pk2(o2, o3);
                    if (dry) *(u32x2*)((bf16*)((unsigned char*)a.out + 40 * MiB) + (m0 + iTok) * 512 + ((64 * hd + 64 * half + p) & 511)) = ov; else *(u32x2*)(orow + p) = ov;
                }
                ss += __shfl_xor(ss, 16); ss += __shfl_xor(ss, 32);
                if (q16 < 2) { const float sv = (q16 == 0) ? ss : 0.f;
                    if (ssd) SSQM[(m0 + iTok) * 32 + hd * 2 + q16] = sv; else SSQR[(m0 + iTok) * 32 + hd * 4 + half * 2 + q16] = sv; }
            }
            TE(4);
        }
        TE(1);
#undef P3_ISSUE
#undef P3_SCAN
#undef P3_DTLOAD
    }
#ifdef PROBE_SEL
    if (probing && fresh_lane() == 0) ((unsigned*)(a.ws + WS_CTL))[4000] = tacc_;
#endif
#undef TB
#undef TE
}

constexpr int MP = 1032;
constexpr int L4_MERGED = 0, L4_ASTG = 132096, L4_RM = 150528, L4_RR = 151040, L4_RED = 153088, L4_RS = 155136;
static_assert(L4_RS + 256 <= LDS_BYTES, "P4 LDS map");

__device__ __forceinline__ void p4_panel_load(u32x4 (&ar)[16], const bf16* Abase, int tid) {
    const int srow = tid >> 3, soct = tid & 7; const int rot = ((int)blockIdx.x >> 3) & 15;
    const char* ab = (const char*)Abase; const unsigned aoff = (unsigned)((srow * NP + 8 * soct) * 2);
#pragma unroll
    for (int i = 0; i < 16; ++i) ar[i] = *(const u32x4*)(ab + ((rot + i) & 15) * 128 + aoff);
}
template <int SEGSHIFT>
__device__ __forceinline__ void p4_gemmT(f32x16 (&accT)[2][2], u32x4 (&ar)[16], const bf16* Anext  , const LAS float* rsc  , int nseg,
                                         const bf16* WF  , int nt0  , LAS unsigned char* lds, int tid, int lane) {
    const int srow = tid >> 3, soct = tid & 7, r = lane & 31, h = lane >> 5;
    const char* wb = (const char*)WF + (size_t)nt0 * 65536; const unsigned woff = (unsigned)(lane * 16);
    const int rot = ((int)blockIdx.x >> 3) & 15;
    bf16x8 wc[4][2];
    { const char* wk0 = wb + rot * 4096;
#pragma unroll
      for (int s = 0; s < 4; ++s) { wc[s][0] = *(const bf16x8*)(wk0 + s * 1024 + woff); wc[s][1] = *(const bf16x8*)(wk0 + 65536 + s * 1024 + woff); } }
#define P4_STAGE_WRITE(ki_) do { const int kc_ = ((ki_) + rot) & 15; const float sc = rsc[srow * nseg + ((kc_ * 64) >> SEGSHIFT)]; \
        u32x4 o; \
        o.x = pk2(bf_lo(ar[ki_].x) * sc, bf_hi(ar[ki_].x) * sc); o.y = pk2(bf_lo(ar[ki_].y) * sc, bf_hi(ar[ki_].y) * sc); \
        o.z = pk2(bf_lo(ar[ki_].z) * sc, bf_hi(ar[ki_].z) * sc); o.w = pk2(bf_lo(ar[ki_].w) * sc, bf_hi(ar[ki_].w) * sc); \
        *(LAS u32x4*)(lds + L4_ASTG + ((ki_) & 1) * 9216 + (srow * TP + 8 * soct) * 2) = o; } while (0)
    P4_STAGE_WRITE(0);
#pragma unroll
    for (int ki = 0; ki < 16; ++ki) {
        const int kc = (ki + rot) & 15;
        LAS unsigned char* stg = lds + L4_ASTG + (ki & 1) * 9216;
        __syncthreads();
        if (ki + 1 < 16) P4_STAGE_WRITE(ki + 1);
        const int kn = (kc + 1) & 15;
        const char* wk = wb + kn * 4096;
        bf16x8 a0 = *(const LAS bf16x8*)(stg + (r * TP + 8 * h) * 2), a1 = *(const LAS bf16x8*)(stg + ((32 + r) * TP + 8 * h) * 2);
#pragma unroll
        for (int s = 0; s < 4; ++s) {
            bf16x8 n0 = a0, n1 = a1;
            if (s < 3) { n0 = *(const LAS bf16x8*)(stg + (r * TP + 16 * (s + 1) + 8 * h) * 2); n1 = *(const LAS bf16x8*)(stg + ((32 + r) * TP + 16 * (s + 1) + 8 * h) * 2); }
            accT[0][0] = MFMA32(wc[s][0], a0, accT[0][0]); accT[0][1] = MFMA32(wc[s][1], a0, accT[0][1]);
            accT[1][0] = MFMA32(wc[s][0], a1, accT[1][0]); accT[1][1] = MFMA32(wc[s][1], a1, accT[1][1]);
            wc[s][0] = *(const bf16x8*)(wk + s * 1024 + woff); wc[s][1] = *(const bf16x8*)(wk + 65536 + s * 1024 + woff);
            __builtin_amdgcn_sched_barrier(0);
            a0 = n0; a1 = n1;
        }
    }
#undef P4_STAGE_WRITE
    p4_panel_load(ar, Anext, tid);
    __builtin_amdgcn_sched_barrier(0);
    __syncthreads();
}


__device__ __forceinline__ void tail_gemmT(f32x16 (&accT)[2], const bf16* Abase  , const bf16* WF  , int nt  , LAS unsigned char* lds, int tid, int lane) {
    const int srow = tid >> 3, soct = tid & 7, r = lane & 31, h = lane >> 5;
    const char* ab = (const char*)Abase; const unsigned aoff = (unsigned)((srow * 1024 + 8 * soct) * 2);
    const char* wb = (const char*)WF + (size_t)nt * 65536; const unsigned woff = (unsigned)(lane * 16);
    const int rot = ((int)blockIdx.x >> 3) & 15;
    u32x4 ar[16];
#pragma unroll
    for (int i = 0; i < 16; ++i) ar[i] = *(const u32x4*)(ab + ((rot + i) & 15) * 128 + aoff);
    bf16x8 wc[4];
    { const char* wk0 = wb + rot * 4096;
#pragma unroll
      for (int s = 0; s < 4; ++s) wc[s] = *(const bf16x8*)(wk0 + s * 1024 + woff); }
#pragma unroll
    for (int ki = 0; ki < 16; ++ki) {
        const int kc = (ki + rot) & 15;
        LAS unsigned char* stg = lds + L4_ASTG + (ki & 1) * 9216;
        *(LAS u32x4*)(stg + (srow * TP + 8 * soct) * 2) = ar[ki];
        __syncthreads();
        const char* wk = wb + ((kc + 1) & 15) * 4096;
#pragma unroll
        for (int s = 0; s < 4; ++s) {
            const bf16x8 a0 = *(const LAS bf16x8*)(stg + (r * TP + 16 * s + 8 * h) * 2), a1 = *(const LAS bf16x8*)(stg + ((32 + r) * TP + 16 * s + 8 * h) * 2);
            accT[0] = MFMA32(wc[s], a0, accT[0]); accT[1] = MFMA32(wc[s], a1, accT[1]);
            wc[s] = *(const bf16x8*)(wk + s * 1024 + woff);
            __builtin_amdgcn_sched_barrier(0);
        }
    }
    __syncthreads();
}

__device__ __forceinline__ void p4_phase(const Args& a, LAS unsigned char* lds, int tid_in, int lane_in, int wave, int G) {
    const bf16* PROJ = (const bf16*)(a.ws + WS_PROJ);
    const float* SSQM = (const float*)(a.ws + WS_SSQM); const float* SSQR = (const float*)(a.ws + WS_SSQR);
    const float* MOD = (const float*)(a.ws + WS_MOD);
    const bf16* WMF = (const bf16*)(a.ws + WS_WMF); const bf16* WRF = (const bf16*)(a.ws + WS_WRF); const bf16* WOF = (const bf16*)(a.ws + WS_WOF);
    const float* x = a.in[0]; const float* fw = a.in[15]; float* out = a.out;
    LAS float* RM = (LAS float*)(lds + L4_RM); LAS float* RR = (LAS float*)(lds + L4_RR); LAS float* RED = (LAS float*)(lds + L4_RED); LAS float* RS = (LAS float*)(lds + L4_RS);
    for (int blk = blockIdx.x; blk < 256; blk += G) {
        const size_t m0 = (size_t)blk * 64; const int b = blk >> 5;
        int lane = fresh_lane(), tid = wave * 64 + lane, r = lane & 31, h = lane >> 5;
        u32x4 ar[16];
        p4_panel_load(ar, PROJ + m0 * NP + C_Z, tid);
        __syncthreads();
        { const int row = tid >> 3, sub = tid & 7;
          const f32x4 qv = *(const f32x4*)(SSQR + (m0 + row) * 32 + 4 * sub);
          RR[row * 8 + sub] = 1.0f / sqrtf(((qv.x + qv.y) + (qv.z + qv.w)) * (1.f / 128.f) + EPS);
          if (sub < 2) { float s = 0.f;
#pragma unroll
              for (int i = 0; i < 4; ++i) { const f32x4 v = *(const f32x4*)(SSQM + (m0 + row) * 32 + 16 * sub + 4 * i); s += (v.x + v.y) + (v.z + v.w); }
              RM[row * 2 + sub] = 1.0f / sqrtf(s * (1.f / 512.f) + EPS); } }
        __syncthreads();
#ifndef P4_SKIP1
#ifndef P4_REP1
#define P4_REP1 1
#endif
        for (int nh_ = 0; nh_ < 2 * P4_REP1; ++nh_) {
            const int nh = nh_ & 1;
            lane = fresh_lane(); tid = wave * 64 + lane; r = lane & 31; h = lane >> 5;
            const int nt0 = 16 * nh + 2 * wave;
            const bf16* pblk = PROJ + m0 * NP;
            f32x16 accT[2][2];
#pragma unroll
            for (int i = 0; i < 2; ++i)
#pragma unroll
                for (int j = 0; j < 2; ++j)
#pragma unroll
                    for (int e = 0; e < 16; ++e) accT[i][j][e] = 0.f;
            u32x2 gpre[2][2][4];
            { const unsigned lo0 = (unsigned)((r * NP + 4 * h) * 2); const char* gb0 = (const char*)(pblk + C_GAM + 32 * nt0);
#pragma unroll
              for (int rt = 0; rt < 2; ++rt)
#pragma unroll
                  for (int ct = 0; ct < 2; ++ct)
#pragma unroll
                      for (int g4 = 0; g4 < 4; ++g4) gpre[rt][ct][g4] = *(const u32x2*)(gb0 + (lo0 + (unsigned)((32 * rt * NP + 32 * ct + 8 * g4) * 2)));
              __builtin_amdgcn_sched_barrier(0); }
            p4_gemmT<9>(accT, ar, pblk + C_GR, RM, 2, WMF, nt0, lds, tid, lane);
            {
                lane = fresh_lane(); r = lane & 31; h = lane >> 5;
                const unsigned lm = launder((unsigned)(L4_MERGED + (r * MP + 4 * h) * 2));
#pragma unroll
                for (int rt = 0; rt < 2; ++rt)
#pragma unroll
                    for (int ct = 0; ct < 2; ++ct)
#pragma unroll
                        for (int g4 = 0; g4 < 4; ++g4) {
                            const u32x2 gg = gpre[rt][ct][g4];
                            u32x2 ov; ov.x = pk2(accT[rt][ct][4 * g4] * sigm_f(bf_lo(gg.x)), accT[rt][ct][4 * g4 + 1] * sigm_f(bf_hi(gg.x)));
                            ov.y = pk2(accT[rt][ct][4 * g4 + 2] * sigm_f(bf_lo(gg.y)), accT[rt][ct][4 * g4 + 3] * sigm_f(bf_hi(gg.y)));
                            *(LAS u32x2*)(lds + lm + (unsigned)((32 * rt * MP + 32 * (nt0 + ct) + 8 * g4) * 2)) = ov; }
            }
#pragma unroll
            for (int i = 0; i < 2; ++i)
#pragma unroll
                for (int j = 0; j < 2; ++j)
#pragma unroll
                    for (int e = 0; e < 16; ++e) accT[i][j][e] = 0.f;
            lane = fresh_lane(); tid = wave * 64 + lane; r = lane & 31; h = lane >> 5;
            { const unsigned lo0 = (unsigned)((r * NP + 4 * h) * 2); const char* gb0 = (const char*)(pblk + C_GAR + 32 * nt0);
#pragma unroll
              for (int rt = 0; rt < 2; ++rt)
#pragma unroll
                  for (int ct = 0; ct < 2; ++ct)
#pragma unroll
                      for (int g4 = 0; g4 < 4; ++g4) gpre[rt][ct][g4] = *(const u32x2*)(gb0 + (lo0 + (unsigned)((32 * rt * NP + 32 * ct + 8 * g4) * 2)));
              __builtin_amdgcn_sched_barrier(0); }
            p4_gemmT<7>(accT, ar, pblk + C_Z, RR, 8, WRF, nt0, lds, tid, lane);
            {
                lane = fresh_lane(); r = lane & 31; h = lane >> 5;
                const unsigned lm = launder((unsigned)(L4_MERGED + (r * MP + 4 * h) * 2));
#pragma unroll
                for (int rt = 0; rt < 2; ++rt)
#pragma unroll
                    for (int ct = 0; ct < 2; ++ct)
#pragma unroll
                        for (int g4 = 0; g4 < 4; ++g4) {
                            const u32x2 gg = gpre[rt][ct][g4];
                            LAS u32x2* mp = (LAS u32x2*)(lds + lm + (unsigned)((32 * rt * MP + 32 * (nt0 + ct) + 8 * g4) * 2));
                            const u32x2 pm = *mp;
                            const float v0 = bf_lo(pm.x) + accT[rt][ct][4 * g4] * sigm_f(bf_lo(gg.x)), v1 = bf_hi(pm.x) + accT[rt][ct][4 * g4 + 1] * sigm_f(bf_hi(gg.x));
                            const float v2 = bf_lo(pm.y) + accT[rt][ct][4 * g4 + 2] * sigm_f(bf_lo(gg.y)), v3 = bf_hi(pm.y) + accT[rt][ct][4 * g4 + 3] * sigm_f(bf_hi(gg.y));
                            u32x2 ov; ov.x = pk2(v0, v1); ov.y = pk2(v2, v3);
                            *mp = ov; }
            }
        }
#endif
        __syncthreads();
        lane = fresh_lane(); tid = wave * 64 + lane; r = lane & 31; h = lane >> 5;
#ifndef P4_SKIP2
#ifndef P4_REP2
#define P4_REP2 1
#endif
        _Pragma("nounroll") for (int rep2_ = 0; rep2_ < P4_REP2; ++rep2_) {
            if (rep2_) { __syncthreads(); lane = fresh_lane(); tid = wave * 64 + lane; r = lane & 31; h = lane >> 5; }
            f32x16 acc[2][4];
#pragma unroll
            for (int i = 0; i < 2; ++i)
#pragma unroll
                for (int j = 0; j < 4; ++j)
#pragma unroll
                    for (int e = 0; e < 16; ++e) acc[i][j][e] = 0.f;
            const char* wb = (const char*)WOF + (size_t)(4 * wave) * 65536; const unsigned woff = (unsigned)(lane * 16);
            const int rot2 = ((int)blockIdx.x >> 3) & 31;
            bf16x8 wc[2][4];
#pragma unroll
            for (int s = 0; s < 2; ++s)
#pragma unroll
                for (int ct = 0; ct < 4; ++ct) wc[s][ct] = *(const bf16x8*)(wb + ct * 65536 + (2 * rot2 + s) * 1024 + woff);
            const LAS unsigned char* ma = lds + L4_MERGED + (r * MP + 8 * h) * 2;
            bf16x8 a0 = *(const LAS bf16x8*)(ma + (2 * rot2) * 32), a1 = *(const LAS bf16x8*)(ma + 32 * MP * 2 + (2 * rot2) * 32);
            for (int ki = 0; ki < 32; ++ki) {
                const int kp = (ki + rot2) & 31, kpn = (kp + 1) & 31;
#pragma unroll
                for (int s = 0; s < 2; ++s) {
                    const int ksn = (s == 0) ? 2 * kp + 1 : 2 * kpn;
                    const bf16x8 n0 = *(const LAS bf16x8*)(ma + ksn * 32), n1 = *(const LAS bf16x8*)(ma + 32 * MP * 2 + ksn * 32);
#pragma unroll
                    for (int ct = 0; ct < 4; ++ct) { acc[0][ct] = MFMA32(a0, wc[s][ct], acc[0][ct]); acc[1][ct] = MFMA32(a1, wc[s][ct], acc[1][ct]); }
#pragma unroll
                    for (int ct = 0; ct < 4; ++ct) wc[s][ct] = *(const bf16x8*)(wb + ct * 65536 + (2 * kpn + s) * 1024 + woff);
                    __builtin_amdgcn_sched_barrier(0);
                    a0 = n0; a1 = n1;
                }
            }
            lane = fresh_lane(); r = lane & 31; h = lane >> 5;
            const char* xblk = (const char*)(x + m0 * D); char* oblk = (char*)(out + m0 * D);
            const unsigned eo = launder((unsigned)(4 * (4 * h * D + 128 * wave + r)));
            const unsigned rb = launder((unsigned)(L4_RED + (4 * h * 8 + wave) * 4));
            float gate[4], fwv[4];
#pragma unroll
            for (int ct = 0; ct < 4; ++ct) { const int n = 32 * (4 * wave + ct) + r; gate[ct] = MOD[b * 3072 + 2048 + n]; fwv[ct] = fw[n]; }
            float xv[2][8][4];
#define P4_XLOAD(buf, bidx) do { _Pragma("unroll") for (int e = 0; e < 8; ++e) _Pragma("unroll") for (int ct = 0; ct < 4; ++ct) \
                xv[buf][e][ct] = __builtin_nontemporal_load((const float*)(xblk + (eo + (unsigned)(((32 * ((bidx) >> 1) + (e & 3) + 8 * (2 * ((bidx) & 1) + (e >> 2))) * D + 32 * ct) * 4)))); } while (0)
            P4_XLOAD(0, 0);
#pragma unroll
            for (int bi = 0; bi < 4; ++bi) {
                const int rt = bi >> 1, g8 = bi & 1;
                if (bi + 1 < 4) P4_XLOAD((bi + 1) & 1, bi + 1);
                __builtin_amdgcn_sched_barrier(0);
#pragma unroll
                for (int e = 0; e < 8; ++e) {
                    const int reg = 8 * g8 + e, rowc = 32 * rt + (reg & 3) + 8 * (reg >> 2);
                    float s = 0.f;
#pragma unroll
                    for (int ct = 0; ct < 4; ++ct) { const float v = xv[bi & 1][e][ct] + gate[ct] * acc[rt][ct][reg]; acc[rt][ct][reg] = v; s += v * v; }
                    s += __shfl_xor(s, 16); s += __shfl_xor(s, 8); s += __shfl_xor(s, 4); s += __shfl_xor(s, 2); s += __shfl_xor(s, 1);
                    *(LAS float*)(lds + rb + (unsigned)(rowc * 32)) = s;
                }
                asm volatile("" ::: "memory"); __builtin_amdgcn_sched_barrier(0);
            }
#undef P4_XLOAD
            __syncthreads();
            if (tid < 64) { float s = 0.f;
#pragma unroll
                for (int w = 0; w < 8; ++w) s += RED[tid * 8 + w];
                RS[tid] = 1.0f / sqrtf(s * (1.f / D) + EPS); }
            __syncthreads();
            const unsigned eo2 = launder(eo);
            const unsigned sb = launder((unsigned)(L4_RS + 4 * h * 4));
#pragma unroll
            for (int rt = 0; rt < 2; ++rt)
#pragma unroll
                for (int reg = 0; reg < 16; ++reg) {
                    const int rowc = 32 * rt + (reg & 3) + 8 * (reg >> 2); const float rs = *(const LAS float*)(lds + sb + (unsigned)(rowc * 4));
#pragma unroll
                    for (int ct = 0; ct < 4; ++ct) __builtin_nontemporal_store(acc[rt][ct][reg] * rs * fwv[ct], (float*)(oblk + (eo2 + (unsigned)((rowc * D + 32 * ct) * 4))));
                }
        }
#endif
    }
}

#define XB_TMO      128
#define XB_XCNT(j)  (256  + 64 * (j))
#define XB_XSUB(j)  (1280 + 64 * (j))
#define XB_XGEN(j)  (2304 + 64 * (j))
#define XB_TOP      3328
#define XB_TOPGEN   3392
#define XCD_BAR_WORDS 3456
#define XB_SPIN_CAP (1u << 18)

__device__ __forceinline__ unsigned xb_ld(unsigned* p)              { return __hip_atomic_load(p, __ATOMIC_RELAXED, __HIP_MEMORY_SCOPE_AGENT); }
__device__ __forceinline__ unsigned xb_add(unsigned* p, unsigned v) { return __hip_atomic_fetch_add(p, v, __ATOMIC_RELAXED, __HIP_MEMORY_SCOPE_AGENT); }
__device__ __forceinline__ unsigned xb_xcc_id() { return (unsigned)__builtin_amdgcn_s_getreg((3 << 11) | 20) & 0xFu; }
#define XB_SPIN(cond, bar) do { unsigned _sp = 0; while (cond) { __builtin_amdgcn_s_sleep(1); \
    if ((++_sp & 255u) == 0u) { if (xb_ld(&(bar)[XB_TMO])) break; if (_sp > XB_SPIN_CAP) { atomicAdd(&(bar)[XB_TMO], 1u); break; } } } } while (0)

struct XcdBarrier {
    unsigned* bar; unsigned x;
    volatile LAS unsigned* st;
};

__device__ __forceinline__ XcdBarrier xcd_barrier_post(unsigned* bar, volatile LAS unsigned* st, const int wave_) {
    XcdBarrier b; b.bar = bar; b.x = xb_xcc_id(); b.st = st;
    if (wave_ == 0 && fresh_lane() == 0) (void)xb_add(&bar[XB_XCNT(b.x)], 1u);
    return b;
}
__device__ __forceinline__ void xcd_barrier_complete(unsigned* bar, unsigned x, unsigned& nloc, unsigned& nx) {
    const unsigned G = gridDim.x * gridDim.y * gridDim.z;
    unsigned sum, cnt, mine, sp = 0u;
    for (;;) {
        sum = 0u; cnt = 0u; mine = 0u;
#pragma unroll
        for (unsigned j = 0; j < 16; ++j) { const unsigned c = xb_ld(&bar[XB_XCNT(j)]); sum += c; cnt += (c > 0u) ? 1u : 0u; mine = (j == x) ? c : mine; }
        if (sum == G) break;
        __builtin_amdgcn_s_sleep(1);
        if ((++sp & 255u) == 0u) { if (xb_ld(&bar[XB_TMO])) break; if (sp > XB_SPIN_CAP) { atomicAdd(&bar[XB_TMO], 1u); break; } }
    }
    nloc = mine > 0u ? mine : 1u; nx = cnt > 0u ? cnt : 1u;
}

__device__ __forceinline__ void xcd_barrier(const XcdBarrier& b, const int wave_) {
    asm volatile("s_waitcnt vmcnt(0)" ::: "memory");
    __syncthreads();
    if (wave_ == 0 && fresh_lane() == 0) {
        unsigned* bar = b.bar;
        __builtin_amdgcn_s_waitcnt(0);
        unsigned nloc = b.st[0], nx = b.st[1];
        if (nloc == 0u) { xcd_barrier_complete(bar, b.x, nloc, nx); b.st[0] = nloc; b.st[1] = nx; }
        const unsigned old = xb_add(&bar[XB_XSUB(b.x)], 1u);
        const unsigned gen = old / nloc;
        if (old + 1u == (gen + 1u) * nloc) {
            __builtin_amdgcn_fence(__ATOMIC_RELEASE, "agent");
            asm volatile("s_waitcnt vmcnt(0)" ::: "memory");
            const unsigned og = xb_add(&bar[XB_TOP], 1u);
            const unsigned tg = og / nx;
            if (og + 1u == (tg + 1u) * nx) xb_add(&bar[XB_TOPGEN], 1u);
            else XB_SPIN(xb_ld(&bar[XB_TOPGEN]) == tg, bar);
            __builtin_amdgcn_fence(__ATOMIC_ACQUIRE, "agent");
            xb_add(&bar[XB_XGEN(b.x)], 1u);
            asm volatile("s_waitcnt vmcnt(0)" ::: "memory");
        } else {
            XB_SPIN(xb_ld(&bar[XB_XGEN(b.x)]) == gen, bar);
            __builtin_amdgcn_fence(__ATOMIC_ACQUIRE, "agent");
            asm volatile("s_waitcnt vmcnt(0)" ::: "memory");
        }
    }
    __syncthreads();
}

#ifdef SELF_CLEAN_BARRIER
__device__ unsigned g_bar[4096];
#endif
__global__ void __launch_bounds__(NTHR, 2) hybrid_fwd(Args args) {
    extern __shared__ __attribute__((aligned(16))) unsigned char lds_raw[];
    LAS unsigned char* lds = (LAS unsigned char*)lds_raw;
    const int wave = __builtin_amdgcn_readfirstlane((int)threadIdx.x >> 6), G = gridDim.x; const int tid = 0, lane = 0;
    cg::grid_group grid = cg::this_grid();
    volatile LAS unsigned* misc = (volatile LAS unsigned*)(lds + LDS_MISC);
    if (threadIdx.x < 2) misc[threadIdx.x] = 0u;
    __syncthreads();
    if (args.ph_lo < 0) grid.sync();
    #ifdef SELF_CLEAN_BARRIER
    XcdBarrier xbar = xcd_barrier_post(g_bar, misc, wave);
#else
    XcdBarrier xbar = xcd_barrier_post((unsigned*)(args.ws + WS_CTL), misc, wave);
#endif
    const int lo = args.ph_lo, hi = args.ph_hi;
#ifndef PHMASK
#define PHMASK 31
#endif
#define IN(k) (((PHMASK >> (k)) & 1) && lo <= (k) && (k) < hi)
#define SEAM(k) do { if (IN(k) && IN((k) + 1)) xcd_barrier(xbar, wave); } while (0)
#ifndef REPEAT_MASK
#define REPEAT_MASK 0
#endif
#ifdef PROBE_PH
    unsigned long long pt0_ = 0ull; unsigned pacc_ = 0u;
#define PB(k) do { if (PROBE_PH == (k)) pt0_ = __builtin_amdgcn_s_memrealtime(); } while (0)
#define PE(k) do { if (PROBE_PH == (k)) pacc_ += (unsigned)(__builtin_amdgcn_s_memrealtime() - pt0_); } while (0)
#else
#define PB(k) do {} while (0)
#define PE(k) do {} while (0)
#endif
    PB(20);
#define REP(k) _Pragma("nounroll") for (int rep_ = 0; rep_ < 1 + ((REPEAT_MASK >> (k)) & 1); ++rep_)
#ifdef EXTRA_SYNCS
    for (int es_ = 0; es_ < EXTRA_SYNCS; ++es_) xcd_barrier(xbar, wave);
#endif
    PB(0);
    if (IN(0)) REP(0) { if (rep_) xcd_barrier(xbar, wave); p0_phase(args, lds, tid, lane, wave, G); }
    PE(0); PB(10); __syncthreads();   PE(10); PB(1);
    if (IN(1)) REP(1) { if (rep_) xcd_barrier(xbar, wave); p1_phase(args, lds, tid, lane, wave, G); }
    PE(1); PB(11); SEAM(1); PE(11); PB(2);
    if (IN(2)) REP(2) {
        if (rep_) xcd_barrier(xbar, wave);
        __syncthreads();
        pg8::Gemm g{(const pg8::bf16_t*)((const unsigned char*)args.out + OUT_H), (const pg8::bf16_t*)((const unsigned char*)args.out + OUT_WINT), MTOK, NP_MAIN, D};
        pg8::StaticOrder S; S.init(MTOK, NP_MAIN, G, (int)blockIdx.x);
        pg8::EpiProj E{(pg8::bf16_t*)(args.ws + WS_PROJ), NP};
        pg8::gemm_phase<pg8::EpiProj, pg8::StaticOrder, true, true>(lds, g, S, E, wave);
        for (int blk = blockIdx.x; blk < 256; blk += G) {
            const int lane_ = fresh_lane(), tid_ = wave * 64 + lane_;
            f32x16 accT[2];
#pragma unroll
            for (int i = 0; i < 2; ++i)
#pragma unroll
                for (int e = 0; e < 16; ++e) accT[i][e] = 0.f;
            tail_gemmT(accT, (const bf16*)((const unsigned char*)args.out + OUT_H) + (size_t)blk * 64 * 1024, (const bf16*)(args.ws + WS_WTF), wave, lds, tid_, lane_);
            const int l2 = fresh_lane(), r2 = l2 & 31, h2 = l2 >> 5;
            bf16* prow = (bf16*)(args.ws + WS_PROJ) + ((size_t)blk * 64 + r2) * NP + NP_MAIN + 32 * wave + 4 * h2;
#pragma unroll
            for (int rt = 0; rt < 2; ++rt)
#pragma unroll
                for (int g4 = 0; g4 < 4; ++g4) { u32x2 ov; ov.x = pk2(accT[rt][4 * g4], accT[rt][4 * g4 + 1]); ov.y = pk2(accT[rt][4 * g4 + 2], accT[rt][4 * g4 + 3]);
                    *(u32x2*)(prow + (size_t)rt * 32 * NP + 8 * g4) = ov; }
        }
    }
    PE(2); PB(12); SEAM(2); PE(12); PB(3);
    if (IN(3)) { p3a_phase(args, wave, G); PE(3); PB(13); xcd_barrier(xbar, wave); PE(13); PB(4); if ((REPEAT_MASK >> 3) & 1) { p3_phase(args, lds, tid, lane, wave, G, true); xcd_barrier(xbar, wave); } p3_phase(args, lds, tid, lane, wave, G); }
    PE(4); PB(14); SEAM(3); PE(14); PB(5);
    if (IN(4)) REP(4) { if (rep_) xcd_barrier(xbar, wave); p4_phase(args, lds, tid, lane, wave, G); }
#undef REP
    PE(5); PE(20);
#if defined(SELF_CLEAN_BARRIER) && !defined(PROBE_PH)
    {
        __syncthreads();
        if (wave == 0) {
            const int l_ = fresh_lane();
            unsigned last_ = 0u;
            if (l_ == 0) last_ = (__hip_atomic_fetch_add(&g_bar[4032], 1u, __ATOMIC_RELAXED, __HIP_MEMORY_SCOPE_AGENT) == (unsigned)G - 1u) ? 1u : 0u;
            last_ = (unsigned)__builtin_amdgcn_readfirstlane((int)last_);
            if (last_) {
                if (l_ < 16) { __hip_atomic_store(&g_bar[XB_XCNT(l_)], 0u, __ATOMIC_RELAXED, __HIP_MEMORY_SCOPE_AGENT); __hip_atomic_store(&g_bar[XB_XSUB(l_)], 0u, __ATOMIC_RELAXED, __HIP_MEMORY_SCOPE_AGENT); __hip_atomic_store(&g_bar[XB_XGEN(l_)], 0u, __ATOMIC_RELAXED, __HIP_MEMORY_SCOPE_AGENT); }
                if (l_ == 16) { __hip_atomic_store(&g_bar[XB_TOP], 0u, __ATOMIC_RELAXED, __HIP_MEMORY_SCOPE_AGENT); __hip_atomic_store(&g_bar[XB_TOPGEN], 0u, __ATOMIC_RELAXED, __HIP_MEMORY_SCOPE_AGENT);
                                __hip_atomic_store(&g_bar[XB_TMO], 0u, __ATOMIC_RELAXED, __HIP_MEMORY_SCOPE_AGENT); __hip_atomic_store(&g_bar[4032], 0u, __ATOMIC_RELAXED, __HIP_MEMORY_SCOPE_AGENT); }
            }
        }
    }
#endif
#ifdef PROBE_PH
    if (blockIdx.x == PROBE_PBLK && wave == 0 && fresh_lane() == 0) ((unsigned*)(args.ws + WS_CTL))[4001] = pacc_;
    if (blockIdx.x == 0) { xcd_barrier(xbar, wave); } else { xcd_barrier(xbar, wave); }
    if (blockIdx.x == 0 && wave == 0 && fresh_lane() == 0) { asm volatile("s_waitcnt vmcnt(0)" ::: "memory"); args.out[0] = 50.0f * floorf(0.01f * (float)__hip_atomic_load((unsigned*)(args.ws + WS_CTL) + 4001, __ATOMIC_RELAXED, __HIP_MEMORY_SCOPE_AGENT) / 50.0f + 0.5f); }
#endif
#ifdef PROBE_SEL
    if (blockIdx.x == 0 && wave == 0 && fresh_lane() == 0) { asm volatile("s_waitcnt vmcnt(0)" ::: "memory"); args.out[0] = 0.01f * (float)((volatile unsigned*)(args.ws + WS_CTL))[4000]; }
#endif
#undef IN
#undef SEAM
}

extern "C" void kernel_launch(void* const* d_in, const int* in_sizes, int n_in, void* d_out, int out_size, void* d_ws, size_t ws_size, hipStream_t stream) {
    static int grid = 0;
    if (grid == 0) {
        if (n_in != 16 || out_size != MTOK * D || ws_size < WS_END) { fprintf(stderr, "kernel_launch: unexpected shapes (n_in %d out %d ws %zu)\n", n_in, out_size, ws_size); grid = -1; return; }
        int dev = 0, cus = 0, per_cu = 0;
        (void)hipGetDevice(&dev);
        (void)hipDeviceGetAttribute(&cus, hipDeviceAttributeMultiprocessorCount, dev);
        if (hipFuncSetAttribute((const void*)hybrid_fwd, hipFuncAttributeMaxDynamicSharedMemorySize, LDS_BYTES) != hipSuccess) { fprintf(stderr, "kernel_launch: hipFuncSetAttribute failed\n"); grid = -1; return; }
        if (hipOccupancyMaxActiveBlocksPerMultiprocessor(&per_cu, (const void*)hybrid_fwd, NTHR, LDS_BYTES) != hipSuccess || per_cu < 1) { fprintf(stderr, "kernel_launch: occupancy query says %d\n", per_cu); per_cu = 1; }
        (void)hipGetLastError();
        grid = cus * per_cu;
        if (grid > 256) grid = 256;
        if (grid < 1) grid = 1;
    }
    if (grid < 0) return;
#ifndef SELF_CLEAN_BARRIER
    if (hipMemsetAsync((char*)d_ws + WS_CTL, 0, CTL_BYTES, stream) != hipSuccess) { fprintf(stderr, "kernel_launch: memset of the barrier words failed\n"); return; }
#endif
    Args a{};
    for (int i = 0; i < 16; ++i) a.in[i] = (const float*)d_in[i];
    a.out = (float*)d_out; a.ws = (unsigned char*)d_ws;
#if N_LAUNCHES == 1
    a.ph_lo = 0; a.ph_hi = NPH;
    void* kargs[] = {&a};
    hipError_t e = hipLaunchCooperativeKernel((const void*)hybrid_fwd, dim3(grid), dim3(NTHR), kargs, LDS_BYTES, stream);
    if (e != hipSuccess) fprintf(stderr, "kernel_launch: cooperative launch failed: %s (grid %d)\n", hipGetErrorString(e), grid);
#else
    for (int p = 0; p < NPH; ++p) {
        a.ph_lo = p; a.ph_hi = p + 1;
        hipLaunchKernelGGL(hybrid_fwd, dim3(grid), dim3(NTHR), LDS_BYTES, stream, a);
    }
#endif
}
```

```cpp
#include <hip/hip_runtime.h>
#include <hip/hip_cooperative_groups.h>
#include <cstdio>
#include <cstdint>
namespace cg = cooperative_groups;
#define N_LAUNCHES 1
#define REPEAT_MASK 0
#define P4_REP2 1
__device__ __forceinline__ unsigned launder(unsigned v) { asm volatile("" : "+v"(v)); return v; }
__device__ __forceinline__ int fresh_lane() { unsigned z; asm volatile("v_mov_b32 %0, 0" : "=v"(z)); return (int)__builtin_amdgcn_mbcnt_hi(~0u, __builtin_amdgcn_mbcnt_lo(~0u, z)); }
namespace pg8 {
#define PG8_LAS __attribute__((address_space(3)))
typedef unsigned short bf16_t;
typedef short bf16x8 __attribute__((ext_vector_type(8)));
typedef float f32x4 __attribute__((ext_vector_type(4)));
typedef unsigned u32x4 __attribute__((ext_vector_type(4)));
constexpr int BM = 256, BK = 64, HALF = 128, HTB = HALF * BK * 2  , STAGE_BYTES = 8 * HTB, NXCD = 8, WGM = 8;

__host__ __device__ __forceinline__ int lds_byte(int r, int c) { const int st = (r >> 4) * 2 + (c >> 5), rr = r & 15, cc = c & 31, ob = rr * 64 + cc * 2; return st * 1024 + (ob ^ (((ob >> 9) & 1) << 5)); }
__host__ __device__ __forceinline__ void stage_rc(int b, int& R, int& C) { const int st = b / 1024, sb = b % 1024, swz = sb ^ (((sb >> 9) & 1) << 5); R = (st >> 1) * 16 + swz / 64; C = (st & 1) * 32 + (swz % 64) / 2; }
__host__ __device__ __forceinline__ int perm32(int rho) { const int n = rho >> 4, i = rho & 15; return 8 * (i >> 2) + 4 * n + (i & 3); }

struct Unit { int pm, pn; };
struct Gemm { const bf16_t* A; const bf16_t* Bt; int M, N, K; };

struct StaticOrder {
    int nM, nN, nwg, G, c;
    __host__ __device__ void init(int M, int N, int G_, int c_) { nM = M / BM; nN = N / BM; nwg = nM * nN; G = G_; c = c_; }
    __host__ __device__ bool next(int i, Unit& u) const {
        const long L = (long)i * G + c; if (L >= nwg) return false;
        int wgid = (int)L; { const int q = nwg / NXCD, r = nwg % NXCD, xcd = wgid % NXCD, off = wgid / NXCD; wgid = (xcd < r ? xcd * (q + 1) : r * (q + 1) + (xcd - r) * q) + off; }
        const int nig = WGM * nN, gid = wgid / nig, fm = gid * WGM, gsz = (nM - fm) < WGM ? (nM - fm) : WGM;
        u.pm = fm + ((wgid % nig) % gsz); u.pn = (wgid % nig) / gsz; return true;
    }
    __device__ __forceinline__ void a_ready(const Unit&) const {}
    __device__ __forceinline__ void done(const Unit&) const {}
};
__device__ __forceinline__ unsigned cvt_pk_bf16(float lo, float hi) { unsigned r; asm volatile("v_cvt_pk_bf16_f32 %0, %1, %2" : "=v"(r) : "v"(lo), "v"(hi)); return r; }
struct EpiProj {
    static constexpr bool PERM = true, AFTER_DRAIN = false;
    bf16_t* O; int ldc;
    __device__ __forceinline__ void operator()(const f32x4 (&acc)[2][2][4][2], const Unit& u, int wr, int wc, int fr, int fq) const {
        const int row0 = u.pm * BM + wr * 64 + fr; const int col0 = u.pn * BM + wc * 32 + 8 * fq;
#pragma unroll
        for (int ai = 0; ai < 2; ++ai)
#pragma unroll
            for (int m = 0; m < 4; ++m) { bf16_t* rowp = O + (size_t)(row0 + ai * HALF + m * 16) * ldc + col0;
#pragma unroll
                for (int bj = 0; bj < 2; ++bj) { const f32x4 v0 = acc[ai][bj][m][0], v1 = acc[ai][bj][m][1];
                    u32x4 w; w.x = cvt_pk_bf16(v0[0], v0[1]); w.y = cvt_pk_bf16(v0[2], v0[3]); w.z = cvt_pk_bf16(v1[0], v1[1]); w.w = cvt_pk_bf16(v1[2], v1[3]);
                    __builtin_nontemporal_store(w, (u32x4*)(rowp + bj * HALF)); } }
    }
    __device__ __forceinline__ void fused(f32x4 (&)[2][2][4][2], const Unit&, int, int, int, int, PG8_LAS unsigned char*, int, int) const {}
};
template <class Epi, class Sched, bool ALIGN_EPI = false, bool SP2 = false>
__device__ __forceinline__ void gemm_phase(PG8_LAS unsigned char* lds, const Gemm g, const Sched& S, const Epi& E, const int wid) {
    const int lane = ::fresh_lane(), tid = wid * 64 + lane, wr = wid >> 2, wc = wid & 3, fr = lane & 15, fq = lane >> 4;
    const int K = g.K, nt = K / BK;
    unsigned voffA[2], voffB[2];
#pragma unroll
    for (int i = 0; i < 2; ++i) { int R, C; stage_rc(tid * 16 + i * 8192, R, C); const int Rb = Epi::PERM ? ((R & ~31) + perm32(R & 31)) : R;
        voffA[i] = (unsigned)(R * K + C) * 2u; voffB[i] = (unsigned)(Rb * K + C) * 2u; }
    const size_t kstep = (size_t)(BK * 2);
    const size_t hstep = (size_t)HALF * K * 2;
    const size_t tstep = 2 * hstep;
    const unsigned ldsw = (unsigned)wid * 1024u;
    const int aoff = lds_byte(wr * 64 + fr, fq * 8), boff = lds_byte(wc * 32 + fr, fq * 8);
#define PG8_SA(b, h) (((b) * 2 + (h)) * HTB)
#define PG8_SB(b, h) ((4 + (b) * 2 + (h)) * HTB)
#define PG8_STAGE(bufoff, gbase, voff) do { _Pragma("unroll") for (int _i = 0; _i < 2; ++_i) \
        __builtin_amdgcn_global_load_lds((const unsigned*)((const char*)(gbase) + (voff)[_i]), (PG8_LAS unsigned*)(lds + (bufoff) + ldsw + _i * 8192), 16, 0, 0); } while (0)
#define PG8_LDA(dst, b, h) do { _Pragma("unroll") for (int m = 0; m < 4; ++m) _Pragma("unroll") for (int k = 0; k < 2; ++k) dst[m][k] = *(const PG8_LAS bf16x8*)(lds + PG8_SA(b, h) + aoff + m * 2048 + k * 1024); } while (0)
#define PG8_LDB(dst, b, h) do { _Pragma("unroll") for (int n = 0; n < 2; ++n) _Pragma("unroll") for (int k = 0; k < 2; ++k) dst[n][k] = *(const PG8_LAS bf16x8*)(lds + PG8_SB(b, h) + boff + n * 2048 + k * 1024); } while (0)
#define PG8_MMA(ai, bj, At, Bt) do { __builtin_amdgcn_s_setprio(1); _Pragma("unroll") for (int m = 0; m < 4; ++m) _Pragma("unroll") for (int n = 0; n < 2; ++n) _Pragma("unroll") for (int k = 0; k < 2; ++k) \
        acc[ai][bj][m][n] = __builtin_amdgcn_mfma_f32_16x16x32_bf16(Bt[n][k], At[m][k], acc[ai][bj][m][n], 0, 0, 0); __builtin_amdgcn_s_setprio(0); } while (0)
#define PG8_WAIT_V(n) asm volatile("s_waitcnt vmcnt(" #n ")" ::: "memory")
#define PG8_WAIT_L(n) asm volatile("s_waitcnt lgkmcnt(" #n ")" ::: "memory")
#define PG8_BAR __builtin_amdgcn_s_barrier()
#define PG8_SCHED __builtin_amdgcn_sched_barrier(0)
    Unit cur, nxt; int ui = 0;
    if (!S.next(0, cur)) return;
    f32x4 acc[2][2][4][2];
#pragma unroll
    for (int a = 0; a < 2; ++a)
#pragma unroll
        for (int b = 0; b < 2; ++b)
#pragma unroll
            for (int m = 0; m < 4; ++m)
#pragma unroll
                for (int n = 0; n < 2; ++n) acc[a][b][m][n] = (f32x4){0.f, 0.f, 0.f, 0.f};
    bf16x8 At[4][2], B0[2][2], B1[2][2];
    const char* cA = (const char*)g.A + (size_t)cur.pm * tstep; const char* cB = (const char*)g.Bt + (size_t)cur.pn * tstep;
    S.a_ready(cur);
    if constexpr (SP2) {
        PG8_STAGE(PG8_SB(0, 0), cB, voffB); PG8_STAGE(PG8_SB(0, 1), cB + hstep, voffB); PG8_STAGE(PG8_SA(0, 0), cA, voffA); PG8_STAGE(PG8_SA(0, 1), cA + hstep, voffA);
        if (wr == 1) PG8_BAR;
        PG8_WAIT_V(2); PG8_BAR;
        PG8_STAGE(PG8_SB(1, 0), cB + kstep, voffB); PG8_STAGE(PG8_SA(1, 0), cA + kstep, voffA); PG8_STAGE(PG8_SB(1, 1), cB + hstep + kstep, voffB);
        PG8_WAIT_V(6); PG8_BAR;
    } else {
        PG8_STAGE(PG8_SB(0, 0), cB, voffB); PG8_STAGE(PG8_SA(0, 0), cA, voffA); PG8_STAGE(PG8_SB(0, 1), cB + hstep, voffB); PG8_STAGE(PG8_SA(0, 1), cA + hstep, voffA);
        if (wr == 1) PG8_BAR;
        PG8_WAIT_V(4); PG8_BAR;
        PG8_STAGE(PG8_SB(1, 0), cB + kstep, voffB); PG8_STAGE(PG8_SA(1, 0), cA + kstep, voffA); PG8_STAGE(PG8_SB(1, 1), cB + hstep + kstep, voffB);
        PG8_WAIT_V(6); PG8_BAR;
    }
    for (;;) {
        const bool has_next = S.next(ui + 1, nxt);
        const char* nA = has_next ? (const char*)g.A + (size_t)nxt.pm * tstep : cA; const char* nB = has_next ? (const char*)g.Bt + (size_t)nxt.pn * tstep : cB;
        for (int t = 0; t < nt; t += 2) {
            const bool last = (t == nt - 2);
            const char* a1 = cA + (size_t)(t + 1) * kstep;
            const char* a2 = last ? nA : cA + (size_t)(t + 2) * kstep; const char* b2 = last ? nB : cB + (size_t)(t + 2) * kstep;
            const char* a3 = a2 + kstep; const char* b3 = b2 + kstep;
            if (last && has_next) S.a_ready(nxt);
            if constexpr (SP2) {
            PG8_LDB(B0, 0, 0); PG8_LDB(B1, 0, 1); PG8_SCHED; PG8_LDA(At, 0, 0); PG8_STAGE(PG8_SA(1, 1), a1 + hstep, voffA);
            PG8_WAIT_V(8); PG8_WAIT_L(0); PG8_BAR; PG8_MMA(0, 0, At, B0); PG8_MMA(0, 1, At, B1); PG8_BAR; PG8_SCHED;
            PG8_LDA(At, 0, 1); PG8_STAGE(PG8_SB(0, 0), b2, voffB); PG8_STAGE(PG8_SB(0, 1), b2 + hstep, voffB); PG8_STAGE(PG8_SA(0, 0), a2, voffA);
            PG8_WAIT_V(8); PG8_WAIT_L(0); PG8_BAR; PG8_MMA(1, 0, At, B0); PG8_MMA(1, 1, At, B1); PG8_BAR; PG8_SCHED;
            PG8_LDB(B0, 1, 0); PG8_LDB(B1, 1, 1); PG8_SCHED; PG8_LDA(At, 1, 0); PG8_STAGE(PG8_SA(0, 1), a2 + hstep, voffA);
            PG8_WAIT_V(8); PG8_WAIT_L(0); PG8_BAR; PG8_MMA(0, 0, At, B0); PG8_MMA(0, 1, At, B1); PG8_BAR; PG8_SCHED;
            PG8_LDA(At, 1, 1); PG8_STAGE(PG8_SB(1, 0), b3, voffB); PG8_STAGE(PG8_SB(1, 1), b3 + hstep, voffB); PG8_STAGE(PG8_SA(1, 0), a3, voffA);
            PG8_WAIT_V(8); PG8_WAIT_L(0); PG8_BAR; PG8_MMA(1, 0, At, B0); PG8_MMA(1, 1, At, B1); PG8_BAR; PG8_SCHED;
            } else {
            PG8_LDB(B0, 0, 0); PG8_SCHED; PG8_LDA(At, 0, 0); PG8_STAGE(PG8_SA(1, 1), a1 + hstep, voffA);
            PG8_WAIT_L(8); PG8_BAR; PG8_WAIT_L(0); PG8_MMA(0, 0, At, B0); PG8_BAR; PG8_SCHED;
            PG8_LDB(B1, 0, 1); PG8_STAGE(PG8_SB(0, 0), b2, voffB);
            PG8_BAR; PG8_WAIT_L(0); PG8_MMA(0, 1, At, B1); PG8_BAR;
            PG8_LDA(At, 0, 1); PG8_STAGE(PG8_SA(0, 0), a2, voffA);
            PG8_BAR; PG8_WAIT_L(0); PG8_MMA(1, 0, At, B0); PG8_BAR; PG8_SCHED;
            PG8_STAGE(PG8_SB(0, 1), b2 + hstep, voffB);
            PG8_WAIT_V(6); PG8_BAR; PG8_MMA(1, 1, At, B1); PG8_BAR;
            PG8_LDB(B0, 1, 0); PG8_SCHED; PG8_LDA(At, 1, 0); PG8_STAGE(PG8_SA(0, 1), a2 + hstep, voffA);
            PG8_WAIT_L(8); PG8_BAR; PG8_WAIT_L(0); PG8_MMA(0, 0, At, B0); PG8_BAR; PG8_SCHED;
            PG8_LDB(B1, 1, 1); PG8_STAGE(PG8_SB(1, 0), b3, voffB);
            PG8_BAR; PG8_WAIT_L(0); PG8_MMA(0, 1, At, B1); PG8_BAR;
            PG8_LDA(At, 1, 1); PG8_STAGE(PG8_SA(1, 0), a3, voffA);
            PG8_BAR; PG8_WAIT_L(0); PG8_MMA(1, 0, At, B0); PG8_BAR; PG8_SCHED;
            PG8_STAGE(PG8_SB(1, 1), b3 + hstep, voffB);
            PG8_WAIT_V(6); PG8_BAR; PG8_MMA(1, 1, At, B1); PG8_BAR;
            }
        }
        if constexpr (ALIGN_EPI) { if (wr == 0) PG8_BAR; }
        if constexpr (!Epi::AFTER_DRAIN) { E(acc, cur, wr, wc, fr, fq); S.done(cur); }
        if (!has_next) break;
#pragma unroll
        for (int a = 0; a < 2; ++a)
#pragma unroll
            for (int b = 0; b < 2; ++b)
#pragma unroll
                for (int m = 0; m < 4; ++m)
#pragma unroll
                    for (int n = 0; n < 2; ++n) acc[a][b][m][n] = (f32x4){0.f, 0.f, 0.f, 0.f};
        cur = nxt; cA = nA; cB = nB; ++ui;
        if constexpr (ALIGN_EPI) { if (wr == 1) PG8_BAR; }
    }
    PG8_WAIT_V(0);
    if constexpr (!ALIGN_EPI) { if (wr == 0) PG8_BAR; }
    PG8_BAR;
    if constexpr (Epi::AFTER_DRAIN) { E.fused(acc, cur, wr, wc, fr, fq, lds, wid, lane); S.done(cur); }
#undef PG8_SA
#undef PG8_SB
#undef PG8_STAGE
#undef PG8_LDA
#undef PG8_LDB
#undef PG8_MMA
#undef PG8_WAIT_V
#undef PG8_WAIT_L
#undef PG8_BAR
#undef PG8_SCHED
}
}

#define LAS __attribute__((address_space(3)))
typedef unsigned short bf16;
typedef short bf16x8 __attribute__((ext_vector_type(8)));
typedef short s16x4 __attribute__((ext_vector_type(4)));
typedef float f32x4 __attribute__((ext_vector_type(4)));
typedef float f32x16 __attribute__((ext_vector_type(16)));
typedef unsigned u32x4 __attribute__((ext_vector_type(4)));
typedef unsigned u32x2 __attribute__((ext_vector_type(2)));
typedef float f32x2_t __attribute__((ext_vector_type(2)));
typedef __bf16 bf16x2_t __attribute__((ext_vector_type(2)));

#ifndef N_LAUNCHES
#define N_LAUNCHES 1
#endif
constexpr int NPH = 5;
constexpr int D = 1024, NB = 8, SEQ = 2048, MTOK = NB * SEQ, NIN = 7440, NP = 7424, NP_MAIN = 7168;
constexpr int C_Z = 0, C_X = 1024, C_B = 2048, C_C = 2176, C_Q = 2304, C_K = 2816, C_V = 3328, C_GR = 4352, C_GAM = 5376, C_GAR = 6400;
constexpr float EPS = 1e-6f;
constexpr size_t MiB = 1u << 20;
constexpr size_t WS_PROJ = 0;
constexpr size_t WS_WMF = 232 * MiB, WS_WRF = 234 * MiB, WS_WOF = 236 * MiB;
constexpr size_t WS_MOD = 238 * MiB;
constexpr size_t WS_DT = 239 * MiB;
constexpr size_t WS_SSQM = 240 * MiB;
constexpr size_t WS_SSQR = 242 * MiB;
constexpr int CW_MODCNT = 3900;
constexpr size_t WS_CTL = 244 * MiB, CTL_BYTES = 16384;
constexpr size_t WS_WTF = 245 * MiB;
constexpr size_t WS_END = 246 * MiB;
constexpr size_t OUT_H = 0, OUT_WINT = 32 * MiB;
constexpr int LDS_BYTES = 155648, LDS_MISC = 155520;
constexpr int NTHR = 512;

struct Args { const float* in[16]; float* out; unsigned char* ws; int ph_lo, ph_hi; };

__device__ __forceinline__ float bf_lo(unsigned u) { return __uint_as_float(u << 16); }
__device__ __forceinline__ float bf_hi(unsigned u) { return __uint_as_float(u & 0xffff0000u); }
__device__ __forceinline__ unsigned pk2(float lo, float hi) { f32x2_t v = {lo, hi}; bf16x2_t b = __builtin_convertvector(v, bf16x2_t); return __builtin_bit_cast(unsigned, b); }
__device__ __forceinline__ float silu_f(float x) { return x * __builtin_amdgcn_rcpf(1.f + __expf(-x)); }
__device__ __forceinline__ float sigm_f(float x) { return __builtin_amdgcn_rcpf(1.f + __expf(-x)); }
__device__ __forceinline__ float wave_sum(float v) {
#pragma unroll
    for (int o = 1; o < 64; o <<= 1) v += __shfl_xor(v, o);
    return v;
}
__device__ __forceinline__ int crow(int reg, int h) { return (reg & 3) + 8 * (reg >> 2) + 4 * h; }
#define MFMA32(a, b, c) __builtin_amdgcn_mfma_f32_32x32x16_bf16((a), (b), (c), 0, 0, 0)
#define MFMA16(a, b, c) __builtin_amdgcn_mfma_f32_16x16x32_bf16((a), (b), (c), 0, 0, 0)
__device__ __forceinline__ s16x4 tr_read(const LAS unsigned char* p) {
    typedef short v4i16_t __attribute__((ext_vector_type(4)));
    return __builtin_bit_cast(s16x4, __builtin_amdgcn_ds_read_tr16_b64_v4i16((LAS v4i16_t*)p));
}
__device__ __forceinline__ bf16x8 tr_pair(const LAS unsigned char* plo, const LAS unsigned char* phi) {
    const s16x4 lo = tr_read(plo), hi = tr_read(phi);
    return __builtin_shufflevector(lo, hi, 0, 1, 2, 3, 4, 5, 6, 7);
}
__device__ __forceinline__ bf16x8 pack8(float a0, float a1, float a2, float a3, float a4, float a5, float a6, float a7) {
    u32x4 p; p.x = pk2(a0, a1); p.y = pk2(a2, a3); p.z = pk2(a4, a5); p.w = pk2(a6, a7);
    return __builtin_bit_cast(bf16x8, p);
}

__device__ __forceinline__ void p0_load_tile(const float* W, int ldw, int k0, int n0, LAS float* scr, int lane) {
    float t[32];
#pragma unroll
    for (int i = 0; i < 32; ++i) t[i] = __builtin_nontemporal_load(W + (size_t)(k0 + 2 * i + (lane >> 5)) * ldw + n0 + (lane & 31));
#pragma unroll
    for (int i = 0; i < 32; ++i) scr[(2 * i + (lane >> 5)) * 33 + (lane & 31)] = t[i];
}
__device__ __forceinline__ void p0_phase(const Args& a, LAS unsigned char* lds, int tid_unused, int lane_unused, int wave, int G) {
    const int lane = fresh_lane(), tid = wave * 64 + lane;
    const float* cvec = a.in[1]; const float* w_ada = a.in[2]; const float* b_ada = a.in[3];
    float* MOD = (float*)(a.ws + WS_MOD);
    LAS float* cT = (LAS float*)lds;
    LAS float* red = (LAS float*)(lds + 32768);
    if ((int)blockIdx.x < 192) {
        { float t[16];
#pragma unroll
          for (int i = 0; i < 16; ++i) t[i] = cvec[tid + 512 * i];
#pragma unroll
          for (int i = 0; i < 16; ++i) { const int idx = tid + 512 * i; cT[(idx & 1023) * 8 + (idx >> 10)] = t[i]; } }
        __syncthreads();
        for (int item = blockIdx.x; item < 192; item += G) {
            const int j0 = item * 16, col = lane & 15, rsub = lane >> 4, kq = wave;
            float w[32];
#pragma unroll
            for (int i = 0; i < 32; ++i) w[i] = __builtin_nontemporal_load(w_ada + (size_t)(kq * 128 + 4 * i + rsub) * 3072 + j0 + col);
            float acc[8];
#pragma unroll
            for (int bb = 0; bb < 8; ++bb) acc[bb] = 0.f;
#pragma unroll
            for (int i = 0; i < 32; ++i) { const int k = kq * 128 + 4 * i + rsub;
                const f32x4 c0 = *(const LAS f32x4*)(cT + k * 8), c1 = *(const LAS f32x4*)(cT + k * 8 + 4);
                acc[0] += c0.x * w[i]; acc[1] += c0.y * w[i]; acc[2] += c0.z * w[i]; acc[3] += c0.w * w[i];
                acc[4] += c1.x * w[i]; acc[5] += c1.y * w[i]; acc[6] += c1.z * w[i]; acc[7] += c1.w * w[i]; }
#pragma unroll
            for (int bb = 0; bb < 8; ++bb) { acc[bb] += __shfl_xor(acc[bb], 16); acc[bb] += __shfl_xor(acc[bb], 32); }
            if (lane < 16) {
#pragma unroll
                for (int bb = 0; bb < 8; ++bb) red[(kq * 8 + bb) * 16 + col] = acc[bb]; }
            __syncthreads();
            if (tid < 128) { const int bb = tid >> 4, cc = tid & 15; float sum = 0.f;
#pragma unroll
                for (int q = 0; q < 8; ++q) sum += red[(q * 8 + bb) * 16 + cc];
                __hip_atomic_store(&MOD[bb * 3072 + j0 + cc], sum + b_ada[j0 + cc], __ATOMIC_RELAXED, __HIP_MEMORY_SCOPE_AGENT); }
            asm volatile("s_waitcnt vmcnt(0)" ::: "memory");
            __syncthreads();
            if (tid == 0) __hip_atomic_fetch_add((unsigned*)(a.ws + WS_CTL) + CW_MODCNT, 1u, __ATOMIC_RELAXED, __HIP_MEMORY_SCOPE_AGENT);
        }
    }
    LAS float* scr = (LAS float*)(lds + 40960 + wave * 8448);
    const int gw = blockIdx.x * 8 + wave, NGW = G * 8;
    constexpr int I_IN = 16 * (NP / 32), I_W = 16 * 32;
    bf16* WINT = (bf16*)((unsigned char*)a.out + OUT_WINT);
    for (int it = gw; it < I_IN + 3 * I_W + 128; it += NGW) {
        if (it >= I_IN + 3 * I_W) {
            const int r_ = it - (I_IN + 3 * I_W), nt = r_ & 7, kb = r_ >> 3;
            p0_load_tile(a.in[5], NIN, 64 * kb, NP_MAIN + 16 + 32 * nt, scr, lane);
            bf16* WF = (bf16*)(a.ws + WS_WTF);
            const int r = lane & 31, h = lane >> 5;
#pragma unroll
            for (int s4 = 0; s4 < 4; ++s4) { const LAS float* s = scr + (16 * s4 + 8 * h) * 33 + r;
                u32x4 o; o.x = pk2(s[0 * 33], s[1 * 33]); o.y = pk2(s[2 * 33], s[3 * 33]); o.z = pk2(s[4 * 33], s[5 * 33]); o.w = pk2(s[6 * 33], s[7 * 33]);
                *(u32x4*)(WF + ((size_t)(nt * 64 + 4 * kb + s4) * 64 + lane) * 8) = o; }
        } else if (it < I_IN) {
            const int nblk = NP / 32, kb = it / nblk, nb = it % nblk, k0 = 64 * kb, n0p = 32 * nb, n0 = n0p + (n0p >= 2304 ? 16 : 0);
            p0_load_tile(a.in[5], NIN, k0, n0, scr, lane);
            const int c = lane & 7;
#pragma unroll
            for (int j = 0; j < 4; ++j) { const int n = (lane >> 3) + 8 * j; const LAS float* s = scr + (8 * c) * 33 + n;
                u32x4 o; o.x = pk2(s[0 * 33], s[1 * 33]); o.y = pk2(s[2 * 33], s[3 * 33]); o.z = pk2(s[4 * 33], s[5 * 33]); o.w = pk2(s[6 * 33], s[7 * 33]);
                *(u32x4*)(WINT + (size_t)(n0p + n) * 1024 + k0 + 8 * c) = o; }
        } else {
            int r_ = it - I_IN; const int which = r_ / I_W; r_ -= which * I_W;
            const float* W = a.in[12 + which];
            bf16* WF = (bf16*)(a.ws + WS_WMF + (size_t)which * 2 * MiB);
            const int nt = r_ & 31, kb = r_ >> 5;
            p0_load_tile(W, 1024, 64 * kb, 32 * nt, scr, lane);
            const int r = lane & 31, h = lane >> 5;
#pragma unroll
            for (int s4 = 0; s4 < 4; ++s4) { const LAS float* s = scr + (16 * s4 + 8 * h) * 33 + r;
                f32x4 m0 = (f32x4){1.f, 1.f, 1.f, 1.f}, m1 = m0;
                if (which == 0) { m0 = *(const f32x4*)(a.in[11] + 64 * kb + 16 * s4 + 8 * h); m1 = *(const f32x4*)(a.in[11] + 64 * kb + 16 * s4 + 8 * h + 4); }
                u32x4 o; o.x = pk2(s[0 * 33] * m0.x, s[1 * 33] * m0.y); o.y = pk2(s[2 * 33] * m0.z, s[3 * 33] * m0.w); o.z = pk2(s[4 * 33] * m1.x, s[5 * 33] * m1.y); o.w = pk2(s[6 * 33] * m1.z, s[7 * 33] * m1.w);
                *(u32x4*)(WF + ((size_t)(nt * 64 + 4 * kb + s4) * 64 + lane) * 8) = o; }
        }
    }
}

__device__ __forceinline__ void p1_phase(const Args& a, LAS unsigned char* lds, int tid_unused, int lane_unused, int wave, int G) {
    const int lane_in = fresh_lane(), tid = wave * 64 + lane_in;
    const float* x = a.in[0]; const float* norm_w = a.in[4]; const float* w_in = a.in[5]; const float* dt_bias = a.in[8];
    const float* MOD = (const float*)(a.ws + WS_MOD);
    float* DT = (float*)(a.ws + WS_DT);
    bf16* H = (bf16*)((unsigned char*)a.out + OUT_H);
    LAS float* wdt = (LAS float*)lds;
    { float t[32];
#pragma unroll
      for (int i = 0; i < 32; ++i) { const int idx = tid + NTHR * i; t[i] = w_in[(size_t)(idx >> 4) * NIN + 2304 + (idx & 15)]; }
#pragma unroll
      for (int i = 0; i < 32; ++i) { const int idx = tid + NTHR * i; wdt[(idx & 15) * 1028 + (idx >> 4)] = t[i]; } }
    if (wave == 0) {
        unsigned* cnt = (unsigned*)(a.ws + WS_CTL) + CW_MODCNT; unsigned spins = 0u;
        while ((unsigned)__builtin_amdgcn_readfirstlane((int)__hip_atomic_load(cnt, __ATOMIC_RELAXED, __HIP_MEMORY_SCOPE_AGENT)) < 192u) { __builtin_amdgcn_s_sleep(1); if (++spins > (1u << 20)) break; }
        __builtin_amdgcn_fence(__ATOMIC_ACQUIRE, "agent");
        asm volatile("s_waitcnt vmcnt(0)" ::: "memory");
    }
    __syncthreads();
    for (int blk = blockIdx.x; blk < 256; blk += G) {
        const int b = blk >> 5;
        float gk[16], sh[16];
#pragma unroll
        for (int jj = 0; jj < 4; ++jj) { const int k = 4 * lane_in + 256 * jj;
            const f32x4 nw = *(const f32x4*)(norm_w + k), sc = *(const f32x4*)(MOD + b * 3072 + 1024 + k), sf = *(const f32x4*)(MOD + b * 3072 + k);
#pragma unroll
            for (int e = 0; e < 4; ++e) { gk[4 * jj + e] = nw[e] * (1.f + sc[e]); sh[4 * jj + e] = sf[e]; } }
        f32x4 vn[2][4];
        { const int lane = fresh_lane();
#pragma unroll
          for (int rr = 0; rr < 2; ++rr)
#pragma unroll
              for (int jj = 0; jj < 4; ++jj) vn[rr][jj] = __builtin_nontemporal_load((const f32x4*)(x + (size_t)(blk * 64 + wave * 8 + rr) * D) + lane + 64 * jj); }
        for (int g = 0; g < 4; ++g) {
            asm volatile("" ::: "memory");
            const int lane = fresh_lane();
            const int m0 = blk * 64 + wave * 8 + g * 2;
            f32x4 v[2][4];
#pragma unroll
            for (int rr = 0; rr < 2; ++rr)
#pragma unroll
                for (int jj = 0; jj < 4; ++jj) v[rr][jj] = vn[rr][jj];
            if (g + 1 < 4) {
#pragma unroll
                for (int rr = 0; rr < 2; ++rr)
#pragma unroll
                    for (int jj = 0; jj < 4; ++jj) vn[rr][jj] = __builtin_nontemporal_load((const f32x4*)(x + (size_t)(m0 + 2 + rr) * D) + lane + 64 * jj);
            }
            __builtin_amdgcn_sched_barrier(0);
            float hv[2][16];
#pragma unroll
            for (int rr = 0; rr < 2; ++rr) {
                float ss = 0.f;
#pragma unroll
                for (int jj = 0; jj < 4; ++jj) ss += (v[rr][jj].x * v[rr][jj].x + v[rr][jj].y * v[rr][jj].y) + (v[rr][jj].z * v[rr][jj].z + v[rr][jj].w * v[rr][jj].w);
                const float rs = 1.0f / sqrtf(wave_sum(ss) * (1.f / D) + EPS);
                unsigned long long* o8 = (unsigned long long*)(H + (size_t)(m0 + rr) * D) + lane;
#pragma unroll
                for (int jj = 0; jj < 4; ++jj) {
#pragma unroll
                    for (int e = 0; e < 4; ++e) hv[rr][4 * jj + e] = v[rr][jj][e] * rs * gk[4 * jj + e] + sh[4 * jj + e];
                    o8[64 * jj] = (unsigned long long)pk2(hv[rr][4 * jj], hv[rr][4 * jj + 1]) | ((unsigned long long)pk2(hv[rr][4 * jj + 2], hv[rr][4 * jj + 3]) << 32);
                }
            }
            float acc[32];
#pragma unroll
            for (int i = 0; i < 32; ++i) acc[i] = 0.f;
#pragma unroll
            for (int j = 0; j < 16; ++j) {
#pragma unroll
                for (int jj = 0; jj < 4; ++jj) { const f32x4 w = *(const LAS f32x4*)(wdt + j * 1028 + 4 * lane + 256 * jj);
#pragma unroll
                    for (int rr = 0; rr < 2; ++rr) acc[rr * 16 + j] += (hv[rr][4 * jj] * w.x + hv[rr][4 * jj + 1] * w.y) + (hv[rr][4 * jj + 2] * w.z + hv[rr][4 * jj + 3] * w.w); }
                if ((j & 3) == 3) asm volatile("" ::: "memory");
            }
#pragma unroll
            for (int half = 16; half >= 1; half >>= 1) {
                const bool up = (lane & half) != 0;
#pragma unroll
                for (int i = 0; i < half; ++i) { float lo_ = acc[i], hi_ = acc[i + half]; asm volatile("" : "+v"(lo_), "+v"(hi_));
                    const float keep = up ? hi_ : lo_, send = up ? lo_ : hi_; acc[i] = keep + __shfl_xor(send, half); }
            }
            const float tot = acc[0] + __shfl_xor(acc[0], 32);
            const float xr_ = tot + dt_bias[lane & 15];
            const float dtv = xr_ > 20.f ? xr_ : log1pf(__expf(xr_));
            if (lane < 32) DT[(size_t)m0 * 16 + lane] = dtv;
        }
    }
}

constexpr size_t OUT_XBCC = 0;
__device__ __forceinline__ void p3a_phase(const Args& a, int wave, int G) {
    const bf16* PROJ = (const bf16*)(a.ws + WS_PROJ);
    bf16* XBCC = (bf16*)((unsigned char*)a.out + OUT_XBCC);
    const float* conv_w = a.in[6]; const float* conv_b = a.in[7];
    const int lane = fresh_lane(), tid = wave * 64 + lane;
    if (tid >= 480) return;
    const int oct = tid % 160, tgl = tid / 160;
    float cw[4][8], cb[8];
#pragma unroll
    for (int e = 0; e < 8; ++e) { cb[e] = conv_b[8 * oct + e];
#pragma unroll
        for (int k = 0; k < 4; ++k) cw[k][e] = conv_w[k * 1280 + 8 * oct + e]; }
    for (int blk = blockIdx.x; blk < 256; blk += G) {
        for (int tg = tgl; tg < 8; tg += 3) {
            const int m0 = blk * 64 + 8 * tg, ts0 = m0 & (SEQ - 1);
            const char* src = (const char*)(PROJ + (size_t)m0 * NP + C_X + 8 * oct);
            u32x4 raw[11];
#pragma unroll
            for (int i = 0; i < 11; ++i) { const bool ok = (ts0 - 3 + i) >= 0; raw[i] = ok ? *(const u32x4*)(src + ((long)i - 3) * (NP * 2)) : (u32x4){0u, 0u, 0u, 0u}; }
#pragma unroll
            for (int jj = 0; jj < 8; ++jj) {
                float o[8];
#pragma unroll
                for (int e = 0; e < 8; ++e) {
                    float s_ = cb[e];
#pragma unroll
                    for (int k = 0; k < 4; ++k) { const unsigned w = raw[jj + k][e >> 1]; s_ += cw[k][e] * ((e & 1) ? bf_hi(w) : bf_lo(w)); }
                    o[e] = silu_f(s_);
                }
                u32x4 ov; ov.x = pk2(o[0], o[1]); ov.y = pk2(o[2], o[3]); ov.z = pk2(o[4], o[5]); ov.w = pk2(o[6], o[7]);
                *(u32x4*)(XBCC + (size_t)(m0 + jj) * 1280 + 8 * oct) = ov;
            }
        }
    }
}

constexpr int TP = 72;
constexpr int L_CQ = 0, L_BK = 18432, L_BKW = 36864, L_XV = 55296, L_ST0 = 73728, L_ST1 = 82944, L_ACS = 92160, L_DTJ = 93184, L_WJ = 94208, L_CW = 95232;

__device__ __forceinline__ void p3_phase(const Args& a, LAS unsigned char* lds, int tid_in, int lane_in, int wave, int G, const bool dry = false) {
    bf16* PROJ = (bf16*)(a.ws + WS_PROJ);
    const float* DT = (const float*)(a.ws + WS_DT);
    float* SSQM = (float*)(a.ws + WS_SSQM); float* SSQR = (float*)(a.ws + WS_SSQR);
    const float* conv_w = a.in[6]; const float* conv_b = a.in[7]; const float* a_log = a.in[9]; const float* d_skip = a.in[10]; const float* m_norm_w = a.in[11];
    const int pt = wave & 1, it = wave >> 1;
#ifdef PROBE_SEL
    unsigned long long t0_ = 0ull; unsigned tacc_ = 0u;
    const bool probing = ((int)blockIdx.x == PROBE_BLK && wave == PROBE_WAVE);
#define TB(k) do { if (PROBE_SEL == (k) && probing) t0_ = __builtin_amdgcn_s_memrealtime(); } while (0)
#define TE(k) do { if (PROBE_SEL == (k) && probing) tacc_ += (unsigned)(__builtin_amdgcn_s_memrealtime() - t0_); } while (0)
#else
#define TB(k) do {} while (0)
#define TE(k) do {} while (0)
#endif
    for (int item = blockIdx.x; item < 256; item += G) {
        const int lane = fresh_lane(), tid = wave * 64 + lane;
        const int r = lane & 31, h = lane >> 5, i16 = lane & 15, q4 = i16 >> 2, p4 = i16 & 3, blk16 = (lane >> 4) & 1;
        const int xcd_ = item & 7, kk_ = item >> 3;
        const bool ssd = kk_ < 16;
        int b, hd, half;
        if (ssd) { const int pair = 2 * xcd_ + (kk_ >> 3); b = pair >> 1; hd = 8 * (pair & 1) + (kk_ & 7); half = 0; }
        else { const int t = xcd_ * 16 + (kk_ - 16); b = t >> 4; hd = (t >> 1) & 7; half = t & 1; }
        const size_t mb = (size_t)b * SEQ;
        __syncthreads();
        for (int idx = tid; idx < 9216 / 4; idx += NTHR) ((LAS unsigned*)(lds + L_ST0))[idx] = 0u;
        const float lg = ssd ? 0.f : log1pf(-exp2f(-5.0f - (float)hd));
        if (!ssd && tid < 256) { const int par = tid >> 7, j = tid & 127;
            ((LAS float*)(lds + L_ACS))[par * 128 + j] = (float)(j + 1) * lg * 1.4426950408889634f; ((LAS float*)(lds + L_DTJ))[par * 128 + j] = (float)(j + 1) * lg * 1.4426950408889634f; ((LAS float*)(lds + L_WJ))[par * 128 + j] = __expf((float)(127 - j) * lg); }
        const float Ah = ssd ? -__expf(a_log[hd]) : 0.f;
        const float Dsk = ssd ? d_skip[hd] : 0.f;
        const int ltile = 3 - (tid >> 7), loct = tid & 7, ltg = (tid >> 3) & 15;
        int lcol = 0;
        float invf[8];
        if (ssd) {
            lcol = (ltile == 0) ? (64 * hd + 8 * loct) : (ltile == 1 ? (1024 + 64 * (hd >> 3) + 8 * loct) : (1152 + 64 * (hd >> 3) + 8 * loct));
            if (ltile == 3) lcol = 1024 + 64 * (hd >> 3) + 8 * loct;
#pragma unroll
            for (int e = 0; e < 8; ++e) invf[e] = 0.f;
        } else {
#pragma unroll
            for (int e = 0; e < 8; ++e) invf[e] = exp2f(-(float)(8 * (tid & 3) + e) * (13.287712379549449f / 32.f));
        }
        f32x16 sacc;
#pragma unroll
        for (int i = 0; i < 16; ++i) sacc[i] = 0.f;
        u32x4 raw[8];
        const int rj = tid >> 2, ro4 = tid & 3;
        const int j0 = 8 * ltg;
        const char* pbase = (const char*)(PROJ + mb * NP);
        const char* xbase = (const char*)((const bf16*)((const unsigned char*)a.out + OUT_XBCC) + mb * 1280);
        const unsigned soff = (unsigned)((j0 * 1280 + lcol) * 2);
        const unsigned roff = (unsigned)((rj * NP) * 2);
#define P3_ISSUE(cc) do { const char* cbp = pbase + (size_t)(cc) * (128 * NP * 2); \
        if (ssd) { const char* xp = xbase + (size_t)(cc) * (128 * 1280 * 2) + soff; _Pragma("unroll") for (int i = 0; i < 8; ++i) raw[i] = *(const u32x4*)(xp + i * (1280 * 2)); } \
        else { const char* rp = cbp + roff; \
            raw[0] = *(const u32x4*)(rp + (C_Q + 64 * hd + 8 * ro4) * 2); raw[1] = *(const u32x4*)(rp + (C_Q + 64 * hd + 32 + 8 * ro4) * 2); \
            raw[2] = *(const u32x4*)(rp + (C_K + 64 * hd + 8 * ro4) * 2); raw[3] = *(const u32x4*)(rp + (C_K + 64 * hd + 32 + 8 * ro4) * 2); \
            raw[4] = *(const u32x4*)(rp + (C_V + 128 * hd + 64 * half + 16 * ro4) * 2); raw[5] = *(const u32x4*)(rp + (C_V + 128 * hd + 64 * half + 16 * ro4 + 8) * 2); } } while (0)
        float dq0 = 0.f, dq1 = 0.f;
#define P3_SCAN(cc) do { LAS float* ACSw = (LAS float*)(lds + L_ACS) + ((cc) & 1) * 128; LAS float* DTJw = (LAS float*)(lds + L_DTJ) + ((cc) & 1) * 128; LAS float* WJw = (LAS float*)(lds + L_WJ) + ((cc) & 1) * 128; \
        const float v0 = dq0 * Ah, v1 = dq1 * Ah, s_ = v0 + v1; float incl = s_; \
        _Pragma("unroll") for (int o = 1; o < 64; o <<= 1) { const float t = __shfl_up(incl, o); if (lane >= o) incl += t; } \
        const float c0 = (incl - s_) + v0, tot = __shfl(incl, 63), c1 = (lane == 63) ? tot : c0 + v1; \
        ACSw[2 * lane] = c0 * 1.4426950408889634f; ACSw[2 * lane + 1] = c1 * 1.4426950408889634f; \
        DTJw[2 * lane] = c0 * 1.4426950408889634f - __log2f(dq0); DTJw[2 * lane + 1] = c1 * 1.4426950408889634f - __log2f(dq1); \
        WJw[2 * lane] = dq0 * __expf(tot - c0); WJw[2 * lane + 1] = dq1 * __expf(tot - c1); } while (0)
#define P3_DTLOAD(cc) do { dq0 = DT[(mb + (size_t)(cc) * 128 + 2 * lane) * 16 + hd]; dq1 = DT[(mb + (size_t)(cc) * 128 + 2 * lane + 1) * 16 + hd]; } while (0)
        if (ssd && wave == 0) { P3_DTLOAD(0); P3_SCAN(0); P3_DTLOAD(1); }
        u32x2 zzn[4];
        { const bf16* orow0 = PROJ + (mb + 16 * wave + i16) * NP + (ssd ? (C_Z + 64 * hd) : (C_GR + 128 * hd + 64 * half));
#pragma unroll
          for (int g4 = 0; g4 < 4; ++g4) zzn[g4] = *(const u32x2*)(orow0 + 16 * g4 + 4 * (lane >> 4)); }
        P3_ISSUE(0);

        TB(1);
        for (int c = 0; c < 16; ++c) {
            const int par = c & 1;
            const size_t m0 = mb + (size_t)c * 128;
            LAS float* ACS = (LAS float*)(lds + L_ACS) + par * 128; LAS float* DTJ = (LAS float*)(lds + L_DTJ) + par * 128; LAS float* WJ = (LAS float*)(lds + L_WJ) + par * 128;
            TB(5);
            __syncthreads();
            TE(5); TB(2);
#ifndef P3_REPL
#define P3_REPL 1
#endif
            _Pragma("nounroll") for (int repl_ = 0; repl_ < P3_REPL; ++repl_) {
            if (repl_) __syncthreads();
            if (ssd) {
                {
                    LAS unsigned char* dst = lds + (ltile == 0 ? L_XV : (ltile == 1 ? L_BK : (ltile == 2 ? L_CQ : L_BKW)));
#pragma unroll
                    for (int jj = 0; jj < 8; ++jj) {
                        u32x4 v = raw[jj];
                        if (ltile == 3) { const float wj = WJ[j0 + jj];
                            v.x = pk2(bf_lo(v.x) * wj, bf_hi(v.x) * wj); v.y = pk2(bf_lo(v.y) * wj, bf_hi(v.y) * wj); v.z = pk2(bf_lo(v.z) * wj, bf_hi(v.z) * wj); v.w = pk2(bf_lo(v.w) * wj, bf_hi(v.w) * wj); }
                        *(LAS u32x4*)(dst + ((j0 + jj) * TP + 8 * loct) * 2) = v;
                    }
                }
            } else {
                const int j = rj, o4 = ro4;
                const u32x4 q1 = raw[0], q2 = raw[1], k1 = raw[2], k2 = raw[3];
                const float pos = (float)(c * 128 + j), wj = WJ[j];
                float ql[8], qh[8], kl[8], kh[8];
#pragma unroll
                for (int e = 0; e < 8; ++e) {
                    const float rev = pos * invf[e] * 0.15915494309189535f, fr = rev - floorf(rev);
                    const float cs = __builtin_amdgcn_cosf(fr), sn = __builtin_amdgcn_sinf(fr);
                    const unsigned wq1 = q1[e >> 1], wq2 = q2[e >> 1], wk1 = k1[e >> 1], wk2 = k2[e >> 1];
                    const float a1 = (e & 1) ? bf_hi(wq1) : bf_lo(wq1), a2 = (e & 1) ? bf_hi(wq2) : bf_lo(wq2);
                    const float b1 = ((e & 1) ? bf_hi(wk1) : bf_lo(wk1)) * 0.125f, b2 = ((e & 1) ? bf_hi(wk2) : bf_lo(wk2)) * 0.125f;
                    ql[e] = a1 * cs - a2 * sn; qh[e] = a1 * sn + a2 * cs;
                    kl[e] = b1 * cs - b2 * sn; kh[e] = b1 * sn + b2 * cs;
                }
                u32x4 t;
                t.x = pk2(ql[0], ql[1]); t.y = pk2(ql[2], ql[3]); t.z = pk2(ql[4], ql[5]); t.w = pk2(ql[6], ql[7]); *(LAS u32x4*)(lds + L_CQ + (j * TP + 8 * o4) * 2) = t;
                t.x = pk2(qh[0], qh[1]); t.y = pk2(qh[2], qh[3]); t.z = pk2(qh[4], qh[5]); t.w = pk2(qh[6], qh[7]); *(LAS u32x4*)(lds + L_CQ + (j * TP + 32 + 8 * o4) * 2) = t;
                t.x = pk2(kl[0], kl[1]); t.y = pk2(kl[2], kl[3]); t.z = pk2(kl[4], kl[5]); t.w = pk2(kl[6], kl[7]); *(LAS u32x4*)(lds + L_BK + (j * TP + 8 * o4) * 2) = t;
                t.x = pk2(kh[0], kh[1]); t.y = pk2(kh[2], kh[3]); t.z = pk2(kh[4], kh[5]); t.w = pk2(kh[6], kh[7]); *(LAS u32x4*)(lds + L_BK + (j * TP + 32 + 8 * o4) * 2) = t;
                t.x = pk2(kl[0] * wj, kl[1] * wj); t.y = pk2(kl[2] * wj, kl[3] * wj); t.z = pk2(kl[4] * wj, kl[5] * wj); t.w = pk2(kl[6] * wj, kl[7] * wj); *(LAS u32x4*)(lds + L_BKW + (j * TP + 8 * o4) * 2) = t;
                t.x = pk2(kh[0] * wj, kh[1] * wj); t.y = pk2(kh[2] * wj, kh[3] * wj); t.z = pk2(kh[4] * wj, kh[5] * wj); t.w = pk2(kh[6] * wj, kh[7] * wj); *(LAS u32x4*)(lds + L_BKW + (j * TP + 32 + 8 * o4) * 2) = t;
                *(LAS u32x4*)(lds + L_XV + (j * TP + 16 * o4) * 2) = raw[4]; *(LAS u32x4*)(lds + L_XV + (j * TP + 16 * o4 + 8) * 2) = raw[5];
            }
            }
            TE(2); TB(6);
            __syncthreads();
            TE(6); TB(3);
            const int q16 = lane >> 4, iTok = 16 * wave + i16;
            bf16* orow = PROJ + (m0 + iTok) * NP + (ssd ? (C_Z + 64 * hd) : (C_GR + 128 * hd + 64 * half));
            u32x2 zz[4];
#pragma unroll
            for (int g4 = 0; g4 < 4; ++g4) zz[g4] = zzn[g4];
            if (c + 1 < 16) {
#pragma unroll
                for (int g4 = 0; g4 < 4; ++g4) zzn[g4] = *(const u32x2*)(orow + 128 * NP + 16 * g4 + 4 * q16);
                P3_ISSUE(c + 1);
            }
            __builtin_amdgcn_sched_barrier(0);
            if (ssd && wave == 0 && c + 1 < 16) { P3_SCAN(c + 1); if (c + 2 < 16) P3_DTLOAD(c + 2); }
#ifndef P3_REPC
#define P3_REPC 1
#endif
            f32x16 acc;
            float acs_i = 0.f;
            LAS unsigned char* STw = lds + (par ? L_ST0 : L_ST1);
            _Pragma("nounroll") for (int repc_ = 0; repc_ < P3_REPC; ++repc_) {
            bf16x8 cqb[2];
#pragma unroll
            for (int s = 0; s < 2; ++s) cqb[s] = *(const LAS bf16x8*)(lds + L_CQ + (iTok * TP + 32 * s + 8 * q16) * 2);
            const LAS unsigned char* STr = lds + (par ? L_ST1 : L_ST0);
#pragma unroll
            for (int i = 0; i < 16; ++i) acc[i] = 0.f;
            f32x4 ya[4];
#pragma unroll
            for (int p4t = 0; p4t < 4; ++p4t) { ya[p4t] = (f32x4){0.f, 0.f, 0.f, 0.f};
#pragma unroll
                for (int s = 0; s < 2; ++s) { const bf16x8 sa = *(const LAS bf16x8*)(STr + ((16 * p4t + i16) * TP + 32 * s + 8 * q16) * 2); ya[p4t] = MFMA16(sa, cqb[s], ya[p4t]); } }
            acs_i = ACS[iTok];
            { const float ei = __builtin_amdgcn_exp2f(acs_i);
#pragma unroll
              for (int p4t = 0; p4t < 4; ++p4t) ya[p4t] = ya[p4t] * ei; }
            const int nblk = (wave >> 1) + 1;
            bf16x8 kq0[2], kq1[2];
#pragma unroll
            for (int s = 0; s < 2; ++s) { kq0[s] = *(const LAS bf16x8*)(lds + L_BK + (i16 * TP + 32 * s + 8 * q16) * 2); kq1[s] = *(const LAS bf16x8*)(lds + L_BK + ((16 + i16) * TP + 32 * s + 8 * q16) * 2); }
            for (int jb = 0; jb < nblk; ++jb) {
                const int j0 = 32 * jb;
                f32x4 t0 = (f32x4){0.f, 0.f, 0.f, 0.f}, t1 = t0;
#pragma unroll
                for (int s = 0; s < 2; ++s) { t0 = MFMA16(kq0[s], cqb[s], t0); t1 = MFMA16(kq1[s], cqb[s], t1); }
#pragma unroll
                for (int s = 0; s < 2; ++s) { kq0[s] = *(const LAS bf16x8*)(lds + L_BK + ((j0 + 32 + i16) * TP + 32 * s + 8 * q16) * 2); kq1[s] = *(const LAS bf16x8*)(lds + L_BK + ((j0 + 48 + i16) * TP + 32 * s + 8 * q16) * 2); }
                const f32x4 b0 = *(const LAS f32x4*)(DTJ + j0 + 4 * q16), b1 = *(const LAS f32x4*)(DTJ + j0 + 16 + 4 * q16);
                bf16x8 xa[4];
#pragma unroll
                for (int p4t = 0; p4t < 4; ++p4t) { const LAS unsigned char* xb = lds + L_XV + ((j0 + 4 * q16 + q4) * TP + 16 * p4t + 4 * p4) * 2; xa[p4t] = tr_pair(xb, xb + 16 * TP * 2); }
                __builtin_amdgcn_sched_barrier(0);
                const bool lastb = (jb == nblk - 1);
                float pv[8];
#pragma unroll
                for (int e = 0; e < 4; ++e) {
                    float v0 = t0[e] * __builtin_amdgcn_exp2f(acs_i - b0[e]), v1 = t1[e] * __builtin_amdgcn_exp2f(acs_i - b1[e]);
                    if (lastb && (j0 + 4 * q16 + e) > iTok) v0 = 0.f;
                    if (lastb && (j0 + 16 + 4 * q16 + e) > iTok) v1 = 0.f;
                    pv[e] = v0; pv[4 + e] = v1;
                }
                const bf16x8 pf = pack8(pv[0], pv[1], pv[2], pv[3], pv[4], pv[5], pv[6], pv[7]);
#pragma unroll
                for (int p4t = 0; p4t < 4; ++p4t) ya[p4t] = MFMA16(xa[p4t], pf, ya[p4t]);
            }
#pragma unroll
            for (int p4t = 0; p4t < 4; ++p4t)
#pragma unroll
                for (int e = 0; e < 4; ++e) acc[4 * p4t + e] = ya[p4t][e];
            }
            TE(3); TB(4);
            if (it < 2 && c < 15) {
                const int nt = it;
                const float dec = __builtin_amdgcn_exp2f(ACS[127]);
#pragma unroll
                for (int i = 0; i < 16; ++i) sacc[i] *= dec;
                f32x16 sacc2;
#pragma unroll
                for (int i = 0; i < 16; ++i) sacc2[i] = 0.f;
#pragma unroll
                for (int ks = 0; ks < 8; ++ks) {
                    const LAS unsigned char* xb = lds + L_XV + ((16 * ks + 8 * h + q4) * TP + 32 * pt + 16 * blk16 + 4 * p4) * 2;
                    const LAS unsigned char* kb = lds + L_BKW + ((16 * ks + 8 * h + q4) * TP + 32 * nt + 16 * blk16 + 4 * p4) * 2;
                    const bf16x8 xa = tr_pair(xb, xb + 4 * TP * 2), kbf = tr_pair(kb, kb + 4 * TP * 2);
                    if (ks & 1) sacc2 = MFMA32(xa, kbf, sacc2); else sacc = MFMA32(xa, kbf, sacc);
                }
#pragma unroll
                for (int i = 0; i < 16; ++i) sacc[i] += sacc2[i];
#pragma unroll
                for (int i = 0; i < 16; ++i) { const int p = 32 * pt + crow(i, h);
                    *(LAS unsigned short*)(STw + (p * TP + 32 * nt + r) * 2) = (unsigned short)(pk2(sacc[i], 0.f) & 0xffffu); }
            }
            {
                float ss = 0.f;
#pragma unroll
                for (int g4 = 0; g4 < 4; ++g4) {
                    const int p = 16 * g4 + 4 * q16;
                    const float z0 = bf_lo(zz[g4].x), z1 = bf_hi(zz[g4].x), z2 = bf_lo(zz[g4].y), z3 = bf_hi(zz[g4].y);
                    float y0 = acc[4 * g4], y1 = acc[4 * g4 + 1], y2 = acc[4 * g4 + 2], y3 = acc[4 * g4 + 3];
                    float o0, o1, o2, o3;
                    if (ssd) {
                        const u32x2 xv = *(const LAS u32x2*)(lds + L_XV + (iTok * TP + p) * 2);
                        y0 = (y0 + Dsk * bf_lo(xv.x)) * silu_f(z0); y1 = (y1 + Dsk * bf_hi(xv.x)) * silu_f(z1); y2 = (y2 + Dsk * bf_lo(xv.y)) * silu_f(z2); y3 = (y3 + Dsk * bf_hi(xv.y)) * silu_f(z3);
                        ss += (y0 * y0 + y1 * y1) + (y2 * y2 + y3 * y3);
                        o0 = y0; o1 = y1; o2 = y2; o3 = y3;
                    } else {
                        ss += (y0 * y0 + y1 * y1) + (y2 * y2 + y3 * y3);
                        o0 = y0 * silu_f(z0); o1 = y1 * silu_f(z1); o2 = y2 * silu_f(z2); o3 = y3 * silu_f(z3);
                    }
                    u32x2 ov; ov.x = pk2(o0, o1); ov.y = pk2(o2, o3);
                    if (dry) *(u32x2*)((bf16*)((unsigned char*)a.out + 40 * MiB) + (m0 + iTok) * 512 + ((64 * hd + 64 * half + p) & 511)) = ov; else *(u32x2*)(orow + p) = ov;
                }
                ss += __shfl_xor(ss, 16); ss += __shfl_xor(ss, 32);
                if (q16 < 2) { const float sv = (q16 == 0) ? ss : 0.f;
                    if (ssd) SSQM[(m0 + iTok) * 32 + hd * 2 + q16] = sv; else SSQR[(m0 + iTok) * 32 + hd * 4 + half * 2 + q16] = sv; }
            }
            TE(4);
        }
        TE(1);
#undef P3_ISSUE
#undef P3_SCAN
#undef P3_DTLOAD
    }
#ifdef PROBE_SEL
    if (probing && fresh_lane() == 0) ((unsigned*)(a.ws + WS_CTL))[4000] = tacc_;
#endif
#undef TB
#undef TE
}

constexpr int MP = 1032;
constexpr int L4_MERGED = 0, L4_ASTG = 132096, L4_RM = 150528, L4_RR = 151040, L4_RED = 153088, L4_RS = 155136;
static_assert(L4_RS + 256 <= LDS_BYTES, "P4 LDS map");

__device__ __forceinline__ void p4_panel_load(u32x4 (&ar)[16], const bf16* Abase, int tid) {
    const int srow = tid >> 3, soct = tid & 7; const int rot = ((int)blockIdx.x >> 3) & 15;
    const char* ab = (const char*)Abase; const unsigned aoff = (unsigned)((srow * NP + 8 * soct) * 2);
#pragma unroll
    for (int i = 0; i < 16; ++i) ar[i] = *(const u32x4*)(ab + ((rot + i) & 15) * 128 + aoff);
}
template <int SEGSHIFT>
__device__ __forceinline__ void p4_gemmT(f32x16 (&accT)[2][2], u32x4 (&ar)[16], const bf16* Anext  , const LAS float* rsc  , int nseg,
                                         const bf16* WF  , int nt0  , LAS unsigned char* lds, int tid, int lane) {
    const int srow = tid >> 3, soct = tid & 7, r = lane & 31, h = lane >> 5;
    const char* wb = (const char*)WF + (size_t)nt0 * 65536; const unsigned woff = (unsigned)(lane * 16);
    const int rot = ((int)blockIdx.x >> 3) & 15;
    bf16x8 wc[4][2];
    { const char* wk0 = wb + rot * 4096;
#pragma unroll
      for (int s = 0; s < 4; ++s) { wc[s][0] = *(const bf16x8*)(wk0 + s * 1024 + woff); wc[s][1] = *(const bf16x8*)(wk0 + 65536 + s * 1024 + woff); } }
#define P4_STAGE_WRITE(ki_) do { const int kc_ = ((ki_) + rot) & 15; const float sc = rsc[srow * nseg + ((kc_ * 64) >> SEGSHIFT)]; \
        u32x4 o; \
        o.x = pk2(bf_lo(ar[ki_].x) * sc, bf_hi(ar[ki_].x) * sc); o.y = pk2(bf_lo(ar[ki_].y) * sc, bf_hi(ar[ki_].y) * sc); \
        o.z = pk2(bf_lo(ar[ki_].z) * sc, bf_hi(ar[ki_].z) * sc); o.w = pk2(bf_lo(ar[ki_].w) * sc, bf_hi(ar[ki_].w) * sc); \
        *(LAS u32x4*)(lds + L4_ASTG + ((ki_) & 1) * 9216 + (srow * TP + 8 * soct) * 2) = o; } while (0)
    P4_STAGE_WRITE(0);
#pragma unroll
    for (int ki = 0; ki < 16; ++ki) {
        const int kc = (ki + rot) & 15;
        LAS unsigned char* stg = lds + L4_ASTG + (ki & 1) * 9216;
        __syncthreads();
        if (ki + 1 < 16) P4_STAGE_WRITE(ki + 1);
        const int kn = (kc + 1) & 15;
        const char* wk = wb + kn * 4096;
        bf16x8 a0 = *(const LAS bf16x8*)(stg + (r * TP + 8 * h) * 2), a1 = *(const LAS bf16x8*)(stg + ((32 + r) * TP + 8 * h) * 2);
#pragma unroll
        for (int s = 0; s < 4; ++s) {
            bf16x8 n0 = a0, n1 = a1;
            if (s < 3) { n0 = *(const LAS bf16x8*)(stg + (r * TP + 16 * (s + 1) + 8 * h) * 2); n1 = *(const LAS bf16x8*)(stg + ((32 + r) * TP + 16 * (s + 1) + 8 * h) * 2); }
            accT[0][0] = MFMA32(wc[s][0], a0, accT[0][0]); accT[0][1] = MFMA32(wc[s][1], a0, accT[0][1]);
            accT[1][0] = MFMA32(wc[s][0], a1, accT[1][0]); accT[1][1] = MFMA32(wc[s][1], a1, accT[1][1]);
            wc[s][0] = *(const bf16x8*)(wk + s * 1024 + woff); wc[s][1] = *(const bf16x8*)(wk + 65536 + s * 1024 + woff);
            __builtin_amdgcn_sched_barrier(0);
            a0 = n0; a1 = n1;
        }
    }
#undef P4_STAGE_WRITE
    p4_panel_load(ar, Anext, tid);
    __builtin_amdgcn_sched_barrier(0);
    __syncthreads();
}


__device__ __forceinline__ void tail_gemmT(f32x16 (&accT)[2], const bf16* Abase  , const bf16* WF  , int nt  , LAS unsigned char* lds, int tid, int lane) {
    const int srow = tid >> 3, soct = tid & 7, r = lane & 31, h = lane >> 5;
    const char* ab = (const char*)Abase; const unsigned aoff = (unsigned)((srow * 1024 + 8 * soct) * 2);
    const char* wb = (const char*)WF + (size_t)nt * 65536; const unsigned woff = (unsigned)(lane * 16);
    const int rot = ((int)blockIdx.x >> 3) & 15;
    u32x4 ar[16];
#pragma unroll
    for (int i = 0; i < 16; ++i) ar[i] = *(const u32x4*)(ab + ((rot + i) & 15) * 128 + aoff);
    bf16x8 wc[4];
    { const char* wk0 = wb + rot * 4096;
#pragma unroll
      for (int s = 0; s < 4; ++s) wc[s] = *(const bf16x8*)(wk0 + s * 1024 + woff); }
#pragma unroll
    for (int ki = 0; ki < 16; ++ki) {
        const int kc = (ki + rot) & 15;
        LAS unsigned char* stg = lds + L4_ASTG + (ki & 1) * 9216;
        *(LAS u32x4*)(stg + (srow * TP + 8 * soct) * 2) = ar[ki];
        __syncthreads();
        const char* wk = wb + ((kc + 1) & 15) * 4096;
#pragma unroll
        for (int s = 0; s < 4; ++s) {
            const bf16x8 a0 = *(const LAS bf16x8*)(stg + (r * TP + 16 * s + 8 * h) * 2), a1 = *(const LAS bf16x8*)(stg + ((32 + r) * TP + 16 * s + 8 * h) * 2);
            accT[0] = MFMA32(wc[s], a0, accT[0]); accT[1] = MFMA32(wc[s], a1, accT[1]);
            wc[s] = *(const bf16x8*)(wk + s * 1024 + woff);
            __builtin_amdgcn_sched_barrier(0);
        }
    }
    __syncthreads();
}

__device__ __forceinline__ void p4_phase(const Args& a, LAS unsigned char* lds, int tid_in, int lane_in, int wave, int G) {
    const bf16* PROJ = (const bf16*)(a.ws + WS_PROJ);
    const float* SSQM = (const float*)(a.ws + WS_SSQM); const float* SSQR = (const float*)(a.ws + WS_SSQR);
    const float* MOD = (const float*)(a.ws + WS_MOD);
    const bf16* WMF = (const bf16*)(a.ws + WS_WMF); const bf16* WRF = (const bf16*)(a.ws + WS_WRF); const bf16* WOF = (const bf16*)(a.ws + WS_WOF);
    const float* x = a.in[0]; const float* fw = a.in[15]; float* out = a.out;
    LAS float* RM = (LAS float*)(lds + L4_RM); LAS float* RR = (LAS float*)(lds + L4_RR); LAS float* RED = (LAS float*)(lds + L4_RED); LAS float* RS = (LAS float*)(lds + L4_RS);
    for (int blk = blockIdx.x; blk < 256; blk += G) {
        const size_t m0 = (size_t)blk * 64; const int b = blk >> 5;
        int lane = fresh_lane(), tid = wave * 64 + lane, r = lane & 31, h = lane >> 5;
        u32x4 ar[16];
        p4_panel_load(ar, PROJ + m0 * NP + C_Z, tid);
        __syncthreads();
        { const int row = tid >> 3, sub = tid & 7;
          const f32x4 qv = *(const f32x4*)(SSQR + (m0 + row) * 32 + 4 * sub);
          RR[row * 8 + sub] = 1.0f / sqrtf(((qv.x + qv.y) + (qv.z + qv.w)) * (1.f / 128.f) + EPS);
          if (sub < 2) { float s = 0.f;
#pragma unroll
              for (int i = 0; i < 4; ++i) { const f32x4 v = *(const f32x4*)(SSQM + (m0 + row) * 32 + 16 * sub + 4 * i); s += (v.x + v.y) + (v.z + v.w); }
              RM[row * 2 + sub] = 1.0f / sqrtf(s * (1.f / 512.f) + EPS); } }
        __syncthreads();
#ifndef P4_SKIP1
#ifndef P4_REP1
#define P4_REP1 1
#endif
        for (int nh_ = 0; nh_ < 2 * P4_REP1; ++nh_) {
            const int nh = nh_ & 1;
            lane = fresh_lane(); tid = wave * 64 + lane; r = lane & 31; h = lane >> 5;
            const int nt0 = 16 * nh + 2 * wave;
            const bf16* pblk = PROJ + m0 * NP;
            f32x16 accT[2][2];
#pragma unroll
            for (int i = 0; i < 2; ++i)
#pragma unroll
                for (int j = 0; j < 2; ++j)
#pragma unroll
                    for (int e = 0; e < 16; ++e) accT[i][j][e] = 0.f;
            u32x2 gpre[2][2][4];
            { const unsigned lo0 = (unsigned)((r * NP + 4 * h) * 2); const char* gb0 = (const char*)(pblk + C_GAM + 32 * nt0);
#pragma unroll
              for (int rt = 0; rt < 2; ++rt)
#pragma unroll
                  for (int ct = 0; ct < 2; ++ct)
#pragma unroll
                      for (int g4 = 0; g4 < 4; ++g4) gpre[rt][ct][g4] = *(const u32x2*)(gb0 + (lo0 + (unsigned)((32 * rt * NP + 32 * ct + 8 * g4) * 2)));
              __builtin_amdgcn_sched_barrier(0); }
            p4_gemmT<9>(accT, ar, pblk + C_GR, RM, 2, WMF, nt0, lds, tid, lane);
            {
                lane = fresh_lane(); r = lane & 31; h = lane >> 5;
                const unsigned lm = launder((unsigned)(L4_MERGED + (r * MP + 4 * h) * 2));
#pragma unroll
                for (int rt = 0; rt < 2; ++rt)
#pragma unroll
                    for (int ct = 0; ct < 2; ++ct)
#pragma unroll
                        for (int g4 = 0; g4 < 4; ++g4) {
                            const u32x2 gg = gpre[rt][ct][g4];
                            u32x2 ov; ov.x = pk2(accT[rt][ct][4 * g4] * sigm_f(bf_lo(gg.x)), accT[rt][ct][4 * g4 + 1] * sigm_f(bf_hi(gg.x)));
                            ov.y = pk2(accT[rt][ct][4 * g4 + 2] * sigm_f(bf_lo(gg.y)), accT[rt][ct][4 * g4 + 3] * sigm_f(bf_hi(gg.y)));
                            *(LAS u32x2*)(lds + lm + (unsigned)((32 * rt * MP + 32 * (nt0 + ct) + 8 * g4) * 2)) = ov; }
            }
#pragma unroll
            for (int i = 0; i < 2; ++i)
#pragma unroll
                for (int j = 0; j < 2; ++j)
#pragma unroll
                    for (int e = 0; e < 16; ++e) accT[i][j][e] = 0.f;
            lane = fresh_lane(); tid = wave * 64 + lane; r = lane & 31; h = lane >> 5;
            { const unsigned lo0 = (unsigned)((r * NP + 4 * h) * 2); const char* gb0 = (const char*)(pblk + C_GAR + 32 * nt0);
#pragma unroll
              for (int rt = 0; rt < 2; ++rt)
#pragma unroll
                  for (int ct = 0; ct < 2; ++ct)
#pragma unroll
                      for (int g4 = 0; g4 < 4; ++g4) gpre[rt][ct][g4] = *(const u32x2*)(gb0 + (lo0 + (unsigned)((32 * rt * NP + 32 * ct + 8 * g4) * 2)));
              __builtin_amdgcn_sched_barrier(0); }
            p4_gemmT<7>(accT, ar, pblk + C_Z, RR, 8, WRF, nt0, lds, tid, lane);
            {
                lane = fresh_lane(); r = lane & 31; h = lane >> 5;
                const unsigned lm = launder((unsigned)(L4_MERGED + (r * MP + 4 * h) * 2));
#pragma unroll
                for (int rt = 0; rt < 2; ++rt)
#pragma unroll
                    for (int ct = 0; ct < 2; ++ct)
#pragma unroll
                        for (int g4 = 0; g4 < 4; ++g4) {
                            const u32x2 gg = gpre[rt][ct][g4];
                            LAS u32x2* mp = (LAS u32x2*)(lds + lm + (unsigned)((32 * rt * MP + 32 * (nt0 + ct) + 8 * g4) * 2));
                            const u32x2 pm = *mp;
                            const float v0 = bf_lo(pm.x) + accT[rt][ct][4 * g4] * sigm_f(bf_lo(gg.x)), v1 = bf_hi(pm.x) + accT[rt][ct][4 * g4 + 1] * sigm_f(bf_hi(gg.x));
                            const float v2 = bf_lo(pm.y) + accT[rt][ct][4 * g4 + 2] * sigm_f(bf_lo(gg.y)), v3 = bf_hi(pm.y) + accT[rt][ct][4 * g4 + 3] * sigm_f(bf_hi(gg.y));
                            u32x2 ov; ov.x = pk2(v0, v1); ov.y = pk2(v2, v3);
                            *mp = ov; }
            }
        }
#endif
        __syncthreads();
        lane = fresh_lane(); tid = wave * 64 + lane; r = lane & 31; h = lane >> 5;
#ifndef P4_SKIP2
#ifndef P4_REP2
#define P4_REP2 1
#endif
        _Pragma("nounroll") for (int rep2_ = 0; rep2_ < P4_REP2; ++rep2_) {
            if (rep2_) { __syncthreads(); lane = fresh_lane(); tid = wave * 64 + lane; r = lane & 31; h = lane >> 5; }
            f32x16 acc[2][4];
#pragma unroll
            for (int i = 0; i < 2; ++i)
#pragma unroll
                for (int j = 0; j < 4; ++j)
#pragma unroll
                    for (int e = 0; e < 16; ++e) acc[i][j][e] = 0.f;
            const char* wb = (const char*)WOF + (size_t)(4 * wave) * 65536; const unsigned woff = (unsigned)(lane * 16);
            const int rot2 = ((int)blockIdx.x >> 3) & 31;
            bf16x8 wc[2][4];
#pragma unroll
            for (int s = 0; s < 2; ++s)
#pragma unroll
                for (int ct = 0; ct < 4; ++ct) wc[s][ct] = *(const bf16x8*)(wb + ct * 65536 + (2 * rot2 + s) * 1024 + woff);
            const LAS unsigned char* ma = lds + L4_MERGED + (r * MP + 8 * h) * 2;
            bf16x8 a0 = *(const LAS bf16x8*)(ma + (2 * rot2) * 32), a1 = *(const LAS bf16x8*)(ma + 32 * MP * 2 + (2 * rot2) * 32);
            for (int ki = 0; ki < 32; ++ki) {
                const int kp = (ki + rot2) & 31, kpn = (kp + 1) & 31;
#pragma unroll
                for (int s = 0; s < 2; ++s) {
                    const int ksn = (s == 0) ? 2 * kp + 1 : 2 * kpn;
                    const bf16x8 n0 = *(const LAS bf16x8*)(ma + ksn * 32), n1 = *(const LAS bf16x8*)(ma + 32 * MP * 2 + ksn * 32);
#pragma unroll
                    for (int ct = 0; ct < 4; ++ct) { acc[0][ct] = MFMA32(a0, wc[s][ct], acc[0][ct]); acc[1][ct] = MFMA32(a1, wc[s][ct], acc[1][ct]); }
#pragma unroll
                    for (int ct = 0; ct < 4; ++ct) wc[s][ct] = *(const bf16x8*)(wb + ct * 65536 + (2 * kpn + s) * 1024 + woff);
                    __builtin_amdgcn_sched_barrier(0);
                    a0 = n0; a1 = n1;
                }
            }
            lane = fresh_lane(); r = lane & 31; h = lane >> 5;
            const char* xblk = (const char*)(x + m0 * D); char* oblk = (char*)(out + m0 * D);
            const unsigned eo = launder((unsigned)(4 * (4 * h * D + 128 * wave + r)));
            const unsigned rb = launder((unsigned)(L4_RED + (4 * h * 8 + wave) * 4));
            float gate[4], fwv[4];
#pragma unroll
            for (int ct = 0; ct < 4; ++ct) { const int n = 32 * (4 * wave + ct) + r; gate[ct] = MOD[b * 3072 + 2048 + n]; fwv[ct] = fw[n]; }
            float xv[2][8][4];
#define P4_XLOAD(buf, bidx) do { _Pragma("unroll") for (int e = 0; e < 8; ++e) _Pragma("unroll") for (int ct = 0; ct < 4; ++ct) \
                xv[buf][e][ct] = __builtin_nontemporal_load((const float*)(xblk + (eo + (unsigned)(((32 * ((bidx) >> 1) + (e & 3) + 8 * (2 * ((bidx) & 1) + (e >> 2))) * D + 32 * ct) * 4)))); } while (0)
            P4_XLOAD(0, 0);
#pragma unroll
            for (int bi = 0; bi < 4; ++bi) {
                const int rt = bi >> 1, g8 = bi & 1;
                if (bi + 1 < 4) P4_XLOAD((bi + 1) & 1, bi + 1);
                __builtin_amdgcn_sched_barrier(0);
#pragma unroll
                for (int e = 0; e < 8; ++e) {
                    const int reg = 8 * g8 + e, rowc = 32 * rt + (reg & 3) + 8 * (reg >> 2);
                    float s = 0.f;
#pragma unroll
                    for (int ct = 0; ct < 4; ++ct) { const float v = xv[bi & 1][e][ct] + gate[ct] * acc[rt][ct][reg]; acc[rt][ct][reg] = v; s += v * v; }
                    s += __shfl_xor(s, 16); s += __shfl_xor(s, 8); s += __shfl_xor(s, 4); s += __shfl_xor(s, 2); s += __shfl_xor(s, 1);
                    *(LAS float*)(lds + rb + (unsigned)(rowc * 32)) = s;
                }
                asm volatile("" ::: "memory"); __builtin_amdgcn_sched_barrier(0);
            }
#undef P4_XLOAD
            __syncthreads();
            if (tid < 64) { float s = 0.f;
#pragma unroll
                for (int w = 0; w < 8; ++w) s += RED[tid * 8 + w];
                RS[tid] = 1.0f / sqrtf(s * (1.f / D) + EPS); }
            __syncthreads();
            const unsigned eo2 = launder(eo);
            const unsigned sb = launder((unsigned)(L4_RS + 4 * h * 4));
#pragma unroll
            for (int rt = 0; rt < 2; ++rt)
#pragma unroll
                for (int reg = 0; reg < 16; ++reg) {
                    const int rowc = 32 * rt + (reg & 3) + 8 * (reg >> 2); const float rs = *(const LAS float*)(lds + sb + (unsigned)(rowc * 4));
#pragma unroll
                    for (int ct = 0; ct < 4; ++ct) __builtin_nontemporal_store(acc[rt][ct][reg] * rs * fwv[ct], (float*)(oblk + (eo2 + (unsigned)((rowc * D + 32 * ct) * 4))));
                }
        }
#endif
    }
}

#define XB_TMO      128
#define XB_XCNT(j)  (256  + 64 * (j))
#define XB_XSUB(j)  (1280 + 64 * (j))
#define XB_XGEN(j)  (2304 + 64 * (j))
#define XB_TOP      3328
#define XB_TOPGEN   3392
#define XCD_BAR_WORDS 3456
#define XB_SPIN_CAP (1u << 18)

__device__ __forceinline__ unsigned xb_ld(unsigned* p)              { return __hip_atomic_load(p, __ATOMIC_RELAXED, __HIP_MEMORY_SCOPE_AGENT); }
__device__ __forceinline__ unsigned xb_add(unsigned* p, unsigned v) { return __hip_atomic_fetch_add(p, v, __ATOMIC_RELAXED, __HIP_MEMORY_SCOPE_AGENT); }
__device__ __forceinline__ unsigned xb_xcc_id() { return (unsigned)__builtin_amdgcn_s_getreg((3 << 11) | 20) & 0xFu; }
#define XB_SPIN(cond, bar) do { unsigned _sp = 0; while (cond) { __builtin_amdgcn_s_sleep(1); \
    if ((++_sp & 255u) == 0u) { if (xb_ld(&(bar)[XB_TMO])) break; if (_sp > XB_SPIN_CAP) { atomicAdd(&(bar)[XB_TMO], 1u); break; } } } } while (0)

struct XcdBarrier {
    unsigned* bar; unsigned x;
    volatile LAS unsigned* st;
};

__device__ __forceinline__ XcdBarrier xcd_barrier_post(unsigned* bar, volatile LAS unsigned* st, const int wave_) {
    XcdBarrier b; b.bar = bar; b.x = xb_xcc_id(); b.st = st;
    if (wave_ == 0 && fresh_lane() == 0) (void)xb_add(&bar[XB_XCNT(b.x)], 1u);
    return b;
}
__device__ __forceinline__ void xcd_barrier_complete(unsigned* bar, unsigned x, unsigned& nloc, unsigned& nx) {
    const unsigned G = gridDim.x * gridDim.y * gridDim.z;
    unsigned sum, cnt, mine, sp = 0u;
    for (;;) {
        sum = 0u; cnt = 0u; mine = 0u;
#pragma unroll
        for (unsigned j = 0; j < 16; ++j) { const unsigned c = xb_ld(&bar[XB_XCNT(j)]); sum += c; cnt += (c > 0u) ? 1u : 0u; mine = (j == x) ? c : mine; }
        if (sum == G) break;
        __builtin_amdgcn_s_sleep(1);
        if ((++sp & 255u) == 0u) { if (xb_ld(&bar[XB_TMO])) break; if (sp > XB_SPIN_CAP) { atomicAdd(&bar[XB_TMO], 1u); break; } }
    }
    nloc = mine > 0u ? mine : 1u; nx = cnt > 0u ? cnt : 1u;
}

__device__ __forceinline__ void xcd_barrier(const XcdBarrier& b, const int wave_) {
    asm volatile("s_waitcnt vmcnt(0)" ::: "memory");
    __syncthreads();
    if (wave_ == 0 && fresh_lane() == 0) {
        unsigned* bar = b.bar;
        __builtin_amdgcn_s_waitcnt(0);
        unsigned nloc = b.st[0], nx = b.st[1];
        if (nloc == 0u) { xcd_barrier_complete(bar, b.x, nloc, nx); b.st[0] = nloc; b.st[1] = nx; }
        const unsigned old = xb_add(&bar[XB_XSUB(b.x)], 1u);
        const unsigned gen = old / nloc;
        if (old + 1u == (gen + 1u) * nloc) {
            __builtin_amdgcn_fence(__ATOMIC_RELEASE, "agent");
            asm volatile("s_waitcnt vmcnt(0)" ::: "memory");
            const unsigned og = xb_add(&bar[XB_TOP], 1u);
            const unsigned tg = og / nx;
            if (og + 1u == (tg + 1u) * nx) xb_add(&bar[XB_TOPGEN], 1u);
            else XB_SPIN(xb_ld(&bar[XB_TOPGEN]) == tg, bar);
            __builtin_amdgcn_fence(__ATOMIC_ACQUIRE, "agent");
            xb_add(&bar[XB_XGEN(b.x)], 1u);
            asm volatile("s_waitcnt vmcnt(0)" ::: "memory");
        } else {
            XB_SPIN(xb_ld(&bar[XB_XGEN(b.x)]) == gen, bar);
            __builtin_amdgcn_fence(__ATOMIC_ACQUIRE, "agent");
            asm volatile("s_waitcnt vmcnt(0)" ::: "memory");
        }
    }
    __syncthreads();
}

#ifdef SELF_CLEAN_BARRIER
__device__ unsigned g_bar[4096];
#endif
__global__ void __launch_bounds__(NTHR, 2) hybrid_fwd(Args args) {
    extern __shared__ __attribute__((aligned(16))) unsigned char lds_raw[];
    LAS unsigned char* lds = (LAS unsigned char*)lds_raw;
    const int wave = __builtin_amdgcn_readfirstlane((int)threadIdx.x >> 6), G = gridDim.x; const int tid = 0, lane = 0;
    cg::grid_group grid = cg::this_grid();
    volatile LAS unsigned* misc = (volatile LAS unsigned*)(lds + LDS_MISC);
    if (threadIdx.x < 2) misc[threadIdx.x] = 0u;
    __syncthreads();
    if (args.ph_lo < 0) grid.sync();
    #ifdef SELF_CLEAN_BARRIER
    XcdBarrier xbar = xcd_barrier_post(g_bar, misc, wave);
#else
    XcdBarrier xbar = xcd_barrier_post((unsigned*)(args.ws + WS_CTL), misc, wave);
#endif
    const int lo = args.ph_lo, hi = args.ph_hi;
#ifndef PHMASK
#define PHMASK 31
#endif
#define IN(k) (((PHMASK >> (k)) & 1) && lo <= (k) && (k) < hi)
#define SEAM(k) do { if (IN(k) && IN((k) + 1)) xcd_barrier(xbar, wave); } while (0)
#ifndef REPEAT_MASK
#define REPEAT_MASK 0
#endif
#ifdef PROBE_PH
    unsigned long long pt0_ = 0ull; unsigned pacc_ = 0u;
#define PB(k) do { if (PROBE_PH == (k)) pt0_ = __builtin_amdgcn_s_memrealtime(); } while (0)
#define PE(k) do { if (PROBE_PH == (k)) pacc_ += (unsigned)(__builtin_amdgcn_s_memrealtime() - pt0_); } while (0)
#else
#define PB(k) do {} while (0)
#define PE(k) do {} while (0)
#endif
    PB(20);
#define REP(k) _Pragma("nounroll") for (int rep_ = 0; rep_ < 1 + ((REPEAT_MASK >> (k)) & 1); ++rep_)
#ifdef EXTRA_SYNCS
    for (int es_ = 0; es_ < EXTRA_SYNCS; ++es_) xcd_barrier(xbar, wave);
#endif
    PB(0);
    if (IN(0)) REP(0) { if (rep_) xcd_barrier(xbar, wave); p0_phase(args, lds, tid, lane, wave, G); }
    PE(0); PB(10); __syncthreads();   PE(10); PB(1);
    if (IN(1)) REP(1) { if (rep_) xcd_barrier(xbar, wave); p1_phase(args, lds, tid, lane, wave, G); }
    PE(1); PB(11); SEAM(1); PE(11); PB(2);
    if (IN(2)) REP(2) {
        if (rep_) xcd_barrier(xbar, wave);
        __syncthreads();
        pg8::Gemm g{(const pg8::bf16_t*)((const unsigned char*)args.out + OUT_H), (const pg8::bf16_t*)((const unsigned char*)args.out + OUT_WINT), MTOK, NP_MAIN, D};
        pg8::StaticOrder S; S.init(MTOK, NP_MAIN, G, (int)blockIdx.x);
        pg8::EpiProj E{(pg8::bf16_t*)(args.ws + WS_PROJ), NP};
        pg8::gemm_phase<pg8::EpiProj, pg8::StaticOrder, true, true>(lds, g, S, E, wave);
        for (int blk = blockIdx.x; blk < 256; blk += G) {
            const int lane_ = fresh_lane(), tid_ = wave * 64 + lane_;
            f32x16 accT[2];
#pragma unroll
            for (int i = 0; i < 2; ++i)
#pragma unroll
                for (int e = 0; e < 16; ++e) accT[i][e] = 0.f;
            tail_gemmT(accT, (const bf16*)((const unsigned char*)args.out + OUT_H) + (size_t)blk * 64 * 1024, (const bf16*)(args.ws + WS_WTF), wave, lds, tid_, lane_);
            const int l2 = fresh_lane(), r2 = l2 & 31, h2 = l2 >> 5;
            bf16* prow = (bf16*)(args.ws + WS_PROJ) + ((size_t)blk * 64 + r2) * NP + NP_MAIN + 32 * wave + 4 * h2;
#pragma unroll
            for (int rt = 0; rt < 2; ++rt)
#pragma unroll
                for (int g4 = 0; g4 < 4; ++g4) { u32x2 ov; ov.x = pk2(accT[rt][4 * g4], accT[rt][4 * g4 + 1]); ov.y = pk2(accT[rt][4 * g4 + 2], accT[rt][4 * g4 + 3]);
                    *(u32x2*)(prow + (size_t)rt * 32 * NP + 8 * g4) = ov; }
        }
    }
    PE(2); PB(12); SEAM(2); PE(12); PB(3);
    if (IN(3)) { p3a_phase(args, wave, G); PE(3); PB(13); xcd_barrier(xbar, wave); PE(13); PB(4); if ((REPEAT_MASK >> 3) & 1) { p3_phase(args, lds, tid, lane, wave, G, true); xcd_barrier(xbar, wave); } p3_phase(args, lds, tid, lane, wave, G); }
    PE(4); PB(14); SEAM(3); PE(14); PB(5);
    if (IN(4)) REP(4) { if (rep_) xcd_barrier(xbar, wave); p4_phase(args, lds, tid, lane, wave, G); }
#undef REP
    PE(5); PE(20);
#if defined(SELF_CLEAN_BARRIER) && !defined(PROBE_PH)
    {
        __syncthreads();
        if (wave == 0) {
            const int l_ = fresh_lane();
            unsigned last_ = 0u;
            if (l_ == 0) last_ = (__hip_atomic_fetch_add(&g_bar[4032], 1u, __ATOMIC_RELAXED, __HIP_MEMORY_SCOPE_AGENT) == (unsigned)G - 1u) ? 1u : 0u;
            last_ = (unsigned)__builtin_amdgcn_readfirstlane((int)last_);
            if (last_) {
                if (l_ < 16) { __hip_atomic_store(&g_bar[XB_XCNT(l_)], 0u, __ATOMIC_RELAXED, __HIP_MEMORY_SCOPE_AGENT); __hip_atomic_store(&g_bar[XB_XSUB(l_)], 0u, __ATOMIC_RELAXED, __HIP_MEMORY_SCOPE_AGENT); __hip_atomic_store(&g_bar[XB_XGEN(l_)], 0u, __ATOMIC_RELAXED, __HIP_MEMORY_SCOPE_AGENT); }
                if (l_ == 16) { __hip_atomic_store(&g_bar[XB_TOP], 0u, __ATOMIC_RELAXED, __HIP_MEMORY_SCOPE_AGENT); __hip_atomic_store(&g_bar[XB_TOPGEN], 0u, __ATOMIC_RELAXED, __HIP_MEMORY_SCOPE_AGENT);
                                __hip_atomic_store(&g_bar[XB_TMO], 0u, __ATOMIC_RELAXED, __HIP_MEMORY_SCOPE_AGENT); __hip_atomic_store(&g_bar[4032], 0u, __ATOMIC_RELAXED, __HIP_MEMORY_SCOPE_AGENT); }
            }
        }
    }
#endif
#ifdef PROBE_PH
    if (blockIdx.x == PROBE_PBLK && wave == 0 && fresh_lane() == 0) ((unsigned*)(args.ws + WS_CTL))[4001] = pacc_;
    if (blockIdx.x == 0) { xcd_barrier(xbar, wave); } else { xcd_barrier(xbar, wave); }
    if (blockIdx.x == 0 && wave == 0 && fresh_lane() == 0) { asm volatile("s_waitcnt vmcnt(0)" ::: "memory"); args.out[0] = 50.0f * floorf(0.01f * (float)__hip_atomic_load((unsigned*)(args.ws + WS_CTL) + 4001, __ATOMIC_RELAXED, __HIP_MEMORY_SCOPE_AGENT) / 50.0f + 0.5f); }
#endif
#ifdef PROBE_SEL
    if (blockIdx.x == 0 && wave == 0 && fresh_lane() == 0) { asm volatile("s_waitcnt vmcnt(0)" ::: "memory"); args.out[0] = 0.01f * (float)((volatile unsigned*)(args.ws + WS_CTL))[4000]; }
#endif
#undef IN
#undef SEAM
}

extern "C" void kernel_launch(void* const* d_in, const int* in_sizes, int n_in, void* d_out, int out_size, void* d_ws, size_t ws_size, hipStream_t stream) {
    static int grid = 0;
    if (grid == 0) {
        if (n_in != 16 || out_size != MTOK * D || ws_size < WS_END) { fprintf(stderr, "kernel_launch: unexpected shapes (n_in %d out %d ws %zu)\n", n_in, out_size, ws_size); grid = -1; return; }
        int dev = 0, cus = 0, per_cu = 0;
        (void)hipGetDevice(&dev);
        (void)hipDeviceGetAttribute(&cus, hipDeviceAttributeMultiprocessorCount, dev);
        if (hipFuncSetAttribute((const void*)hybrid_fwd, hipFuncAttributeMaxDynamicSharedMemorySize, LDS_BYTES) != hipSuccess) { fprintf(stderr, "kernel_launch: hipFuncSetAttribute failed\n"); grid = -1; return; }
        if (hipOccupancyMaxActiveBlocksPerMultiprocessor(&per_cu, (const void*)hybrid_fwd, NTHR, LDS_BYTES) != hipSuccess || per_cu < 1) { fprintf(stderr, "kernel_launch: occupancy query says %d\n", per_cu); per_cu = 1; }
        (void)hipGetLastError();
        grid = cus * per_cu;
        if (grid > 256) grid = 256;
        if (grid < 1) grid = 1;
    }
    if (grid < 0) return;
#ifndef SELF_CLEAN_BARRIER
    if (hipMemsetAsync((char*)d_ws + WS_CTL, 0, CTL_BYTES, stream) != hipSuccess) { fprintf(stderr, "kernel_launch: memset of the barrier words failed\n"); return; }
#endif
    Args a{};
    for (int i = 0; i < 16; ++i) a.in[i] = (const float*)d_in[i];
    a.out = (float*)d_out; a.ws = (unsigned char*)d_ws;
#if N_LAUNCHES == 1
    a.ph_lo = 0; a.ph_hi = NPH;
    void* kargs[] = {&a};
    hipError_t e = hipLaunchCooperativeKernel((const void*)hybrid_fwd, dim3(grid), dim3(NTHR), kargs, LDS_BYTES, stream);
    if (e != hipSuccess) fprintf(stderr, "kernel_launch: cooperative launch failed: %s (grid %d)\n", hipGetErrorString(e), grid);
#else
    for (int p = 0; p < NPH; ++p) {
        a.ph_lo = p; a.ph_hi = p + 1;
        hipLaunchKernelGGL(hybrid_fwd, dim3(grid), dim3(NTHR), LDS_BYTES, stream, a);
    }
#endif
}
```

```cpp
#include <hip/hip_runtime.h>
#include <hip/hip_cooperative_groups.h>
#include <cstdio>
#include <cstdint>
namespace cg = cooperative_groups;
#define N_LAUNCHES 1
#define REPEAT_MASK 0
#define P4_REP2 1
__device__ __forceinline__ unsigned launder(unsigned v) { asm volatile("" : "+v"(v)); return v; }
__device__ __forceinline__ int fresh_lane() { unsigned z; asm volatile("v_mov_b32 %0, 0" : "=v"(z)); return (int)__builtin_amdgcn_mbcnt_hi(~0u, __builtin_amdgcn_mbcnt_lo(~0u, z)); }
namespace pg8 {
#define PG8_LAS __attribute__((address_space(3)))
typedef unsigned short bf16_t;
typedef short bf16x8 __attribute__((ext_vector_type(8)));
typedef float f32x4 __attribute__((ext_vector_type(4)));
typedef unsigned u32x4 __attribute__((ext_vector_type(4)));
constexpr int BM = 256, BK = 64, HALF = 128, HTB = HALF * BK * 2  , STAGE_BYTES = 8 * HTB, NXCD = 8, WGM = 8;

__host__ __device__ __forceinline__ int lds_byte(int r, int c) { const int st = (r >> 4) * 2 + (c >> 5), rr = r & 15, cc = c & 31, ob = rr * 64 + cc * 2; return st * 1024 + (ob ^ (((ob >> 9) & 1) << 5)); }
__host__ __device__ __forceinline__ void stage_rc(int b, int& R, int& C) { const int st = b / 1024, sb = b % 1024, swz = sb ^ (((sb >> 9) & 1) << 5); R = (st >> 1) * 16 + swz / 64; C = (st & 1) * 32 + (swz % 64) / 2; }
__host__ __device__ __forceinline__ int perm32(int rho) { const int n = rho >> 4, i = rho & 15; return 8 * (i >> 2) + 4 * n + (i & 3); }

struct Unit { int pm, pn; };
struct Gemm { const bf16_t* A; const bf16_t* Bt; int M, N, K; };

struct StaticOrder {
    int nM, nN, nwg, G, c;
    __host__ __device__ void init(int M, int N, int G_, int c_) { nM = M / BM; nN = N / BM; nwg = nM * nN; G = G_; c = c_; }
    __host__ __device__ bool next(int i, Unit& u) const {
        const long L = (long)i * G + c; if (L >= nwg) return false;
        int wgid = (int)L; { const int q = nwg / NXCD, r = nwg % NXCD, xcd = wgid % NXCD, off = wgid / NXCD; wgid = (xcd < r ? xcd * (q + 1) : r * (q + 1) + (xcd - r) * q) + off; }
        const int nig = WGM * nN, gid = wgid / nig, fm = gid * WGM, gsz = (nM - fm) < WGM ? (nM - fm) : WGM;
        u.pm = fm + ((wgid % nig) % gsz); u.pn = (wgid % nig) / gsz; return true;
    }
    __device__ __forceinline__ void a_ready(const Unit&) const {}
    __device__ __forceinline__ void done(const Unit&) const {}
};
__device__ __forceinline__ unsigned cvt_pk_bf16(float lo, float hi) { unsigned r; asm volatile("v_cvt_pk_bf16_f32 %0, %1, %2" : "=v"(r) : "v"(lo), "v"(hi)); return r; }
struct EpiProj {
    static constexpr bool PERM = true, AFTER_DRAIN = false;
    bf16_t* O; int ldc;
    __device__ __forceinline__ void operator()(const f32x4 (&acc)[2][2][4][2], const Unit& u, int wr, int wc, int fr, int fq) const {
        const int row0 = u.pm * BM + wr * 64 + fr; const int col0 = u.pn * BM + wc * 32 + 8 * fq;
#pragma unroll
        for (int ai = 0; ai < 2; ++ai)
#pragma unroll
            for (int m = 0; m < 4; ++m) { bf16_t* rowp = O + (size_t)(row0 + ai * HALF + m * 16) * ldc + col0;
#pragma unroll
                for (int bj = 0; bj < 2; ++bj) { const f32x4 v0 = acc[ai][bj][m][0], v1 = acc[ai][bj][m][1];
                    u32x4 w; w.x = cvt_pk_bf16(v0[0], v0[1]); w.y = cvt_pk_bf16(v0[2], v0[3]); w.z = cvt_pk_bf16(v1[0], v1[1]); w.w = cvt_pk_bf16(v1[2], v1[3]);
                    __builtin_nontemporal_store(w, (u32x4*)(rowp + bj * HALF)); } }
    }
    __device__ __forceinline__ void fused(f32x4 (&)[2][2][4][2], const Unit&, int, int, int, int, PG8_LAS unsigned char*, int, int) const {}
};
template <class Epi, class Sched, bool ALIGN_EPI = false, bool SP2 = false>
__device__ __forceinline__ void gemm_phase(PG8_LAS unsigned char* lds, const Gemm g, const Sched& S, const Epi& E, const int wid) {
    const int lane = ::fresh_lane(), tid = wid * 64 + lane, wr = wid >> 2, wc = wid & 3, fr = lane & 15, fq = lane >> 4;
    const int K = g.K, nt = K / BK;
    unsigned voffA[2], voffB[2];
#pragma unroll
    for (int i = 0; i < 2; ++i) { int R, C; stage_rc(tid * 16 + i * 8192, R, C); const int Rb = Epi::PERM ? ((R & ~31) + perm32(R & 31)) : R;
        voffA[i] = (unsigned)(R * K + C) * 2u; voffB[i] = (unsigned)(Rb * K + C) * 2u; }
    const size_t kstep = (size_t)(BK * 2);
    const size_t hstep = (size_t)HALF * K * 2;
    const size_t tstep = 2 * hstep;
    const unsigned ldsw = (unsigned)wid * 1024u;
    const int aoff = lds_byte(wr * 64 + fr, fq * 8), boff = lds_byte(wc * 32 + fr, fq * 8);
#define PG8_SA(b, h) (((b) * 2 + (h)) * HTB)
#define PG8_SB(b, h) ((4 + (b) * 2 + (h)) * HTB)
#define PG8_STAGE(bufoff, gbase, voff) do { _Pragma("unroll") for (int _i = 0; _i < 2; ++_i) \
        __builtin_amdgcn_global_load_lds((const unsigned*)((const char*)(gbase) + (voff)[_i]), (PG8_LAS unsigned*)(lds + (bufoff) + ldsw + _i * 8192), 16, 0, 0); } while (0)
#define PG8_LDA(dst, b, h) do { _Pragma("unroll") for (int m = 0; m < 4; ++m) _Pragma("unroll") for (int k = 0; k < 2; ++k) dst[m][k] = *(const PG8_LAS bf16x8*)(lds + PG8_SA(b, h) + aoff + m * 2048 + k * 1024); } while (0)
#define PG8_LDB(dst, b, h) do { _Pragma("unroll") for (int n = 0; n < 2; ++n) _Pragma("unroll") for (int k = 0; k < 2; ++k) dst[n][k] = *(const PG8_LAS bf16x8*)(lds + PG8_SB(b, h) + boff + n * 2048 + k * 1024); } while (0)
#define PG8_MMA(ai, bj, At, Bt) do { __builtin_amdgcn_s_setprio(1); _Pragma("unroll") for (int m = 0; m < 4; ++m) _Pragma("unroll") for (int n = 0; n < 2; ++n) _Pragma("unroll") for (int k = 0; k < 2; ++k) \
        acc[ai][bj][m][n] = __builtin_amdgcn_mfma_f32_16x16x32_bf16(Bt[n][k], At[m][k], acc[ai][bj][m][n], 0, 0, 0); __builtin_amdgcn_s_setprio(0); } while (0)
#define PG8_WAIT_V(n) asm volatile("s_waitcnt vmcnt(" #n ")" ::: "memory")
#define PG8_WAIT_L(n) asm volatile("s_waitcnt lgkmcnt(" #n ")" ::: "memory")
#define PG8_BAR __builtin_amdgcn_s_barrier()
#define PG8_SCHED __builtin_amdgcn_sched_barrier(0)
    Unit cur, nxt; int ui = 0;
    if (!S.next(0, cur)) return;
    f32x4 acc[2][2][4][2];
#pragma unroll
    for (int a = 0; a < 2; ++a)
#pragma unroll
        for (int b = 0; b < 2; ++b)
#pragma unroll
            for (int m = 0; m < 4; ++m)
#pragma unroll
                for (int n = 0; n < 2; ++n) acc[a][b][m][n] = (f32x4){0.f, 0.f, 0.f, 0.f};
    bf16x8 At[4][2], B0[2][2], B1[2][2];
    const char* cA = (const char*)g.A + (size_t)cur.pm * tstep; const char* cB = (const char*)g.Bt + (size_t)cur.pn * tstep;
    S.a_ready(cur);
    if constexpr (SP2) {
        PG8_STAGE(PG8_SB(0, 0), cB, voffB); PG8_STAGE(PG8_SB(0, 1), cB + hstep, voffB); PG8_STAGE(PG8_SA(0, 0), cA, voffA); PG8_STAGE(PG8_SA(0, 1), cA + hstep, voffA);
        if (wr == 1) PG8_BAR;
        PG8_WAIT_V(2); PG8_BAR;
        PG8_STAGE(PG8_SB(1, 0), cB + kstep, voffB); PG8_STAGE(PG8_SA(1, 0), cA + kstep, voffA); PG8_STAGE(PG8_SB(1, 1), cB + hstep + kstep, voffB);
        PG8_WAIT_V(6); PG8_BAR;
    } else {
        PG8_STAGE(PG8_SB(0, 0), cB, voffB); PG8_STAGE(PG8_SA(0, 0), cA, voffA); PG8_STAGE(PG8_SB(0, 1), cB + hstep, voffB); PG8_STAGE(PG8_SA(0, 1), cA + hstep, voffA);
        if (wr == 1) PG8_BAR;
        PG8_WAIT_V(4); PG8_BAR;
        PG8_STAGE(PG8_SB(1, 0), cB + kstep, voffB); PG8_STAGE(PG8_SA(1, 0), cA + kstep, voffA); PG8_STAGE(PG8_SB(1, 1), cB + hstep + kstep, voffB);
        PG8_WAIT_V(6); PG8_BAR;
    }
    for (;;) {
        const bool has_next = S.next(ui + 1, nxt);
        const char* nA = has_next ? (const char*)g.A + (size_t)nxt.pm * tstep : cA; const char* nB = has_next ? (const char*)g.Bt + (size_t)nxt.pn * tstep : cB;
        for (int t = 0; t < nt; t += 2) {
            const bool last = (t == nt - 2);
            const char* a1 = cA + (size_t)(t + 1) * kstep;
            const char* a2 = last ? nA : cA + (size_t)(t + 2) * kstep; const char* b2 = last ? nB : cB + (size_t)(t + 2) * kstep;
            const char* a3 = a2 + kstep; const char* b3 = b2 + kstep;
            if (last && has_next) S.a_ready(nxt);
            if constexpr (SP2) {
            PG8_LDB(B0, 0, 0); PG8_LDB(B1, 0, 1); PG8_SCHED; PG8_LDA(At, 0, 0); PG8_STAGE(PG8_SA(1, 1), a1 + hstep, voffA);
            PG8_WAIT_V(8); PG8_WAIT_L(0); PG8_BAR; PG8_MMA(0, 0, At, B0); PG8_MMA(0, 1, At, B1); PG8_BAR; PG8_SCHED;
            PG8_LDA(At, 0, 1); PG8_STAGE(PG8_SB(0, 0), b2, voffB); PG8_STAGE(PG8_SB(0, 1), b2 + hstep, voffB); PG8_STAGE(PG8_SA(0, 0), a2, voffA);
            PG8_WAIT_V(8); PG8_WAIT_L(0); PG8_BAR; PG8_MMA(1, 0, At, B0); PG8_MMA(1, 1, At, B1); PG8_BAR; PG8_SCHED;
            PG8_LDB(B0, 1, 0); PG8_LDB(B1, 1, 1); PG8_SCHED; PG8_LDA(At, 1, 0); PG8_STAGE(PG8_SA(0, 1), a2 + hstep, voffA);
            PG8_WAIT_V(8); PG8_WAIT_L(0); PG8_BAR; PG8_MMA(0, 0, At, B0); PG8_MMA(0, 1, At, B1); PG8_BAR; PG8_SCHED;
            PG8_LDA(At, 1, 1); PG8_STAGE(PG8_SB(1, 0), b3, voffB); PG8_STAGE(PG8_SB(1, 1), b3 + hstep, voffB); PG8_STAGE(PG8_SA(1, 0), a3, voffA);
            PG8_WAIT_V(8); PG8_WAIT_L(0); PG8_BAR; PG8_MMA(1, 0, At, B0); PG8_MMA(1, 1, At, B1); PG8_BAR; PG8_SCHED;
            } else {
            PG8_LDB(B0, 0, 0); PG8_SCHED; PG8_LDA(At, 0, 0); PG8_STAGE(PG8_SA(1, 1), a1 + hstep, voffA);
            PG8_WAIT_L(8); PG8_BAR; PG8_WAIT_L(0); PG8_MMA(0, 0, At, B0); PG8_BAR; PG8_SCHED;
            PG8_LDB(B1, 0, 1); PG8_STAGE(PG8_SB(0, 0), b2, voffB);
            PG8_BAR; PG8_WAIT_L(0); PG8_MMA(0, 1, At, B1); PG8_BAR;
            PG8_LDA(At, 0, 1); PG8_STAGE(PG8_SA(0, 0), a2, voffA);
            PG8_BAR; PG8_WAIT_L(0); PG8_MMA(1, 0, At, B0); PG8_BAR; PG8_SCHED;
            PG8_STAGE(PG8_SB(0, 1), b2 + hstep, voffB);
            PG8_WAIT_V(6); PG8_BAR; PG8_MMA(1, 1, At, B1); PG8_BAR;
            PG8_LDB(B0, 1, 0); PG8_SCHED; PG8_LDA(At, 1, 0); PG8_STAGE(PG8_SA(0, 1), a2 + hstep, voffA);
            PG8_WAIT_L(8); PG8_BAR; PG8_WAIT_L(0); PG8_MMA(0, 0, At, B0); PG8_BAR; PG8_SCHED;
            PG8_LDB(B1, 1, 1); PG8_STAGE(PG8_SB(1, 0), b3, voffB);
            PG8_BAR; PG8_WAIT_L(0); PG8_MMA(0, 1, At, B1); PG8_BAR;
            PG8_LDA(At, 1, 1); PG8_STAGE(PG8_SA(1, 0), a3, voffA);
            PG8_BAR; PG8_WAIT_L(0); PG8_MMA(1, 0, At, B0); PG8_BAR; PG8_SCHED;
            PG8_STAGE(PG8_SB(1, 1), b3 + hstep, voffB);
            PG8_WAIT_V(6); PG8_BAR; PG8_MMA(1, 1, At, B1); PG8_BAR;
            }
        }
        if constexpr (ALIGN_EPI) { if (wr == 0) PG8_BAR; }
        if constexpr (!Epi::AFTER_DRAIN) { E(acc, cur, wr, wc, fr, fq); S.done(cur); }
        if (!has_next) break;
#pragma unroll
        for (int a = 0; a < 2; ++a)
#pragma unroll
            for (int b = 0; b < 2; ++b)
#pragma unroll
                for (int m = 0; m < 4; ++m)
#pragma unroll
                    for (int n = 0; n < 2; ++n) acc[a][b][m][n] = (f32x4){0.f, 0.f, 0.f, 0.f};
        cur = nxt; cA = nA; cB = nB; ++ui;
        if constexpr (ALIGN_EPI) { if (wr == 1) PG8_BAR; }
    }
    PG8_WAIT_V(0);
    if constexpr (!ALIGN_EPI) { if (wr == 0) PG8_BAR; }
    PG8_BAR;
    if constexpr (Epi::AFTER_DRAIN) { E.fused(acc, cur, wr, wc, fr, fq, lds, wid, lane); S.done(cur); }
#undef PG8_SA
#undef PG8_SB
#undef PG8_STAGE
#undef PG8_LDA
#undef PG8_LDB
#undef PG8_MMA
#undef PG8_WAIT_V
#undef PG8_WAIT_L
#undef PG8_BAR
#undef PG8_SCHED
}
}

#define LAS __attribute__((address_space(3)))
typedef unsigned short bf16;
typedef short bf16x8 __attribute__((ext_vector_type(8)));
typedef short s16x4 __attribute__((ext_vector_type(4)));
typedef float f32x4 __attribute__((ext_vector_type(4)));
typedef float f32x16 __attribute__((ext_vector_type(16)));
typedef unsigned u32x4 __attribute__((ext_vector_type(4)));
typedef unsigned u32x2 __attribute__((ext_vector_type(2)));
typedef float f32x2_t __attribute__((ext_vector_type(2)));
typedef __bf16 bf16x2_t __attribute__((ext_vector_type(2)));

#ifndef N_LAUNCHES
#define N_LAUNCHES 1
#endif
constexpr int NPH = 5;
constexpr int D = 1024, NB = 8, SEQ = 2048, MTOK = NB * SEQ, NIN = 7440, NP = 7424, NP_MAIN = 7168;
constexpr int C_Z = 0, C_X = 1024, C_B = 2048, C_C = 2176, C_Q = 2304, C_K = 2816, C_V = 3328, C_GR = 4352, C_GAM = 5376, C_GAR = 6400;
constexpr float EPS = 1e-6f;
constexpr size_t MiB = 1u << 20;
constexpr size_t WS_PROJ = 0;
constexpr size_t WS_WMF = 232 * MiB, WS_WRF = 234 * MiB, WS_WOF = 236 * MiB;
constexpr size_t WS_MOD = 238 * MiB;
constexpr size_t WS_DT = 239 * MiB;
constexpr size_t WS_SSQM = 240 * MiB;
constexpr size_t WS_SSQR = 242 * MiB;
constexpr int CW_MODCNT = 3900;
constexpr size_t WS_CTL = 244 * MiB, CTL_BYTES = 16384;
constexpr size_t WS_WTF = 245 * MiB;
constexpr size_t WS_END = 246 * MiB;
constexpr size_t OUT_H = 0, OUT_WINT = 32 * MiB;
constexpr int LDS_BYTES = 155648, LDS_MISC = 155520;
constexpr int NTHR = 512;

struct Args { const float* in[16]; float* out; unsigned char* ws; int ph_lo, ph_hi; };

__device__ __forceinline__ float bf_lo(unsigned u) { return __uint_as_float(u << 16); }
__device__ __forceinline__ float bf_hi(unsigned u) { return __uint_as_float(u & 0xffff0000u); }
__device__ __forceinline__ unsigned pk2(float lo, float hi) { f32x2_t v = {lo, hi}; bf16x2_t b = __builtin_convertvector(v, bf16x2_t); return __builtin_bit_cast(unsigned, b); }
__device__ __forceinline__ float silu_f(float x) { return x * __builtin_amdgcn_rcpf(1.f + __expf(-x)); }
__device__ __forceinline__ float sigm_f(float x) { return __builtin_amdgcn_rcpf(1.f + __expf(-x)); }
__device__ __forceinline__ float wave_sum(float v) {
#pragma unroll
    for (int o = 1; o < 64; o <<= 1) v += __shfl_xor(v, o);
    return v;
}
__device__ __forceinline__ int crow(int reg, int h) { return (reg & 3) + 8 * (reg >> 2) + 4 * h; }
#define MFMA32(a, b, c) __builtin_amdgcn_mfma_f32_32x32x16_bf16((a), (b), (c), 0, 0, 0)
#define MFMA16(a, b, c) __builtin_amdgcn_mfma_f32_16x16x32_bf16((a), (b), (c), 0, 0, 0)
__device__ __forceinline__ s16x4 tr_read(const LAS unsigned char* p) {
    typedef short v4i16_t __attribute__((ext_vector_type(4)));
    return __builtin_bit_cast(s16x4, __builtin_amdgcn_ds_read_tr16_b64_v4i16((LAS v4i16_t*)p));
}
__device__ __forceinline__ bf16x8 tr_pair(const LAS unsigned char* plo, const LAS unsigned char* phi) {
    const s16x4 lo = tr_read(plo), hi = tr_read(phi);
    return __builtin_shufflevector(lo, hi, 0, 1, 2, 3, 4, 5, 6, 7);
}
__device__ __forceinline__ bf16x8 pack8(float a0, float a1, float a2, float a3, float a4, float a5, float a6, float a7) {
    u32x4 p; p.x = pk2(a0, a1); p.y = pk2(a2, a3); p.z = pk2(a4, a5); p.w = pk2(a6, a7);
    return __builtin_bit_cast(bf16x8, p);
}

__device__ __forceinline__ void p0_load_tile(const float* W, int ldw, int k0, int n0, LAS float* scr, int lane) {
    float t[32];
#pragma unroll
    for (int i = 0; i < 32; ++i) t[i] = __builtin_nontemporal_load(W + (size_t)(k0 + 2 * i + (lane >> 5)) * ldw + n0 + (lane & 31));
#pragma unroll
    for (int i = 0; i < 32; ++i) scr[(2 * i + (lane >> 5)) * 33 + (lane & 31)] = t[i];
}
__device__ __forceinline__ void p0_phase(const Args& a, LAS unsigned char* lds, int tid_unused, int lane_unused, int wave, int G) {
    const int lane = fresh_lane(), tid = wave * 64 + lane;
    const float* cvec = a.in[1]; const float* w_ada = a.in[2]; const float* b_ada = a.in[3];
    float* MOD = (float*)(a.ws + WS_MOD);
    LAS float* cT = (LAS float*)lds;
    LAS float* red = (LAS float*)(lds + 32768);
    if ((int)blockIdx.x < 192) {
        { float t[16];
#pragma unroll
          for (int i = 0; i < 16; ++i) t[i] = cvec[tid + 512 * i];
#pragma unroll
          for (int i = 0; i < 16; ++i) { const int idx = tid + 512 * i; cT[(idx & 1023) * 8 + (idx >> 10)] = t[i]; } }
        __syncthreads();
        for (int item = blockIdx.x; item < 192; item += G) {
            const int j0 = item * 16, col = lane & 15, rsub = lane >> 4, kq = wave;
            float w[32];
#pragma unroll
            for (int i = 0; i < 32; ++i) w[i] = __builtin_nontemporal_load(w_ada + (size_t)(kq * 128 + 4 * i + rsub) * 3072 + j0 + col);
            float acc[8];
#pragma unroll
            for (int bb = 0; bb < 8; ++bb) acc[bb] = 0.f;
#pragma unroll
            for (int i = 0; i < 32; ++i) { const int k = kq * 128 + 4 * i + rsub;
                const f32x4 c0 = *(const LAS f32x4*)(cT + k * 8), c1 = *(const LAS f32x4*)(cT + k * 8 + 4);
                acc[0] += c0.x * w[i]; acc[1] += c0.y * w[i]; acc[2] += c0.z * w[i]; acc[3] += c0.w * w[i];
                acc[4] += c1.x * w[i]; acc[5] += c1.y * w[i]; acc[6] += c1.z * w[i]; acc[7] += c1.w * w[i]; }
#pragma unroll
            for (int bb = 0; bb < 8; ++bb) { acc[bb] += __shfl_xor(acc[bb], 16); acc[bb] += __shfl_xor(acc[bb], 32); }
            if (lane < 16) {
#pragma unroll
                for (int bb = 0; bb < 8; ++bb) red[(kq * 8 + bb) * 16 + col] = acc[bb]; }
            __syncthreads();
            if (tid < 128) { const int bb = tid >> 4, cc = tid & 15; float sum = 0.f;
#pragma unroll
                for (int q = 0; q < 8; ++q) sum += red[(q * 8 + bb) * 16 + cc];
                __hip_atomic_store(&MOD[bb * 3072 + j0 + cc], sum + b_ada[j0 + cc], __ATOMIC_RELAXED, __HIP_MEMORY_SCOPE_AGENT); }
            asm volatile("s_waitcnt vmcnt(0)" ::: "memory");
            __syncthreads();
            if (tid == 0) __hip_atomic_fetch_add((unsigned*)(a.ws + WS_CTL) + CW_MODCNT, 1u, __ATOMIC_RELAXED, __HIP_MEMORY_SCOPE_AGENT);
        }
    }
    LAS float* scr = (LAS float*)(lds + 40960 + wave * 8448);
    const int gw = blockIdx.x * 8 + wave, NGW = G * 8;
    constexpr int I_IN = 16 * (NP / 32), I_W = 16 * 32;
    bf16* WINT = (bf16*)((unsigned char*)a.out + OUT_WINT);
    for (int it = gw; it < I_IN + 3 * I_W + 128; it += NGW) {
        if (it >= I_IN + 3 * I_W) {
            const int r_ = it - (I_IN + 3 * I_W), nt = r_ & 7, kb = r_ >> 3;
            p0_load_tile(a.in[5], NIN, 64 * kb, NP_MAIN + 16 + 32 * nt, scr, lane);
            bf16* WF = (bf16*)(a.ws + WS_WTF);
            const int r = lane & 31, h = lane >> 5;
#pragma unroll
            for (int s4 = 0; s4 < 4; ++s4) { const LAS float* s = scr + (16 * s4 + 8 * h) * 33 + r;
                u32x4 o; o.x = pk2(s[0 * 33], s[1 * 33]); o.y = pk2(s[2 * 33], s[3 * 33]); o.z = pk2(s[4 * 33], s[5 * 33]); o.w = pk2(s[6 * 33], s[7 * 33]);
                *(u32x4*)(WF + ((size_t)(nt * 64 + 4 * kb + s4) * 64 + lane) * 8) = o; }
        } else if (it < I_IN) {
            const int nblk = NP / 32, kb = it / nblk, nb = it % nblk, k0 = 64 * kb, n0p = 32 * nb, n0 = n0p + (n0p >= 2304 ? 16 : 0);
            p0_load_tile(a.in[5], NIN, k0, n0, scr, lane);
            const int c = lane & 7;
#pragma unroll
            for (int j = 0; j < 4; ++j) { const int n = (lane >> 3) + 8 * j; const LAS float* s = scr + (8 * c) * 33 + n;
                u32x4 o; o.x = pk2(s[0 * 33], s[1 * 33]); o.y = pk2(s[2 * 33], s[3 * 33]); o.z = pk2(s[4 * 33], s[5 * 33]); o.w = pk2(s[6 * 33], s[7 * 33]);
                *(u32x4*)(WINT + (size_t)(n0p + n) * 1024 + k0 + 8 * c) = o; }
        } else {
            int r_ = it - I_IN; const int which = r_ / I_W; r_ -= which * I_W;
            const float* W = a.in[12 + which];
            bf16* WF = (bf16*)(a.ws + WS_WMF + (size_t)which * 2 * MiB);
            const int nt = r_ & 31, kb = r_ >> 5;
            p0_load_tile(W, 1024, 64 * kb, 32 * nt, scr, lane);
            const int r = lane & 31, h = lane >> 5;
#pragma unroll
            for (int s4 = 0; s4 < 4; ++s4) { const LAS float* s = scr + (16 * s4 + 8 * h) * 33 + r;
                f32x4 m0 = (f32x4){1.f, 1.f, 1.f, 1.f}, m1 = m0;
                if (which == 0) { m0 = *(const f32x4*)(a.in[11] + 64 * kb + 16 * s4 + 8 * h); m1 = *(const f32x4*)(a.in[11] + 64 * kb + 16 * s4 + 8 * h + 4); }
                u32x4 o; o.x = pk2(s[0 * 33] * m0.x, s[1 * 33] * m0.y); o.y = pk2(s[2 * 33] * m0.z, s[3 * 33] * m0.w); o.z = pk2(s[4 * 33] * m1.x, s[5 * 33] * m1.y); o.w = pk2(s[6 * 33] * m1.z, s[7 * 33] * m1.w);
                *(u32x4*)(WF + ((size_t)(nt * 64 + 4 * kb + s4) * 64 + lane) * 8) = o; }
        }
    }
}

__device__ __forceinline__ void p1_phase(const Args& a, LAS unsigned char* lds, int tid_unused, int lane_unused, int wave, int G) {
    const int lane_in = fresh_lane(), tid = wave * 64 + lane_in;
    const float* x = a.in[0]; const float* norm_w = a.in[4]; const float* w_in = a.in[5]; const float* dt_bias = a.in[8];
    const float* MOD = (const float*)(a.ws + WS_MOD);
    float* DT = (float*)(a.ws + WS_DT);
    bf16* H = (bf16*)((unsigned char*)a.out + OUT_H);
    LAS float* wdt = (LAS float*)lds;
    { float t[32];
#pragma unroll
      for (int i = 0; i < 32; ++i) { const int idx = tid + NTHR * i; t[i] = w_in[(size_t)(idx >> 4) * NIN + 2304 + (idx & 15)]; }
#pragma unroll
      for (int i = 0; i < 32; ++i) { const int idx = tid + NTHR * i; wdt[(idx & 15) * 1028 + (idx >> 4)] = t[i]; } }
    if (wave == 0) {
        unsigned* cnt = (unsigned*)(a.ws + WS_CTL) + CW_MODCNT; unsigned spins = 0u;
        while ((unsigned)__builtin_amdgcn_readfirstlane((int)__hip_atomic_load(cnt, __ATOMIC_RELAXED, __HIP_MEMORY_SCOPE_AGENT)) < 192u) { __builtin_amdgcn_s_sleep(1); if (++spins > (1u << 20)) break; }
        __builtin_amdgcn_fence(__ATOMIC_ACQUIRE, "agent");
        asm volatile("s_waitcnt vmcnt(0)" ::: "memory");
    }
    __syncthreads();
    for (int blk = blockIdx.x; blk < 256; blk += G) {
        const int b = blk >> 5;
        float gk[16], sh[16];
#pragma unroll
        for (int jj = 0; jj < 4; ++jj) { const int k = 4 * lane_in + 256 * jj;
            const f32x4 nw = *(const f32x4*)(norm_w + k), sc = *(const f32x4*)(MOD + b * 3072 + 1024 + k), sf = *(const f32x4*)(MOD + b * 3072 + k);
#pragma unroll
            for (int e = 0; e < 4; ++e) { gk[4 * jj + e] = nw[e] * (1.f + sc[e]); sh[4 * jj + e] = sf[e]; } }
        f32x4 vn[2][4];
        { const int lane = fresh_lane();
#pragma unroll
          for (int rr = 0; rr < 2; ++rr)
#pragma unroll
              for (int jj = 0; jj < 4; ++jj) vn[rr][jj] = __builtin_nontemporal_load((const f32x4*)(x + (size_t)(blk * 64 + wave * 8 + rr) * D) + lane + 64 * jj); }
        for (int g = 0; g < 4; ++g) {
            asm volatile("" ::: "memory");
            const int lane = fresh_lane();
            const int m0 = blk * 64 + wave * 8 + g * 2;
            f32x4 v[2][4];
#pragma unroll
            for (int rr = 0; rr < 2; ++rr)
#pragma unroll
                for (int jj = 0; jj < 4; ++jj) v[rr][jj] = vn[rr][jj];
            if (g + 1 < 4) {
#pragma unroll
                for (int rr = 0; rr < 2; ++rr)
#pragma unroll
                    for (int jj = 0; jj < 4; ++jj) vn[rr][jj] = __builtin_nontemporal_load((const f32x4*)(x + (size_t)(m0 + 2 + rr) * D) + lane + 64 * jj);
            }
            __builtin_amdgcn_sched_barrier(0);
            float hv[2][16];
#pragma unroll
            for (int rr = 0; rr < 2; ++rr) {
                float ss = 0.f;
#pragma unroll
                for (int jj = 0; jj < 4; ++jj) ss += (v[rr][jj].x * v[rr][jj].x + v[rr][jj].y * v[rr][jj].y) + (v[rr][jj].z * v[rr][jj].z + v[rr][jj].w * v[rr][jj].w);
                const float rs = 1.0f / sqrtf(wave_sum(ss) * (1.f / D) + EPS);
                unsigned long long* o8 = (unsigned long long*)(H + (size_t)(m0 + rr) * D) + lane;
#pragma unroll
                for (int jj = 0; jj < 4; ++jj) {
#pragma unroll
                    for (int e = 0; e < 4; ++e) hv[rr][4 * jj + e] = v[rr][jj][e] * rs * gk[4 * jj + e] + sh[4 * jj + e];
                    o8[64 * jj] = (unsigned long long)pk2(hv[rr][4 * jj], hv[rr][4 * jj + 1]) | ((unsigned long long)pk2(hv[rr][4 * jj + 2], hv[rr][4 * jj + 3]) << 32);
                }
            }
            float acc[32];
#pragma unroll
            for (int i = 0; i < 32; ++i) acc[i] = 0.f;
#pragma unroll
            for (int j = 0; j < 16; ++j) {
#pragma unroll
                for (int jj = 0; jj < 4; ++jj) { const f32x4 w = *(const LAS f32x4*)(wdt + j * 1028 + 4 * lane + 256 * jj);
#pragma unroll
                    for (int rr = 0; rr < 2; ++rr) acc[rr * 16 + j] += (hv[rr][4 * jj] * w.x + hv[rr][4 * jj + 1] * w.y) + (hv[rr][4 * jj + 2] * w.z + hv[rr][4 * jj + 3] * w.w); }
                if ((j & 3) == 3) asm volatile("" ::: "memory");
            }
#pragma unroll
            for (int half = 16; half >= 1; half >>= 1) {
                const bool up = (lane & half) != 0;
#pragma unroll
                for (int i = 0; i < half; ++i) { float lo_ = acc[i], hi_ = acc[i + half]; asm volatile("" : "+v"(lo_), "+v"(hi_));
                    const float keep = up ? hi_ : lo_, send = up ? lo_ : hi_; acc[i] = keep + __shfl_xor(send, half); }
            }
            const float tot = acc[0] + __shfl_xor(acc[0], 32);
            const float xr_ = tot + dt_bias[lane & 15];
            const float dtv = xr_ > 20.f ? xr_ : log1pf(__expf(xr_));
            if (lane < 32) DT[(size_t)m0 * 16 + lane] = dtv;
        }
    }
}

constexpr size_t OUT_XBCC = 0;
__device__ __forceinline__ void p3a_phase(const Args& a, int wave, int G) {
    const bf16* PROJ = (const bf16*)(a.ws + WS_PROJ);
    bf16* XBCC = (bf16*)((unsigned char*)a.out + OUT_XBCC);
    const float* conv_w = a.in[6]; const float* conv_b = a.in[7];
    const int lane = fresh_lane(), tid = wave * 64 + lane;
    if (tid >= 480) return;
    const int oct = tid % 160, tgl = tid / 160;
    float cw[4][8], cb[8];
#pragma unroll
    for (int e = 0; e < 8; ++e) { cb[e] = conv_b[8 * oct + e];
#pragma unroll
        for (int k = 0; k < 4; ++k) cw[k][e] = conv_w[k * 1280 + 8 * oct + e]; }
    for (int blk = blockIdx.x; blk < 256; blk += G) {
        for (int tg = tgl; tg < 8; tg += 3) {
            const int m0 = blk * 64 + 8 * tg, ts0 = m0 & (SEQ - 1);
            const char* src = (const char*)(PROJ + (size_t)m0 * NP + C_X + 8 * oct);
            u32x4 raw[11];
#pragma unroll
            for (int i = 0; i < 11; ++i) { const bool ok = (ts0 - 3 + i) >= 0; raw[i] = ok ? *(const u32x4*)(src + ((long)i - 3) * (NP * 2)) : (u32x4){0u, 0u, 0u, 0u}; }
#pragma unroll
            for (int jj = 0; jj < 8; ++jj) {
                float o[8];
#pragma unroll
                for (int e = 0; e < 8; ++e) {
                    float s_ = cb[e];
#pragma unroll
                    for (int k = 0; k < 4; ++k) { const unsigned w = raw[jj + k][e >> 1]; s_ += cw[k][e] * ((e & 1) ? bf_hi(w) : bf_lo(w)); }
                    o[e] = silu_f(s_);
                }
                u32x4 ov; ov.x = pk2(o[0], o[1]); ov.y = pk2(o[2], o[3]); ov.z = pk2(o[4], o[5]); ov.w = pk2(o[6], o[7]);
                __builtin_nontemporal_store(ov, (u32x4*)(XBCC + (size_t)(m0 + jj) * 1280 + 8 * oct));
            }
        }
    }
}

constexpr int TP = 72;
constexpr int L_CQ = 0, L_BK = 18432, L_BKW = 36864, L_XV = 55296, L_ST0 = 73728, L_ST1 = 82944, L_ACS = 92160, L_DTJ = 93184, L_WJ = 94208, L_CW = 95232;

__device__ __forceinline__ void p3_phase(const Args& a, LAS unsigned char* lds, int tid_in, int lane_in, int wave, int G, const bool dry = false) {
    bf16* PROJ = (bf16*)(a.ws + WS_PROJ);
    const float* DT = (const float*)(a.ws + WS_DT);
    float* SSQM = (float*)(a.ws + WS_SSQM); float* SSQR = (float*)(a.ws + WS_SSQR);
    const float* conv_w = a.in[6]; const float* conv_b = a.in[7]; const float* a_log = a.in[9]; const float* d_skip = a.in[10]; const float* m_norm_w = a.in[11];
    const int pt = wave & 1, it = wave >> 1;
#ifdef PROBE_SEL
    unsigned long long t0_ = 0ull; unsigned tacc_ = 0u;
    const bool probing = ((int)blockIdx.x == PROBE_BLK && wave == PROBE_WAVE);
#define TB(k) do { if (PROBE_SEL == (k) && probing) t0_ = __builtin_amdgcn_s_memrealtime(); } while (0)
#define TE(k) do { if (PROBE_SEL == (k) && probing) tacc_ += (unsigned)(__builtin_amdgcn_s_memrealtime() - t0_); } while (0)
#else
#define TB(k) do {} while (0)
#define TE(k) do {} while (0)
#endif
    for (int item = blockIdx.x; item < 256; item += G) {
        const int lane = fresh_lane(), tid = wave * 64 + lane;
        const int r = lane & 31, h = lane >> 5, i16 = lane & 15, q4 = i16 >> 2, p4 = i16 & 3, blk16 = (lane >> 4) & 1;
        const int xcd_ = item & 7, kk_ = item >> 3;
        const bool ssd = kk_ < 16;
        int b, hd, half;
        if (ssd) { const int pair = 2 * xcd_ + (kk_ >> 3); b = pair >> 1; hd = 8 * (pair & 1) + (kk_ & 7); half = 0; }
        else { const int t = xcd_ * 16 + (kk_ - 16); b = t >> 4; hd = (t >> 1) & 7; half = t & 1; }
        const size_t mb = (size_t)b * SEQ;
        __syncthreads();
        for (int idx = tid; idx < 9216 / 4; idx += NTHR) ((LAS unsigned*)(lds + L_ST0))[idx] = 0u;
        const float lg = ssd ? 0.f : log1pf(-exp2f(-5.0f - (float)hd));
        if (!ssd && tid < 256) { const int par = tid >> 7, j = tid & 127;
            ((LAS float*)(lds + L_ACS))[par * 128 + j] = (float)(j + 1) * lg * 1.4426950408889634f; ((LAS float*)(lds + L_DTJ))[par * 128 + j] = (float)(j + 1) * lg * 1.4426950408889634f; ((LAS float*)(lds + L_WJ))[par * 128 + j] = __expf((float)(127 - j) * lg); }
        const float Ah = ssd ? -__expf(a_log[hd]) : 0.f;
        const float Dsk = ssd ? d_skip[hd] : 0.f;
        const int ltile = 3 - (tid >> 7), loct = tid & 7, ltg = (tid >> 3) & 15;
        int lcol = 0;
        float invf[8];
        if (ssd) {
            lcol = (ltile == 0) ? (64 * hd + 8 * loct) : (ltile == 1 ? (1024 + 64 * (hd >> 3) + 8 * loct) : (1152 + 64 * (hd >> 3) + 8 * loct));
            if (ltile == 3) lcol = 1024 + 64 * (hd >> 3) + 8 * loct;
#pragma unroll
            for (int e = 0; e < 8; ++e) invf[e] = 0.f;
        } else {
#pragma unroll
            for (int e = 0; e < 8; ++e) invf[e] = exp2f(-(float)(8 * (tid & 3) + e) * (13.287712379549449f / 32.f));
        }
        f32x16 sacc;
#pragma unroll
        for (int i = 0; i < 16; ++i) sacc[i] = 0.f;
        u32x4 raw[8];
        const int rj = tid >> 2, ro4 = tid & 3;
        const int j0 = 8 * ltg;
        const char* pbase = (const char*)(PROJ + mb * NP);
        const char* xbase = (const char*)((const bf16*)((const unsigned char*)a.out + OUT_XBCC) + mb * 1280);
        const unsigned soff = (unsigned)((j0 * 1280 + lcol) * 2);
        const unsigned roff = (unsigned)((rj * NP) * 2);
#define P3_ISSUE(cc) do { const char* cbp = pbase + (size_t)(cc) * (128 * NP * 2); \
        if (ssd) { const char* xp = xbase + (size_t)(cc) * (128 * 1280 * 2) + soff; _Pragma("unroll") for (int i = 0; i < 8; ++i) raw[i] = *(const u32x4*)(xp + i * (1280 * 2)); } \
        else { const char* rp = cbp + roff; \
            raw[0] = *(const u32x4*)(rp + (C_Q + 64 * hd + 8 * ro4) * 2); raw[1] = *(const u32x4*)(rp + (C_Q + 64 * hd + 32 + 8 * ro4) * 2); \
            raw[2] = *(const u32x4*)(rp + (C_K + 64 * hd + 8 * ro4) * 2); raw[3] = *(const u32x4*)(rp + (C_K + 64 * hd + 32 + 8 * ro4) * 2); \
            raw[4] = *(const u32x4*)(rp + (C_V + 128 * hd + 64 * half + 16 * ro4) * 2); raw[5] = *(const u32x4*)(rp + (C_V + 128 * hd + 64 * half + 16 * ro4 + 8) * 2); } } while (0)
        float dq0 = 0.f, dq1 = 0.f;
#define P3_SCAN(cc) do { LAS float* ACSw = (LAS float*)(lds + L_ACS) + ((cc) & 1) * 128; LAS float* DTJw = (LAS float*)(lds + L_DTJ) + ((cc) & 1) * 128; LAS float* WJw = (LAS float*)(lds + L_WJ) + ((cc) & 1) * 128; \
        const float v0 = dq0 * Ah, v1 = dq1 * Ah, s_ = v0 + v1; float incl = s_; \
        _Pragma("unroll") for (int o = 1; o < 64; o <<= 1) { const float t = __shfl_up(incl, o); if (lane >= o) incl += t; } \
        const float c0 = (incl - s_) + v0, tot = __shfl(incl, 63), c1 = (lane == 63) ? tot : c0 + v1; \
        ACSw[2 * lane] = c0 * 1.4426950408889634f; ACSw[2 * lane + 1] = c1 * 1.4426950408889634f; \
        DTJw[2 * lane] = c0 * 1.4426950408889634f - __log2f(dq0); DTJw[2 * lane + 1] = c1 * 1.4426950408889634f - __log2f(dq1); \
        WJw[2 * lane] = dq0 * __expf(tot - c0); WJw[2 * lane + 1] = dq1 * __expf(tot - c1); } while (0)
#define P3_DTLOAD(cc) do { dq0 = DT[(mb + (size_t)(cc) * 128 + 2 * lane) * 16 + hd]; dq1 = DT[(mb + (size_t)(cc) * 128 + 2 * lane + 1) * 16 + hd]; } while (0)
        if (ssd && wave == 0) { P3_DTLOAD(0); P3_SCAN(0); P3_DTLOAD(1); }
        u32x2 zzn[4];
        { const bf16* orow0 = PROJ + (mb + 16 * wave + i16) * NP + (ssd ? (C_Z + 64 * hd) : (C_GR + 128 * hd + 64 * half));
#pragma unroll
          for (int g4 = 0; g4 < 4; ++g4) zzn[g4] = *(const u32x2*)(orow0 + 16 * g4 + 4 * (lane >> 4)); }
        P3_ISSUE(0);

        TB(1);
        for (int c = 0; c < 16; ++c) {
            const int par = c & 1;
            const size_t m0 = mb + (size_t)c * 128;
            LAS float* ACS = (LAS float*)(lds + L_ACS) + par * 128; LAS float* DTJ = (LAS float*)(lds + L_DTJ) + par * 128; LAS float* WJ = (LAS float*)(lds + L_WJ) + par * 128;
            TB(5);
            __syncthreads();
            TE(5); TB(2);
#ifndef P3_REPL
#define P3_REPL 1
#endif
            _Pragma("nounroll") for (int repl_ = 0; repl_ < P3_REPL; ++repl_) {
            if (repl_) __syncthreads();
            if (ssd) {
                {
                    LAS unsigned char* dst = lds + (ltile == 0 ? L_XV : (ltile == 1 ? L_BK : (ltile == 2 ? L_CQ : L_BKW)));
#pragma unroll
                    for (int jj = 0; jj < 8; ++jj) {
                        u32x4 v = raw[jj];
                        if (ltile == 3) { const float wj = WJ[j0 + jj];
                            v.x = pk2(bf_lo(v.x) * wj, bf_hi(v.x) * wj); v.y = pk2(bf_lo(v.y) * wj, bf_hi(v.y) * wj); v.z = pk2(bf_lo(v.z) * wj, bf_hi(v.z) * wj); v.w = pk2(bf_lo(v.w) * wj, bf_hi(v.w) * wj); }
                        *(LAS u32x4*)(dst + ((j0 + jj) * TP + 8 * loct) * 2) = v;
                    }
                }
            } else {
                const int j = rj, o4 = ro4;
                const u32x4 q1 = raw[0], q2 = raw[1], k1 = raw[2], k2 = raw[3];
                const float pos = (float)(c * 128 + j), wj = WJ[j];
                float ql[8], qh[8], kl[8], kh[8];
#pragma unroll
                for (int e = 0; e < 8; ++e) {
                    const float rev = pos * invf[e] * 0.15915494309189535f, fr = rev - floorf(rev);
                    const float cs = __builtin_amdgcn_cosf(fr), sn = __builtin_amdgcn_sinf(fr);
                    const unsigned wq1 = q1[e >> 1], wq2 = q2[e >> 1], wk1 = k1[e >> 1], wk2 = k2[e >> 1];
                    const float a1 = (e & 1) ? bf_hi(wq1) : bf_lo(wq1), a2 = (e & 1) ? bf_hi(wq2) : bf_lo(wq2);
                    const float b1 = ((e & 1) ? bf_hi(wk1) : bf_lo(wk1)) * 0.125f, b2 = ((e & 1) ? bf_hi(wk2) : bf_lo(wk2)) * 0.125f;
                    ql[e] = a1 * cs - a2 * sn; qh[e] = a1 * sn + a2 * cs;
                    kl[e] = b1 * cs - b2 * sn; kh[e] = b1 * sn + b2 * cs;
                }
                u32x4 t;
                t.x = pk2(ql[0], ql[1]); t.y = pk2(ql[2], ql[3]); t.z = pk2(ql[4], ql[5]); t.w = pk2(ql[6], ql[7]); *(LAS u32x4*)(lds + L_CQ + (j * TP + 8 * o4) * 2) = t;
                t.x = pk2(qh[0], qh[1]); t.y = pk2(qh[2], qh[3]); t.z = pk2(qh[4], qh[5]); t.w = pk2(qh[6], qh[7]); *(LAS u32x4*)(lds + L_CQ + (j * TP + 32 + 8 * o4) * 2) = t;
                t.x = pk2(kl[0], kl[1]); t.y = pk2(kl[2], kl[3]); t.z = pk2(kl[4], kl[5]); t.w = pk2(kl[6], kl[7]); *(LAS u32x4*)(lds + L_BK + (j * TP + 8 * o4) * 2) = t;
                t.x = pk2(kh[0], kh[1]); t.y = pk2(kh[2], kh[3]); t.z = pk2(kh[4], kh[5]); t.w = pk2(kh[6], kh[7]); *(LAS u32x4*)(lds + L_BK + (j * TP + 32 + 8 * o4) * 2) = t;
                t.x = pk2(kl[0] * wj, kl[1] * wj); t.y = pk2(kl[2] * wj, kl[3] * wj); t.z = pk2(kl[4] * wj, kl[5] * wj); t.w = pk2(kl[6] * wj, kl[7] * wj); *(LAS u32x4*)(lds + L_BKW + (j * TP + 8 * o4) * 2) = t;
                t.x = pk2(kh[0] * wj, kh[1] * wj); t.y = pk2(kh[2] * wj, kh[3] * wj); t.z = pk2(kh[4] * wj, kh[5] * wj); t.w = pk2(kh[6] * wj, kh[7] * wj); *(LAS u32x4*)(lds + L_BKW + (j * TP + 32 + 8 * o4) * 2) = t;
                *(LAS u32x4*)(lds + L_XV + (j * TP + 16 * o4) * 2) = raw[4]; *(LAS u32x4*)(lds + L_XV + (j * TP + 16 * o4 + 8) * 2) = raw[5];
            }
            }
            TE(2); TB(6);
            __syncthreads();
            TE(6); TB(3);
            const int q16 = lane >> 4, iTok = 16 * wave + i16;
            bf16* orow = PROJ + (m0 + iTok) * NP + (ssd ? (C_Z + 64 * hd) : (C_GR + 128 * hd + 64 * half));
            u32x2 zz[4];
#pragma unroll
            for (int g4 = 0; g4 < 4; ++g4) zz[g4] = zzn[g4];
            if (c + 1 < 16) {
#pragma unroll
                for (int g4 = 0; g4 < 4; ++g4) zzn[g4] = *(const u32x2*)(orow + 128 * NP + 16 * g4 + 4 * q16);
                P3_ISSUE(c + 1);
            }
            __builtin_amdgcn_sched_barrier(0);
            if (ssd && wave == 0 && c + 1 < 16) { P3_SCAN(c + 1); if (c + 2 < 16) P3_DTLOAD(c + 2); }
#ifndef P3_REPC
#define P3_REPC 1
#endif
            f32x16 acc;
            float acs_i = 0.f;
            LAS unsigned char* STw = lds + (par ? L_ST0 : L_ST1);
            _Pragma("nounroll") for (int repc_ = 0; repc_ < P3_REPC; ++repc_) {
            bf16x8 cqb[2];
#pragma unroll
            for (int s = 0; s < 2; ++s) cqb[s] = *(const LAS bf16x8*)(lds + L_CQ + (iTok * TP + 32 * s + 8 * q16) * 2);
            const LAS unsigned char* STr = lds + (par ? L_ST1 : L_ST0);
#pragma unroll
            for (int i = 0; i < 16; ++i) acc[i] = 0.f;
            f32x4 ya[4];
#pragma unroll
            for (int p4t = 0; p4t < 4; ++p4t) { ya[p4t] = (f32x4){0.f, 0.f, 0.f, 0.f};
#pragma unroll
                for (int s = 0; s < 2; ++s) { const bf16x8 sa = *(const LAS bf16x8*)(STr + ((16 * p4t + i16) * TP + 32 * s + 8 * q16) * 2); ya[p4t] = MFMA16(sa, cqb[s], ya[p4t]); } }
            acs_i = ACS[iTok];
            { const float ei = __builtin_amdgcn_exp2f(acs_i);
#pragma unroll
              for (int p4t = 0; p4t < 4; ++p4t) ya[p4t] = ya[p4t] * ei; }
            const int nblk = (wave >> 1) + 1;
            bf16x8 kq0[2], kq1[2];
#pragma unroll
            for (int s = 0; s < 2; ++s) { kq0[s] = *(const LAS bf16x8*)(lds + L_BK + (i16 * TP + 32 * s + 8 * q16) * 2); kq1[s] = *(const LAS bf16x8*)(lds + L_BK + ((16 + i16) * TP + 32 * s + 8 * q16) * 2); }
            for (int jb = 0; jb < nblk; ++jb) {
                const int j0 = 32 * jb;
                f32x4 t0 = (f32x4){0.f, 0.f, 0.f, 0.f}, t1 = t0;
#pragma unroll
                for (int s = 0; s < 2; ++s) { t0 = MFMA16(kq0[s], cqb[s], t0); t1 = MFMA16(kq1[s], cqb[s], t1); }
#pragma unroll
                for (int s = 0; s < 2; ++s) { kq0[s] = *(const LAS bf16x8*)(lds + L_BK + ((j0 + 32 + i16) * TP + 32 * s + 8 * q16) * 2); kq1[s] = *(const LAS bf16x8*)(lds + L_BK + ((j0 + 48 + i16) * TP + 32 * s + 8 * q16) * 2); }
                const f32x4 b0 = *(const LAS f32x4*)(DTJ + j0 + 4 * q16), b1 = *(const LAS f32x4*)(DTJ + j0 + 16 + 4 * q16);
                bf16x8 xa[4];
#pragma unroll
                for (int p4t = 0; p4t < 4; ++p4t) { const LAS unsigned char* xb = lds + L_XV + ((j0 + 4 * q16 + q4) * TP + 16 * p4t + 4 * p4) * 2; xa[p4t] = tr_pair(xb, xb + 16 * TP * 2); }
                __builtin_amdgcn_sched_barrier(0);
                const bool lastb = (jb == nblk - 1);
                float pv[8];
#pragma unroll
                for (int e = 0; e < 4; ++e) {
                    float v0 = t0[e] * __builtin_amdgcn_exp2f(acs_i - b0[e]), v1 = t1[e] * __builtin_amdgcn_exp2f(acs_i - b1[e]);
                    if (lastb && (j0 + 4 * q16 + e) > iTok) v0 = 0.f;
                    if (lastb && (j0 + 16 + 4 * q16 + e) > iTok) v1 = 0.f;
                    pv[e] = v0; pv[4 + e] = v1;
                }
                const bf16x8 pf = pack8(pv[0], pv[1], pv[2], pv[3], pv[4], pv[5], pv[6], pv[7]);
#pragma unroll
                for (int p4t = 0; p4t < 4; ++p4t) ya[p4t] = MFMA16(xa[p4t], pf, ya[p4t]);
            }
#pragma unroll
            for (int p4t = 0; p4t < 4; ++p4t)
#pragma unroll
                for (int e = 0; e < 4; ++e) acc[4 * p4t + e] = ya[p4t][e];
            }
            TE(3); TB(4);
            if (it < 2 && c < 15) {
                const int nt = it;
                const float dec = __builtin_amdgcn_exp2f(ACS[127]);
#pragma unroll
                for (int i = 0; i < 16; ++i) sacc[i] *= dec;
                f32x16 sacc2;
#pragma unroll
                for (int i = 0; i < 16; ++i) sacc2[i] = 0.f;
#pragma unroll
                for (int ks = 0; ks < 8; ++ks) {
                    const LAS unsigned char* xb = lds + L_XV + ((16 * ks + 8 * h + q4) * TP + 32 * pt + 16 * blk16 + 4 * p4) * 2;
                    const LAS unsigned char* kb = lds + L_BKW + ((16 * ks + 8 * h + q4) * TP + 32 * nt + 16 * blk16 + 4 * p4) * 2;
                    const bf16x8 xa = tr_pair(xb, xb + 4 * TP * 2), kbf = tr_pair(kb, kb + 4 * TP * 2);
                    if (ks & 1) sacc2 = MFMA32(xa, kbf, sacc2); else sacc = MFMA32(xa, kbf, sacc);
                }
#pragma unroll
                for (int i = 0; i < 16; ++i) sacc[i] += sacc2[i];
#pragma unroll
                for (int i = 0; i < 16; ++i) { const int p = 32 * pt + crow(i, h);
                    *(LAS unsigned short*)(STw + (p * TP + 32 * nt + r) * 2) = (unsigned short)(pk2(sacc[i], 0.f) & 0xffffu); }
            }
            {
                float ss = 0.f;
#pragma unroll
                for (int g4 = 0; g4 < 4; ++g4) {
                    const int p = 16 * g4 + 4 * q16;
                    const float z0 = bf_lo(zz[g4].x), z1 = bf_hi(zz[g4].x), z2 = bf_lo(zz[g4].y), z3 = bf_hi(zz[g4].y);
                    float y0 = acc[4 * g4], y1 = acc[4 * g4 + 1], y2 = acc[4 * g4 + 2], y3 = acc[4 * g4 + 3];
                    float o0, o1, o2, o3;
                    if (ssd) {
                        const u32x2 xv = *(const LAS u32x2*)(lds + L_XV + (iTok * TP + p) * 2);
                        y0 = (y0 + Dsk * bf_lo(xv.x)) * silu_f(z0); y1 = (y1 + Dsk * bf_hi(xv.x)) * silu_f(z1); y2 = (y2 + Dsk * bf_lo(xv.y)) * silu_f(z2); y3 = (y3 + Dsk * bf_hi(xv.y)) * silu_f(z3);
                        ss += (y0 * y0 + y1 * y1) + (y2 * y2 + y3 * y3);
                        o0 = y0; o1 = y1; o2 = y2; o3 = y3;
                    } else {
                        ss += (y0 * y0 + y1 * y1) + (y2 * y2 + y3 * y3);
                        o0 = y0 * silu_f(z0); o1 = y1 * silu_f(z1); o2 = y2 * silu_f(z2); o3 = y3 * silu_f(z3);
                    }
                    u32x2 ov; ov.x = pk2(o0, o1); ov.y = pk2(o2, o3);
                    if (dry) *(u32x2*)((bf16*)((unsigned char*)a.out + 40 * MiB) + (m0 + iTok) * 512 + ((64 * hd + 64 * half + p) & 511)) = ov; else *(u32x2*)(orow + p) = ov;
                }
                ss += __shfl_xor(ss, 16); ss += __shfl_xor(ss, 32);
                if (q16 < 2) { const float sv = (q16 == 0) ? ss : 0.f;
                    if (ssd) SSQM[(m0 + iTok) * 32 + hd * 2 + q16] = sv; else SSQR[(m0 + iTok) * 32 + hd * 4 + half * 2 + q16] = sv; }
            }
            TE(4);
        }
        TE(1);
#undef P3_ISSUE
#undef P3_SCAN
#undef P3_DTLOAD
    }
#ifdef PROBE_SEL
    if (probing && fresh_lane() == 0) ((unsigned*)(a.ws + WS_CTL))[4000] = tacc_;
#endif
#undef TB
#undef TE
}

constexpr int MP = 1032;
constexpr int L4_MERGED = 0, L4_ASTG = 132096, L4_RM = 150528, L4_RR = 151040, L4_RED = 153088, L4_RS = 155136;
static_assert(L4_RS + 256 <= LDS_BYTES, "P4 LDS map");

__device__ __forceinline__ void p4_panel_load(u32x4 (&ar)[16], const bf16* Abase, int tid) {
    const int srow = tid >> 3, soct = tid & 7; const int rot = ((int)blockIdx.x >> 3) & 15;
    const char* ab = (const char*)Abase; const unsigned aoff = (unsigned)((srow * NP + 8 * soct) * 2);
#pragma unroll
    for (int i = 0; i < 16; ++i) ar[i] = *(const u32x4*)(ab + ((rot + i) & 15) * 128 + aoff);
}
template <int SEGSHIFT>
__device__ __forceinline__ void p4_gemmT(f32x16 (&accT)[2][2], u32x4 (&ar)[16], const bf16* Anext  , const LAS float* rsc  , int nseg,
                                         const bf16* WF  , int nt0  , LAS unsigned char* lds, int tid, int lane) {
    const int srow = tid >> 3, soct = tid & 7, r = lane & 31, h = lane >> 5;
    const char* wb = (const char*)WF + (size_t)nt0 * 65536; const unsigned woff = (unsigned)(lane * 16);
    const int rot = ((int)blockIdx.x >> 3) & 15;
    bf16x8 wc[4][2];
    { const char* wk0 = wb + rot * 4096;
#pragma unroll
      for (int s = 0; s < 4; ++s) { wc[s][0] = *(const bf16x8*)(wk0 + s * 1024 + woff); wc[s][1] = *(const bf16x8*)(wk0 + 65536 + s * 1024 + woff); } }
#define P4_STAGE_WRITE(ki_) do { const int kc_ = ((ki_) + rot) & 15; const float sc = rsc[srow * nseg + ((kc_ * 64) >> SEGSHIFT)]; \
        u32x4 o; \
        o.x = pk2(bf_lo(ar[ki_].x) * sc, bf_hi(ar[ki_].x) * sc); o.y = pk2(bf_lo(ar[ki_].y) * sc, bf_hi(ar[ki_].y) * sc); \
        o.z = pk2(bf_lo(ar[ki_].z) * sc, bf_hi(ar[ki_].z) * sc); o.w = pk2(bf_lo(ar[ki_].w) * sc, bf_hi(ar[ki_].w) * sc); \
        *(LAS u32x4*)(lds + L4_ASTG + ((ki_) & 1) * 9216 + (srow * TP + 8 * soct) * 2) = o; } while (0)
    P4_STAGE_WRITE(0);
#pragma unroll
    for (int ki = 0; ki < 16; ++ki) {
        const int kc = (ki + rot) & 15;
        LAS unsigned char* stg = lds + L4_ASTG + (ki & 1) * 9216;
        __syncthreads();
        if (ki + 1 < 16) P4_STAGE_WRITE(ki + 1);
        const int kn = (kc + 1) & 15;
        const char* wk = wb + kn * 4096;
        bf16x8 a0 = *(const LAS bf16x8*)(stg + (r * TP + 8 * h) * 2), a1 = *(const LAS bf16x8*)(stg + ((32 + r) * TP + 8 * h) * 2);
#pragma unroll
        for (int s = 0; s < 4; ++s) {
            bf16x8 n0 = a0, n1 = a1;
            if (s < 3) { n0 = *(const LAS bf16x8*)(stg + (r * TP + 16 * (s + 1) + 8 * h) * 2); n1 = *(const LAS bf16x8*)(stg + ((32 + r) * TP + 16 * (s + 1) + 8 * h) * 2); }
            accT[0][0] = MFMA32(wc[s][0], a0, accT[0][0]); accT[0][1] = MFMA32(wc[s][1], a0, accT[0][1]);
            accT[1][0] = MFMA32(wc[s][0], a1, accT[1][0]); accT[1][1] = MFMA32(wc[s][1], a1, accT[1][1]);
            wc[s][0] = *(const bf16x8*)(wk + s * 1024 + woff); wc[s][1] = *(const bf16x8*)(wk + 65536 + s * 1024 + woff);
            __builtin_amdgcn_sched_barrier(0);
            a0 = n0; a1 = n1;
        }
    }
#undef P4_STAGE_WRITE
    p4_panel_load(ar, Anext, tid);
    __builtin_amdgcn_sched_barrier(0);
    __syncthreads();
}


__device__ __forceinline__ void tail_gemmT(f32x16 (&accT)[2], const bf16* Abase  , const bf16* WF  , int nt  , LAS unsigned char* lds, int tid, int lane) {
    const int srow = tid >> 3, soct = tid & 7, r = lane & 31, h = lane >> 5;
    const char* ab = (const char*)Abase; const unsigned aoff = (unsigned)((srow * 1024 + 8 * soct) * 2);
    const char* wb = (const char*)WF + (size_t)nt * 65536; const unsigned woff = (unsigned)(lane * 16);
    const int rot = ((int)blockIdx.x >> 3) & 15;
    u32x4 ar[16];
#pragma unroll
    for (int i = 0; i < 16; ++i) ar[i] = *(const u32x4*)(ab + ((rot + i) & 15) * 128 + aoff);
    bf16x8 wc[4];
    { const char* wk0 = wb + rot * 4096;
#pragma unroll
      for (int s = 0; s < 4; ++s) wc[s] = *(const bf16x8*)(wk0 + s * 1024 + woff); }
#pragma unroll
    for (int ki = 0; ki < 16; ++ki) {
        const int kc = (ki + rot) & 15;
        LAS unsigned char* stg = lds + L4_ASTG + (ki & 1) * 9216;
        *(LAS u32x4*)(stg + (srow * TP + 8 * soct) * 2) = ar[ki];
        __syncthreads();
        const char* wk = wb + ((kc + 1) & 15) * 4096;
#pragma unroll
        for (int s = 0; s < 4; ++s) {
            const bf16x8 a0 = *(const LAS bf16x8*)(stg + (r * TP + 16 * s + 8 * h) * 2), a1 = *(const LAS bf16x8*)(stg + ((32 + r) * TP + 16 * s + 8 * h) * 2);
            accT[0] = MFMA32(wc[s], a0, accT[0]); accT[1] = MFMA32(wc[s], a1, accT[1]);
            wc[s] = *(const bf16x8*)(wk + s * 1024 + woff);
            __builtin_amdgcn_sched_barrier(0);
        }
    }
    __syncthreads();
}

__device__ __forceinline__ void p4_phase(const Args& a, LAS unsigned char* lds, int tid_in, int lane_in, int wave, int G) {
    const bf16* PROJ = (const bf16*)(a.ws + WS_PROJ);
    const float* SSQM = (const float*)(a.ws + WS_SSQM); const float* SSQR = (const float*)(a.ws + WS_SSQR);
    const float* MOD = (const float*)(a.ws + WS_MOD);
    const bf16* WMF = (const bf16*)(a.ws + WS_WMF); const bf16* WRF = (const bf16*)(a.ws + WS_WRF); const bf16* WOF = (const bf16*)(a.ws + WS_WOF);
    const float* x = a.in[0]; const float* fw = a.in[15]; float* out = a.out;
    LAS float* RM = (LAS float*)(lds + L4_RM); LAS float* RR = (LAS float*)(lds + L4_RR); LAS float* RED = (LAS float*)(lds + L4_RED); LAS float* RS = (LAS float*)(lds + L4_RS);
    for (int blk = blockIdx.x; blk < 256; blk += G) {
        const size_t m0 = (size_t)blk * 64; const int b = blk >> 5;
        int lane = fresh_lane(), tid = wave * 64 + lane, r = lane & 31, h = lane >> 5;
        u32x4 ar[16];
        p4_panel_load(ar, PROJ + m0 * NP + C_Z, tid);
        __syncthreads();
        { const int row = tid >> 3, sub = tid & 7;
          const f32x4 qv = *(const f32x4*)(SSQR + (m0 + row) * 32 + 4 * sub);
          RR[row * 8 + sub] = 1.0f / sqrtf(((qv.x + qv.y) + (qv.z + qv.w)) * (1.f / 128.f) + EPS);
          if (sub < 2) { float s = 0.f;
#pragma unroll
              for (int i = 0; i < 4; ++i) { const f32x4 v = *(const f32x4*)(SSQM + (m0 + row) * 32 + 16 * sub + 4 * i); s += (v.x + v.y) + (v.z + v.w); }
              RM[row * 2 + sub] = 1.0f / sqrtf(s * (1.f / 512.f) + EPS); } }
        __syncthreads();
#ifndef P4_SKIP1
#ifndef P4_REP1
#define P4_REP1 1
#endif
        for (int nh_ = 0; nh_ < 2 * P4_REP1; ++nh_) {
            const int nh = nh_ & 1;
            lane = fresh_lane(); tid = wave * 64 + lane; r = lane & 31; h = lane >> 5;
            const int nt0 = 16 * nh + 2 * wave;
            const bf16* pblk = PROJ + m0 * NP;
            f32x16 accT[2][2];
#pragma unroll
            for (int i = 0; i < 2; ++i)
#pragma unroll
                for (int j = 0; j < 2; ++j)
#pragma unroll
                    for (int e = 0; e < 16; ++e) accT[i][j][e] = 0.f;
            u32x2 gpre[2][2][4];
            { const unsigned lo0 = (unsigned)((r * NP + 4 * h) * 2); const char* gb0 = (const char*)(pblk + C_GAM + 32 * nt0);
#pragma unroll
              for (int rt = 0; rt < 2; ++rt)
#pragma unroll
                  for (int ct = 0; ct < 2; ++ct)
#pragma unroll
                      for (int g4 = 0; g4 < 4; ++g4) gpre[rt][ct][g4] = *(const u32x2*)(gb0 + (lo0 + (unsigned)((32 * rt * NP + 32 * ct + 8 * g4) * 2)));
              __builtin_amdgcn_sched_barrier(0); }
            p4_gemmT<9>(accT, ar, pblk + C_GR, RM, 2, WMF, nt0, lds, tid, lane);
            {
                lane = fresh_lane(); r = lane & 31; h = lane >> 5;
                const unsigned lm = launder((unsigned)(L4_MERGED + (r * MP + 4 * h) * 2));
#pragma unroll
                for (int rt = 0; rt < 2; ++rt)
#pragma unroll
                    for (int ct = 0; ct < 2; ++ct)
#pragma unroll
                        for (int g4 = 0; g4 < 4; ++g4) {
                            const u32x2 gg = gpre[rt][ct][g4];
                            u32x2 ov; ov.x = pk2(accT[rt][ct][4 * g4] * sigm_f(bf_lo(gg.x)), accT[rt][ct][4 * g4 + 1] * sigm_f(bf_hi(gg.x)));
                            ov.y = pk2(accT[rt][ct][4 * g4 + 2] * sigm_f(bf_lo(gg.y)), accT[rt][ct][4 * g4 + 3] * sigm_f(bf_hi(gg.y)));
                            *(LAS u32x2*)(lds + lm + (unsigned)((32 * rt * MP + 32 * (nt0 + ct) + 8 * g4) * 2)) = ov; }
            }
#pragma unroll
            for (int i = 0; i < 2; ++i)
#pragma unroll
                for (int j = 0; j < 2; ++j)
#pragma unroll
                    for (int e = 0; e < 16; ++e) accT[i][j][e] = 0.f;
            lane = fresh_lane(); tid = wave * 64 + lane; r = lane & 31; h = lane >> 5;
            { const unsigned lo0 = (unsigned)((r * NP + 4 * h) * 2); const char* gb0 = (const char*)(pblk + C_GAR + 32 * nt0);
#pragma unroll
              for (int rt = 0; rt < 2; ++rt)
#pragma unroll
                  for (int ct = 0; ct < 2; ++ct)
#pragma unroll
                      for (int g4 = 0; g4 < 4; ++g4) gpre[rt][ct][g4] = *(const u32x2*)(gb0 + (lo0 + (unsigned)((32 * rt * NP + 32 * ct + 8 * g4) * 2)));
              __builtin_amdgcn_sched_barrier(0); }
            p4_gemmT<7>(accT, ar, pblk + C_Z, RR, 8, WRF, nt0, lds, tid, lane);
            {
                lane = fresh_lane(); r = lane & 31; h = lane >> 5;
                const unsigned lm = launder((unsigned)(L4_MERGED + (r * MP + 4 * h) * 2));
#pragma unroll
                for (int rt = 0; rt < 2; ++rt)
#pragma unroll
                    for (int ct = 0; ct < 2; ++ct)
#pragma unroll
                        for (int g4 = 0; g4 < 4; ++g4) {
                            const u32x2 gg = gpre[rt][ct][g4];
                            LAS u32x2* mp = (LAS u32x2*)(lds + lm + (unsigned)((32 * rt * MP + 32 * (nt0 + ct) + 8 * g4) * 2));
                            const u32x2 pm = *mp;
                            const float v0 = bf_lo(pm.x) + accT[rt][ct][4 * g4] * sigm_f(bf_lo(gg.x)), v1 = bf_hi(pm.x) + accT[rt][ct][4 * g4 + 1] * sigm_f(bf_hi(gg.x));
                            const float v2 = bf_lo(pm.y) + accT[rt][ct][4 * g4 + 2] * sigm_f(bf_lo(gg.y)), v3 = bf_hi(pm.y) + accT[rt][ct][4 * g4 + 3] * sigm_f(bf_hi(gg.y));
                            u32x2 ov; ov.x = pk2(v0, v1); ov.y = pk2(v2, v3);
                            *mp = ov; }
            }
        }
#endif
        __syncthreads();
        lane = fresh_lane(); tid = wave * 64 + lane; r = lane & 31; h = lane >> 5;
#ifndef P4_SKIP2
#ifndef P4_REP2
#define P4_REP2 1
#endif
        _Pragma("nounroll") for (int rep2_ = 0; rep2_ < P4_REP2; ++rep2_) {
            if (rep2_) { __syncthreads(); lane = fresh_lane(); tid = wave * 64 + lane; r = lane & 31; h = lane >> 5; }
            f32x16 acc[2][4];
#pragma unroll
            for (int i = 0; i < 2; ++i)
#pragma unroll
                for (int j = 0; j < 4; ++j)
#pragma unroll
                    for (int e = 0; e < 16; ++e) acc[i][j][e] = 0.f;
            const char* wb = (const char*)WOF + (size_t)(4 * wave) * 65536; const unsigned woff = (unsigned)(lane * 16);
            const int rot2 = ((int)blockIdx.x >> 3) & 31;
            bf16x8 wc[2][4];
#pragma unroll
            for (int s = 0; s < 2; ++s)
#pragma unroll
                for (int ct = 0; ct < 4; ++ct) wc[s][ct] = *(const bf16x8*)(wb + ct * 65536 + (2 * rot2 + s) * 1024 + woff);
            const LAS unsigned char* ma = lds + L4_MERGED + (r * MP + 8 * h) * 2;
            bf16x8 a0 = *(const LAS bf16x8*)(ma + (2 * rot2) * 32), a1 = *(const LAS bf16x8*)(ma + 32 * MP * 2 + (2 * rot2) * 32);
            for (int ki = 0; ki < 32; ++ki) {
                const int kp = (ki + rot2) & 31, kpn = (kp + 1) & 31;
#pragma unroll
                for (int s = 0; s < 2; ++s) {
                    const int ksn = (s == 0) ? 2 * kp + 1 : 2 * kpn;
                    const bf16x8 n0 = *(const LAS bf16x8*)(ma + ksn * 32), n1 = *(const LAS bf16x8*)(ma + 32 * MP * 2 + ksn * 32);
#pragma unroll
                    for (int ct = 0; ct < 4; ++ct) { acc[0][ct] = MFMA32(a0, wc[s][ct], acc[0][ct]); acc[1][ct] = MFMA32(a1, wc[s][ct], acc[1][ct]); }
#pragma unroll
                    for (int ct = 0; ct < 4; ++ct) wc[s][ct] = *(const bf16x8*)(wb + ct * 65536 + (2 * kpn + s) * 1024 + woff);
                    __builtin_amdgcn_sched_barrier(0);
                    a0 = n0; a1 = n1;
                }
            }
            lane = fresh_lane(); r = lane & 31; h = lane >> 5;
            const char* xblk = (const char*)(x + m0 * D); char* oblk = (char*)(out + m0 * D);
            const unsigned eo = launder((unsigned)(4 * (4 * h * D + 128 * wave + r)));
            const unsigned rb = launder((unsigned)(L4_RED + (4 * h * 8 + wave) * 4));
            float gate[4], fwv[4];
#pragma unroll
            for (int ct = 0; ct < 4; ++ct) { const int n = 32 * (4 * wave + ct) + r; gate[ct] = MOD[b * 3072 + 2048 + n]; fwv[ct] = fw[n]; }
            float xv[2][8][4];
#define P4_XLOAD(buf, bidx) do { _Pragma("unroll") for (int e = 0; e < 8; ++e) _Pragma("unroll") for (int ct = 0; ct < 4; ++ct) \
                xv[buf][e][ct] = __builtin_nontemporal_load((const float*)(xblk + (eo + (unsigned)(((32 * ((bidx) >> 1) + (e & 3) + 8 * (2 * ((bidx) & 1) + (e >> 2))) * D + 32 * ct) * 4)))); } while (0)
            P4_XLOAD(0, 0);
#pragma unroll
            for (int bi = 0; bi < 4; ++bi) {
                const int rt = bi >> 1, g8 = bi & 1;
                if (bi + 1 < 4) P4_XLOAD((bi + 1) & 1, bi + 1);
                __builtin_amdgcn_sched_barrier(0);
#pragma unroll
                for (int e = 0; e < 8; ++e) {
                    const int reg = 8 * g8 + e, rowc = 32 * rt + (reg & 3) + 8 * (reg >> 2);
                    float s = 0.f;
#pragma unroll
                    for (int ct = 0; ct < 4; ++ct) { const float v = xv[bi & 1][e][ct] + gate[ct] * acc[rt][ct][reg]; acc[rt][ct][reg] = v; s += v * v; }
                    s += __shfl_xor(s, 16); s += __shfl_xor(s, 8); s += __shfl_xor(s, 4); s += __shfl_xor(s, 2); s += __shfl_xor(s, 1);
                    *(LAS float*)(lds + rb + (unsigned)(rowc * 32)) = s;
                }
                asm volatile("" ::: "memory"); __builtin_amdgcn_sched_barrier(0);
            }
#undef P4_XLOAD
            __syncthreads();
            if (tid < 64) { float s = 0.f;
#pragma unroll
                for (int w = 0; w < 8; ++w) s += RED[tid * 8 + w];
                RS[tid] = 1.0f / sqrtf(s * (1.f / D) + EPS); }
            __syncthreads();
            const unsigned eo2 = launder(eo);
            const unsigned sb = launder((unsigned)(L4_RS + 4 * h * 4));
#pragma unroll
            for (int rt = 0; rt < 2; ++rt)
#pragma unroll
                for (int reg = 0; reg < 16; ++reg) {
                    const int rowc = 32 * rt + (reg & 3) + 8 * (reg >> 2); const float rs = *(const LAS float*)(lds + sb + (unsigned)(rowc * 4));
#pragma unroll
                    for (int ct = 0; ct < 4; ++ct) __builtin_nontemporal_store(acc[rt][ct][reg] * rs * fwv[ct], (float*)(oblk + (eo2 + (unsigned)((rowc * D + 32 * ct) * 4))));
                }
        }
#endif
    }
}

#define XB_TMO      128
#define XB_XCNT(j)  (256  + 64 * (j))
#define XB_XSUB(j)  (1280 + 64 * (j))
#define XB_XGEN(j)  (2304 + 64 * (j))
#define XB_TOP      3328
#define XB_TOPGEN   3392
#define XCD_BAR_WORDS 3456
#define XB_SPIN_CAP (1u << 18)

__device__ __forceinline__ unsigned xb_ld(unsigned* p)              { return __hip_atomic_load(p, __ATOMIC_RELAXED, __HIP_MEMORY_SCOPE_AGENT); }
__device__ __forceinline__ unsigned xb_add(unsigned* p, unsigned v) { return __hip_atomic_fetch_add(p, v, __ATOMIC_RELAXED, __HIP_MEMORY_SCOPE_AGENT); }
__device__ __forceinline__ unsigned xb_xcc_id() { return (unsigned)__builtin_amdgcn_s_getreg((3 << 11) | 20) & 0xFu; }
#define XB_SPIN(cond, bar) do { unsigned _sp = 0; while (cond) { __builtin_amdgcn_s_sleep(1); \
    if ((++_sp & 255u) == 0u) { if (xb_ld(&(bar)[XB_TMO])) break; if (_sp > XB_SPIN_CAP) { atomicAdd(&(bar)[XB_TMO], 1u); break; } } } } while (0)

struct XcdBarrier {
    unsigned* bar; unsigned x;
    volatile LAS unsigned* st;
};

__device__ __forceinline__ XcdBarrier xcd_barrier_post(unsigned* bar, volatile LAS unsigned* st, const int wave_) {
    XcdBarrier b; b.bar = bar; b.x = xb_xcc_id(); b.st = st;
    if (wave_ == 0 && fresh_lane() == 0) (void)xb_add(&bar[XB_XCNT(b.x)], 1u);
    return b;
}
__device__ __forceinline__ void xcd_barrier_complete(unsigned* bar, unsigned x, unsigned& nloc, unsigned& nx) {
    const unsigned G = gridDim.x * gridDim.y * gridDim.z;
    unsigned sum, cnt, mine, sp = 0u;
    for (;;) {
        sum = 0u; cnt = 0u; mine = 0u;
#pragma unroll
        for (unsigned j = 0; j < 16; ++j) { const unsigned c = xb_ld(&bar[XB_XCNT(j)]); sum += c; cnt += (c > 0u) ? 1u : 0u; mine = (j == x) ? c : mine; }
        if (sum == G) break;
        __builtin_amdgcn_s_sleep(1);
        if ((++sp & 255u) == 0u) { if (xb_ld(&bar[XB_TMO])) break; if (sp > XB_SPIN_CAP) { atomicAdd(&bar[XB_TMO], 1u); break; } }
    }
    nloc = mine > 0u ? mine : 1u; nx = cnt > 0u ? cnt : 1u;
}

__device__ __forceinline__ void xcd_barrier(const XcdBarrier& b, const int wave_) {
    asm volatile("s_waitcnt vmcnt(0)" ::: "memory");
    __syncthreads();
    if (wave_ == 0 && fresh_lane() == 0) {
        unsigned* bar = b.bar;
        __builtin_amdgcn_s_waitcnt(0);
        unsigned nloc = b.st[0], nx = b.st[1];
        if (nloc == 0u) { xcd_barrier_complete(bar, b.x, nloc, nx); b.st[0] = nloc; b.st[1] = nx; }
        const unsigned old = xb_add(&bar[XB_XSUB(b.x)], 1u);
        const unsigned gen = old / nloc;
        if (old + 1u == (gen + 1u) * nloc) {
            __builtin_amdgcn_fence(__ATOMIC_RELEASE, "agent");
            asm volatile("s_waitcnt vmcnt(0)" ::: "memory");
            const unsigned og = xb_add(&bar[XB_TOP], 1u);
            const unsigned tg = og / nx;
            if (og + 1u == (tg + 1u) * nx) xb_add(&bar[XB_TOPGEN], 1u);
            else XB_SPIN(xb_ld(&bar[XB_TOPGEN]) == tg, bar);
            __builtin_amdgcn_fence(__ATOMIC_ACQUIRE, "agent");
            xb_add(&bar[XB_XGEN(b.x)], 1u);
            asm volatile("s_waitcnt vmcnt(0)" ::: "memory");
        } else {
            XB_SPIN(xb_ld(&bar[XB_XGEN(b.x)]) == gen, bar);
            __builtin_amdgcn_fence(__ATOMIC_ACQUIRE, "agent");
            asm volatile("s_waitcnt vmcnt(0)" ::: "memory");
        }
    }
    __syncthreads();
}

#ifdef SELF_CLEAN_BARRIER
__device__ unsigned g_bar[4096];
#endif
__global__ void __launch_bounds__(NTHR, 2) hybrid_fwd(Args args) {
    extern __shared__ __attribute__((aligned(16))) unsigned char lds_raw[];
    LAS unsigned char* lds = (LAS unsigned char*)lds_raw;
    const int wave = __builtin_amdgcn_readfirstlane((int)threadIdx.x >> 6), G = gridDim.x; const int tid = 0, lane = 0;
    cg::grid_group grid = cg::this_grid();
    volatile LAS unsigned* misc = (volatile LAS unsigned*)(lds + LDS_MISC);
    if (threadIdx.x < 2) misc[threadIdx.x] = 0u;
    __syncthreads();
    if (args.ph_lo < 0) grid.sync();
    #ifdef SELF_CLEAN_BARRIER
    XcdBarrier xbar = xcd_barrier_post(g_bar, misc, wave);
#else
    XcdBarrier xbar = xcd_barrier_post((unsigned*)(args.ws + WS_CTL), misc, wave);
#endif
    const int lo = args.ph_lo, hi = args.ph_hi;
#ifndef PHMASK
#define PHMASK 31
#endif
#define IN(k) (((PHMASK >> (k)) & 1) && lo <= (k) && (k) < hi)
#define SEAM(k) do { if (IN(k) && IN((k) + 1)) xcd_barrier(xbar, wave); } while (0)
#ifndef REPEAT_MASK
#define REPEAT_MASK 0
#endif
#ifdef PROBE_PH
    unsigned long long pt0_ = 0ull; unsigned pacc_ = 0u;
#define PB(k) do { if (PROBE_PH == (k)) pt0_ = __builtin_amdgcn_s_memrealtime(); } while (0)
#define PE(k) do { if (PROBE_PH == (k)) pacc_ += (unsigned)(__builtin_amdgcn_s_memrealtime() - pt0_); } while (0)
#else
#define PB(k) do {} while (0)
#define PE(k) do {} while (0)
#endif
    PB(20);
#define REP(k) _Pragma("nounroll") for (int rep_ = 0; rep_ < 1 + ((REPEAT_MASK >> (k)) & 1); ++rep_)
#ifdef EXTRA_SYNCS
    for (int es_ = 0; es_ < EXTRA_SYNCS; ++es_) xcd_barrier(xbar, wave);
#endif
    PB(0);
    if (IN(0)) REP(0) { if (rep_) xcd_barrier(xbar, wave); p0_phase(args, lds, tid, lane, wave, G); }
    PE(0); PB(10); __syncthreads();   PE(10); PB(1);
    if (IN(1)) REP(1) { if (rep_) xcd_barrier(xbar, wave); p1_phase(args, lds, tid, lane, wave, G); }
    PE(1); PB(11); SEAM(1); PE(11); PB(2);
    if (IN(2)) REP(2) {
        if (rep_) xcd_barrier(xbar, wave);
        __syncthreads();
        pg8::Gemm g{(const pg8::bf16_t*)((const unsigned char*)args.out + OUT_H), (const pg8::bf16_t*)((const unsigned char*)args.out + OUT_WINT), MTOK, NP_MAIN, D};
        pg8::StaticOrder S; S.init(MTOK, NP_MAIN, G, (int)blockIdx.x);
        pg8::EpiProj E{(pg8::bf16_t*)(args.ws + WS_PROJ), NP};
        pg8::gemm_phase<pg8::EpiProj, pg8::StaticOrder, true, true>(lds, g, S, E, wave);
        for (int blk = blockIdx.x; blk < 256; blk += G) {
            const int lane_ = fresh_lane(), tid_ = wave * 64 + lane_;
            f32x16 accT[2];
#pragma unroll
            for (int i = 0; i < 2; ++i)
#pragma unroll
                for (int e = 0; e < 16; ++e) accT[i][e] = 0.f;
            tail_gemmT(accT, (const bf16*)((const unsigned char*)args.out + OUT_H) + (size_t)blk * 64 * 1024, (const bf16*)(args.ws + WS_WTF), wave, lds, tid_, lane_);
            const int l2 = fresh_lane(), r2 = l2 & 31, h2 = l2 >> 5;
            bf16* prow = (bf16*)(args.ws + WS_PROJ) + ((size_t)blk * 64 + r2) * NP + NP_MAIN + 32 * wave + 4 * h2;
#pragma unroll
            for (int rt = 0; rt < 2; ++rt)
#pragma unroll
                for (int g4 = 0; g4 < 4; ++g4) { u32x2 ov; ov.x = pk2(accT[rt][4 * g4], accT[rt][4 * g4 + 1]); ov.y = pk2(accT[rt][4 * g4 + 2], accT[rt][4 * g4 + 3]);
                    *(u32x2*)(prow + (size_t)rt * 32 * NP + 8 * g4) = ov; }
        }
    }
    PE(2); PB(12); SEAM(2); PE(12); PB(3);
    if (IN(3)) { p3a_phase(args, wave, G); PE(3); PB(13); xcd_barrier(xbar, wave); PE(13); PB(4); if ((REPEAT_MASK >> 3) & 1) { p3_phase(args, lds, tid, lane, wave, G, true); xcd_barrier(xbar, wave); } p3_phase(args, lds, tid, lane, wave, G); }
    PE(4); PB(14); SEAM(3); PE(14); PB(5);
    if (IN(4)) REP(4) { if (rep_) xcd_barrier(xbar, wave); p4_phase(args, lds, tid, lane, wave, G); }
#undef REP
    PE(5); PE(20);
#if defined(SELF_CLEAN_BARRIER) && !defined(PROBE_PH)
    {
        __syncthreads();
        if (wave == 0) {
            const int l_ = fresh_lane();
            unsigned last_ = 0u;
            if (l_ == 0) last_ = (__hip_atomic_fetch_add(&g_bar[4032], 1u, __ATOMIC_RELAXED, __HIP_MEMORY_SCOPE_AGENT) == (unsigned)G - 1u) ? 1u : 0u;
            last_ = (unsigned)__builtin_amdgcn_readfirstlane((int)last_);
            if (last_) {
                if (l_ < 16) { __hip_atomic_store(&g_bar[XB_XCNT(l_)], 0u, __ATOMIC_RELAXED, __HIP_MEMORY_SCOPE_AGENT); __hip_atomic_store(&g_bar[XB_XSUB(l_)], 0u, __ATOMIC_RELAXED, __HIP_MEMORY_SCOPE_AGENT); __hip_atomic_store(&g_bar[XB_XGEN(l_)], 0u, __ATOMIC_RELAXED, __HIP_MEMORY_SCOPE_AGENT); }
                if (l_ == 16) { __hip_atomic_store(&g_bar[XB_TOP], 0u, __ATOMIC_RELAXED, __HIP_MEMORY_SCOPE_AGENT); __hip_atomic_store(&g_bar[XB_TOPGEN], 0u, __ATOMIC_RELAXED, __HIP_MEMORY_SCOPE_AGENT);
                                __hip_atomic_store(&g_bar[XB_TMO], 0u, __ATOMIC_RELAXED, __HIP_MEMORY_SCOPE_AGENT); __hip_atomic_store(&g_bar[4032], 0u, __ATOMIC_RELAXED, __HIP_MEMORY_SCOPE_AGENT); }
            }
        }
    }
#endif
#ifdef PROBE_PH
    if (blockIdx.x == PROBE_PBLK && wave == 0 && fresh_lane() == 0) ((unsigned*)(args.ws + WS_CTL))[4001] = pacc_;
    if (blockIdx.x == 0) { xcd_barrier(xbar, wave); } else { xcd_barrier(xbar, wave); }
    if (blockIdx.x == 0 && wave == 0 && fresh_lane() == 0) { asm volatile("s_waitcnt vmcnt(0)" ::: "memory"); args.out[0] = 50.0f * floorf(0.01f * (float)__hip_atomic_load((unsigned*)(args.ws + WS_CTL) + 4001, __ATOMIC_RELAXED, __HIP_MEMORY_SCOPE_AGENT) / 50.0f + 0.5f); }
#endif
#ifdef PROBE_SEL
    if (blockIdx.x == 0 && wave == 0 && fresh_lane() == 0) { asm volatile("s_waitcnt vmcnt(0)" ::: "memory"); args.out[0] = 0.01f * (float)((volatile unsigned*)(args.ws + WS_CTL))[4000]; }
#endif
#undef IN
#undef SEAM
}

extern "C" void kernel_launch(void* const* d_in, const int* in_sizes, int n_in, void* d_out, int out_size, void* d_ws, size_t ws_size, hipStream_t stream) {
    static int grid = 0;
    if (grid == 0) {
        if (n_in != 16 || out_size != MTOK * D || ws_size < WS_END) { fprintf(stderr, "kernel_launch: unexpected shapes (n_in %d out %d ws %zu)\n", n_in, out_size, ws_size); grid = -1; return; }
        int dev = 0, cus = 0, per_cu = 0;
        (void)hipGetDevice(&dev);
        (void)hipDeviceGetAttribute(&cus, hipDeviceAttributeMultiprocessorCount, dev);
        if (hipFuncSetAttribute((const void*)hybrid_fwd, hipFuncAttributeMaxDynamicSharedMemorySize, LDS_BYTES) != hipSuccess) { fprintf(stderr, "kernel_launch: hipFuncSetAttribute failed\n"); grid = -1; return; }
        if (hipOccupancyMaxActiveBlocksPerMultiprocessor(&per_cu, (const void*)hybrid_fwd, NTHR, LDS_BYTES) != hipSuccess || per_cu < 1) { fprintf(stderr, "kernel_launch: occupancy query says %d\n", per_cu); per_cu = 1; }
        (void)hipGetLastError();
        grid = cus * per_cu;
        if (grid > 256) grid = 256;
        if (grid < 1) grid = 1;
    }
    if (grid < 0) return;
#ifndef SELF_CLEAN_BARRIER
    if (hipMemsetAsync((char*)d_ws + WS_CTL, 0, CTL_BYTES, stream) != hipSuccess) { fprintf(stderr, "kernel_launch: memset of the barrier words failed\n"); return; }
#endif
    Args a{};
    for (int i = 0; i < 16; ++i) a.in[i] = (const float*)d_in[i];
    a.out = (float*)d_out; a.ws = (unsigned char*)d_ws;
#if N_LAUNCHES == 1
    a.ph_lo = 0; a.ph_hi = NPH;
    void* kargs[] = {&a};
    hipError_t e = hipLaunchCooperativeKernel((const void*)hybrid_fwd, dim3(grid), dim3(NTHR), kargs, LDS_BYTES, stream);
    if (e != hipSuccess) fprintf(stderr, "kernel_launch: cooperative launch failed: %s (grid %d)\n", hipGetErrorString(e), grid);
#else
    for (int p = 0; p < NPH; ++p) {
        a.ph_lo = p; a.ph_hi = p + 1;
        hipLaunchKernelGGL(hybrid_fwd, dim3(grid), dim3(NTHR), LDS_BYTES, stream, a);
    }
#endif
}
```
